# Optimizing an MI355X kernel written in HIP

```python
import jax, jax.numpy as jnp
from jax import lax
import numpy as np

D_MODEL = 1024
BATCH = 8
SEQ = 4096
DEPTH = 2

HEAD_DIM = 64
MIX_WIDTH = D_MODEL
FOX_HEADS = MIX_WIDTH // (4 * HEAD_DIM)
MOBA_HEADS = MIX_WIDTH // (4 * HEAD_DIM)
RWKV_HEADS = MIX_WIDTH // (2 * HEAD_DIM)
FOX_WIDTH = FOX_HEADS * HEAD_DIM
MOBA_WIDTH = MOBA_HEADS * HEAD_DIM
RWKV_WIDTH = RWKV_HEADS * HEAD_DIM
RWKV_DECAY_LORA = 64
RWKV_ICLR_LORA = 64
RWKV_GATE_LORA = 160
RWKV_GN_EPS = 64e-5
FOX_IN = 3 * FOX_WIDTH + FOX_HEADS
MOBA_IN = 3 * MOBA_WIDTH
RWKV_IN = 3 * RWKV_WIDTH + RWKV_DECAY_LORA + RWKV_ICLR_LORA + RWKV_GATE_LORA
IN_WIDTH = FOX_IN + MOBA_IN + RWKV_IN
FOX_QBLOCK = 128
MOBA_BLOCK = 256
MOBA_TOPK = 3
MOBA_QCHUNK = 32
ROPE_THETA = 500000.0
ROPE_DIM = HEAD_DIM // 4
FFN_DIM = 2816
MEM_LEN = 256
XATTN_HEADS = 4
XATTN_HEAD_DIM = 128
XATTN_WIDTH = XATTN_HEADS * XATTN_HEAD_DIM
NORM_EPS = 1e-6

kernel_name = 'hybrid_fox_rwkv7_moba_macaron'


def rms_norm(t, g):
    tf = t.astype(jnp.float32)
    y = tf * lax.rsqrt(jnp.mean(tf * tf, axis=-1, keepdims=True) + NORM_EPS)
    return (y * g).astype(t.dtype)


def swiglu(h, w_in, w_out):
    gate, up = jnp.split(h @ w_in, 2, axis=-1)
    return (jax.nn.silu(gate) * up) @ w_out


def split_heads(t, n_heads):
    B, S, _ = t.shape
    return t.reshape(B, S, n_heads, HEAD_DIM).transpose(0, 2, 1, 3)


def merge_heads(t):
    B, H, S, d = t.shape
    return t.transpose(0, 2, 1, 3).reshape(B, S, H * d)


def rope_tables(positions):
    inv_freq = ROPE_THETA ** (-jnp.arange(0, ROPE_DIM, 2, dtype=jnp.float32) / ROPE_DIM)
    ang = positions.astype(jnp.float32)[..., None] * inv_freq
    return jnp.cos(ang), jnp.sin(ang)


def apply_partial_rope(t, cos, sin):
    half = ROPE_DIM // 2
    x1, x2, rest = t[..., :half], t[..., half:ROPE_DIM], t[..., ROPE_DIM:]
    c, s = cos[:, None], sin[:, None]
    out = jnp.concatenate([x1 * c - x2 * s, x2 * c + x1 * s, rest.astype(jnp.float32)], axis=-1)
    return out.astype(t.dtype)


def forgetting_attention(q, k, v, log_f):
    B, H, S, d = q.shape
    c = jnp.cumsum(log_f, axis=-1)
    n_qb = S // FOX_QBLOCK
    q_blocks = q.reshape(B, H, n_qb, FOX_QBLOCK, d).transpose(2, 0, 1, 3, 4)
    c_blocks = c.reshape(B, H, n_qb, FOX_QBLOCK).transpose(2, 0, 1, 3)
    k_pos = jnp.arange(S)
    scale = d ** -0.5

    def block(args):
        i, q_i, c_i = args
        s = jnp.einsum('bhqd,bhkd->bhqk', q_i, k).astype(jnp.float32) * scale
        s = s + c_i[..., None] - c[:, :, None, :]
        q_pos = i * FOX_QBLOCK + jnp.arange(FOX_QBLOCK)
        s = jnp.where(k_pos[None, :] <= q_pos[:, None], s, -jnp.inf)
        p = jax.nn.softmax(s, axis=-1).astype(v.dtype)
        return jnp.einsum('bhqk,bhkd->bhqd', p, v)

    out = lax.map(block, (jnp.arange(n_qb), q_blocks, c_blocks))
    return out.transpose(1, 2, 0, 3, 4).reshape(B, H, S, d)


def fox_mixer(z, f_bias, q_gain, k_gain):
    q, k, v, f = jnp.split(z, [FOX_WIDTH, 2 * FOX_WIDTH, 3 * FOX_WIDTH], axis=-1)
    q = rms_norm(split_heads(q, FOX_HEADS), q_gain)
    k = rms_norm(split_heads(k, FOX_HEADS), k_gain)
    v = split_heads(v, FOX_HEADS)
    log_f = jax.nn.log_sigmoid(f.astype(jnp.float32) + f_bias).transpose(0, 2, 1)
    return merge_heads(forgetting_attention(q, k, v, log_f))


def moba_attention(q, k, v):
    B, H, S, d = q.shape
    s_pad = -(-S // MOBA_BLOCK) * MOBA_BLOCK
    pad = ((0, 0), (0, 0), (0, s_pad - S), (0, 0))
    k_pad = jnp.pad(k, pad)
    v_pad = jnp.pad(v, pad)
    n_blk = s_pad // MOBA_BLOCK
    top_k = min(MOBA_TOPK, n_blk)
    k_blk = k_pad.reshape(B, H, n_blk, MOBA_BLOCK, d)
    v_blk = v_pad.reshape(B, H, n_blk, MOBA_BLOCK, d)
    k_mean = jnp.mean(k_blk.astype(jnp.float32), axis=3)
    n_chunk = S // MOBA_QCHUNK
    q_chunks = q.reshape(B, H, n_chunk, MOBA_QCHUNK, d).transpose(2, 0, 1, 3, 4)
    b_idx = jnp.arange(B)[:, None, None, None]
    h_idx = jnp.arange(H)[None, :, None, None]
    blk_ids = jnp.arange(n_blk)
    scale = d ** -0.5

    def chunk(args):
        i, q_i = args
        q_start = i * MOBA_QCHUNK
        q_blk = q_start // MOBA_BLOCK
        gate = jnp.einsum('bhqd,bhnd->bhqn', q_i.astype(jnp.float32), k_mean)
        gate = jnp.where(blk_ids < q_blk, gate, -jnp.inf)
        _, sel = lax.top_k(gate, top_k)
        valid = sel < q_blk
        k_sel = k_blk[b_idx, h_idx, sel]
        v_sel = v_blk[b_idx, h_idx, sel]
        s_sel = jnp.einsum('bhqd,bhqnkd->bhqnk', q_i, k_sel).astype(jnp.float32) * scale
        s_sel = jnp.where(valid[..., None], s_sel, -jnp.inf)
        s_sel = s_sel.reshape(B, H, MOBA_QCHUNK, top_k * MOBA_BLOCK)
        blk_start = q_blk * MOBA_BLOCK
        k_own = lax.dynamic_slice_in_dim(k_pad, blk_start, MOBA_BLOCK, axis=2)
        v_own = lax.dynamic_slice_in_dim(v_pad, blk_start, MOBA_BLOCK, axis=2)
        s_own = jnp.einsum('bhqd,bhkd->bhqk', q_i, k_own).astype(jnp.float32) * scale
        q_pos = q_start + jnp.arange(MOBA_QCHUNK)
        k_pos = blk_start + jnp.arange(MOBA_BLOCK)
        s_own = jnp.where(k_pos[None, :] <= q_pos[:, None], s_own, -jnp.inf)
        p = jax.nn.softmax(jnp.concatenate([s_sel, s_own], axis=-1), axis=-1).astype(v.dtype)
        p_sel = p[..., :top_k * MOBA_BLOCK].reshape(B, H, MOBA_QCHUNK, top_k, MOBA_BLOCK)
        p_own = p[..., top_k * MOBA_BLOCK:]
        return (jnp.einsum('bhqnk,bhqnkd->bhqd', p_sel, v_sel)
                + jnp.einsum('bhqk,bhkd->bhqd', p_own, v_own))

    out = lax.map(chunk, (jnp.arange(n_chunk), q_chunks))
    return out.transpose(1, 2, 0, 3, 4).reshape(B, H, S, d)


def moba_mixer(z, cos, sin, q_gain, k_gain):
    q, k, v = jnp.split(z, [MOBA_WIDTH, 2 * MOBA_WIDTH], axis=-1)
    q = apply_partial_rope(rms_norm(split_heads(q, MOBA_HEADS), q_gain), cos, sin)
    k = apply_partial_rope(rms_norm(split_heads(k, MOBA_HEADS), k_gain), cos, sin)
    v = split_heads(v, MOBA_HEADS)
    return merge_heads(moba_attention(q, k, v))


def rwkv7_mixer(z, mu, w0, w2, a0, a2, g2, k_k, k_a, r_k, ln_w, ln_b):
    B, S, _ = z.shape
    zf = z.astype(jnp.float32)
    z_prev = jnp.pad(zf, ((0, 0), (1, 0), (0, 0)))[:, :S]
    zf = zf + (z_prev - zf) * mu
    W = RWKV_WIDTH
    r, k, v, w_lo, a_lo, g_lo = jnp.split(
        zf, [W, 2 * W, 3 * W, 3 * W + RWKV_DECAY_LORA, 3 * W + RWKV_DECAY_LORA + RWKV_ICLR_LORA], axis=-1)
    w_raw = w0 + jnp.tanh(w_lo) @ w2
    decay = jnp.exp(-jnp.exp(-jax.nn.softplus(-w_raw) - 0.5))
    a = jax.nn.sigmoid(a0 + a_lo @ a2)
    g = jax.nn.sigmoid(g_lo) @ g2
    kk = k * k_k
    k = k * (1.0 + (a - 1.0) * k_a)

    def hd(t):
        return t.reshape(B, S, RWKV_HEADS, HEAD_DIM)

    r, k, v, decay, a, kk = hd(r), hd(k), hd(v), hd(decay), hd(a), hd(kk)
    kk = kk / jnp.maximum(jnp.sqrt(jnp.sum(kk * kk, axis=-1, keepdims=True)), 1e-12)

    def step(state, inp):
        r_t, w_t, k_t, v_t, kk_t, a_t = inp
        sa = jnp.einsum('bhij,bhj->bhi', state, -kk_t)
        state = (state * w_t[:, :, None, :] + sa[..., None] * (kk_t * a_t)[:, :, None, :]
                 + v_t[..., None] * k_t[:, :, None, :])
        return state, jnp.einsum('bhij,bhj->bhi', state, r_t)

    xs = tuple(t.transpose(1, 0, 2, 3) for t in (r, decay, k, v, kk, a))
    state0 = jnp.zeros((B, RWKV_HEADS, HEAD_DIM, HEAD_DIM), jnp.float32)
    _, ys = lax.scan(step, state0, xs)
    y = ys.transpose(1, 0, 2, 3)
    mean = jnp.mean(y, axis=-1, keepdims=True)
    var = jnp.mean(jnp.square(y - mean), axis=-1, keepdims=True)
    y = ((y - mean) * lax.rsqrt(var + RWKV_GN_EPS)).reshape(B, S, W) * ln_w + ln_b
    bonus = (jnp.sum(r * k * r_k, axis=-1, keepdims=True) * v).reshape(B, S, W)
    return ((y + bonus) * g).astype(z.dtype)


def memory_cross_attention(h, m, w_q, w_kv, q_gain, k_gain, w_o):
    B, S, _ = h.shape
    M = m.shape[1]
    q = rms_norm((h @ w_q).reshape(B, S, XATTN_HEADS, XATTN_HEAD_DIM), q_gain)
    kv = (m @ w_kv).reshape(B, M, 2, XATTN_HEADS, XATTN_HEAD_DIM)
    k = rms_norm(kv[:, :, 0], k_gain)
    v = kv[:, :, 1]
    s = jnp.einsum('bqhd,bkhd->bhqk', q, k).astype(jnp.float32) * (XATTN_HEAD_DIM ** -0.5)
    p = jax.nn.softmax(s, axis=-1).astype(v.dtype)
    o = jnp.einsum('bhqk,bkhd->bqhd', p, v).reshape(B, S, XATTN_WIDTH)
    return o @ w_o


def setup_inputs(seed: int = 0) -> dict:
    key = jax.random.key(seed)
    ks = iter(jax.random.split(key, 64))
    L, D = DEPTH, D_MODEL

    def nrm(shape, scale):
        return jax.random.normal(next(ks), shape, jnp.float32) * scale

    def gain(shape):
        return 1.0 + nrm(shape, 0.02)

    x = nrm((BATCH, SEQ, D), 1.0)
    mem = nrm((BATCH, MEM_LEN, D), 1.0)
    offset = jax.random.randint(next(ks), (BATCH, 1), 0, SEQ, dtype=jnp.int32)
    positions = (offset + jnp.arange(SEQ, dtype=jnp.int32)[None, :]).astype(jnp.int32)
    return {
        'x': x, 'mem': mem, 'positions': positions,
        'ffn1_norm': gain((L, D)),
        'ffn1_w_in': nrm((L, D, 2 * FFN_DIM), D ** -0.5),
        'ffn1_w_out': nrm((L, FFN_DIM, D), FFN_DIM ** -0.5),
        'mix_norm': gain((L, D)),
        'mix_w_in': nrm((L, D, IN_WIDTH), D ** -0.5),
        'mix_w_out': nrm((L, MIX_WIDTH, D), MIX_WIDTH ** -0.5),
        'fox_f_bias': 3.0 + nrm((L, FOX_HEADS), 0.5),
        'fox_q_gain': gain((L, HEAD_DIM)),
        'fox_k_gain': gain((L, HEAD_DIM)),
        'moba_q_gain': gain((L, HEAD_DIM)),
        'moba_k_gain': gain((L, HEAD_DIM)),
        'rwkv_mu': jax.random.uniform(next(ks), (L, RWKV_IN), jnp.float32, 0.0, 1.0),
        'rwkv_w0': nrm((L, RWKV_WIDTH), 1.0) - 1.0,
        'rwkv_w2': nrm((L, RWKV_DECAY_LORA, RWKV_WIDTH), RWKV_DECAY_LORA ** -0.5),
        'rwkv_a0': nrm((L, RWKV_WIDTH), 0.5),
        'rwkv_a2': nrm((L, RWKV_ICLR_LORA, RWKV_WIDTH), RWKV_ICLR_LORA ** -0.5),
        'rwkv_g2': nrm((L, RWKV_GATE_LORA, RWKV_WIDTH), RWKV_GATE_LORA ** -0.5),
        'rwkv_k_k': 0.85 + nrm((L, RWKV_WIDTH), 0.05),
        'rwkv_k_a': 1.0 + nrm((L, RWKV_WIDTH), 0.05),
        'rwkv_r_k': nrm((L, RWKV_HEADS, HEAD_DIM), 0.1),
        'rwkv_ln_w': gain((L, RWKV_WIDTH)),
        'rwkv_ln_b': nrm((L, RWKV_WIDTH), 0.02),
        'xattn_norm': gain((L, D)),
        'xattn_mem_norm': gain((L, D)),
        'xattn_w_q': nrm((L, D, XATTN_WIDTH), D ** -0.5),
        'xattn_w_kv': nrm((L, D, 2 * XATTN_WIDTH), D ** -0.5),
        'xattn_q_gain': gain((L, XATTN_HEAD_DIM)),
        'xattn_k_gain': gain((L, XATTN_HEAD_DIM)),
        'xattn_w_out': nrm((L, XATTN_WIDTH, D), XATTN_WIDTH ** -0.5),
        'ffn2_norm': gain((L, D)),
        'ffn2_w_in': nrm((L, D, 2 * FFN_DIM), D ** -0.5),
        'ffn2_w_out': nrm((L, FFN_DIM, D), FFN_DIM ** -0.5),
    }


def reference(x, mem, positions, ffn1_norm, ffn1_w_in, ffn1_w_out, mix_norm, mix_w_in, mix_w_out,
              fox_f_bias, fox_q_gain, fox_k_gain, moba_q_gain, moba_k_gain,
              rwkv_mu, rwkv_w0, rwkv_w2, rwkv_a0, rwkv_a2, rwkv_g2, rwkv_k_k, rwkv_k_a, rwkv_r_k,
              rwkv_ln_w, rwkv_ln_b, xattn_norm, xattn_mem_norm, xattn_w_q, xattn_w_kv,
              xattn_q_gain, xattn_k_gain, xattn_w_out, ffn2_norm, ffn2_w_in, ffn2_w_out):
    cos, sin = rope_tables(positions)
    for l in range(DEPTH):
        x = x + 0.5 * swiglu(rms_norm(x, ffn1_norm[l]), ffn1_w_in[l], ffn1_w_out[l]).astype(x.dtype)
        z = rms_norm(x, mix_norm[l]) @ mix_w_in[l]
        z_fox, z_moba, z_rwkv = jnp.split(z, [FOX_IN, FOX_IN + MOBA_IN], axis=-1)
        y_fox = fox_mixer(z_fox, fox_f_bias[l], fox_q_gain[l], fox_k_gain[l])
        y_rwkv = rwkv7_mixer(z_rwkv, rwkv_mu[l], rwkv_w0[l], rwkv_w2[l], rwkv_a0[l], rwkv_a2[l],
                             rwkv_g2[l], rwkv_k_k[l], rwkv_k_a[l], rwkv_r_k[l], rwkv_ln_w[l], rwkv_ln_b[l])
        y_moba = moba_mixer(z_moba, cos, sin, moba_q_gain[l], moba_k_gain[l])
        y = jnp.concatenate([y_fox, y_rwkv, y_moba], axis=-1) @ mix_w_out[l]
        x = x + y.astype(x.dtype)
        x = x + memory_cross_attention(rms_norm(x, xattn_norm[l]), rms_norm(mem, xattn_mem_norm[l]),
                                       xattn_w_q[l], xattn_w_kv[l], xattn_q_gain[l], xattn_k_gain[l],
                                       xattn_w_out[l]).astype(x.dtype)
        x = x + 0.5 * swiglu(rms_norm(x, ffn2_norm[l]), ffn2_w_in[l], ffn2_w_out[l]).astype(x.dtype)
    return x
```

```cpp
#include <hip/hip_runtime.h>
#include <hip/hip_cooperative_groups.h>
#include <cstdio>
#include <cstdint>
namespace cg = cooperative_groups;
namespace pg8 {
#define PG8_LAS __attribute__((address_space(3)))
typedef unsigned short bf16_t;
typedef short bf16x8 __attribute__((ext_vector_type(8)));
typedef float f32x4 __attribute__((ext_vector_type(4)));
typedef unsigned u32x4 __attribute__((ext_vector_type(4)));
constexpr int BM = 256, BK = 64, HALF = 128, HTB = HALF * BK * 2  , STAGE_BYTES = 8 * HTB, NXCD = 8, WGM = 8;

__host__ __device__ __forceinline__ int lds_byte(int r, int c) { const int st = (r >> 4) * 2 + (c >> 5), rr = r & 15, cc = c & 31, ob = rr * 64 + cc * 2; return st * 1024 + (ob ^ (((ob >> 9) & 1) << 5)); }
__host__ __device__ __forceinline__ void stage_rc(int b, int& R, int& C) { const int st = b / 1024, sb = b % 1024, swz = sb ^ (((sb >> 9) & 1) << 5); R = (st >> 1) * 16 + swz / 64; C = (st & 1) * 32 + (swz % 64) / 2; }
__host__ __device__ __forceinline__ int perm32(int rho) { const int n = rho >> 4, i = rho & 15; return 8 * (i >> 2) + 4 * n + (i & 3); }

struct Unit { int pm, pn; };
struct Gemm { const bf16_t* A; const bf16_t* Bt; int M, N, K, lda; };

struct StaticOrder {
    int nM, nN, nwg, G, c;
    __host__ __device__ void init(int M, int N, int G_, int c_) { nM = M / BM; nN = N / BM; nwg = nM * nN; G = G_; c = c_; }
    __host__ __device__ bool next(int i, Unit& u) const {
        const long L = (long)i * G + c; if (L >= nwg) return false;
        int wgid = (int)L; { const int q = nwg / NXCD, r = nwg % NXCD, xcd = wgid % NXCD, off = wgid / NXCD; wgid = (xcd < r ? xcd * (q + 1) : r * (q + 1) + (xcd - r) * q) + off; }
        const int nig = WGM * nN, gid = wgid / nig, fm = gid * WGM, gsz = (nM - fm) < WGM ? (nM - fm) : WGM;
        u.pm = fm + ((wgid % nig) % gsz); u.pn = (wgid % nig) / gsz; return true;
    }
    __device__ __forceinline__ void a_ready(const Unit&) const {}
    __device__ __forceinline__ void done(const Unit&) const {}
};
__device__ __forceinline__ unsigned cvt_pk_bf16(float lo, float hi) { unsigned r; asm volatile("v_cvt_pk_bf16_f32 %0, %1, %2" : "=v"(r) : "v"(lo), "v"(hi)); return r; }
__device__ __forceinline__ float silu_f(float x) { return x * __builtin_amdgcn_rcpf(1.0f + __builtin_amdgcn_exp2f(-1.4426950408889634f * x)); }
struct EpiSwiglu {
    static constexpr bool PERM = true, AFTER_DRAIN = false;
    bf16_t* O; int ldc;
    __device__ __forceinline__ void operator()(const f32x4 (&acc)[2][2][4][2], const Unit& u, int wr, int wc, int fr, int fq) const {
        const int row0 = u.pm * BM + wr * 64 + fr, col0 = u.pn * HALF + wc * 32 + 8 * fq;
#pragma unroll
        for (int ai = 0; ai < 2; ++ai)
#pragma unroll
            for (int m = 0; m < 4; ++m) {
                const f32x4 g0 = acc[ai][0][m][0], g1 = acc[ai][0][m][1], u0 = acc[ai][1][m][0], u1 = acc[ai][1][m][1];
                u32x4 w;
                w.x = cvt_pk_bf16(silu_f(g0[0]) * u0[0], silu_f(g0[1]) * u0[1]); w.y = cvt_pk_bf16(silu_f(g0[2]) * u0[2], silu_f(g0[3]) * u0[3]);
                w.z = cvt_pk_bf16(silu_f(g1[0]) * u1[0], silu_f(g1[1]) * u1[1]); w.w = cvt_pk_bf16(silu_f(g1[2]) * u1[2], silu_f(g1[3]) * u1[3]);
                *(u32x4*)(O + (size_t)(row0 + ai * HALF + m * 16) * ldc + col0) = w;
            }
    }
};
struct EpiResid {
    static constexpr bool PERM = false, AFTER_DRAIN = false;
    const float* base; float* out; int ldc; float scale;
    __device__ __forceinline__ void operator()(const f32x4 (&acc)[2][2][4][2], const Unit& u, int wr, int wc, int fr, int fq) const {
        const int row0 = u.pm * BM + wr * 64 + fr, col0 = u.pn * BM + wc * 32 + 4 * fq;
#pragma unroll
        for (int ai = 0; ai < 2; ++ai)
#pragma unroll
            for (int m = 0; m < 4; ++m) { const size_t off = (size_t)(row0 + ai * HALF + m * 16) * ldc + col0;
#pragma unroll
                for (int bj = 0; bj < 2; ++bj)
#pragma unroll
                    for (int n = 0; n < 2; ++n) { const f32x4 b = *(const f32x4*)(base + off + bj * HALF + n * 16); *(f32x4*)(out + off + bj * HALF + n * 16) = b + acc[ai][bj][m][n] * scale; }
                asm volatile("" ::: "memory"); }
    }
};
struct EpiBf16 {
    static constexpr bool PERM = true, AFTER_DRAIN = false;
    bf16_t* O; int ldc; int ncols; bf16_t* halo;
    __device__ __forceinline__ void operator()(const f32x4 (&acc)[2][2][4][2], const Unit& u, int wr, int wc, int fr, int fq) const {
        const int row0 = u.pm * BM + wr * 64 + fr, col0 = u.pn * BM + wc * 32 + 8 * fq;
#pragma unroll
        for (int ai = 0; ai < 2; ++ai)
#pragma unroll
            for (int m = 0; m < 4; ++m) { const int row = row0 + ai * HALF + m * 16;
#pragma unroll
                for (int bj = 0; bj < 2; ++bj) { const int col = col0 + bj * HALF;
                    if (col < ncols) { const f32x4 v0 = acc[ai][bj][m][0], v1 = acc[ai][bj][m][1]; u32x4 w;
                        w.x = cvt_pk_bf16(v0[0], v0[1]); w.y = cvt_pk_bf16(v0[2], v0[3]); w.z = cvt_pk_bf16(v1[0], v1[1]); w.w = cvt_pk_bf16(v1[2], v1[3]);
                        *(u32x4*)(O + (size_t)row * ldc + col) = w;
                        if (halo && (row & 63) == 63) *(u32x4*)(halo + (size_t)(row >> 6) * ldc + col) = w; } } }
    }
};
template <class Epi, class Sched, bool ALIGN_EPI = false, bool SP2 = false>
__device__ __forceinline__ void gemm_phase(PG8_LAS unsigned char* lds, const Gemm g, const Sched& S, const Epi& E) {
    int tid_ = threadIdx.x; asm volatile("" : "+v"(tid_)); const int tid = tid_, wid = __builtin_amdgcn_readfirstlane(tid >> 6), lane = tid & 63, wr = wid >> 2, wc = wid & 3, fr = lane & 15, fq = lane >> 4;
    const int K = g.K, nt = K / BK;
    unsigned voffA[2], voffB[2];
#pragma unroll
    for (int i = 0; i < 2; ++i) { int R, C; stage_rc(tid * 16 + i * 8192, R, C); const int Rb = Epi::PERM ? ((R & ~31) + perm32(R & 31)) : R;
        voffA[i] = (unsigned)(R * g.lda + C) * 2u; voffB[i] = (unsigned)(Rb * K + C) * 2u; }
    const size_t kstep = (size_t)(BK * 2);
    const size_t hstep = (size_t)HALF * K * 2;
    const size_t tstep = 2 * hstep; const size_t hstepA = (size_t)HALF * g.lda * 2, tstepA = 2 * hstepA;
    const unsigned ldsw = (unsigned)wid * 1024u;
    const int aoff = lds_byte(wr * 64 + fr, fq * 8), boff = lds_byte(wc * 32 + fr, fq * 8);
#define PG8_SA(b, h) (((b) * 2 + (h)) * HTB)
#define PG8_SB(b, h) ((4 + (b) * 2 + (h)) * HTB)
#define PG8_STAGE(bufoff, gbase, voff) do { _Pragma("unroll") for (int _i = 0; _i < 2; ++_i) \
        __builtin_amdgcn_global_load_lds((const unsigned*)((const char*)(gbase) + (voff)[_i]), (PG8_LAS unsigned*)(lds + (bufoff) + ldsw + _i * 8192), 16, 0, 0); } while (0)
#define PG8_LDA(dst, b, h) do { _Pragma("unroll") for (int m = 0; m < 4; ++m) _Pragma("unroll") for (int k = 0; k < 2; ++k) dst[m][k] = *(const PG8_LAS bf16x8*)(lds + PG8_SA(b, h) + aoff + m * 2048 + k * 1024); } while (0)
#define PG8_LDB(dst, b, h) do { _Pragma("unroll") for (int n = 0; n < 2; ++n) _Pragma("unroll") for (int k = 0; k < 2; ++k) dst[n][k] = *(const PG8_LAS bf16x8*)(lds + PG8_SB(b, h) + boff + n * 2048 + k * 1024); } while (0)
#define PG8_MMA(ai, bj, At, Bt) do { __builtin_amdgcn_s_setprio(1); _Pragma("unroll") for (int m = 0; m < 4; ++m) _Pragma("unroll") for (int n = 0; n < 2; ++n) _Pragma("unroll") for (int k = 0; k < 2; ++k) \
        acc[ai][bj][m][n] = __builtin_amdgcn_mfma_f32_16x16x32_bf16(Bt[n][k], At[m][k], acc[ai][bj][m][n], 0, 0, 0); __builtin_amdgcn_s_setprio(0); } while (0)
#define PG8_WAIT_V(n) asm volatile("s_waitcnt vmcnt(" #n ")" ::: "memory")
#define PG8_WAIT_L(n) asm volatile("s_waitcnt lgkmcnt(" #n ")" ::: "memory")
#define PG8_BAR __builtin_amdgcn_s_barrier()
#define PG8_SCHED __builtin_amdgcn_sched_barrier(0)
    Unit cur, nxt; int ui = 0;
    if (!S.next(0, cur)) return;
    f32x4 acc[2][2][4][2];
#pragma unroll
    for (int a = 0; a < 2; ++a)
#pragma unroll
        for (int b = 0; b < 2; ++b)
#pragma unroll
            for (int m = 0; m < 4; ++m)
#pragma unroll
                for (int n = 0; n < 2; ++n) acc[a][b][m][n] = (f32x4){0.f, 0.f, 0.f, 0.f};
    bf16x8 At[4][2], B0[2][2], B1[2][2];
    const char* cA = (const char*)g.A + (size_t)cur.pm * tstepA; const char* cB = (const char*)g.Bt + (size_t)cur.pn * tstep;
    S.a_ready(cur);
    if constexpr (SP2) {
        PG8_STAGE(PG8_SB(0, 0), cB, voffB); PG8_STAGE(PG8_SB(0, 1), cB + hstep, voffB); PG8_STAGE(PG8_SA(0, 0), cA, voffA); PG8_STAGE(PG8_SA(0, 1), cA + hstepA, voffA);
        if (wr == 1) PG8_BAR;
        PG8_WAIT_V(2); PG8_BAR;
        PG8_STAGE(PG8_SB(1, 0), cB + kstep, voffB); PG8_STAGE(PG8_SA(1, 0), cA + kstep, voffA); PG8_STAGE(PG8_SB(1, 1), cB + hstep + kstep, voffB);
        PG8_WAIT_V(6); PG8_BAR;
    } else {
        PG8_STAGE(PG8_SB(0, 0), cB, voffB); PG8_STAGE(PG8_SA(0, 0), cA, voffA); PG8_STAGE(PG8_SB(0, 1), cB + hstep, voffB); PG8_STAGE(PG8_SA(0, 1), cA + hstepA, voffA);
        if (wr == 1) PG8_BAR;
        PG8_WAIT_V(4); PG8_BAR;
        PG8_STAGE(PG8_SB(1, 0), cB + kstep, voffB); PG8_STAGE(PG8_SA(1, 0), cA + kstep, voffA); PG8_STAGE(PG8_SB(1, 1), cB + hstep + kstep, voffB);
        PG8_WAIT_V(6); PG8_BAR;
    }
    for (;;) {
        const bool has_next = S.next(ui + 1, nxt);
        const char* nA = has_next ? (const char*)g.A + (size_t)nxt.pm * tstepA : cA; const char* nB = has_next ? (const char*)g.Bt + (size_t)nxt.pn * tstep : cB;
        for (int t = 0; t < nt; t += 2) {
            const bool last = (t == nt - 2);
            const char* a1 = cA + (size_t)(t + 1) * kstep;
            const char* a2 = last ? nA : cA + (size_t)(t + 2) * kstep; const char* b2 = last ? nB : cB + (size_t)(t + 2) * kstep;
            const char* a3 = a2 + kstep; const char* b3 = b2 + kstep;
            if (last && has_next) S.a_ready(nxt);
            if constexpr (SP2) {
            PG8_LDB(B0, 0, 0); PG8_LDB(B1, 0, 1); PG8_SCHED; PG8_LDA(At, 0, 0); PG8_STAGE(PG8_SA(1, 1), a1 + hstepA, voffA);
            PG8_WAIT_V(8); PG8_WAIT_L(0); PG8_BAR; PG8_MMA(0, 0, At, B0); PG8_MMA(0, 1, At, B1); PG8_BAR; PG8_SCHED;
            PG8_LDA(At, 0, 1); PG8_STAGE(PG8_SB(0, 0), b2, voffB); PG8_STAGE(PG8_SB(0, 1), b2 + hstep, voffB); PG8_STAGE(PG8_SA(0, 0), a2, voffA);
            PG8_WAIT_V(8); PG8_WAIT_L(0); PG8_BAR; PG8_MMA(1, 0, At, B0); PG8_MMA(1, 1, At, B1); PG8_BAR; PG8_SCHED;
            PG8_LDB(B0, 1, 0); PG8_LDB(B1, 1, 1); PG8_SCHED; PG8_LDA(At, 1, 0); PG8_STAGE(PG8_SA(0, 1), a2 + hstepA, voffA);
            PG8_WAIT_V(8); PG8_WAIT_L(0); PG8_BAR; PG8_MMA(0, 0, At, B0); PG8_MMA(0, 1, At, B1); PG8_BAR; PG8_SCHED;
            PG8_LDA(At, 1, 1); PG8_STAGE(PG8_SB(1, 0), b3, voffB); PG8_STAGE(PG8_SB(1, 1), b3 + hstep, voffB); PG8_STAGE(PG8_SA(1, 0), a3, voffA);
            PG8_WAIT_V(8); PG8_WAIT_L(0); PG8_BAR; PG8_MMA(1, 0, At, B0); PG8_MMA(1, 1, At, B1); PG8_BAR; PG8_SCHED;
            } else {
            PG8_LDB(B0, 0, 0); PG8_SCHED; PG8_LDA(At, 0, 0); PG8_STAGE(PG8_SA(1, 1), a1 + hstepA, voffA);
            PG8_WAIT_L(8); PG8_BAR; PG8_WAIT_L(0); PG8_MMA(0, 0, At, B0); PG8_BAR; PG8_SCHED;
            PG8_LDB(B1, 0, 1); PG8_STAGE(PG8_SB(0, 0), b2, voffB);
            PG8_BAR; PG8_WAIT_L(0); PG8_MMA(0, 1, At, B1); PG8_BAR;
            PG8_LDA(At, 0, 1); PG8_STAGE(PG8_SA(0, 0), a2, voffA);
            PG8_BAR; PG8_WAIT_L(0); PG8_MMA(1, 0, At, B0); PG8_BAR; PG8_SCHED;
            PG8_STAGE(PG8_SB(0, 1), b2 + hstep, voffB);
            PG8_WAIT_V(6); PG8_BAR; PG8_MMA(1, 1, At, B1); PG8_BAR;
            PG8_LDB(B0, 1, 0); PG8_SCHED; PG8_LDA(At, 1, 0); PG8_STAGE(PG8_SA(0, 1), a2 + hstepA, voffA);
            PG8_WAIT_L(8); PG8_BAR; PG8_WAIT_L(0); PG8_MMA(0, 0, At, B0); PG8_BAR; PG8_SCHED;
            PG8_LDB(B1, 1, 1); PG8_STAGE(PG8_SB(1, 0), b3, voffB);
            PG8_BAR; PG8_WAIT_L(0); PG8_MMA(0, 1, At, B1); PG8_BAR;
            PG8_LDA(At, 1, 1); PG8_STAGE(PG8_SA(1, 0), a3, voffA);
            PG8_BAR; PG8_WAIT_L(0); PG8_MMA(1, 0, At, B0); PG8_BAR; PG8_SCHED;
            PG8_STAGE(PG8_SB(1, 1), b3 + hstep, voffB);
            PG8_WAIT_V(6); PG8_BAR; PG8_MMA(1, 1, At, B1); PG8_BAR;
            }
        }
        if constexpr (ALIGN_EPI) { if (wr == 0) PG8_BAR; }
        if constexpr (!Epi::AFTER_DRAIN) { E(acc, cur, wr, wc, fr, fq); S.done(cur); }
        if (!has_next) break;
#pragma unroll
        for (int a = 0; a < 2; ++a)
#pragma unroll
            for (int b = 0; b < 2; ++b)
#pragma unroll
                for (int m = 0; m < 4; ++m)
#pragma unroll
                    for (int n = 0; n < 2; ++n) acc[a][b][m][n] = (f32x4){0.f, 0.f, 0.f, 0.f};
        cur = nxt; cA = nA; cB = nB; ++ui;
        if constexpr (ALIGN_EPI) { if (wr == 1) PG8_BAR; }
    }
    PG8_WAIT_V(0);
    if constexpr (!ALIGN_EPI) { if (wr == 0) PG8_BAR; }
    PG8_BAR;
    if constexpr (Epi::AFTER_DRAIN) { E.fused(acc, cur, wr, wc, fr, fq, lds, wid, lane); S.done(cur); }
#undef PG8_SA
#undef PG8_SB
#undef PG8_STAGE
#undef PG8_LDA
#undef PG8_LDB
#undef PG8_MMA
#undef PG8_WAIT_V
#undef PG8_WAIT_L
#undef PG8_BAR
#undef PG8_SCHED
}
}

#define LAS __attribute__((address_space(3)))
#define DEV __device__ __forceinline__
typedef unsigned short bf16_t;
typedef short bf16x8 __attribute__((ext_vector_type(8)));
typedef short s16x4 __attribute__((ext_vector_type(4)));
typedef float f32x4 __attribute__((ext_vector_type(4)));
typedef float f32x16 __attribute__((ext_vector_type(16)));
typedef unsigned u32x2 __attribute__((ext_vector_type(2)));
typedef unsigned u32x4 __attribute__((ext_vector_type(4)));
typedef unsigned u32x8 __attribute__((ext_vector_type(8)));

constexpr int NB = 8, SEQ = 4096, DM = 1024, TOK = NB * SEQ, FF = 2816, NL = 2, MEMLEN = 256;
constexpr int ZP = 3392;
constexpr int ZC_FQ = 0, ZC_RR = 256, ZC_MQ = 768, ZC_FK = 1024, ZC_FV = 1280, ZC_MK = 1536, ZC_MV = 1792, ZC_RK = 2048, ZC_RV = 2560, ZC_LO = 3072, ZC_FF = 3360, ZC_VALID = 3368;
constexpr float NORM_EPS = 1e-6f, GN_EPS = 64e-5f, LOG2E = 1.4426950408889634f;
constexpr float C2_64 = 0.125f * LOG2E, C2_128 = 0.08838834764831845f * LOG2E;
constexpr size_t MiB = 1u << 20;
constexpr size_t WS_CTL = 0;
constexpr size_t WS_W = 1 * MiB, WL_BYTES = 48 * MiB;
constexpr size_t OFF_F1I = 0, OFF_F1O = 11 * MiB, OFF_F2I = 17 * MiB, OFF_F2O = 28 * MiB, OFF_MI = 34 * MiB, OFF_MO = 41 * MiB, OFF_XQ = 43 * MiB, OFF_XKV = 44 * MiB, OFF_XO = 46 * MiB;
constexpr size_t OFF_W2T = 47 * MiB, OFF_A2T = OFF_W2T + 65536, OFF_G2T = OFF_A2T + 65536;
constexpr size_t WS_Z = 97 * MiB;
constexpr size_t WS_C = WS_Z + 212 * MiB;
constexpr size_t WS_HN = WS_C;
constexpr size_t WS_WD = WS_C, WS_KK = WS_C + 64 * MiB, WS_KA = WS_C + 96 * MiB;
constexpr size_t WS_VTF = WS_C + 128 * MiB, WS_VTM = WS_C + 144 * MiB;
constexpr size_t WS_LOGF = WS_C + 160 * MiB, WS_KMP = WS_LOGF + 512 * 1024, WS_ZHALO = WS_C + 161 * MiB;
constexpr size_t WS_KVX = WS_C + 165 * MiB, WS_VTX = WS_C + 173 * MiB, WS_MEMN = WS_C + 177 * MiB, WS_END = WS_C + 185 * MiB;
static_assert(WS_END <= 512 * MiB, "workspace map");
constexpr int LDS_BYTES = 131072 + 1024;

struct Args { const float* in[35]; float* out; unsigned char* ws; int ph_lo, ph_hi; };

DEV float bf2f(unsigned short b) { return __uint_as_float((unsigned)b << 16); }
DEV unsigned f2bf(float f) { unsigned u = __float_as_uint(f); return (u + 0x7fffu + ((u >> 16) & 1u)) >> 16; }
DEV unsigned pk2(float lo, float hi) { return f2bf(lo) | (f2bf(hi) << 16); }
DEV float wave_sum(float v) {
#pragma unroll
    for (int o = 1; o < 64; o <<= 1) v += __shfl_xor(v, o);
    return v;
}
#define LDS_WAIT() asm volatile("s_waitcnt lgkmcnt(0)" ::: "memory")

struct MatInfo { const float* src; bf16_t* dst; int K, Ns, Nd, map; };
DEV MatInfo matinfo(const Args& a, int m) {
    const int l = m / 12, k = m % 12; unsigned char* wl = a.ws + WS_W + (size_t)l * WL_BYTES; MatInfo r;
    switch (k) {
    case 0:  r.src = a.in[4] + (size_t)l * DM * 2 * FF;  r.dst = (bf16_t*)(wl + OFF_F1I); r.K = DM; r.Ns = 2 * FF; r.Nd = 2 * FF; r.map = 1; break;
    case 1:  r.src = a.in[5] + (size_t)l * FF * DM;      r.dst = (bf16_t*)(wl + OFF_F1O); r.K = FF; r.Ns = DM; r.Nd = DM; r.map = 0; break;
    case 2:  r.src = a.in[33] + (size_t)l * DM * 2 * FF; r.dst = (bf16_t*)(wl + OFF_F2I); r.K = DM; r.Ns = 2 * FF; r.Nd = 2 * FF; r.map = 1; break;
    case 3:  r.src = a.in[34] + (size_t)l * FF * DM;     r.dst = (bf16_t*)(wl + OFF_F2O); r.K = FF; r.Ns = DM; r.Nd = DM; r.map = 0; break;
    case 4:  r.src = a.in[7] + (size_t)l * DM * 3364;    r.dst = (bf16_t*)(wl + OFF_MI);  r.K = DM; r.Ns = 3364; r.Nd = 3584; r.map = 2; break;
    case 5:  r.src = a.in[8] + (size_t)l * DM * DM;      r.dst = (bf16_t*)(wl + OFF_MO);  r.K = DM; r.Ns = DM; r.Nd = DM; r.map = 0; break;
    case 6:  r.src = a.in[27] + (size_t)l * DM * 512;    r.dst = (bf16_t*)(wl + OFF_XQ);  r.K = DM; r.Ns = 512; r.Nd = 512; r.map = 0; break;
    case 7:  r.src = a.in[28] + (size_t)l * DM * 1024;   r.dst = (bf16_t*)(wl + OFF_XKV); r.K = DM; r.Ns = 1024; r.Nd = 1024; r.map = 0; break;
    case 8:  r.src = a.in[31] + (size_t)l * 512 * DM;    r.dst = (bf16_t*)(wl + OFF_XO);  r.K = 512; r.Ns = DM; r.Nd = DM; r.map = 0; break;
    case 9:  r.src = a.in[16] + (size_t)l * 64 * 512;    r.dst = (bf16_t*)(wl + OFF_W2T); r.K = 64; r.Ns = 512; r.Nd = 512; r.map = 0; break;
    case 10: r.src = a.in[18] + (size_t)l * 64 * 512;    r.dst = (bf16_t*)(wl + OFF_A2T); r.K = 64; r.Ns = 512; r.Nd = 512; r.map = 0; break;
    default: r.src = a.in[19] + (size_t)l * 160 * 512;   r.dst = (bf16_t*)(wl + OFF_G2T); r.K = 160; r.Ns = 512; r.Nd = 512; r.map = 0; break;
    }
    return r;
}
DEV int srccol(int map, int n) {
    if (map == 0) return n;
    if (map == 1) { const int p = n >> 8, r = n & 255; return r < 128 ? p * 128 + r : FF + p * 128 + (r - 128); }
    if (n < 256) return n;
    if (n < 768) return 1540 + (n - 256);
    if (n < 1024) return 772 + (n - 768);
    if (n < 1280) return 256 + (n - 1024);
    if (n < 1536) return 512 + (n - 1280);
    if (n < 1792) return 1028 + (n - 1536);
    if (n < 2048) return 1284 + (n - 1792);
    if (n < 2560) return 2052 + (n - 2048);
    if (n < 3072) return 2564 + (n - 2560);
    if (n < 3360) return 3076 + (n - 3072);
    if (n < 3364) return 768 + (n - 3360);
    return -1;
}
DEV void transpose_item(const MatInfo& mi, LAS float* scr, int item, int lane) {
    const int nblk = mi.Nd / 32, kb = item / nblk, nb = item % nblk, k0 = 64 * kb, n0 = 32 * nb;
    const int sc = srccol(mi.map, n0 + (lane & 31));
#pragma unroll 8
    for (int i = 0; i < 32; ++i) { const int kk = 2 * i + (lane >> 5), k = k0 + kk;
        scr[kk * 33 + (lane & 31)] = (sc >= 0 && k < mi.K) ? mi.src[(size_t)k * mi.Ns + sc] : 0.f; }
    LDS_WAIT(); asm volatile("" ::: "memory");
    const int c = lane & 7;
#pragma unroll
    for (int j = 0; j < 4; ++j) { const int n = (lane >> 3) + 8 * j; const LAS float* s = scr + (8 * c) * 33 + n;
        u32x4 o; o.x = pk2(s[0 * 33], s[1 * 33]); o.y = pk2(s[2 * 33], s[3 * 33]); o.z = pk2(s[4 * 33], s[5 * 33]); o.w = pk2(s[6 * 33], s[7 * 33]);
        if (k0 + 8 * c < mi.K) *(u32x4*)(mi.dst + (size_t)(n0 + n) * mi.K + k0 + 8 * c) = o; }
    LDS_WAIT(); asm volatile("" ::: "memory");
}
DEV void norm_row(const float* xrow, const float* g, bf16_t* orow, int lane) {
    const f32x4* xr = (const f32x4*)xrow + lane; const f32x4* gr = (const f32x4*)g + lane;
    f32x4 v[4]; float s = 0.f;
#pragma unroll
    for (int j = 0; j < 4; ++j) { v[j] = xr[64 * j]; s += (v[j].x * v[j].x + v[j].y * v[j].y) + (v[j].z * v[j].z + v[j].w * v[j].w); }
    const float rstd = rsqrtf(wave_sum(s) * (1.f / DM) + NORM_EPS);
    u32x2* o8 = (u32x2*)orow + lane;
#pragma unroll
    for (int j = 0; j < 4; ++j) { const f32x4 gg = gr[64 * j]; u32x2 w; w.x = pk2(v[j].x * rstd * gg.x, v[j].y * rstd * gg.y); w.y = pk2(v[j].z * rstd * gg.z, v[j].w * rstd * gg.w); o8[64 * j] = w; }
}
DEV void norm_phase(const float* x, const float* g, bf16_t* out, int nrows, int gw, int NGW, int lane) {
    for (int m = gw; m < nrows; m += NGW) norm_row(x + (size_t)m * DM, g, out + (size_t)m * DM, lane);
}
DEV void p0_prologue(const Args& a, LAS unsigned char* lds, int gw, int NGW, int wid, int lane, int tid) {
    LAS float* scr = (LAS float*)(lds + wid * 8704);
    int base = 0;
    for (int m = 0; m < 24; ++m) {
        const MatInfo mi = matinfo(a, m); const int items = ((mi.K + 63) / 64) * (mi.Nd / 32);
        int first = gw - (base % NGW); if (first < 0) first += NGW;
        for (int it = first; it < items; it += NGW) transpose_item(mi, scr, it, lane);
        base += items;
    }
    for (int m = gw; m < NL * NB * MEMLEN; m += NGW) { const int l = m / (NB * MEMLEN), r = m % (NB * MEMLEN);
        norm_row(a.in[1] + (size_t)r * DM, a.in[26] + l * DM, (bf16_t*)(a.ws + WS_MEMN) + (size_t)m * DM, lane); }
    if (blockIdx.x == 0 && tid < 64) ((unsigned*)(a.ws + WS_CTL))[tid * 64] = 0u;
}
DEV void xkv_post(const Args& a, int gw, int NGW, int lane) {
    for (int it = gw; it < NL * NB * MEMLEN * 4; it += NGW) {
        const int hd = it & 3, row = (it >> 2) % (NB * MEMLEN), l = it / (4 * NB * MEMLEN), b = row / MEMLEN, m = row % MEMLEN;
        bf16_t* kr = (bf16_t*)(a.ws + WS_KVX) + ((size_t)l * NB * MEMLEN + row) * 1024 + hd * 128;
        const unsigned kv = *((const unsigned*)kr + lane); float k0 = bf2f(kv & 0xffff), k1 = bf2f(kv >> 16);
        const float rstd = rsqrtf(wave_sum(k0 * k0 + k1 * k1) * (1.f / 128) + NORM_EPS);
        const float* kg = a.in[30] + l * 128;
        *((unsigned*)kr + lane) = pk2(k0 * rstd * kg[2 * lane], k1 * rstd * kg[2 * lane + 1]);
        const unsigned vv = *((const unsigned*)(kr + 512) + lane);
        bf16_t* vt = (bf16_t*)(a.ws + WS_VTX) + (((size_t)(l * NB + b) * 4 + hd) * 128) * MEMLEN + m;
        vt[(size_t)(2 * lane) * MEMLEN] = (bf16_t)(vv & 0xffff); vt[(size_t)(2 * lane + 1) * MEMLEN] = (bf16_t)(vv >> 16);
    }
}

DEV float sigmoid_f(float x) { return __builtin_amdgcn_rcpf(1.0f + __builtin_amdgcn_exp2f(-LOG2E * x)); }
DEV float tanh_f(float x) { const float e = __builtin_amdgcn_exp2f(-2.f * LOG2E * fabsf(x)); const float t = (1.f - e) * __builtin_amdgcn_rcpf(1.f + e); return x < 0.f ? -t : t; }
DEV void unpack8(const u32x4 v, float (&f)[8]) {
    f[0] = __uint_as_float(v.x << 16); f[1] = __uint_as_float(v.x & 0xffff0000u); f[2] = __uint_as_float(v.y << 16); f[3] = __uint_as_float(v.y & 0xffff0000u);
    f[4] = __uint_as_float(v.z << 16); f[5] = __uint_as_float(v.z & 0xffff0000u); f[6] = __uint_as_float(v.w << 16); f[7] = __uint_as_float(v.w & 0xffff0000u);
}
DEV u32x4 pack8(const float (&f)[8]) { u32x4 o; o.x = pk2(f[0], f[1]); o.y = pk2(f[2], f[3]); o.z = pk2(f[4], f[5]); o.w = pk2(f[6], f[7]); return o; }
DEV int crow(int r, int hi) { return (r & 3) + 8 * (r >> 2) + 4 * hi; }

DEV void prep_tile(const Args& a, int l, int tile, LAS unsigned char* lds) {
    int tid_ = threadIdx.x; asm volatile("" : "+v"(tid_)); const int tid = tid_, lane = tid & 63, wid = __builtin_amdgcn_readfirstlane(tid >> 6);
    const int row0 = tile * 64, b = row0 / SEQ, t0 = row0 % SEQ;
    bf16_t* Z = (bf16_t*)(a.ws + WS_Z) + (size_t)row0 * ZP;
    {
        const int ch = tid % 228, sub = tid / 228; const bool act = tid < 456;
        const int col = ch < 64 ? ZC_RR + 8 * ch : ZC_RK + 8 * (ch - 64), mi = ch < 64 ? 8 * ch : 512 + 8 * (ch - 64);
        const int ts = 32 * sub; float prev[8], mu[8];
#pragma unroll
        for (int i = 0; i < 8; ++i) { prev[i] = 0.f; mu[i] = 0.f; }
        if (act) {
            const float* mup = a.in[14] + l * 1824 + mi;
#pragma unroll
            for (int i = 0; i < 8; ++i) mu[i] = mup[i];
            if (sub == 1) unpack8(*(const u32x4*)(Z + (size_t)(ts - 1) * ZP + col), prev);
            else if (t0 != 0) unpack8(*(const u32x4*)((const bf16_t*)(a.ws + WS_ZHALO) + (size_t)(tile - 1) * ZP + col), prev);
        }
        __syncthreads();
        if (act) {
#pragma unroll 4
            for (int tt = 0; tt < 32; ++tt) { u32x4* p = (u32x4*)(Z + (size_t)(ts + tt) * ZP + col); float cur[8], o[8]; unpack8(*p, cur);
#pragma unroll
                for (int i = 0; i < 8; ++i) { o[i] = cur[i] + (prev[i] - cur[i]) * mu[i]; prev[i] = cur[i]; }
                *p = pack8(o); }
        }
    }
    LAS float* kbuf = (LAS float*)lds;
    {
        const float* gfq = a.in[10] + l * 64; const float* gfk = a.in[11] + l * 64; const float* gmq = a.in[12] + l * 64; const float* gmk = a.in[13] + l * 64;
        const int* pos = (const int*)a.in[2] + b * SEQ + t0;
        for (int it = 0; it < 16; ++it) {
            const int item = it * 512 + tid, g8 = item >> 3, sub8 = item & 7, slot = g8 >> 6, token = g8 & 63, h = slot & 3, kind = slot >> 2;
            const int cb = (kind == 0 ? ZC_FQ : kind == 1 ? ZC_FK : kind == 2 ? ZC_MQ : ZC_MK) + 64 * h + 8 * sub8;
            const float* gp = (kind == 0 ? gfq : kind == 1 ? gfk : kind == 2 ? gmq : gmk) + 8 * sub8;
            u32x4* p = (u32x4*)(Z + (size_t)token * ZP + cb); float v[8]; unpack8(*p, v);
            float ss = 0.f;
#pragma unroll
            for (int i = 0; i < 8; ++i) ss += v[i] * v[i];
            ss += __shfl_xor(ss, 1); ss += __shfl_xor(ss, 2); ss += __shfl_xor(ss, 4);
            const float rstd = rsqrtf(ss * (1.f / 64) + NORM_EPS);
#pragma unroll
            for (int i = 0; i < 8; ++i) v[i] = v[i] * rstd * gp[i];
            float pr[8];
#pragma unroll
            for (int i = 0; i < 8; ++i) pr[i] = __shfl_xor(v[i], 1);
            if (kind >= 2 && sub8 < 2) {
                const float posf = (float)pos[token];
#pragma unroll
                for (int i = 0; i < 8; ++i) {
                    const float invf = (float)__builtin_exp2(-(double)i * 0.125 * 18.931568569324174);
                    const float ang = posf * invf; const double rev = (double)ang * 0.15915494309189535; const float fr = (float)(rev - __builtin_floor(rev));
                    const float sn = __builtin_amdgcn_sinf(fr), cs = __builtin_amdgcn_cosf(fr);
                    v[i] = sub8 == 0 ? v[i] * cs - pr[i] * sn : v[i] * cs + pr[i] * sn; }
            }
            if (kind == 3) {
#pragma unroll
                for (int i = 0; i < 8; ++i) kbuf[(token * 4 + h) * 64 + 8 * sub8 + i] = v[i]; }
            if (kind == 0 || kind == 2) {
#pragma unroll
                for (int i = 0; i < 8; ++i) v[i] *= C2_64; }
            *p = pack8(v);
        }
    }
    __syncthreads();
    if (tid < 256) { const int h = tid >> 6, d = tid & 63; float s = 0.f;
        for (int t = 0; t < 64; ++t) s += kbuf[(t * 4 + h) * 64 + d];
        ((float*)(a.ws + WS_KMP))[(((size_t)(b * 4 + h) * 64) + (t0 >> 6)) * 64 + d] = s; }
    for (int it = 0; it < 8; ++it) {
        const int item = it * 512 + tid, which = item >> 11, rem = item & 2047, tg = rem >> 8, c = rem & 255;
        const bf16_t* src = Z + (size_t)(8 * tg) * ZP + (which ? ZC_MV : ZC_FV) + c; unsigned short e[8];
#pragma unroll
        for (int i = 0; i < 8; ++i) e[i] = src[(size_t)i * ZP];
        u32x4 o; o.x = e[0] | ((unsigned)e[1] << 16); o.y = e[2] | ((unsigned)e[3] << 16); o.z = e[4] | ((unsigned)e[5] << 16); o.w = e[6] | ((unsigned)e[7] << 16);
        bf16_t* vt = (bf16_t*)(a.ws + (which ? WS_VTM : WS_VTF)) + ((size_t)(b * 4 + (c >> 6)) * 64 + (c & 63)) * SEQ + t0 + 8 * tg;
        *(u32x4*)vt = o;
    }
    if (tid < 256) { const int token = tid >> 2, h = tid & 3; const float x = bf2f(Z[(size_t)token * ZP + ZC_FF + h]) + a.in[9][l * 4 + h];
        const float lf = fminf(x, 0.f) - __logf(1.f + __expf(-fabsf(x)));
        ((float*)(a.ws + WS_LOGF))[(size_t)(b * 4 + h) * SEQ + t0 + token] = lf; }
    __syncthreads();
    LAS bf16_t* al = (LAS bf16_t*)lds;
    for (int item = tid; item < 64 * 36; item += 512) { const int token = item / 36, c = item % 36; float v[8]; unpack8(*(const u32x4*)(Z + (size_t)token * ZP + ZC_LO + 8 * c), v);
        if (c < 8) {
#pragma unroll
            for (int i = 0; i < 8; ++i) v[i] = tanh_f(v[i]); }
        else if (c >= 16) {
#pragma unroll
            for (int i = 0; i < 8; ++i) v[i] = sigmoid_f(v[i]); }
        *(LAS u32x4*)(al + token * 296 + 8 * c) = pack8(v); }
    __syncthreads();
    const unsigned char* wl = a.ws + WS_W + (size_t)l * WL_BYTES;
    const bf16_t* w2t = (const bf16_t*)(wl + OFF_W2T); const bf16_t* a2t = (const bf16_t*)(wl + OFF_A2T); const bf16_t* g2t = (const bf16_t*)(wl + OFF_G2T);
    const int r32 = lane & 31, hi = lane >> 5;
    for (int uu = 0; uu < 2; ++uu) {
        const int u = wid + 8 * uu, h = u & 7, th = u >> 3, token = 32 * th + r32;
        f32x16 aw[2], aa[2], ag[2];
#pragma unroll
        for (int ct = 0; ct < 2; ++ct) { aw[ct] = f32x16{}; aa[ct] = f32x16{}; ag[ct] = f32x16{}; }
        const LAS bf16_t* arow = al + token * 296 + 8 * hi;
#pragma unroll 1
        for (int ks = 0; ks < 4; ++ks) { const bf16x8 bw = *(const LAS bf16x8*)(arow + 16 * ks), ba = *(const LAS bf16x8*)(arow + 64 + 16 * ks);
#pragma unroll
            for (int ct = 0; ct < 2; ++ct) { const int chn = 64 * h + 32 * ct + r32;
                aw[ct] = __builtin_amdgcn_mfma_f32_32x32x16_bf16(*(const bf16x8*)(w2t + chn * 64 + 16 * ks + 8 * hi), bw, aw[ct], 0, 0, 0);
                aa[ct] = __builtin_amdgcn_mfma_f32_32x32x16_bf16(*(const bf16x8*)(a2t + chn * 64 + 16 * ks + 8 * hi), ba, aa[ct], 0, 0, 0); } }
#pragma unroll 1
        for (int ks = 0; ks < 10; ++ks) { const bf16x8 bg = *(const LAS bf16x8*)(arow + 128 + 16 * ks);
#pragma unroll
            for (int ct = 0; ct < 2; ++ct) { const int chn = 64 * h + 32 * ct + r32;
                ag[ct] = __builtin_amdgcn_mfma_f32_32x32x16_bf16(*(const bf16x8*)(g2t + chn * 160 + 16 * ks + 8 * hi), bg, ag[ct], 0, 0, 0); } }
        bf16_t* zr = Z + (size_t)token * ZP; const size_t grow = (size_t)(row0 + token);
        float* wd = (float*)(a.ws + WS_WD) + grow * 512; bf16_t* kkp = (bf16_t*)(a.ws + WS_KK) + grow * 512; bf16_t* kap = (bf16_t*)(a.ws + WS_KA) + grow * 512;
        const float* w0 = a.in[15] + l * 512; const float* a0 = a.in[17] + l * 512; const float* k_k = a.in[20] + l * 512; const float* k_a = a.in[21] + l * 512;
        float ss = 0.f;
#pragma unroll
        for (int ct = 0; ct < 2; ++ct)
#pragma unroll
            for (int rg = 0; rg < 4; ++rg) { const int c0 = 64 * h + 32 * ct + 8 * rg + 4 * hi;
                const u32x2 kraw = *(const u32x2*)(zr + ZC_RK + c0); const f32x4 w04 = *(const f32x4*)(w0 + c0), a04 = *(const f32x4*)(a0 + c0), kk4 = *(const f32x4*)(k_k + c0);
                f32x4 dec; u32x2 gp; float gv[4];
#pragma unroll
                for (int i = 0; i < 4; ++i) { const int r = 4 * rg + i;
                    const float kv = (i < 2) ? __uint_as_float((i & 1) ? (kraw.x & 0xffff0000u) : (kraw.x << 16)) : __uint_as_float((i & 1) ? (kraw.y & 0xffff0000u) : (kraw.y << 16));
                    const float wr_ = w04[i] + aw[ct][r]; const float sp = fmaxf(-wr_, 0.f) + __logf(1.f + __expf(-fabsf(wr_)));
                    dec[i] = __expf(-__expf(-sp - 0.5f));
                    aa[ct][r] = sigmoid_f(a04[i] + aa[ct][r]);
                    gv[i] = ag[ct][r];
                    const float kkv = kv * kk4[i]; aw[ct][r] = kkv; ss += kkv * kkv; }
                *(f32x4*)(wd + c0) = dec;
                gp.x = pk2(gv[0], gv[1]); gp.y = pk2(gv[2], gv[3]);
                *(u32x2*)(zr + (c0 < 256 ? ZC_FV + c0 : ZC_MV + (c0 - 256))) = gp; __builtin_amdgcn_sched_barrier(0); }
        ss += __shfl_xor(ss, 32);
        const float inv = 1.f / fmaxf(sqrtf(ss), 1e-12f);
#pragma unroll
        for (int ct = 0; ct < 2; ++ct)
#pragma unroll
            for (int rg = 0; rg < 4; ++rg) { const int c0 = 64 * h + 32 * ct + 8 * rg + 4 * hi; const f32x4 ka4 = *(const f32x4*)(k_a + c0);
                const u32x2 kraw = *(const u32x2*)(zr + ZC_RK + c0); const float kf4[4] = {bf2f(kraw.x & 0xffff), __uint_as_float(kraw.x & 0xffff0000u), bf2f(kraw.y & 0xffff), __uint_as_float(kraw.y & 0xffff0000u)};
                float kk[4], ka[4], kp[4];
#pragma unroll
                for (int i = 0; i < 4; ++i) { const int r = 4 * rg + i; kk[i] = aw[ct][r] * inv; ka[i] = kk[i] * aa[ct][r]; kp[i] = kf4[i] * (1.f + (aa[ct][r] - 1.f) * ka4[i]); }
                u32x2 o; o.x = pk2(kk[0], kk[1]); o.y = pk2(kk[2], kk[3]); *(u32x2*)(kkp + c0) = o;
                o.x = pk2(ka[0], ka[1]); o.y = pk2(ka[2], ka[3]); *(u32x2*)(kap + c0) = o;
                o.x = pk2(kp[0], kp[1]); o.y = pk2(kp[2], kp[3]); *(u32x2*)(zr + ZC_RK + c0) = o; __builtin_amdgcn_sched_barrier(0); }
    }
    __syncthreads();
}

template <int MODE, int D>
DEV void attn_unit(LAS unsigned char* lds, const bf16_t* Qp, int ldq, const bf16_t* Kp, int ldk, const bf16_t* Vt, int ldv, bf16_t* Op, int ldo,
                   int q0, int ntiles, int qb, const float* aux, const float* qgain) {
    constexpr int KP = D + 8, KBYTES = 64 * KP * 2, VP = 72, VBYTES = D * VP * 2, NLD = D / 64;
    int tid_ = threadIdx.x; asm volatile("" : "+v"(tid_)); const int tid = tid_, lane = tid & 63, wid = __builtin_amdgcn_readfirstlane(tid >> 6), r32 = lane & 31, hi = lane >> 5;
    LAS float* cl = (LAS float*)lds; LAS unsigned* selm = (LAS unsigned*)(lds + 8192);
    LAS unsigned char* kb = lds + 16384; LAS unsigned char* vb = kb + 2 * KBYTES;
    const int q = q0 + wid * 32 + r32;
    if (MODE == 0) {
        const int n = 64 * ntiles; float v[8]; float run = 0.f;
#pragma unroll
        for (int i = 0; i < 8; ++i) { const int idx = 8 * tid + i; v[i] = idx < n ? aux[idx] : 0.f; run += v[i]; v[i] = run; }
        float sc = run;
#pragma unroll
        for (int o = 1; o < 64; o <<= 1) { const float t = __shfl_up(sc, o); if (lane >= o) sc += t; }
        LAS float* wsum = (LAS float*)kb;
        if (lane == 63) wsum[wid] = sc;
        __syncthreads();
        float off = sc - run;
        for (int w = 0; w < wid; ++w) off += wsum[w];
#pragma unroll
        for (int i = 0; i < 8; ++i) cl[8 * tid + i] = (off + v[i]) * LOG2E;
    }
    if (MODE == 1) {
        LAS float* km = cl;
        for (int e = tid; e < 16 * 64; e += 512) { const int nblk = e >> 6, d = e & 63; const float* pp = aux + (size_t)(4 * nblk) * 64 + d;
            km[e] = ((pp[0] + pp[64]) + (pp[128] + pp[192])) * (1.f / 256); }
        __syncthreads();
        if (tid < 256) { const bf16_t* qr = Qp + (size_t)(q0 + tid) * ldq; float g[16];
#pragma unroll
            for (int nb = 0; nb < 16; ++nb) g[nb] = 0.f;
            for (int c = 0; c < 8; ++c) { float qv[8]; unpack8(*(const u32x4*)(qr + 8 * c), qv);
#pragma unroll
                for (int nb = 0; nb < 16; ++nb) {
#pragma unroll
                    for (int i = 0; i < 8; ++i) g[nb] += qv[i] * km[nb * 64 + 8 * c + i]; } }
            unsigned m = 0u;
#pragma unroll
            for (int pick = 0; pick < 3; ++pick) { float best = -INFINITY; int bi = -1;
#pragma unroll
                for (int nb = 0; nb < 16; ++nb) { if (nb < qb && !((m >> nb) & 1u) && g[nb] > best) { best = g[nb]; bi = nb; } }
                if (bi >= 0) m |= 1u << bi; }
            selm[tid] = m; }
    }
    bf16x8 qf[D / 16];
#pragma unroll
    for (int d0 = 0; d0 < D / 16; ++d0) qf[d0] = *(const bf16x8*)(Qp + (size_t)q * ldq + d0 * 16 + hi * 8);
    if (MODE == 2) {
        float ss = 0.f;
#pragma unroll
        for (int d0 = 0; d0 < D / 16; ++d0) { float qv[8]; unpack8(__builtin_bit_cast(u32x4, qf[d0]), qv);
#pragma unroll
            for (int i = 0; i < 8; ++i) ss += qv[i] * qv[i]; }
        ss += __shfl_xor(ss, 32);
        const float rstd = rsqrtf(ss * (1.f / D) + NORM_EPS) * C2_128;
#pragma unroll
        for (int d0 = 0; d0 < D / 16; ++d0) { float qv[8]; unpack8(__builtin_bit_cast(u32x4, qf[d0]), qv);
#pragma unroll
            for (int i = 0; i < 8; ++i) qv[i] = qv[i] * rstd * qgain[d0 * 16 + hi * 8 + i];
            qf[d0] = __builtin_bit_cast(bf16x8, pack8(qv)); __builtin_amdgcn_sched_barrier(0); }
    }
    float mrun = -INFINITY, lrun = 0.f; f32x16 o[D / 32];
#pragma unroll
    for (int dt = 0; dt < D / 32; ++dt) o[dt] = f32x16{};
    __syncthreads();
    const float cq = (MODE == 0) ? cl[q] : 0.f;
    const unsigned sel = (MODE == 1) ? selm[wid * 32 + r32] : 0u;
    u32x4 kreg[NLD], vreg[NLD];
#define ATT_LOAD(t) do { _Pragma("unroll") for (int i_ = 0; i_ < NLD; ++i_) { const int idx_ = tid + 512 * i_; \
        kreg[i_] = *(const u32x4*)(Kp + (size_t)(64 * (t) + idx_ / (D / 8)) * ldk + (idx_ % (D / 8)) * 8); \
        vreg[i_] = *(const u32x4*)(Vt + (size_t)(idx_ >> 3) * ldv + 64 * (t) + (idx_ & 7) * 8); } } while (0)
#define ATT_STORE(buf) do { _Pragma("unroll") for (int i_ = 0; i_ < NLD; ++i_) { const int idx_ = tid + 512 * i_; \
        *(LAS u32x4*)(kb + (buf) * KBYTES + ((idx_ / (D / 8)) * KP + (idx_ % (D / 8)) * 8) * 2) = kreg[i_]; \
        *(LAS u32x4*)(vb + (buf) * VBYTES + ((idx_ >> 3) * VP + (idx_ & 7) * 8) * 2) = vreg[i_]; } } while (0)
    ATT_LOAD(0); ATT_STORE(0);
    __syncthreads();
    for (int t = 0; t < ntiles; ++t) {
        const int buf = t & 1, key0 = 64 * t;
        if (t + 1 < ntiles) ATT_LOAD(t + 1);
        bool work = true; const int nblk = key0 >> 8;
        if (MODE == 0) work = key0 <= q0 + wid * 32 + 31;
        if (MODE == 1) work = (nblk == qb) ? (key0 <= q0 + wid * 32 + 31) : (__any((sel >> nblk) & 1u) != 0);
        if (work) {
            const LAS unsigned char* kt = kb + buf * KBYTES; const LAS unsigned char* vt = vb + buf * VBYTES;
            constexpr int NKH = (D == 64) ? 2 : 1;
#pragma unroll 1
            for (int ks = 0; ks < 2 / NKH; ++ks) {
            f32x16 p[NKH];
#pragma unroll
            for (int kh = 0; kh < NKH; ++kh) { p[kh] = f32x16{}; const int khh = ks * NKH + kh;
#pragma unroll
                for (int d0 = 0; d0 < D / 16; ++d0) { const bf16x8 kf = *(const LAS bf16x8*)(kt + ((32 * khh + r32) * KP + 16 * d0 + 8 * hi) * 2);
                    p[kh] = __builtin_amdgcn_mfma_f32_32x32x16_bf16(kf, qf[d0], p[kh], 0, 0, 0); } }
            if (MODE == 0) {
#pragma unroll
                for (int kh = 0; kh < NKH; ++kh)
#pragma unroll
                    for (int rg = 0; rg < 4; ++rg) { const int kk0 = key0 + 32 * (ks * NKH + kh) + 8 * rg + 4 * hi; const f32x4 ck = *(const LAS f32x4*)(cl + kk0);
#pragma unroll
                        for (int i = 0; i < 4; ++i) { const float s = p[kh][4 * rg + i] + (cq - ck[i]); p[kh][4 * rg + i] = (kk0 + i > q) ? -INFINITY : s; } }
            }
            if (MODE == 1) {
                if (nblk == qb) {
#pragma unroll
                    for (int kh = 0; kh < NKH; ++kh)
#pragma unroll
                        for (int r = 0; r < 16; ++r) { if (key0 + 32 * (ks * NKH + kh) + crow(r, hi) > q) p[kh][r] = -INFINITY; }
                } else if (!((sel >> nblk) & 1u)) {
#pragma unroll
                    for (int kh = 0; kh < NKH; ++kh)
#pragma unroll
                        for (int r = 0; r < 16; ++r) p[kh][r] = -INFINITY;
                }
            }
            float mx = p[0][0];
#pragma unroll
            for (int kh = 0; kh < NKH; ++kh)
#pragma unroll
                for (int r = 0; r < 16; ++r) mx = fmaxf(mx, p[kh][r]);
            mx = fmaxf(mx, __shfl_xor(mx, 32));
            const float mnew = fmaxf(mrun, mx), muse = (mnew == -INFINITY) ? 0.f : mnew;
            const float alpha = __builtin_amdgcn_exp2f(mrun - muse);
            mrun = mnew; lrun *= alpha;
#pragma unroll
            for (int dt = 0; dt < D / 32; ++dt) o[dt] *= alpha;
            float ps = 0.f;
#pragma unroll
            for (int kh = 0; kh < NKH; ++kh)
#pragma unroll
                for (int r = 0; r < 16; ++r) { p[kh][r] = __builtin_amdgcn_exp2f(p[kh][r] - muse); ps += p[kh][r]; }
            lrun += ps;
            bf16x8 pb[NKH][2];
#pragma unroll
            for (int kh = 0; kh < NKH; ++kh)
#pragma unroll
                for (int j = 0; j < 2; ++j) { u32x4 w; w.x = pk2(p[kh][8 * j + 0], p[kh][8 * j + 1]); w.y = pk2(p[kh][8 * j + 2], p[kh][8 * j + 3]); w.z = pk2(p[kh][8 * j + 4], p[kh][8 * j + 5]); w.w = pk2(p[kh][8 * j + 6], p[kh][8 * j + 7]);
                    pb[kh][j] = __builtin_bit_cast(bf16x8, w); }
#pragma unroll
            for (int dt = 0; dt < D / 32; ++dt)
#pragma unroll
                for (int kh = 0; kh < NKH; ++kh)
#pragma unroll
                    for (int j = 0; j < 2; ++j) { const LAS unsigned char* vp_ = vt + ((32 * dt + r32) * VP + 32 * (ks * NKH + kh) + 16 * j + 4 * hi) * 2;
                        const u32x2 lo = *(const LAS u32x2*)vp_, hh = *(const LAS u32x2*)(vp_ + 16); u32x4 w; w.x = lo.x; w.y = lo.y; w.z = hh.x; w.w = hh.y;
                        o[dt] = __builtin_amdgcn_mfma_f32_32x32x16_bf16(__builtin_bit_cast(bf16x8, w), pb[kh][j], o[dt], 0, 0, 0); }
            }
        }
        if (t + 1 < ntiles) ATT_STORE(buf ^ 1);
        __syncthreads();
    }
#undef ATT_LOAD
#undef ATT_STORE
    lrun += __shfl_xor(lrun, 32);
    const float inv = 1.f / lrun;
    bf16_t* orow = Op + (size_t)q * ldo;
#pragma unroll
    for (int dt = 0; dt < D / 32; ++dt)
#pragma unroll
        for (int rg = 0; rg < 4; ++rg) { u32x2 w; w.x = pk2(o[dt][4 * rg] * inv, o[dt][4 * rg + 1] * inv); w.y = pk2(o[dt][4 * rg + 2] * inv, o[dt][4 * rg + 3] * inv);
            *(u32x2*)(orow + 32 * dt + 8 * rg + 4 * hi) = w; }
    __syncthreads();
}

struct RwOps { u32x8 w; u32x4 kk, ka, kp, r; };
#define RW_SLOAD(O, pw, pkk, pka, pkp, pr) asm volatile("s_load_dwordx8 %0, %5, 0x0 glc\n\ts_load_dwordx4 %1, %6, 0x0 glc\n\ts_load_dwordx4 %2, %7, 0x0 glc\n\ts_load_dwordx4 %3, %8, 0x0 glc\n\ts_load_dwordx4 %4, %9, 0x0 glc" \
    : "=&s"((O).w), "=&s"((O).kk), "=&s"((O).ka), "=&s"((O).kp), "=&s"((O).r) : "s"(pw), "s"(pkk), "s"(pka), "s"(pkp), "s"(pr) : "memory")
#define RW_SWAIT(O) asm volatile("s_waitcnt lgkmcnt(0)" : "+s"((O).w), "+s"((O).kk), "+s"((O).ka), "+s"((O).kp), "+s"((O).r) :: "memory")
DEV float bflo(unsigned x) { return __uint_as_float(x << 16); }
DEV float bfhi(unsigned x) { return __uint_as_float(x & 0xffff0000u); }
DEV unsigned long long uptr(const void* p) { const unsigned long long v = (unsigned long long)p;
    return ((unsigned long long)(unsigned)__builtin_amdgcn_readfirstlane((int)(v >> 32)) << 32) | (unsigned)__builtin_amdgcn_readfirstlane((int)v); }

DEV void rwkv_unit(const Args& a, int l, int b, int h, LAS unsigned char* lds) {
    int tid_ = threadIdx.x; asm volatile("" : "+v"(tid_)); const int tid = tid_, lane = tid & 63, k = __builtin_amdgcn_readfirstlane(tid >> 6);
    LAS float* sx = (LAS float*)lds;
    LAS float* yb = sx + 1024;
    const size_t rowb = (size_t)b * SEQ;
    bf16_t* Zb = (bf16_t*)(a.ws + WS_Z) + rowb * ZP;
    const unsigned long long pw0 = uptr((const float*)(a.ws + WS_WD) + rowb * 512 + h * 64 + 8 * k);
    const unsigned long long pkk0 = uptr((const bf16_t*)(a.ws + WS_KK) + rowb * 512 + h * 64 + 8 * k);
    const unsigned long long pka0 = uptr((const bf16_t*)(a.ws + WS_KA) + rowb * 512 + h * 64 + 8 * k);
    const unsigned long long pkp0 = uptr(Zb + ZC_RK + h * 64 + 8 * k);
    const unsigned long long pr0 = uptr(Zb + ZC_RR + h * 64 + 8 * k);
    const bf16_t* vp = Zb + ZC_RV + h * 64 + lane;
    const int cch = h * 64 + lane;
    const float lnw = a.in[23][l * 512 + cch], lnb = a.in[24][l * 512 + cch], rkk = a.in[22][l * 512 + cch];
    const int gcol = cch < 256 ? ZC_FV + cch : ZC_MV + (cch - 256);
    float s[8];
#pragma unroll
    for (int j = 0; j < 8; ++j) s[j] = 0.f;
    RwOps oa, ob;
#define RW_ISSUE(O, t) RW_SLOAD(O, pw0 + (unsigned long long)(t) * 2048ull, pkk0 + (unsigned long long)(t) * 1024ull, pka0 + (unsigned long long)(t) * 1024ull, pkp0 + (unsigned long long)(t) * (ZP * 2ull), pr0 + (unsigned long long)(t) * (ZP * 2ull))
#define RW_STEP(O, ON, t) do { \
        RW_SWAIT(O); \
        const float kk_[8] = {bflo((O).kk.x), bfhi((O).kk.x), bflo((O).kk.y), bfhi((O).kk.y), bflo((O).kk.z), bfhi((O).kk.z), bflo((O).kk.w), bfhi((O).kk.w)}; \
        float ps_ = 0.f; _Pragma("unroll") for (int j = 0; j < 8; ++j) ps_ = fmaf(s[j], kk_[j], ps_); \
        sx[((t) & 1) * 512 + k * 64 + lane] = ps_; \
        const float vt_ = bf2f(vraw); vraw = vp[(size_t)(((t) + 1 < SEQ) ? (t) + 1 : (t)) * ZP]; \
        asm volatile("s_waitcnt lgkmcnt(0)\n\ts_barrier" ::: "memory"); \
        float sa_ = 0.f; _Pragma("unroll") for (int k2 = 0; k2 < 8; ++k2) sa_ += sx[((t) & 1) * 512 + k2 * 64 + lane]; \
        sa_ = -sa_; asm volatile("s_waitcnt lgkmcnt(0)" : "+v"(sa_) :: "memory"); \
        RW_ISSUE(ON, ((t) + 1 < SEQ) ? (t) + 1 : (t)); \
        const float w_[8] = {__uint_as_float((O).w[0]), __uint_as_float((O).w[1]), __uint_as_float((O).w[2]), __uint_as_float((O).w[3]), __uint_as_float((O).w[4]), __uint_as_float((O).w[5]), __uint_as_float((O).w[6]), __uint_as_float((O).w[7])}; \
        const float ka_[8] = {bflo((O).ka.x), bfhi((O).ka.x), bflo((O).ka.y), bfhi((O).ka.y), bflo((O).ka.z), bfhi((O).ka.z), bflo((O).ka.w), bfhi((O).ka.w)}; \
        const float kp_[8] = {bflo((O).kp.x), bfhi((O).kp.x), bflo((O).kp.y), bfhi((O).kp.y), bflo((O).kp.z), bfhi((O).kp.z), bflo((O).kp.w), bfhi((O).kp.w)}; \
        const float r_[8] = {bflo((O).r.x), bfhi((O).r.x), bflo((O).r.y), bfhi((O).r.y), bflo((O).r.z), bfhi((O).r.z), bflo((O).r.w), bfhi((O).r.w)}; \
        float py_ = 0.f; \
        _Pragma("unroll") for (int j = 0; j < 8; ++j) { s[j] = fmaf(vt_, kp_[j], fmaf(sa_, ka_[j], s[j] * w_[j])); py_ = fmaf(s[j], r_[j], py_); } \
        yb[((t) & 15) * 512 + k * 64 + lane] = py_; \
    } while (0)
    RW_ISSUE(oa, 0);
    unsigned short vraw = vp[0];
    for (int tc = 0; tc < SEQ / 16; ++tc) {
        const int tb = tc * 16;
#pragma unroll 1
        for (int t2 = 0; t2 < 16; t2 += 2) { RW_STEP(oa, ob, tb + t2); RW_STEP(ob, oa, tb + t2 + 1); }
        RW_SWAIT(oa);
        asm volatile("s_waitcnt lgkmcnt(0)\n\ts_barrier" ::: "memory");
#pragma unroll
        for (int e = 0; e < 2; ++e) {
            const int tt = 2 * k + e, t = tb + tt; float y = 0.f;
#pragma unroll
            for (int k2 = 0; k2 < 8; ++k2) y += yb[tt * 512 + k2 * 64 + lane];
            bf16_t* zr = Zb + (size_t)t * ZP;
            const float rv = bf2f(zr[ZC_RR + cch]), kv = bf2f(zr[ZC_RK + cch]), vv = bf2f(zr[ZC_RV + cch]), gv = bf2f(zr[gcol]);
            const float mean = wave_sum(y) * (1.f / 64); const float d = y - mean; const float var = wave_sum(d * d) * (1.f / 64);
            const float bonus = wave_sum(rv * kv * rkk) * vv;
            const float outv = (d * rsqrtf(var + GN_EPS) * lnw + lnb + bonus) * gv;
            zr[ZC_RR + cch] = (bf16_t)f2bf(outv);
        }
        asm volatile("s_waitcnt lgkmcnt(0)\n\ts_barrier" ::: "memory");
    }
#undef RW_STEP
#undef RW_ISSUE
}

constexpr int N_PHASES = 1 + 15 * NL;
#ifndef PHMASK
#define PHMASK 0xFFFF
#endif
#define PHON(k) ((PHMASK >> (k)) & 1)
__global__ void __launch_bounds__(512, 2) fwd_megakernel(Args a) {
    extern __shared__ __attribute__((aligned(16))) unsigned char lds_raw[];
    LAS unsigned char* lds = (LAS unsigned char*)lds_raw;
    cg::grid_group grid = cg::this_grid();
    const int G = gridDim.x, bid = blockIdx.x, NGW = G * 8;
    unsigned char* ws = a.ws;
    bf16_t* HN = (bf16_t*)(ws + WS_HN); bf16_t* Z = (bf16_t*)(ws + WS_Z); bf16_t* HID = Z; bf16_t* QX = Z;
    for (int ph = a.ph_lo; ph < a.ph_hi; ++ph) {
        if (ph > a.ph_lo) grid.sync();
        int tidp = threadIdx.x; asm volatile("" : "+v"(tidp)); const int tid = tidp, lane = tid & 63, wid = __builtin_amdgcn_readfirstlane(tid >> 6), gw = bid * 8 + wid;
        if (ph == 0) { if (PHON(15)) p0_prologue(a, lds, gw, NGW, wid, lane, tid); continue; }
        const int l = (ph - 1) / 15, kind = (ph - 1) % 15;
        const unsigned char* wl = ws + WS_W + (size_t)l * WL_BYTES;
        if (PHON(0) && (kind == 0 || kind == 3 || kind == 8 || kind == 12)) {
            const float* src = (l == 0 && kind == 0) ? a.in[0] : a.out;
            const float* g = (kind == 0 ? a.in[3] : kind == 3 ? a.in[6] : kind == 8 ? a.in[25] : a.in[32]) + l * DM;
            norm_phase(src, g, HN, TOK, gw, NGW, lane);
            if (l == 0 && kind == 3) xkv_post(a, gw, NGW, lane);
        }
        if (PHON(1) && (kind == 1 || kind == 13)) {
            pg8::Gemm g{HN, (const bf16_t*)(wl + (kind == 1 ? OFF_F1I : OFF_F2I)), TOK, 2 * FF, DM, DM};
            pg8::StaticOrder S; S.init(TOK, 2 * FF, G, bid);
            pg8::EpiSwiglu E{HID, FF};
            pg8::gemm_phase<pg8::EpiSwiglu, pg8::StaticOrder, true, true>(lds, g, S, E);
        }
        if (PHON(2) && (kind == 2 || kind == 14 || kind == 7 || kind == 11)) {
            pg8::Gemm g; pg8::EpiResid E; E.out = a.out; E.ldc = DM; g.M = TOK; g.N = DM;
            if (kind == 2 || kind == 14) { g.A = HID; g.lda = FF; g.K = FF; g.Bt = (const bf16_t*)(wl + (kind == 2 ? OFF_F1O : OFF_F2O)); E.scale = 0.5f; E.base = (l == 0 && kind == 2) ? a.in[0] : a.out; }
            else if (kind == 7) { g.A = Z; g.lda = ZP; g.K = DM; g.Bt = (const bf16_t*)(wl + OFF_MO); E.scale = 1.f; E.base = a.out; }
            else { g.A = QX; g.lda = 512; g.K = 512; g.Bt = (const bf16_t*)(wl + OFF_XO); E.scale = 1.f; E.base = a.out; }
            pg8::StaticOrder S; S.init(TOK, DM, G, bid);
            pg8::gemm_phase<pg8::EpiResid, pg8::StaticOrder, true, true>(lds, g, S, E);
        }
        if (PHON(4) && (kind == 4 || kind == 9 || (kind == 0 && l == 0))) {
            const int ng = (kind == 0) ? NL : 1;
            for (int gi = 0; gi < ng; ++gi) {
                pg8::Gemm g; pg8::EpiBf16 E; int cidx = bid;
                if (kind == 4) { g.A = HN; g.lda = DM; g.K = DM; g.M = TOK; g.N = 3584; g.Bt = (const bf16_t*)(wl + OFF_MI); E.O = Z; E.ldc = ZP; E.ncols = ZC_VALID; E.halo = (bf16_t*)(ws + WS_ZHALO); }
                else if (kind == 9) { g.A = HN; g.lda = DM; g.K = DM; g.M = TOK; g.N = 512; g.Bt = (const bf16_t*)(wl + OFF_XQ); E.O = QX; E.ldc = 512; E.ncols = 512; E.halo = nullptr; }
                else { g.A = (const bf16_t*)(ws + WS_MEMN) + (size_t)gi * NB * MEMLEN * DM; g.lda = DM; g.K = DM; g.M = NB * MEMLEN; g.N = 1024;
                       g.Bt = (const bf16_t*)(ws + WS_W + (size_t)gi * WL_BYTES + OFF_XKV); E.O = (bf16_t*)(ws + WS_KVX) + (size_t)gi * NB * MEMLEN * 1024; E.ldc = 1024; E.ncols = 1024; E.halo = nullptr;
                       cidx = (bid + gi * (G / 2)) % G; }
                pg8::StaticOrder S; S.init(g.M, g.N, G, cidx);
                pg8::gemm_phase<pg8::EpiBf16, pg8::StaticOrder, true, true>(lds, g, S, E);
            }
        }
        if (PHON(5) && kind == 5) { for (int tile = bid; tile < TOK / 64; tile += G) prep_tile(a, l, tile, lds); }
        if (PHON(6) && kind == 6) {
            unsigned* ctr = (unsigned*)(ws + WS_CTL) + 64 * (1 + l); LAS unsigned* qw = (LAS unsigned*)(lds + 131072);
            for (;;) {
                __syncthreads();
                if (tid == 0) *qw = atomicAdd(ctr, 1u);
                __syncthreads();
                const int item = (int)*qw;
                if (item >= 64 + 1024) break;
                if (item < 64) { if (PHON(7)) rwkv_unit(a, l, item >> 3, item & 7, lds); }
                else {
                    const int j = item - 64, qb = 15 - (j >> 6), kk = j & 63, type = kk >> 5, bh = kk & 31, b = bh >> 2, h = bh & 3;
                    bf16_t* Zb = Z + (size_t)b * SEQ * ZP;
                    if (type == 0) { if (PHON(8)) attn_unit<0, 64>(lds, Zb + ZC_FQ + 64 * h, ZP, Zb + ZC_FK + 64 * h, ZP, (const bf16_t*)(ws + WS_VTF) + (size_t)bh * 64 * SEQ, SEQ, Zb + ZC_FQ + 64 * h, ZP,
                                                   256 * qb, 4 * (qb + 1), qb, (const float*)(ws + WS_LOGF) + (size_t)bh * SEQ, nullptr); }
                    else if (PHON(9)) attn_unit<1, 64>(lds, Zb + ZC_MQ + 64 * h, ZP, Zb + ZC_MK + 64 * h, ZP, (const bf16_t*)(ws + WS_VTM) + (size_t)bh * 64 * SEQ, SEQ, Zb + ZC_MQ + 64 * h, ZP,
                                          256 * qb, 4 * (qb + 1), qb, (const float*)(ws + WS_KMP) + (size_t)bh * 64 * 64, nullptr);
                }
            }
        }
        if (PHON(10) && kind == 10) {
            for (int u = bid; u < NB * 4 * 16; u += G) { const int b = u >> 6, hd = (u >> 4) & 3, qb = u & 15;
                bf16_t* qp = QX + (size_t)b * SEQ * 512 + hd * 128;
                attn_unit<2, 128>(lds, qp, 512, (const bf16_t*)(ws + WS_KVX) + ((size_t)l * NB + b) * MEMLEN * 1024 + hd * 128, 1024,
                                  (const bf16_t*)(ws + WS_VTX) + ((size_t)(l * NB + b) * 4 + hd) * 128 * MEMLEN, MEMLEN, qp, 512, 256 * qb, MEMLEN / 64, qb, nullptr, a.in[29] + l * 128); }
        }
    }
}

#ifndef MK_MULTI
#define MK_MULTI 0
#endif
extern "C" void kernel_launch(void* const* d_in, const int* in_sizes, int n_in, void* d_out, int out_size, void* d_ws, size_t ws_size, hipStream_t stream) {
    static int grid_blocks = 0;
    if (grid_blocks == 0) {
        if (n_in != 35 || ws_size < WS_END) { fprintf(stderr, "kernel_launch: unexpected n_in %d / ws %zu\n", n_in, ws_size); grid_blocks = -1; return; }
        int dev = 0, cus = 0, per_cu = 0;
        hipGetDevice(&dev); hipDeviceGetAttribute(&cus, hipDeviceAttributeMultiprocessorCount, dev);
        if (hipFuncSetAttribute((const void*)fwd_megakernel, hipFuncAttributeMaxDynamicSharedMemorySize, LDS_BYTES) != hipSuccess) { fprintf(stderr, "kernel_launch: hipFuncSetAttribute failed\n"); grid_blocks = -1; return; }
        if (hipOccupancyMaxActiveBlocksPerMultiprocessor(&per_cu, (const void*)fwd_megakernel, 512, LDS_BYTES) != hipSuccess || per_cu < 1) { fprintf(stderr, "kernel_launch: occupancy query says %d\n", per_cu); per_cu = 1; }
        (void)hipGetLastError();
        grid_blocks = cus * per_cu;
    }
    if (grid_blocks < 0) return;
    Args a{};
    for (int i = 0; i < 35; ++i) a.in[i] = (const float*)d_in[i];
    a.out = (float*)d_out; a.ws = (unsigned char*)d_ws;
#if MK_MULTI
    for (int ph = 0; ph < N_PHASES; ++ph) { a.ph_lo = ph; a.ph_hi = ph + 1; hipLaunchKernelGGL(fwd_megakernel, dim3(grid_blocks), dim3(512), LDS_BYTES, stream, a); }
#else
    a.ph_lo = 0; a.ph_hi = N_PHASES;
    void* args[] = {&a};
    hipError_t e = hipLaunchCooperativeKernel((const void*)fwd_megakernel, dim3(grid_blocks), dim3(512), args, LDS_BYTES, stream);
    if (e != hipSuccess) fprintf(stderr, "cooperative launch failed: %s (grid %d)\n", hipGetErrorString(e), grid_blocks);
#endif
}
```

```cpp
#include <hip/hip_runtime.h>
#include <hip/hip_cooperative_groups.h>
#include <cstdio>
#include <cstdint>
namespace cg = cooperative_groups;
namespace pg8 {
#define PG8_LAS __attribute__((address_space(3)))
typedef unsigned short bf16_t;
typedef short bf16x8 __attribute__((ext_vector_type(8)));
typedef float f32x4 __attribute__((ext_vector_type(4)));
typedef unsigned u32x4 __attribute__((ext_vector_type(4)));
constexpr int BM = 256, BK = 64, HALF = 128, HTB = HALF * BK * 2  , STAGE_BYTES = 8 * HTB, NXCD = 8, WGM = 8;

__host__ __device__ __forceinline__ int lds_byte(int r, int c) { const int st = (r >> 4) * 2 + (c >> 5), rr = r & 15, cc = c & 31, ob = rr * 64 + cc * 2; return st * 1024 + (ob ^ (((ob >> 9) & 1) << 5)); }
__host__ __device__ __forceinline__ void stage_rc(int b, int& R, int& C) { const int st = b / 1024, sb = b % 1024, swz = sb ^ (((sb >> 9) & 1) << 5); R = (st >> 1) * 16 + swz / 64; C = (st & 1) * 32 + (swz % 64) / 2; }
__host__ __device__ __forceinline__ int perm32(int rho) { const int n = rho >> 4, i = rho & 15; return 8 * (i >> 2) + 4 * n + (i & 3); }

struct Unit { int pm, pn; };
struct Gemm { const bf16_t* A; const bf16_t* Bt; int M, N, K, lda; };

struct StaticOrder {
    int nM, nN, nwg, G, c;
    __host__ __device__ void init(int M, int N, int G_, int c_) { nM = M / BM; nN = N / BM; nwg = nM * nN; G = G_; c = c_; }
    __host__ __device__ bool next(int i, Unit& u) const {
        const long L = (long)i * G + c; if (L >= nwg) return false;
        int wgid = (int)L; { const int q = nwg / NXCD, r = nwg % NXCD, xcd = wgid % NXCD, off = wgid / NXCD; wgid = (xcd < r ? xcd * (q + 1) : r * (q + 1) + (xcd - r) * q) + off; }
        const int nig = WGM * nN, gid = wgid / nig, fm = gid * WGM, gsz = (nM - fm) < WGM ? (nM - fm) : WGM;
        u.pm = fm + ((wgid % nig) % gsz); u.pn = (wgid % nig) / gsz; return true;
    }
    __device__ __forceinline__ void a_ready(const Unit&) const {}
    __device__ __forceinline__ void done(const Unit&) const {}
};
__device__ __forceinline__ unsigned cvt_pk_bf16(float lo, float hi) { unsigned r; asm volatile("v_cvt_pk_bf16_f32 %0, %1, %2" : "=v"(r) : "v"(lo), "v"(hi)); return r; }
__device__ __forceinline__ float silu_f(float x) { return x * __builtin_amdgcn_rcpf(1.0f + __builtin_amdgcn_exp2f(-1.4426950408889634f * x)); }
__device__ __forceinline__ float row_rstd(const float* ssq, int row) { const f32x4* p = (const f32x4*)(ssq + (size_t)row * 16); const f32x4 s = (p[0] + p[1]) + (p[2] + p[3]);
    return __builtin_amdgcn_rsqf(((s[0] + s[1]) + (s[2] + s[3])) * (1.0f / 1024.0f) + 1e-6f); }
struct EpiSwiglu {
    static constexpr bool PERM = true, AFTER_DRAIN = false;
    bf16_t* O; int ldc; const float* ssq;
    __device__ __forceinline__ void operator()(const f32x4 (&acc)[2][2][4][2], const Unit& u, int wr, int wc, int fr, int fq) const {
        const int row0 = u.pm * BM + wr * 64 + fr, col0 = u.pn * HALF + wc * 32 + 8 * fq;
#pragma unroll
        for (int ai = 0; ai < 2; ++ai)
#pragma unroll
            for (int m = 0; m < 4; ++m) {
                const float rs = row_rstd(ssq, row0 + ai * HALF + m * 16);
                const f32x4 g0 = acc[ai][0][m][0] * rs, g1 = acc[ai][0][m][1] * rs, u0 = acc[ai][1][m][0] * rs, u1 = acc[ai][1][m][1] * rs;
                u32x4 w;
                w.x = cvt_pk_bf16(silu_f(g0[0]) * u0[0], silu_f(g0[1]) * u0[1]); w.y = cvt_pk_bf16(silu_f(g0[2]) * u0[2], silu_f(g0[3]) * u0[3]);
                w.z = cvt_pk_bf16(silu_f(g1[0]) * u1[0], silu_f(g1[1]) * u1[1]); w.w = cvt_pk_bf16(silu_f(g1[2]) * u1[2], silu_f(g1[3]) * u1[3]);
                *(u32x4*)(O + (size_t)(row0 + ai * HALF + m * 16) * ldc + col0) = w;
            }
    }
};
struct EpiResid {
    static constexpr bool PERM = false, AFTER_DRAIN = false;
    const float* base; float* out; int ldc; float scale;
    bf16_t* hn; const float* gn; float* ssq;
    __device__ __forceinline__ void operator()(const f32x4 (&acc)[2][2][4][2], const Unit& u, int wr, int wc, int fr, int fq) const {
        const int row0 = u.pm * BM + wr * 64 + fr, col0 = u.pn * BM + wc * 32 + 4 * fq;
#pragma unroll
        for (int ai = 0; ai < 2; ++ai)
#pragma unroll
            for (int m = 0; m < 4; ++m) { const int row = row0 + ai * HALF + m * 16; const size_t off = (size_t)row * ldc + col0; float ss = 0.f;
#pragma unroll
                for (int bj = 0; bj < 2; ++bj)
#pragma unroll
                    for (int n = 0; n < 2; ++n) { const f32x4 b = *(const f32x4*)(base + off + bj * HALF + n * 16); const f32x4 v = b + acc[ai][bj][m][n] * scale; *(f32x4*)(out + off + bj * HALF + n * 16) = v;
                        if (hn) { const f32x4 g4 = *(const f32x4*)(gn + col0 + bj * HALF + n * 16); ss += (v[0] * v[0] + v[1] * v[1]) + (v[2] * v[2] + v[3] * v[3]);
                            const f32x4 vg = v * g4; typedef unsigned u32x2_ __attribute__((ext_vector_type(2))); u32x2_ w; w.x = cvt_pk_bf16(vg[0], vg[1]); w.y = cvt_pk_bf16(vg[2], vg[3]); *(u32x2_*)(hn + off + bj * HALF + n * 16) = w; } }
                if (hn) { ss += __shfl_xor(ss, 16); ss += __shfl_xor(ss, 32); if (fq == 0) ssq[(size_t)row * 16 + u.pn * 4 + wc] = ss; }
                asm volatile("" ::: "memory"); }
    }
};
struct EpiBf16 {
    static constexpr bool PERM = true, AFTER_DRAIN = false;
    bf16_t* O; int ldc; int ncols; bf16_t* halo; const float* ssq;
    __device__ __forceinline__ void operator()(const f32x4 (&acc)[2][2][4][2], const Unit& u, int wr, int wc, int fr, int fq) const {
        const int row0 = u.pm * BM + wr * 64 + fr, col0 = u.pn * BM + wc * 32 + 8 * fq;
#pragma unroll
        for (int ai = 0; ai < 2; ++ai)
#pragma unroll
            for (int m = 0; m < 4; ++m) { const int row = row0 + ai * HALF + m * 16; const float rs = ssq ? row_rstd(ssq, row) : 1.0f;
#pragma unroll
                for (int bj = 0; bj < 2; ++bj) { const int col = col0 + bj * HALF;
                    if (col < ncols) { const f32x4 v0 = acc[ai][bj][m][0] * rs, v1 = acc[ai][bj][m][1] * rs; u32x4 w;
                        w.x = cvt_pk_bf16(v0[0], v0[1]); w.y = cvt_pk_bf16(v0[2], v0[3]); w.z = cvt_pk_bf16(v1[0], v1[1]); w.w = cvt_pk_bf16(v1[2], v1[3]);
                        *(u32x4*)(O + (size_t)row * ldc + col) = w;
                        if (halo && (row & 63) == 63) *(u32x4*)(halo + (size_t)(row >> 6) * ldc + col) = w; } } }
    }
};
template <class Epi, class Sched, bool ALIGN_EPI = false, bool SP2 = false>
__device__ __forceinline__ void gemm_phase(PG8_LAS unsigned char* lds, const Gemm g, const Sched& S, const Epi& E) {
    int tid_ = threadIdx.x; asm volatile("" : "+v"(tid_)); const int tid = tid_, wid = __builtin_amdgcn_readfirstlane(tid >> 6), lane = tid & 63, wr = wid >> 2, wc = wid & 3, fr = lane & 15, fq = lane >> 4;
    const int K = g.K, nt = K / BK;
    unsigned voffA[2], voffB[2];
#pragma unroll
    for (int i = 0; i < 2; ++i) { int R, C; stage_rc(tid * 16 + i * 8192, R, C); const int Rb = Epi::PERM ? ((R & ~31) + perm32(R & 31)) : R;
        voffA[i] = (unsigned)(R * g.lda + C) * 2u; voffB[i] = (unsigned)(Rb * K + C) * 2u; }
    const size_t kstep = (size_t)(BK * 2);
    const size_t hstep = (size_t)HALF * K * 2;
    const size_t tstep = 2 * hstep; const size_t hstepA = (size_t)HALF * g.lda * 2, tstepA = 2 * hstepA;
    const unsigned ldsw = (unsigned)wid * 1024u;
    const int aoff = lds_byte(wr * 64 + fr, fq * 8), boff = lds_byte(wc * 32 + fr, fq * 8);
#define PG8_SA(b, h) (((b) * 2 + (h)) * HTB)
#define PG8_SB(b, h) ((4 + (b) * 2 + (h)) * HTB)
#define PG8_STAGE(bufoff, gbase, voff) do { _Pragma("unroll") for (int _i = 0; _i < 2; ++_i) \
        __builtin_amdgcn_global_load_lds((const unsigned*)((const char*)(gbase) + (voff)[_i]), (PG8_LAS unsigned*)(lds + (bufoff) + ldsw + _i * 8192), 16, 0, 0); } while (0)
#define PG8_LDA(dst, b, h) do { _Pragma("unroll") for (int m = 0; m < 4; ++m) _Pragma("unroll") for (int k = 0; k < 2; ++k) dst[m][k] = *(const PG8_LAS bf16x8*)(lds + PG8_SA(b, h) + aoff + m * 2048 + k * 1024); } while (0)
#define PG8_LDB(dst, b, h) do { _Pragma("unroll") for (int n = 0; n < 2; ++n) _Pragma("unroll") for (int k = 0; k < 2; ++k) dst[n][k] = *(const PG8_LAS bf16x8*)(lds + PG8_SB(b, h) + boff + n * 2048 + k * 1024); } while (0)
#define PG8_MMA(ai, bj, At, Bt) do { __builtin_amdgcn_s_setprio(1); _Pragma("unroll") for (int m = 0; m < 4; ++m) _Pragma("unroll") for (int n = 0; n < 2; ++n) _Pragma("unroll") for (int k = 0; k < 2; ++k) \
        acc[ai][bj][m][n] = __builtin_amdgcn_mfma_f32_16x16x32_bf16(Bt[n][k], At[m][k], acc[ai][bj][m][n], 0, 0, 0); __builtin_amdgcn_s_setprio(0); } while (0)
#define PG8_WAIT_V(n) asm volatile("s_waitcnt vmcnt(" #n ")" ::: "memory")
#define PG8_WAIT_L(n) asm volatile("s_waitcnt lgkmcnt(" #n ")" ::: "memory")
#define PG8_BAR __builtin_amdgcn_s_barrier()
#define PG8_SCHED __builtin_amdgcn_sched_barrier(0)
    Unit cur, nxt; int ui = 0;
    if (!S.next(0, cur)) return;
    f32x4 acc[2][2][4][2];
#pragma unroll
    for (int a = 0; a < 2; ++a)
#pragma unroll
        for (int b = 0; b < 2; ++b)
#pragma unroll
            for (int m = 0; m < 4; ++m)
#pragma unroll
                for (int n = 0; n < 2; ++n) acc[a][b][m][n] = (f32x4){0.f, 0.f, 0.f, 0.f};
    bf16x8 At[4][2], B0[2][2], B1[2][2];
    const char* cA = (const char*)g.A + (size_t)cur.pm * tstepA; const char* cB = (const char*)g.Bt + (size_t)cur.pn * tstep;
    S.a_ready(cur);
    if constexpr (SP2) {
        PG8_STAGE(PG8_SB(0, 0), cB, voffB); PG8_STAGE(PG8_SB(0, 1), cB + hstep, voffB); PG8_STAGE(PG8_SA(0, 0), cA, voffA); PG8_STAGE(PG8_SA(0, 1), cA + hstepA, voffA);
        if (wr == 1) PG8_BAR;
        PG8_WAIT_V(2); PG8_BAR;
        PG8_STAGE(PG8_SB(1, 0), cB + kstep, voffB); PG8_STAGE(PG8_SA(1, 0), cA + kstep, voffA); PG8_STAGE(PG8_SB(1, 1), cB + hstep + kstep, voffB);
        PG8_WAIT_V(6); PG8_BAR;
    } else {
        PG8_STAGE(PG8_SB(0, 0), cB, voffB); PG8_STAGE(PG8_SA(0, 0), cA, voffA); PG8_STAGE(PG8_SB(0, 1), cB + hstep, voffB); PG8_STAGE(PG8_SA(0, 1), cA + hstepA, voffA);
        if (wr == 1) PG8_BAR;
        PG8_WAIT_V(4); PG8_BAR;
        PG8_STAGE(PG8_SB(1, 0), cB + kstep, voffB); PG8_STAGE(PG8_SA(1, 0), cA + kstep, voffA); PG8_STAGE(PG8_SB(1, 1), cB + hstep + kstep, voffB);
        PG8_WAIT_V(6); PG8_BAR;
    }
    for (;;) {
        const bool has_next = S.next(ui + 1, nxt);
        const char* nA = has_next ? (const char*)g.A + (size_t)nxt.pm * tstepA : cA; const char* nB = has_next ? (const char*)g.Bt + (size_t)nxt.pn * tstep : cB;
        for (int t = 0; t < nt; t += 2) {
            const bool last = (t == nt - 2);
            const char* a1 = cA + (size_t)(t + 1) * kstep;
            const char* a2 = last ? nA : cA + (size_t)(t + 2) * kstep; const char* b2 = last ? nB : cB + (size_t)(t + 2) * kstep;
            const char* a3 = a2 + kstep; const char* b3 = b2 + kstep;
            if (last && has_next) S.a_ready(nxt);
            if constexpr (SP2) {
            PG8_LDB(B0, 0, 0); PG8_LDB(B1, 0, 1); PG8_SCHED; PG8_LDA(At, 0, 0); PG8_STAGE(PG8_SA(1, 1), a1 + hstepA, voffA);
            PG8_WAIT_V(8); PG8_WAIT_L(0); PG8_BAR; PG8_MMA(0, 0, At, B0); PG8_MMA(0, 1, At, B1); PG8_BAR; PG8_SCHED;
            PG8_LDA(At, 0, 1); PG8_STAGE(PG8_SB(0, 0), b2, voffB); PG8_STAGE(PG8_SB(0, 1), b2 + hstep, voffB); PG8_STAGE(PG8_SA(0, 0), a2, voffA);
            PG8_WAIT_V(8); PG8_WAIT_L(0); PG8_BAR; PG8_MMA(1, 0, At, B0); PG8_MMA(1, 1, At, B1); PG8_BAR; PG8_SCHED;
            PG8_LDB(B0, 1, 0); PG8_LDB(B1, 1, 1); PG8_SCHED; PG8_LDA(At, 1, 0); PG8_STAGE(PG8_SA(0, 1), a2 + hstepA, voffA);
            PG8_WAIT_V(8); PG8_WAIT_L(0); PG8_BAR; PG8_MMA(0, 0, At, B0); PG8_MMA(0, 1, At, B1); PG8_BAR; PG8_SCHED;
            PG8_LDA(At, 1, 1); PG8_STAGE(PG8_SB(1, 0), b3, voffB); PG8_STAGE(PG8_SB(1, 1), b3 + hstep, voffB); PG8_STAGE(PG8_SA(1, 0), a3, voffA);
            PG8_WAIT_V(8); PG8_WAIT_L(0); PG8_BAR; PG8_MMA(1, 0, At, B0); PG8_MMA(1, 1, At, B1); PG8_BAR; PG8_SCHED;
            } else {
            PG8_LDB(B0, 0, 0); PG8_SCHED; PG8_LDA(At, 0, 0); PG8_STAGE(PG8_SA(1, 1), a1 + hstepA, voffA);
            PG8_WAIT_L(8); PG8_BAR; PG8_WAIT_L(0); PG8_MMA(0, 0, At, B0); PG8_BAR; PG8_SCHED;
            PG8_LDB(B1, 0, 1); PG8_STAGE(PG8_SB(0, 0), b2, voffB);
            PG8_BAR; PG8_WAIT_L(0); PG8_MMA(0, 1, At, B1); PG8_BAR;
            PG8_LDA(At, 0, 1); PG8_STAGE(PG8_SA(0, 0), a2, voffA);
            PG8_BAR; PG8_WAIT_L(0); PG8_MMA(1, 0, At, B0); PG8_BAR; PG8_SCHED;
            PG8_STAGE(PG8_SB(0, 1), b2 + hstep, voffB);
            PG8_WAIT_V(6); PG8_BAR; PG8_MMA(1, 1, At, B1); PG8_BAR;
            PG8_LDB(B0, 1, 0); PG8_SCHED; PG8_LDA(At, 1, 0); PG8_STAGE(PG8_SA(0, 1), a2 + hstepA, voffA);
            PG8_WAIT_L(8); PG8_BAR; PG8_WAIT_L(0); PG8_MMA(0, 0, At, B0); PG8_BAR; PG8_SCHED;
            PG8_LDB(B1, 1, 1); PG8_STAGE(PG8_SB(1, 0), b3, voffB);
            PG8_BAR; PG8_WAIT_L(0); PG8_MMA(0, 1, At, B1); PG8_BAR;
            PG8_LDA(At, 1, 1); PG8_STAGE(PG8_SA(1, 0), a3, voffA);
            PG8_BAR; PG8_WAIT_L(0); PG8_MMA(1, 0, At, B0); PG8_BAR; PG8_SCHED;
            PG8_STAGE(PG8_SB(1, 1), b3 + hstep, voffB);
            PG8_WAIT_V(6); PG8_BAR; PG8_MMA(1, 1, At, B1); PG8_BAR;
            }
        }
        if constexpr (ALIGN_EPI) { if (wr == 0) PG8_BAR; }
        if constexpr (!Epi::AFTER_DRAIN) { E(acc, cur, wr, wc, fr, fq); S.done(cur); }
        if (!has_next) break;
#pragma unroll
        for (int a = 0; a < 2; ++a)
#pragma unroll
            for (int b = 0; b < 2; ++b)
#pragma unroll
                for (int m = 0; m < 4; ++m)
#pragma unroll
                    for (int n = 0; n < 2; ++n) acc[a][b][m][n] = (f32x4){0.f, 0.f, 0.f, 0.f};
        cur = nxt; cA = nA; cB = nB; ++ui;
        if constexpr (ALIGN_EPI) { if (wr == 1) PG8_BAR; }
    }
    PG8_WAIT_V(0);
    if constexpr (!ALIGN_EPI) { if (wr == 0) PG8_BAR; }
    PG8_BAR;
    if constexpr (Epi::AFTER_DRAIN) { E.fused(acc, cur, wr, wc, fr, fq, lds, wid, lane); S.done(cur); }
#undef PG8_SA
#undef PG8_SB
#undef PG8_STAGE
#undef PG8_LDA
#undef PG8_LDB
#undef PG8_MMA
#undef PG8_WAIT_V
#undef PG8_WAIT_L
#undef PG8_BAR
#undef PG8_SCHED
}
}

#define LAS __attribute__((address_space(3)))
#define DEV __device__ __forceinline__
typedef unsigned short bf16_t;
typedef short bf16x8 __attribute__((ext_vector_type(8)));
typedef short s16x4 __attribute__((ext_vector_type(4)));
typedef float f32x4 __attribute__((ext_vector_type(4)));
typedef float f32x16 __attribute__((ext_vector_type(16)));
typedef unsigned u32x2 __attribute__((ext_vector_type(2)));
typedef unsigned u32x4 __attribute__((ext_vector_type(4)));
typedef unsigned u32x8 __attribute__((ext_vector_type(8)));

constexpr int NB = 8, SEQ = 4096, DM = 1024, TOK = NB * SEQ, FF = 2816, NL = 2, MEMLEN = 256;
constexpr int ZP = 3392;
constexpr int ZC_FQ = 0, ZC_RR = 256, ZC_MQ = 768, ZC_FK = 1024, ZC_FV = 1280, ZC_MK = 1536, ZC_MV = 1792, ZC_RK = 2048, ZC_RV = 2560, ZC_LO = 3072, ZC_FF = 3360, ZC_VALID = 3368;
constexpr float NORM_EPS = 1e-6f, GN_EPS = 64e-5f, LOG2E = 1.4426950408889634f;
constexpr float C2_64 = 0.125f * LOG2E, C2_128 = 0.08838834764831845f * LOG2E;
constexpr size_t MiB = 1u << 20;
constexpr size_t WS_CTL = 0;
constexpr size_t WS_W = 1 * MiB, WL_BYTES = 48 * MiB;
constexpr size_t OFF_F1I = 0, OFF_F1O = 11 * MiB, OFF_F2I = 17 * MiB, OFF_F2O = 28 * MiB, OFF_MI = 34 * MiB, OFF_MO = 41 * MiB, OFF_XQ = 43 * MiB, OFF_XKV = 44 * MiB, OFF_XO = 46 * MiB;
constexpr size_t OFF_W2T = 47 * MiB, OFF_A2T = OFF_W2T + 65536, OFF_G2T = OFF_A2T + 65536;
constexpr size_t WS_Z = 97 * MiB;
constexpr size_t WS_C = WS_Z + 212 * MiB;
constexpr size_t WS_HN = WS_C;
constexpr size_t WS_WD = WS_C, WS_KK = WS_C + 64 * MiB, WS_KA = WS_C + 96 * MiB;
constexpr size_t WS_VTF = WS_C + 128 * MiB, WS_VTM = WS_C + 144 * MiB;
constexpr size_t WS_LOGF = WS_C + 160 * MiB, WS_KMP = WS_LOGF + 512 * 1024, WS_ZHALO = WS_C + 161 * MiB;
constexpr size_t WS_KVX = WS_C + 165 * MiB, WS_VTX = WS_C + 173 * MiB, WS_MEMN = WS_C + 177 * MiB, WS_SSQ = WS_C + 185 * MiB, WS_END = WS_C + 187 * MiB;
static_assert(WS_END <= 512 * MiB, "workspace map");
constexpr int LDS_BYTES = 131072 + 1024;

struct Args { const float* in[35]; float* out; unsigned char* ws; int ph_lo, ph_hi; };

DEV float bf2f(unsigned short b) { return __uint_as_float((unsigned)b << 16); }
typedef float f32x2_t __attribute__((ext_vector_type(2))); typedef __bf16 bf16x2_t __attribute__((ext_vector_type(2)));
DEV unsigned pk2(float lo, float hi) { const f32x2_t v = {lo, hi}; const bf16x2_t r = __builtin_convertvector(v, bf16x2_t); return __builtin_bit_cast(unsigned, r); }
DEV unsigned f2bf(float f) { return pk2(f, f) & 0xffffu; }
DEV float wave_sum(float v) {
#pragma unroll
    for (int o = 1; o < 64; o <<= 1) v += __shfl_xor(v, o);
    return v;
}
#define LDS_WAIT() asm volatile("s_waitcnt lgkmcnt(0)" ::: "memory")

struct MatInfo { const float* src; bf16_t* dst; int K, Ns, Nd, map; };
DEV MatInfo matinfo(const Args& a, int m) {
    const int l = m / 12, k = m % 12; unsigned char* wl = a.ws + WS_W + (size_t)l * WL_BYTES; MatInfo r;
    switch (k) {
    case 0:  r.src = a.in[4] + (size_t)l * DM * 2 * FF;  r.dst = (bf16_t*)(wl + OFF_F1I); r.K = DM; r.Ns = 2 * FF; r.Nd = 2 * FF; r.map = 1; break;
    case 1:  r.src = a.in[5] + (size_t)l * FF * DM;      r.dst = (bf16_t*)(wl + OFF_F1O); r.K = FF; r.Ns = DM; r.Nd = DM; r.map = 0; break;
    case 2:  r.src = a.in[33] + (size_t)l * DM * 2 * FF; r.dst = (bf16_t*)(wl + OFF_F2I); r.K = DM; r.Ns = 2 * FF; r.Nd = 2 * FF; r.map = 1; break;
    case 3:  r.src = a.in[34] + (size_t)l * FF * DM;     r.dst = (bf16_t*)(wl + OFF_F2O); r.K = FF; r.Ns = DM; r.Nd = DM; r.map = 0; break;
    case 4:  r.src = a.in[7] + (size_t)l * DM * 3364;    r.dst = (bf16_t*)(wl + OFF_MI);  r.K = DM; r.Ns = 3364; r.Nd = 3584; r.map = 2; break;
    case 5:  r.src = a.in[8] + (size_t)l * DM * DM;      r.dst = (bf16_t*)(wl + OFF_MO);  r.K = DM; r.Ns = DM; r.Nd = DM; r.map = 0; break;
    case 6:  r.src = a.in[27] + (size_t)l * DM * 512;    r.dst = (bf16_t*)(wl + OFF_XQ);  r.K = DM; r.Ns = 512; r.Nd = 512; r.map = 0; break;
    case 7:  r.src = a.in[28] + (size_t)l * DM * 1024;   r.dst = (bf16_t*)(wl + OFF_XKV); r.K = DM; r.Ns = 1024; r.Nd = 1024; r.map = 0; break;
    case 8:  r.src = a.in[31] + (size_t)l * 512 * DM;    r.dst = (bf16_t*)(wl + OFF_XO);  r.K = 512; r.Ns = DM; r.Nd = DM; r.map = 0; break;
    case 9:  r.src = a.in[16] + (size_t)l * 64 * 512;    r.dst = (bf16_t*)(wl + OFF_W2T); r.K = 64; r.Ns = 512; r.Nd = 512; r.map = 0; break;
    case 10: r.src = a.in[18] + (size_t)l * 64 * 512;    r.dst = (bf16_t*)(wl + OFF_A2T); r.K = 64; r.Ns = 512; r.Nd = 512; r.map = 0; break;
    default: r.src = a.in[19] + (size_t)l * 160 * 512;   r.dst = (bf16_t*)(wl + OFF_G2T); r.K = 160; r.Ns = 512; r.Nd = 512; r.map = 0; break;
    }
    return r;
}
DEV int srccol(int map, int n) {
    if (map == 0) return n;
    if (map == 1) { const int p = n >> 8, r = n & 255; return r < 128 ? p * 128 + r : FF + p * 128 + (r - 128); }
    if (n < 256) return n;
    if (n < 768) return 1540 + (n - 256);
    if (n < 1024) return 772 + (n - 768);
    if (n < 1280) return 256 + (n - 1024);
    if (n < 1536) return 512 + (n - 1280);
    if (n < 1792) return 1028 + (n - 1536);
    if (n < 2048) return 1284 + (n - 1792);
    if (n < 2560) return 2052 + (n - 2048);
    if (n < 3072) return 2564 + (n - 2560);
    if (n < 3360) return 3076 + (n - 3072);
    if (n < 3364) return 768 + (n - 3360);
    return -1;
}
DEV void transpose_item(const MatInfo& mi, LAS float* scr, int item, int lane) {
    const int nblk = mi.Nd / 32, kb = item / nblk, nb = item % nblk, k0 = 64 * kb, n0 = 32 * nb;
    const int sc = srccol(mi.map, n0 + (lane & 31));
#pragma unroll 8
    for (int i = 0; i < 32; ++i) { const int kk = 2 * i + (lane >> 5), k = k0 + kk;
        scr[kk * 33 + (lane & 31)] = (sc >= 0 && k < mi.K) ? mi.src[(size_t)k * mi.Ns + sc] : 0.f; }
    LDS_WAIT(); asm volatile("" ::: "memory");
    const int c = lane & 7;
#pragma unroll
    for (int j = 0; j < 4; ++j) { const int n = (lane >> 3) + 8 * j; const LAS float* s = scr + (8 * c) * 33 + n;
        u32x4 o; o.x = pk2(s[0 * 33], s[1 * 33]); o.y = pk2(s[2 * 33], s[3 * 33]); o.z = pk2(s[4 * 33], s[5 * 33]); o.w = pk2(s[6 * 33], s[7 * 33]);
        if (k0 + 8 * c < mi.K) *(u32x4*)(mi.dst + (size_t)(n0 + n) * mi.K + k0 + 8 * c) = o; }
    LDS_WAIT(); asm volatile("" ::: "memory");
}
DEV void norm_row(const float* xrow, const float* g, bf16_t* orow, int lane) {
    const f32x4* xr = (const f32x4*)xrow + lane; const f32x4* gr = (const f32x4*)g + lane;
    f32x4 v[4]; float s = 0.f;
#pragma unroll
    for (int j = 0; j < 4; ++j) { v[j] = xr[64 * j]; s += (v[j].x * v[j].x + v[j].y * v[j].y) + (v[j].z * v[j].z + v[j].w * v[j].w); }
    const float rstd = rsqrtf(wave_sum(s) * (1.f / DM) + NORM_EPS);
    u32x2* o8 = (u32x2*)orow + lane;
#pragma unroll
    for (int j = 0; j < 4; ++j) { const f32x4 gg = gr[64 * j]; u32x2 w; w.x = pk2(v[j].x * rstd * gg.x, v[j].y * rstd * gg.y); w.y = pk2(v[j].z * rstd * gg.z, v[j].w * rstd * gg.w); o8[64 * j] = w; }
}
DEV void norm_row2(const float* xa, const float* xb, const float* g, bf16_t* oa, bf16_t* ob, int lane) {
    const f32x4* xra = (const f32x4*)xa + lane; const f32x4* xrb = (const f32x4*)xb + lane; const f32x4* gr = (const f32x4*)g + lane;
    f32x4 va[4], vb[4]; float sa = 0.f, sb = 0.f;
#pragma unroll
    for (int j = 0; j < 4; ++j) { va[j] = xra[64 * j]; vb[j] = xrb[64 * j]; }
#pragma unroll
    for (int j = 0; j < 4; ++j) { sa += (va[j].x * va[j].x + va[j].y * va[j].y) + (va[j].z * va[j].z + va[j].w * va[j].w); sb += (vb[j].x * vb[j].x + vb[j].y * vb[j].y) + (vb[j].z * vb[j].z + vb[j].w * vb[j].w); }
#pragma unroll
    for (int o = 1; o < 64; o <<= 1) { sa += __shfl_xor(sa, o); sb += __shfl_xor(sb, o); }
    const float ra = rsqrtf(sa * (1.f / DM) + NORM_EPS), rb = rsqrtf(sb * (1.f / DM) + NORM_EPS);
    u32x2* o8a = (u32x2*)oa + lane; u32x2* o8b = (u32x2*)ob + lane;
#pragma unroll
    for (int j = 0; j < 4; ++j) { const f32x4 gg = gr[64 * j]; u32x2 w; w.x = pk2(va[j].x * ra * gg.x, va[j].y * ra * gg.y); w.y = pk2(va[j].z * ra * gg.z, va[j].w * ra * gg.w); o8a[64 * j] = w;
        w.x = pk2(vb[j].x * rb * gg.x, vb[j].y * rb * gg.y); w.y = pk2(vb[j].z * rb * gg.z, vb[j].w * rb * gg.w); o8b[64 * j] = w; }
}
DEV void prenorm_phase(const float* x, const float* g, bf16_t* hn, float* ssq, int nrows, int gw, int NGW, int lane) {
    for (int m = gw; m < nrows; m += NGW) { const f32x4* xr = (const f32x4*)(x + (size_t)m * DM) + lane; const f32x4* gr = (const f32x4*)g + lane; f32x4 v[4]; float s = 0.f;
#pragma unroll
        for (int j = 0; j < 4; ++j) { v[j] = xr[64 * j]; s += (v[j].x * v[j].x + v[j].y * v[j].y) + (v[j].z * v[j].z + v[j].w * v[j].w); }
        s = wave_sum(s);
        u32x2* o8 = (u32x2*)(hn + (size_t)m * DM) + lane;
#pragma unroll
        for (int j = 0; j < 4; ++j) { const f32x4 gg = gr[64 * j]; u32x2 w; w.x = pk2(v[j].x * gg.x, v[j].y * gg.y); w.y = pk2(v[j].z * gg.z, v[j].w * gg.w); o8[64 * j] = w; }
        if (lane < 16) ssq[(size_t)m * 16 + lane] = lane == 0 ? s : 0.f; }
}
DEV void norm_phase(const float* x, const float* g, bf16_t* out, int nrows, int gw, int NGW, int lane) {
    int m = gw;
    for (; m + NGW < nrows; m += 2 * NGW) norm_row2(x + (size_t)m * DM, x + (size_t)(m + NGW) * DM, g, out + (size_t)m * DM, out + (size_t)(m + NGW) * DM, lane);
    if (m < nrows) norm_row(x + (size_t)m * DM, g, out + (size_t)m * DM, lane);
}
DEV void p0_prologue(const Args& a, LAS unsigned char* lds, int gw, int NGW, int wid, int lane, int tid) {
    LAS float* scr = (LAS float*)(lds + wid * 8704);
    int base = 0;
    for (int m = 0; m < 24; ++m) {
        const MatInfo mi = matinfo(a, m); const int items = ((mi.K + 63) / 64) * (mi.Nd / 32);
        int first = gw - (base % NGW); if (first < 0) first += NGW;
        for (int it = first; it < items; it += NGW) transpose_item(mi, scr, it, lane);
        base += items;
    }
    for (int m = gw; m < NL * NB * MEMLEN; m += NGW) { const int l = m / (NB * MEMLEN), r = m % (NB * MEMLEN);
        norm_row(a.in[1] + (size_t)r * DM, a.in[26] + l * DM, (bf16_t*)(a.ws + WS_MEMN) + (size_t)m * DM, lane); }
    if (blockIdx.x == 0 && tid < 64) ((unsigned*)(a.ws + WS_CTL))[tid * 64] = 0u;
}
DEV void xkv_post(const Args& a, int gw, int NGW, int lane) {
    for (int it = gw; it < NL * NB * MEMLEN * 4; it += NGW) {
        const int hd = it & 3, row = (it >> 2) % (NB * MEMLEN), l = it / (4 * NB * MEMLEN), b = row / MEMLEN, m = row % MEMLEN;
        bf16_t* kr = (bf16_t*)(a.ws + WS_KVX) + ((size_t)l * NB * MEMLEN + row) * 1024 + hd * 128;
        const unsigned kv = *((const unsigned*)kr + lane); float k0 = bf2f(kv & 0xffff), k1 = bf2f(kv >> 16);
        const float rstd = rsqrtf(wave_sum(k0 * k0 + k1 * k1) * (1.f / 128) + NORM_EPS);
        const float* kg = a.in[30] + l * 128;
        *((unsigned*)kr + lane) = pk2(k0 * rstd * kg[2 * lane], k1 * rstd * kg[2 * lane + 1]);
        const unsigned vv = *((const unsigned*)(kr + 512) + lane);
        bf16_t* vt = (bf16_t*)(a.ws + WS_VTX) + (((size_t)(l * NB + b) * 4 + hd) * 128) * MEMLEN + m;
        vt[(size_t)(2 * lane) * MEMLEN] = (bf16_t)(vv & 0xffff); vt[(size_t)(2 * lane + 1) * MEMLEN] = (bf16_t)(vv >> 16);
    }
}

DEV float sigmoid_f(float x) { return __builtin_amdgcn_rcpf(1.0f + __builtin_amdgcn_exp2f(-LOG2E * x)); }
DEV float tanh_f(float x) { const float e = __builtin_amdgcn_exp2f(-2.f * LOG2E * fabsf(x)); const float t = (1.f - e) * __builtin_amdgcn_rcpf(1.f + e); return x < 0.f ? -t : t; }
DEV void unpack8(const u32x4 v, float (&f)[8]) {
    f[0] = __uint_as_float(v.x << 16); f[1] = __uint_as_float(v.x & 0xffff0000u); f[2] = __uint_as_float(v.y << 16); f[3] = __uint_as_float(v.y & 0xffff0000u);
    f[4] = __uint_as_float(v.z << 16); f[5] = __uint_as_float(v.z & 0xffff0000u); f[6] = __uint_as_float(v.w << 16); f[7] = __uint_as_float(v.w & 0xffff0000u);
}
DEV u32x4 pack8(const float (&f)[8]) { u32x4 o; o.x = pk2(f[0], f[1]); o.y = pk2(f[2], f[3]); o.z = pk2(f[4], f[5]); o.w = pk2(f[6], f[7]); return o; }
DEV int crow(int r, int hi) { return (r & 3) + 8 * (r >> 2) + 4 * hi; }

DEV void prep_tile(const Args& a, int l, int tile, LAS unsigned char* lds, bool dry = false) {
    int tid_ = threadIdx.x; asm volatile("" : "+v"(tid_)); const int tid = tid_, lane = tid & 63, wid = __builtin_amdgcn_readfirstlane(tid >> 6);
    const int row0 = tile * 64, b = row0 / SEQ, t0 = row0 % SEQ;
    bf16_t* Z = (bf16_t*)(a.ws + WS_Z) + (size_t)row0 * ZP;
    {
        const int ch = tid % 228, sub = tid / 228; const bool act = tid < 456;
        const int col = ch < 64 ? ZC_RR + 8 * ch : ZC_RK + 8 * (ch - 64), mi = ch < 64 ? 8 * ch : 512 + 8 * (ch - 64);
        const int ts = 32 * sub; float prev[8], mu[8];
#pragma unroll
        for (int i = 0; i < 8; ++i) { prev[i] = 0.f; mu[i] = 0.f; }
        if (act) {
            const float* mup = a.in[14] + l * 1824 + mi;
#pragma unroll
            for (int i = 0; i < 8; ++i) mu[i] = mup[i];
            if (sub == 1) unpack8(*(const u32x4*)(Z + (size_t)(ts - 1) * ZP + col), prev);
            else if (t0 != 0) unpack8(*(const u32x4*)((const bf16_t*)(a.ws + WS_ZHALO) + (size_t)(tile - 1) * ZP + col), prev);
        }
        __syncthreads();
        if (act) {
#pragma unroll 1
            for (int t8 = 0; t8 < 32; t8 += 8) { u32x4 raw[8];
#pragma unroll
                for (int tt = 0; tt < 8; ++tt) raw[tt] = *(const u32x4*)(Z + (size_t)(ts + t8 + tt) * ZP + col);
#pragma unroll
                for (int tt = 0; tt < 8; ++tt) { float cur[8], o[8]; unpack8(raw[tt], cur);
#pragma unroll
                    for (int i = 0; i < 8; ++i) { o[i] = cur[i] + (prev[i] - cur[i]) * mu[i]; prev[i] = cur[i]; }
                    if (!dry) *(u32x4*)(Z + (size_t)(ts + t8 + tt) * ZP + col) = pack8(o); } }
        }
    }
    LAS float* kbuf = (LAS float*)lds;
    {
        const float* gfq = a.in[10] + l * 64; const float* gfk = a.in[11] + l * 64; const float* gmq = a.in[12] + l * 64; const float* gmk = a.in[13] + l * 64;
        const int* pos = (const int*)a.in[2] + b * SEQ + t0;
#pragma unroll 2
        for (int it = 0; it < 16; ++it) {
            const int item = it * 512 + tid, g8 = item >> 3, sub8 = item & 7, slot = g8 >> 6, token = g8 & 63, h = slot & 3, kind = slot >> 2;
            const int cb = (kind == 0 ? ZC_FQ : kind == 1 ? ZC_FK : kind == 2 ? ZC_MQ : ZC_MK) + 64 * h + 8 * sub8;
            const float* gp = (kind == 0 ? gfq : kind == 1 ? gfk : kind == 2 ? gmq : gmk) + 8 * sub8;
            u32x4* p = (u32x4*)(Z + (size_t)token * ZP + cb); float v[8]; unpack8(*p, v);
            float ss = 0.f;
#pragma unroll
            for (int i = 0; i < 8; ++i) ss += v[i] * v[i];
            ss += __shfl_xor(ss, 1); ss += __shfl_xor(ss, 2); ss += __shfl_xor(ss, 4);
            const float rstd = rsqrtf(ss * (1.f / 64) + NORM_EPS);
#pragma unroll
            for (int i = 0; i < 8; ++i) v[i] = v[i] * rstd * gp[i];
            float pr[8];
#pragma unroll
            for (int i = 0; i < 8; ++i) pr[i] = __shfl_xor(v[i], 1);
            if (kind >= 2 && sub8 < 2) {
                const float posf = (float)pos[token];
#pragma unroll
                for (int i = 0; i < 8; ++i) {
                    const float invf = (float)__builtin_exp2(-(double)i * 0.125 * 18.931568569324174);
                    const float ang = posf * invf; const double rev = (double)ang * 0.15915494309189535; const float fr = (float)(rev - __builtin_floor(rev));
                    const float sn = __builtin_amdgcn_sinf(fr), cs = __builtin_amdgcn_cosf(fr);
                    v[i] = sub8 == 0 ? v[i] * cs - pr[i] * sn : v[i] * cs + pr[i] * sn; }
            }
            if (kind == 3) {
#pragma unroll
                for (int i = 0; i < 8; ++i) kbuf[(token * 4 + h) * 64 + 8 * sub8 + i] = v[i]; }
            if (kind == 0 || kind == 2) {
#pragma unroll
                for (int i = 0; i < 8; ++i) v[i] *= C2_64; }
            if (!dry) *p = pack8(v);
        }
    }
    __syncthreads();
    if (tid < 256) { const int h = tid >> 6, d = tid & 63; float s = 0.f;
        for (int t = 0; t < 64; ++t) s += kbuf[(t * 4 + h) * 64 + d];
        if (!dry) ((float*)(a.ws + WS_KMP))[(((size_t)(b * 4 + h) * 64) + (t0 >> 6)) * 64 + d] = s; }
#pragma unroll 2
    for (int it = 0; it < 8; ++it) {
        const int item = it * 512 + tid, which = item >> 11, rem = item & 2047, tg = rem >> 8, c = rem & 255;
        const bf16_t* src = Z + (size_t)(8 * tg) * ZP + (which ? ZC_MV : ZC_FV) + c; unsigned short e[8];
#pragma unroll
        for (int i = 0; i < 8; ++i) e[i] = src[(size_t)i * ZP];
        u32x4 o; o.x = e[0] | ((unsigned)e[1] << 16); o.y = e[2] | ((unsigned)e[3] << 16); o.z = e[4] | ((unsigned)e[5] << 16); o.w = e[6] | ((unsigned)e[7] << 16);
        bf16_t* vt = (bf16_t*)(a.ws + (which ? WS_VTM : WS_VTF)) + ((size_t)(b * 4 + (c >> 6)) * 64 + (c & 63)) * SEQ + t0 + 8 * tg;
        if (!dry) *(u32x4*)vt = o;
    }
    if (tid < 256) { const int token = tid >> 2, h = tid & 3; const float x = bf2f(Z[(size_t)token * ZP + ZC_FF + h]) + a.in[9][l * 4 + h];
        const float lf = fminf(x, 0.f) - __logf(1.f + __expf(-fabsf(x)));
        if (!dry) ((float*)(a.ws + WS_LOGF))[(size_t)(b * 4 + h) * SEQ + t0 + token] = lf; }
    __syncthreads();
    LAS bf16_t* al = (LAS bf16_t*)lds;
    for (int item = tid; item < 64 * 36; item += 512) { const int token = item / 36, c = item % 36; float v[8]; unpack8(*(const u32x4*)(Z + (size_t)token * ZP + ZC_LO + 8 * c), v);
        if (c < 8) {
#pragma unroll
            for (int i = 0; i < 8; ++i) v[i] = tanh_f(v[i]); }
        else if (c >= 16) {
#pragma unroll
            for (int i = 0; i < 8; ++i) v[i] = sigmoid_f(v[i]); }
        *(LAS u32x4*)(al + token * 296 + 8 * c) = pack8(v); }
    __syncthreads();
    const unsigned char* wl = a.ws + WS_W + (size_t)l * WL_BYTES;
    const bf16_t* w2t = (const bf16_t*)(wl + OFF_W2T); const bf16_t* a2t = (const bf16_t*)(wl + OFF_A2T); const bf16_t* g2t = (const bf16_t*)(wl + OFF_G2T);
    const int r32 = lane & 31, hi = lane >> 5;
    for (int uu = 0; uu < 2; ++uu) {
        const int u = wid + 8 * uu, h = u & 7, th = u >> 3, token = 32 * th + r32;
        f32x16 aw[2], aa[2], ag[2];
#pragma unroll
        for (int ct = 0; ct < 2; ++ct) { aw[ct] = f32x16{}; aa[ct] = f32x16{}; ag[ct] = f32x16{}; }
        const LAS bf16_t* arow = al + token * 296 + 8 * hi;
#pragma unroll 1
        for (int ks = 0; ks < 4; ++ks) { const bf16x8 bw = *(const LAS bf16x8*)(arow + 16 * ks), ba = *(const LAS bf16x8*)(arow + 64 + 16 * ks);
#pragma unroll
            for (int ct = 0; ct < 2; ++ct) { const int chn = 64 * h + 32 * ct + r32;
                aw[ct] = __builtin_amdgcn_mfma_f32_32x32x16_bf16(*(const bf16x8*)(w2t + chn * 64 + 16 * ks + 8 * hi), bw, aw[ct], 0, 0, 0);
                aa[ct] = __builtin_amdgcn_mfma_f32_32x32x16_bf16(*(const bf16x8*)(a2t + chn * 64 + 16 * ks + 8 * hi), ba, aa[ct], 0, 0, 0); } }
#pragma unroll 1
        for (int ks = 0; ks < 10; ++ks) { const bf16x8 bg = *(const LAS bf16x8*)(arow + 128 + 16 * ks);
#pragma unroll
            for (int ct = 0; ct < 2; ++ct) { const int chn = 64 * h + 32 * ct + r32;
                ag[ct] = __builtin_amdgcn_mfma_f32_32x32x16_bf16(*(const bf16x8*)(g2t + chn * 160 + 16 * ks + 8 * hi), bg, ag[ct], 0, 0, 0); } }
        bf16_t* zr = Z + (size_t)token * ZP; const size_t grow = (size_t)(row0 + token);
        float* wd = (float*)(a.ws + WS_WD) + grow * 512; bf16_t* kkp = (bf16_t*)(a.ws + WS_KK) + grow * 512; bf16_t* kap = (bf16_t*)(a.ws + WS_KA) + grow * 512;
        const float* w0 = a.in[15] + l * 512; const float* a0 = a.in[17] + l * 512; const float* k_k = a.in[20] + l * 512; const float* k_a = a.in[21] + l * 512;
        float ss = 0.f;
#pragma unroll
        for (int ct = 0; ct < 2; ++ct)
#pragma unroll
            for (int rg = 0; rg < 4; ++rg) { const int c0 = 64 * h + 32 * ct + 8 * rg + 4 * hi;
                const u32x2 kraw = *(const u32x2*)(zr + ZC_RK + c0); const f32x4 w04 = *(const f32x4*)(w0 + c0), a04 = *(const f32x4*)(a0 + c0), kk4 = *(const f32x4*)(k_k + c0);
                f32x4 dec; u32x2 gp; float gv[4];
#pragma unroll
                for (int i = 0; i < 4; ++i) { const int r = 4 * rg + i;
                    const float kv = (i < 2) ? __uint_as_float((i & 1) ? (kraw.x & 0xffff0000u) : (kraw.x << 16)) : __uint_as_float((i & 1) ? (kraw.y & 0xffff0000u) : (kraw.y << 16));
                    const float wr_ = w04[i] + aw[ct][r]; const float sp = fmaxf(-wr_, 0.f) + __logf(1.f + __expf(-fabsf(wr_)));
                    dec[i] = __expf(-__expf(-sp - 0.5f));
                    aa[ct][r] = sigmoid_f(a04[i] + aa[ct][r]);
                    gv[i] = ag[ct][r];
                    const float kkv = kv * kk4[i]; aw[ct][r] = kkv; ss += kkv * kkv; }
                if (!dry) *(f32x4*)(wd + c0) = dec;
                gp.x = pk2(gv[0], gv[1]); gp.y = pk2(gv[2], gv[3]);
                if (!dry) *(u32x2*)(zr + (c0 < 256 ? ZC_FV + c0 : ZC_MV + (c0 - 256))) = gp; __builtin_amdgcn_sched_barrier(0); }
        ss += __shfl_xor(ss, 32);
        const float inv = 1.f / fmaxf(sqrtf(ss), 1e-12f);
#pragma unroll
        for (int ct = 0; ct < 2; ++ct)
#pragma unroll
            for (int rg = 0; rg < 4; ++rg) { const int c0 = 64 * h + 32 * ct + 8 * rg + 4 * hi; const f32x4 ka4 = *(const f32x4*)(k_a + c0);
                const u32x2 kraw = *(const u32x2*)(zr + ZC_RK + c0); const float kf4[4] = {bf2f(kraw.x & 0xffff), __uint_as_float(kraw.x & 0xffff0000u), bf2f(kraw.y & 0xffff), __uint_as_float(kraw.y & 0xffff0000u)};
                float kk[4], ka[4], kp[4];
#pragma unroll
                for (int i = 0; i < 4; ++i) { const int r = 4 * rg + i; kk[i] = aw[ct][r] * inv; ka[i] = kk[i] * aa[ct][r]; kp[i] = kf4[i] * (1.f + (aa[ct][r] - 1.f) * ka4[i]); }
                u32x2 o; o.x = pk2(kk[0], kk[1]); o.y = pk2(kk[2], kk[3]); if (!dry) *(u32x2*)(kkp + c0) = o;
                o.x = pk2(ka[0], ka[1]); o.y = pk2(ka[2], ka[3]); if (!dry) *(u32x2*)(kap + c0) = o;
                o.x = pk2(kp[0], kp[1]); o.y = pk2(kp[2], kp[3]); if (!dry) *(u32x2*)(zr + ZC_RK + c0) = o; __builtin_amdgcn_sched_barrier(0); }
    }
    __syncthreads();
}

template <int MODE, int D>
DEV void attn_unit(LAS unsigned char* lds, const bf16_t* Qp, int ldq, const bf16_t* Kp, int ldk, const bf16_t* Vt, int ldv, bf16_t* Op, int ldo,
                   int q0, int ntiles, int qb, const float* aux, const float* qgain, bool dry = false) {
    constexpr int KP = D + 8, KBYTES = 64 * KP * 2, VP = 72, VBYTES = D * VP * 2, NLD = D / 64;
    int tid_ = threadIdx.x; asm volatile("" : "+v"(tid_)); const int tid = tid_, lane = tid & 63, wid = __builtin_amdgcn_readfirstlane(tid >> 6), r32 = lane & 31, hi = lane >> 5;
    LAS float* cl = (LAS float*)lds; LAS unsigned* selm = (LAS unsigned*)(lds + 8192);
    LAS unsigned char* kb = lds + 16384; LAS unsigned char* vb = kb + 2 * KBYTES;
    const int q = q0 + wid * 32 + r32;
    if (MODE == 0) {
        const int n = 64 * ntiles; float v[8]; float run = 0.f;
#pragma unroll
        for (int i = 0; i < 8; ++i) { const int idx = 8 * tid + i; v[i] = idx < n ? aux[idx] : 0.f; run += v[i]; v[i] = run; }
        float sc = run;
#pragma unroll
        for (int o = 1; o < 64; o <<= 1) { const float t = __shfl_up(sc, o); if (lane >= o) sc += t; }
        LAS float* wsum = (LAS float*)kb;
        if (lane == 63) wsum[wid] = sc;
        __syncthreads();
        float off = sc - run;
        for (int w = 0; w < wid; ++w) off += wsum[w];
#pragma unroll
        for (int i = 0; i < 8; ++i) cl[8 * tid + i] = (off + v[i]) * LOG2E;
    }
    if (MODE == 1) {
        LAS float* km = cl;
        for (int e = tid; e < 16 * 64; e += 512) { const int nblk = e >> 6, d = e & 63; const float* pp = aux + (size_t)(4 * nblk) * 64 + d;
            km[e] = ((pp[0] + pp[64]) + (pp[128] + pp[192])) * (1.f / 256); }
        __syncthreads();
        if (tid < 256) { const bf16_t* qr = Qp + (size_t)(q0 + tid) * ldq; float g[16];
#pragma unroll
            for (int nb = 0; nb < 16; ++nb) g[nb] = 0.f;
            for (int c = 0; c < 8; ++c) { float qv[8]; unpack8(*(const u32x4*)(qr + 8 * c), qv);
#pragma unroll
                for (int nb = 0; nb < 16; ++nb) {
#pragma unroll
                    for (int i = 0; i < 8; ++i) g[nb] += qv[i] * km[nb * 64 + 8 * c + i]; } }
            unsigned m = 0u;
#pragma unroll
            for (int pick = 0; pick < 3; ++pick) { float best = -INFINITY; int bi = -1;
#pragma unroll
                for (int nb = 0; nb < 16; ++nb) { if (nb < qb && !((m >> nb) & 1u) && g[nb] > best) { best = g[nb]; bi = nb; } }
                if (bi >= 0) m |= 1u << bi; }
            selm[tid] = m; }
    }
    bf16x8 qf[D / 16];
#pragma unroll
    for (int d0 = 0; d0 < D / 16; ++d0) qf[d0] = *(const bf16x8*)(Qp + (size_t)q * ldq + d0 * 16 + hi * 8);
    if (MODE == 2) {
        float ss = 0.f;
#pragma unroll
        for (int d0 = 0; d0 < D / 16; ++d0) { float qv[8]; unpack8(__builtin_bit_cast(u32x4, qf[d0]), qv);
#pragma unroll
            for (int i = 0; i < 8; ++i) ss += qv[i] * qv[i]; }
        ss += __shfl_xor(ss, 32);
        const float rstd = rsqrtf(ss * (1.f / D) + NORM_EPS) * C2_128;
#pragma unroll
        for (int d0 = 0; d0 < D / 16; ++d0) { float qv[8]; unpack8(__builtin_bit_cast(u32x4, qf[d0]), qv);
#pragma unroll
            for (int i = 0; i < 8; ++i) qv[i] = qv[i] * rstd * qgain[d0 * 16 + hi * 8 + i];
            qf[d0] = __builtin_bit_cast(bf16x8, pack8(qv)); __builtin_amdgcn_sched_barrier(0); }
    }
    float mrun = -INFINITY, lrun = 0.f; f32x16 o[D / 32];
#pragma unroll
    for (int dt = 0; dt < D / 32; ++dt) o[dt] = f32x16{};
    __syncthreads();
    const float cq = (MODE == 0) ? cl[q] : 0.f;
    const unsigned sel = (MODE == 1) ? selm[wid * 32 + r32] : 0u;
    u32x4 kreg[NLD], vreg[NLD];
#define ATT_LOAD(t) do { _Pragma("unroll") for (int i_ = 0; i_ < NLD; ++i_) { const int idx_ = tid + 512 * i_; \
        kreg[i_] = *(const u32x4*)(Kp + (size_t)(64 * (t) + idx_ / (D / 8)) * ldk + (idx_ % (D / 8)) * 8); \
        vreg[i_] = *(const u32x4*)(Vt + (size_t)(idx_ >> 3) * ldv + 64 * (t) + (idx_ & 7) * 8); } } while (0)
#define ATT_STORE(buf) do { _Pragma("unroll") for (int i_ = 0; i_ < NLD; ++i_) { const int idx_ = tid + 512 * i_; \
        *(LAS u32x4*)(kb + (buf) * KBYTES + ((idx_ / (D / 8)) * KP + (idx_ % (D / 8)) * 8) * 2) = kreg[i_]; \
        *(LAS u32x4*)(vb + (buf) * VBYTES + ((idx_ >> 3) * VP + (idx_ & 7) * 8) * 2) = vreg[i_]; } } while (0)
    ATT_LOAD(0); ATT_STORE(0);
    __syncthreads();
    for (int t = 0; t < ntiles; ++t) {
        const int buf = t & 1, key0 = 64 * t;
        if (t + 1 < ntiles) ATT_LOAD(t + 1);
        bool work = true; const int nblk = key0 >> 8;
        if (MODE == 0) work = key0 <= q0 + wid * 32 + 31;
        if (MODE == 1) work = (nblk == qb) ? (key0 <= q0 + wid * 32 + 31) : (__any((sel >> nblk) & 1u) != 0);
        if (work) {
            const LAS unsigned char* kt = kb + buf * KBYTES; const LAS unsigned char* vt = vb + buf * VBYTES;
            constexpr int NKH = (D == 64) ? 2 : 1;
#pragma unroll 1
            for (int ks = 0; ks < 2 / NKH; ++ks) {
            f32x16 p[NKH];
#pragma unroll
            for (int kh = 0; kh < NKH; ++kh) { p[kh] = f32x16{}; const int khh = ks * NKH + kh;
#pragma unroll
                for (int d0 = 0; d0 < D / 16; ++d0) { const bf16x8 kf = *(const LAS bf16x8*)(kt + ((32 * khh + r32) * KP + 16 * d0 + 8 * hi) * 2);
                    p[kh] = __builtin_amdgcn_mfma_f32_32x32x16_bf16(kf, qf[d0], p[kh], 0, 0, 0); } }
            if (MODE == 0) {
#pragma unroll
                for (int kh = 0; kh < NKH; ++kh)
#pragma unroll
                    for (int rg = 0; rg < 4; ++rg) { const int kk0 = key0 + 32 * (ks * NKH + kh) + 8 * rg + 4 * hi; const f32x4 ck = *(const LAS f32x4*)(cl + kk0);
#pragma unroll
                        for (int i = 0; i < 4; ++i) { const float s = p[kh][4 * rg + i] + (cq - ck[i]); p[kh][4 * rg + i] = (kk0 + i > q) ? -INFINITY : s; } }
            }
            if (MODE == 1) {
                if (nblk == qb) {
#pragma unroll
                    for (int kh = 0; kh < NKH; ++kh)
#pragma unroll
                        for (int r = 0; r < 16; ++r) { if (key0 + 32 * (ks * NKH + kh) + crow(r, hi) > q) p[kh][r] = -INFINITY; }
                } else if (!((sel >> nblk) & 1u)) {
#pragma unroll
                    for (int kh = 0; kh < NKH; ++kh)
#pragma unroll
                        for (int r = 0; r < 16; ++r) p[kh][r] = -INFINITY;
                }
            }
            float mx = p[0][0];
#pragma unroll
            for (int kh = 0; kh < NKH; ++kh)
#pragma unroll
                for (int r = 0; r < 16; ++r) mx = fmaxf(mx, p[kh][r]);
            mx = fmaxf(mx, __shfl_xor(mx, 32));
            const float mnew = fmaxf(mrun, mx), muse = (mnew == -INFINITY) ? 0.f : mnew;
            const float alpha = __builtin_amdgcn_exp2f(mrun - muse);
            mrun = mnew; lrun *= alpha;
#pragma unroll
            for (int dt = 0; dt < D / 32; ++dt) o[dt] *= alpha;
            float ps = 0.f;
#pragma unroll
            for (int kh = 0; kh < NKH; ++kh)
#pragma unroll
                for (int r = 0; r < 16; ++r) { p[kh][r] = __builtin_amdgcn_exp2f(p[kh][r] - muse); ps += p[kh][r]; }
            lrun += ps;
            bf16x8 pb[NKH][2];
#pragma unroll
            for (int kh = 0; kh < NKH; ++kh)
#pragma unroll
                for (int j = 0; j < 2; ++j) { u32x4 w; w.x = pk2(p[kh][8 * j + 0], p[kh][8 * j + 1]); w.y = pk2(p[kh][8 * j + 2], p[kh][8 * j + 3]); w.z = pk2(p[kh][8 * j + 4], p[kh][8 * j + 5]); w.w = pk2(p[kh][8 * j + 6], p[kh][8 * j + 7]);
                    pb[kh][j] = __builtin_bit_cast(bf16x8, w); }
#pragma unroll
            for (int dt = 0; dt < D / 32; ++dt)
#pragma unroll
                for (int kh = 0; kh < NKH; ++kh)
#pragma unroll
                    for (int j = 0; j < 2; ++j) { const LAS unsigned char* vp_ = vt + ((32 * dt + r32) * VP + 32 * (ks * NKH + kh) + 16 * j + 4 * hi) * 2;
                        const u32x2 lo = *(const LAS u32x2*)vp_, hh = *(const LAS u32x2*)(vp_ + 16); u32x4 w; w.x = lo.x; w.y = lo.y; w.z = hh.x; w.w = hh.y;
                        o[dt] = __builtin_amdgcn_mfma_f32_32x32x16_bf16(__builtin_bit_cast(bf16x8, w), pb[kh][j], o[dt], 0, 0, 0); }
            }
        }
        if (t + 1 < ntiles) ATT_STORE(buf ^ 1);
        __syncthreads();
    }
#undef ATT_LOAD
#undef ATT_STORE
    lrun += __shfl_xor(lrun, 32);
    const float inv = 1.f / lrun;
    bf16_t* orow = Op + (size_t)q * ldo;
    if (!dry)
#pragma unroll
    for (int dt = 0; dt < D / 32; ++dt)
#pragma unroll
        for (int rg = 0; rg < 4; ++rg) { u32x2 w; w.x = pk2(o[dt][4 * rg] * inv, o[dt][4 * rg + 1] * inv); w.y = pk2(o[dt][4 * rg + 2] * inv, o[dt][4 * rg + 3] * inv);
            *(u32x2*)(orow + 32 * dt + 8 * rg + 4 * hi) = w; }
    __syncthreads();
}

constexpr int RW_NCH = SEQ / 16;
constexpr int RW_ARP = 72, RW_BKTP = 32, RW_VTP = 24, RW_PMP = 24, RW_LP = 20;
constexpr int RW_NBUF = 4;
constexpr int RW_DB = 16640, RW_AR = 0, RW_BKT = 4608, RW_VT = 8704, RW_GC = 11776, RW_TM = 12032, RW_PM1 = 13568, RW_PM2 = 15104;
constexpr int RW_PRIV = RW_NBUF * RW_DB, RW_PRIV_BYTES = 5888, RW_PBK = 0, RW_PLAB = 4608;
constexpr int RW_YB = RW_PRIV + RW_NBUF * RW_PRIV_BYTES, RW_FLG = RW_YB + 2 * 4096, RW_SLOT_BYTES = RW_FLG + 64;
static_assert(RW_PM2 + 32 * RW_PMP * 2 == RW_DB && RW_TM + 32 * RW_PMP * 2 == RW_PM1 && RW_SLOT_BYTES <= 131072 && RW_DB % 16 == 0 && RW_PRIV_BYTES % 16 == 0, "rwkv lds map");
DEV bf16x8 pack_acc8(const f32x16& v, int base) { u32x4 w; w.x = pk2(v[base], v[base + 1]); w.y = pk2(v[base + 2], v[base + 3]); w.z = pk2(v[base + 4], v[base + 5]); w.w = pk2(v[base + 6], v[base + 7]); return __builtin_bit_cast(bf16x8, w); }
DEV int fresh_lane() { int l_; asm volatile("v_mbcnt_lo_u32_b32 %0, -1, 0\n\tv_mbcnt_hi_u32_b32 %0, -1, %0" : "=v"(l_)); return l_; }
DEV void rw_wait(volatile LAS unsigned* f, unsigned target) { while (*f < target) __builtin_amdgcn_s_sleep(1); asm volatile("" ::: "memory"); }
DEV void rw_post_flag(volatile LAS unsigned* f, unsigned v) { asm volatile("s_waitcnt vmcnt(0) lgkmcnt(0)" ::: "memory"); *f = v; }
DEV bf16x8 frag_perm(const LAS bf16_t* rowp, int hi) { const u32x2 lo = *(const LAS u32x2*)(rowp + 4 * hi), hh = *(const LAS u32x2*)(rowp + 8 + 4 * hi); u32x4 w; w.x = lo.x; w.y = lo.y; w.z = hh.x; w.w = hh.y; return __builtin_bit_cast(bf16x8, w); }

struct RwRaw { float w[16]; unsigned short kk[16], ka[16], kp[16], rr[16], vr[16]; };
DEV void rwkv_pre_load(RwRaw& R, int c, const float* WDp, const bf16_t* KKp, const bf16_t* KAp, const bf16_t* Zl) {
#pragma unroll
    for (int t = 0; t < 16; ++t) { const size_t ro = (size_t)(16 * c + t);
        R.w[t] = WDp[ro * 512]; R.kk[t] = KKp[ro * 512]; R.ka[t] = KAp[ro * 512]; R.kp[t] = Zl[ro * ZP + ZC_RK]; R.rr[t] = Zl[ro * ZP + ZC_RR]; R.vr[t] = Zl[ro * ZP + ZC_RV]; }
}
DEV void rwkv_pre_a(const RwRaw& R, int c, LAS unsigned char* sl, volatile LAS unsigned* flg, int lane) {
    const int bi = c & (RW_NBUF - 1);
    LAS bf16_t* BK = (LAS bf16_t*)(sl + RW_PRIV + bi * RW_PRIV_BYTES + RW_PBK);
    LAS unsigned char* db = sl + bi * RW_DB;
    LAS bf16_t* AR = (LAS bf16_t*)(db + RW_AR); LAS bf16_t* BKT = (LAS bf16_t*)(db + RW_BKT); LAS bf16_t* VT = (LAS bf16_t*)(db + RW_VT); LAS float* GC = (LAS float*)(db + RW_GC);
    if (c >= RW_NBUF) rw_wait(flg + 4 + bi, (unsigned)(c - RW_NBUF + 1));
    float g = 1.f; unsigned bkt[16];
#pragma unroll
    for (int t = 0; t < 16; ++t) {
        const float w = R.w[t], kk = bf2f(R.kk[t]), ka = bf2f(R.ka[t]), kp = bf2f(R.kp[t]), rr = bf2f(R.rr[t]);
        const float at = -kk * g; g *= w; const float inv = __builtin_amdgcn_rcpf(g);
        const unsigned bt = f2bf(ka * inv), kt = f2bf(kp * inv);
        AR[t * RW_ARP + lane] = (bf16_t)f2bf(at); AR[(16 + t) * RW_ARP + lane] = (bf16_t)f2bf(rr * g);
        BK[t * RW_ARP + lane] = (bf16_t)bt; BK[(16 + t) * RW_ARP + lane] = (bf16_t)kt;
        if (t & 1) { bkt[t >> 1] |= bt << 16; bkt[8 + (t >> 1)] |= kt << 16; } else { bkt[t >> 1] = bt; bkt[8 + (t >> 1)] = kt; }
    }
    GC[lane] = g;
#pragma unroll
    for (int q4 = 0; q4 < 4; ++q4) { u32x4 w4; w4.x = bkt[4 * q4]; w4.y = bkt[4 * q4 + 1]; w4.z = bkt[4 * q4 + 2]; w4.w = bkt[4 * q4 + 3]; *(LAS u32x4*)(BKT + lane * RW_BKTP + 8 * q4) = w4; }
    { unsigned vv[8];
#pragma unroll
      for (int t = 0; t < 16; ++t) { const unsigned x = R.vr[t]; if (t & 1) vv[t >> 1] |= x << 16; else vv[t >> 1] = x; }
      u32x4 v0; v0.x = vv[0]; v0.y = vv[1]; v0.z = vv[2]; v0.w = vv[3]; u32x4 v1; v1.x = vv[4]; v1.y = vv[5]; v1.z = vv[6]; v1.w = vv[7];
      *(LAS u32x4*)(VT + lane * RW_VTP) = v0; *(LAS u32x4*)(VT + lane * RW_VTP + 8) = v1; }
}
DEV void rwkv_pre_b(int c, LAS unsigned char* sl, volatile LAS unsigned* flg, int lane) {
    const int r32 = lane & 31, hi = lane >> 5, bi = c & (RW_NBUF - 1);
    LAS bf16_t* BK = (LAS bf16_t*)(sl + RW_PRIV + bi * RW_PRIV_BYTES + RW_PBK); LAS float* LAB = (LAS float*)(sl + RW_PRIV + bi * RW_PRIV_BYTES + RW_PLAB);
    LAS unsigned char* db = sl + bi * RW_DB;
    LAS bf16_t* AR = (LAS bf16_t*)(db + RW_AR); LAS bf16_t* TM = (LAS bf16_t*)(db + RW_TM); LAS bf16_t* PM1 = (LAS bf16_t*)(db + RW_PM1); LAS bf16_t* PM2 = (LAS bf16_t*)(db + RW_PM2);
    f32x16 P = f32x16{};
#pragma unroll
    for (int ks = 0; ks < 4; ++ks) P = __builtin_amdgcn_mfma_f32_32x32x16_bf16(*(const LAS bf16x8*)(AR + r32 * RW_ARP + 16 * ks + 8 * hi), *(const LAS bf16x8*)(BK + r32 * RW_ARP + 16 * ks + 8 * hi), P, 0, 0, 0);
    const int n = r32;
#pragma unroll
    for (int r = 0; r < 16; ++r) { const int m = crow(r, hi);
        if (r < 8) { if (n < 16) LAB[m * RW_LP + n] = (n < m) ? P[r] : 0.f; else PM1[m * RW_PMP + (n - 16)] = (bf16_t)f2bf((n - 16 < m) ? P[r] : 0.f); }
        else { if (n < 16) PM2[m * RW_PMP + n] = (bf16_t)f2bf((n <= m - 16) ? P[r] : 0.f); else PM1[m * RW_PMP + (n - 16)] = (bf16_t)f2bf((n - 16 <= m - 16) ? P[r] : 0.f); } }
}
DEV void rwkv_pre_c(int c, LAS unsigned char* sl, volatile LAS unsigned* flg, int lane) {
    const int bi = c & (RW_NBUF - 1);
    const LAS float* LAB = (const LAS float*)(sl + RW_PRIV + bi * RW_PRIV_BYTES + RW_PLAB); LAS bf16_t* TM = (LAS bf16_t*)(sl + bi * RW_DB + RW_TM);
    { const int cc = lane & 15; float T[16];
#pragma unroll
      for (int t = 0; t < 16; ++t) { float acc = (t == cc) ? 1.f : 0.f;
          int z = 0; if (t >= 3) asm volatile("v_and_b32 %0, 0, %1" : "=v"(z) : "v"(T[t - 3]));
          const LAS float* lrow = LAB + t * RW_LP + z;
#pragma unroll
          for (int tau = 0; tau < t; ++tau) acc = fmaf(lrow[tau], T[tau], acc);
          T[t] = acc; }
      if (lane < 16) {
#pragma unroll
          for (int t = 0; t < 16; ++t) TM[t * RW_PMP + cc] = (bf16_t)f2bf(T[t]); } }
    asm volatile("s_waitcnt lgkmcnt(0)" ::: "memory"); flg[bi] = (unsigned)(c + 1);
}
DEV void rwkv_pre(const Args& a, int b, int h, LAS unsigned char* sl, int par) {
    const int lane = fresh_lane();
    volatile LAS unsigned* flg = (volatile LAS unsigned*)(sl + RW_FLG);
    const size_t rowb = (size_t)b * SEQ;
    const bf16_t* Zl = (const bf16_t*)(a.ws + WS_Z) + rowb * ZP + h * 64 + lane;
    const float* WDp = (const float*)(a.ws + WS_WD) + rowb * 512 + h * 64 + lane;
    const bf16_t* KKp = (const bf16_t*)(a.ws + WS_KK) + rowb * 512 + h * 64 + lane;
    const bf16_t* KAp = (const bf16_t*)(a.ws + WS_KA) + rowb * 512 + h * 64 + lane;
    for (int e = lane; e < 32 * RW_PMP; e += 64) { ((LAS bf16_t*)(sl + par * RW_DB + RW_PM2))[e] = 0; ((LAS bf16_t*)(sl + par * RW_DB + RW_TM))[e] = 0; }
    RwRaw R;
    rwkv_pre_load(R, par, WDp, KKp, KAp, Zl);
#pragma unroll 1
    for (int c = par; c < RW_NCH; c += RW_NBUF) {
        rwkv_pre_a(R, c, sl, flg, lane);
        rwkv_pre_b(c, sl, flg, lane);
        asm volatile("" ::: "memory");
        rwkv_pre_load(R, (c + RW_NBUF < RW_NCH) ? c + RW_NBUF : c, WDp, KKp, KAp, Zl);
#if !defined(NOPREC)
        rwkv_pre_c(c, sl, flg, lane);
#endif
    }
}

DEV void rwkv_main(LAS unsigned char* sl) {
    const int lane = fresh_lane(), r32 = lane & 31, hi = lane >> 5;
    volatile LAS unsigned* flg = (volatile LAS unsigned*)(sl + RW_FLG);
    f32x16 ST[2][2];
#pragma unroll
    for (int jt = 0; jt < 2; ++jt)
#pragma unroll
        for (int it = 0; it < 2; ++it) ST[jt][it] = f32x16{};
#pragma unroll 1
    for (int c = 0; c < RW_NCH; ++c) {
        const int bi = c & (RW_NBUF - 1);
        LAS unsigned char* db = sl + bi * RW_DB;
        const LAS bf16_t* AR = (const LAS bf16_t*)(db + RW_AR); const LAS bf16_t* BKT = (const LAS bf16_t*)(db + RW_BKT); const LAS bf16_t* VT = (const LAS bf16_t*)(db + RW_VT);
        const LAS float* GC = (const LAS float*)(db + RW_GC); const LAS bf16_t* TM = (const LAS bf16_t*)(db + RW_TM); const LAS bf16_t* PM1 = (const LAS bf16_t*)(db + RW_PM1); const LAS bf16_t* PM2 = (const LAS bf16_t*)(db + RW_PM2);
        LAS float* YB = (LAS float*)(sl + RW_YB + (c & 1) * 4096);
        rw_wait(flg + bi, (unsigned)(c + 1));
        f32x16 X[2]; X[0] = f32x16{}; X[1] = f32x16{};
#pragma unroll
        for (int jt = 0; jt < 2; ++jt)
#pragma unroll
            for (int rgp = 0; rgp < 2; ++rgp) { const bf16x8 af = frag_perm(AR + r32 * RW_ARP + 32 * jt + 16 * rgp, hi);
#pragma unroll
                for (int it = 0; it < 2; ++it) X[it] = __builtin_amdgcn_mfma_f32_32x32x16_bf16(af, pack_acc8(ST[jt][it], 8 * rgp), X[it], 0, 0, 0); }
        bf16x8 vt[2];
        { const bf16x8 a1 = *(const LAS bf16x8*)(PM1 + r32 * RW_PMP + 8 * hi);
#pragma unroll
          for (int it = 0; it < 2; ++it) { vt[it] = *(const LAS bf16x8*)(VT + (32 * it + r32) * RW_VTP + 8 * hi); X[it] = __builtin_amdgcn_mfma_f32_32x32x16_bf16(a1, vt[it], X[it], 0, 0, 0); } }
        bf16x8 ub[2];
        { const bf16x8 ta = frag_perm(TM + r32 * RW_PMP, hi), pm2 = frag_perm(PM2 + r32 * RW_PMP, hi);
#pragma unroll
          for (int it = 0; it < 2; ++it) { const f32x16 U = __builtin_amdgcn_mfma_f32_32x32x16_bf16(ta, pack_acc8(X[it], 0), f32x16{}, 0, 0, 0);
              ub[it] = pack_acc8(U, 0); X[it] = __builtin_amdgcn_mfma_f32_32x32x16_bf16(pm2, ub[it], X[it], 0, 0, 0); } }
        if (c >= 2) rw_wait(flg + 10 + (c & 1), (unsigned)(c - 1));
#pragma unroll
        for (int it = 0; it < 2; ++it)
#pragma unroll
            for (int r = 8; r < 16; ++r) YB[(crow(r, hi) - 16) * 64 + 32 * it + r32] = X[it][r];
        rw_post_flag(flg + 8 + (c & 1), (unsigned)(c + 1));
#pragma unroll
        for (int jt = 0; jt < 2; ++jt) { const bf16x8 a0 = frag_perm(BKT + (32 * jt + r32) * RW_BKTP, hi), a1 = *(const LAS bf16x8*)(BKT + (32 * jt + r32) * RW_BKTP + 16 + 8 * hi);
#pragma unroll
            for (int it = 0; it < 2; ++it) { ST[jt][it] = __builtin_amdgcn_mfma_f32_32x32x16_bf16(a0, ub[it], ST[jt][it], 0, 0, 0);
                ST[jt][it] = __builtin_amdgcn_mfma_f32_32x32x16_bf16(a1, vt[it], ST[jt][it], 0, 0, 0); }
#pragma unroll
            for (int rg = 0; rg < 4; ++rg) { const f32x4 g4 = *(const LAS f32x4*)(GC + 32 * jt + 8 * rg + 4 * hi);
#pragma unroll
                for (int e = 0; e < 4; ++e) { ST[jt][0][4 * rg + e] *= g4[e]; ST[jt][1][4 * rg + e] *= g4[e]; } } }
        rw_post_flag(flg + 4 + bi, (unsigned)(c + 1));
    }
}

DEV void rwkv_post(const Args& a, int l, int b, int h, LAS unsigned char* sl, int par) {
    const int lane = fresh_lane();
    volatile LAS unsigned* flg = (volatile LAS unsigned*)(sl + RW_FLG);
    bf16_t* Zb = (bf16_t*)(a.ws + WS_Z) + (size_t)b * SEQ * ZP;
    const int gcol0 = h < 4 ? ZC_FV + h * 64 : ZC_MV + (h - 4) * 64;
    const int t = lane >> 2, qd = lane & 3, c0 = h * 64 + 16 * qd;
    const float* rkp = a.in[22] + l * 512 + c0; const float* lw = a.in[23] + l * 512 + c0; const float* lb = a.in[24] + l * 512 + c0;
    const LAS float* YB = (const LAS float*)(sl + RW_YB + par * 4096);
#pragma unroll 1
    for (int c = par; c < RW_NCH; c += 2) {
        bf16_t* zr = Zb + (size_t)(16 * c + t) * ZP;
        const u32x4 r0 = *(const u32x4*)(zr + ZC_RR + c0), r1 = *(const u32x4*)(zr + ZC_RR + c0 + 8), k0 = *(const u32x4*)(zr + ZC_RK + c0), k1 = *(const u32x4*)(zr + ZC_RK + c0 + 8);
        const u32x4 v0 = *(const u32x4*)(zr + ZC_RV + c0), v1 = *(const u32x4*)(zr + ZC_RV + c0 + 8), g0 = *(const u32x4*)(zr + gcol0 + 16 * qd), g1 = *(const u32x4*)(zr + gcol0 + 16 * qd + 8);
        rw_wait(flg + 8 + par, (unsigned)(c + 1));
        float y[16];
#pragma unroll
        for (int q4 = 0; q4 < 4; ++q4) { const f32x4 yy = *(const LAS f32x4*)(YB + t * 64 + 16 * qd + 4 * q4); y[4 * q4] = yy[0]; y[4 * q4 + 1] = yy[1]; y[4 * q4 + 2] = yy[2]; y[4 * q4 + 3] = yy[3]; }
        asm volatile("s_waitcnt lgkmcnt(0)" ::: "memory");
        flg[10 + par] = (unsigned)(c + 1);
        float s = 0.f;
#pragma unroll
        for (int e = 0; e < 16; ++e) s += y[e];
        s += __shfl_xor(s, 1); s += __shfl_xor(s, 2);
        const float mean = s * (1.f / 64); float q = 0.f;
#pragma unroll
        for (int e = 0; e < 16; ++e) { y[e] -= mean; q += y[e] * y[e]; }
        q += __shfl_xor(q, 1); q += __shfl_xor(q, 2);
        const float rstd = rsqrtf(q * (1.f / 64) + GN_EPS);
        float rv[16], kv[16];
        unpack8(r0, *(float(*)[8])&rv[0]); unpack8(r1, *(float(*)[8])&rv[8]); unpack8(k0, *(float(*)[8])&kv[0]); unpack8(k1, *(float(*)[8])&kv[8]);
        float bs = 0.f;
#pragma unroll
        for (int e = 0; e < 16; ++e) bs += rv[e] * kv[e] * rkp[e];
        bs += __shfl_xor(bs, 1); bs += __shfl_xor(bs, 2);
        float vv[16], gv[16], o[16];
        unpack8(v0, *(float(*)[8])&vv[0]); unpack8(v1, *(float(*)[8])&vv[8]); unpack8(g0, *(float(*)[8])&gv[0]); unpack8(g1, *(float(*)[8])&gv[8]);
#pragma unroll
        for (int e = 0; e < 16; ++e) o[e] = (y[e] * rstd * lw[e] + lb[e] + bs * vv[e]) * gv[e];
        *(u32x4*)(zr + ZC_RR + c0) = pack8(*(float(*)[8])&o[0]); *(u32x4*)(zr + ZC_RR + c0 + 8) = pack8(*(float(*)[8])&o[8]);
    }
}

#define XB_TMO      128
#define XB_XCNT(j)  (256  + 64 * (j))
#define XB_XSUB(j)  (1280 + 64 * (j))
#define XB_XGEN(j)  (2304 + 64 * (j))
#define XB_TOP      3328
#define XB_TOPGEN   3392
#define XCD_BAR_WORDS 3456
#define XB_SPIN_CAP (1u << 18)

__device__ __forceinline__ unsigned xb_ld(unsigned* p)              { return __hip_atomic_load(p, __ATOMIC_RELAXED, __HIP_MEMORY_SCOPE_AGENT); }
__device__ __forceinline__ unsigned xb_add(unsigned* p, unsigned v) { return __hip_atomic_fetch_add(p, v, __ATOMIC_RELAXED, __HIP_MEMORY_SCOPE_AGENT); }
__device__ __forceinline__ unsigned xb_xcc_id() { return (unsigned)__builtin_amdgcn_s_getreg((3 << 11) | 20) & 0xFu; }
#define XB_SPIN(cond, bar) do { unsigned _sp = 0; while (cond) { __builtin_amdgcn_s_sleep(1); \
    if ((++_sp & 255u) == 0u) { if (xb_ld(&(bar)[XB_TMO])) break; if (_sp > XB_SPIN_CAP) { atomicAdd(&(bar)[XB_TMO], 1u); break; } } } } while (0)

struct XcdBarrier {
    unsigned* bar; unsigned x;
    volatile LAS unsigned* st;
};

__device__ __forceinline__ XcdBarrier xcd_barrier_post(unsigned* bar, volatile LAS unsigned* st) {
    XcdBarrier b; b.bar = bar; b.x = xb_xcc_id(); b.st = st;
    if (threadIdx.x == 0) (void)xb_add(&bar[XB_XCNT(b.x)], 1u);
    return b;
}
__device__ __forceinline__ void xcd_barrier_complete(unsigned* bar, unsigned x, unsigned& nloc, unsigned& nx) {
    const unsigned G = gridDim.x * gridDim.y * gridDim.z;
    unsigned sum, cnt, mine, sp = 0u;
    for (;;) {
        sum = 0u; cnt = 0u; mine = 0u;
#pragma unroll
        for (unsigned j = 0; j < 16; ++j) { const unsigned c = xb_ld(&bar[XB_XCNT(j)]); sum += c; cnt += (c > 0u) ? 1u : 0u; mine = (j == x) ? c : mine; }
        if (sum == G) break;
        __builtin_amdgcn_s_sleep(1);
        if ((++sp & 255u) == 0u) { if (xb_ld(&bar[XB_TMO])) break; if (sp > XB_SPIN_CAP) { atomicAdd(&bar[XB_TMO], 1u); break; } }
    }
    nloc = mine > 0u ? mine : 1u; nx = cnt > 0u ? cnt : 1u;
}

__device__ __forceinline__ void xcd_barrier(const XcdBarrier& b) {
    asm volatile("s_waitcnt vmcnt(0)" ::: "memory");
    __syncthreads();
    if (threadIdx.x == 0) {
        unsigned* bar = b.bar;
        __builtin_amdgcn_s_waitcnt(0);
        unsigned nloc = b.st[0], nx = b.st[1];
        if (nloc == 0u) { xcd_barrier_complete(bar, b.x, nloc, nx); b.st[0] = nloc; b.st[1] = nx; }
        const unsigned old = xb_add(&bar[XB_XSUB(b.x)], 1u);
        const unsigned gen = old / nloc;
        if (old + 1u == (gen + 1u) * nloc) {
            __builtin_amdgcn_fence(__ATOMIC_RELEASE, "agent");
            asm volatile("s_waitcnt vmcnt(0)" ::: "memory");
            const unsigned og = xb_add(&bar[XB_TOP], 1u);
            const unsigned tg = og / nx;
            if (og + 1u == (tg + 1u) * nx) xb_add(&bar[XB_TOPGEN], 1u);
            else XB_SPIN(xb_ld(&bar[XB_TOPGEN]) == tg, bar);
            __builtin_amdgcn_fence(__ATOMIC_ACQUIRE, "agent");
            xb_add(&bar[XB_XGEN(b.x)], 1u);
            asm volatile("s_waitcnt vmcnt(0)" ::: "memory");
        } else {
            XB_SPIN(xb_ld(&bar[XB_XGEN(b.x)]) == gen, bar);
            __builtin_amdgcn_fence(__ATOMIC_ACQUIRE, "agent");
            asm volatile("s_waitcnt vmcnt(0)" ::: "memory");
        }
    }
    __syncthreads();
}

constexpr int N_PHASES = 1 + 15 * NL;
#ifndef MK_MULTI
#define MK_MULTI 0
#endif
#ifndef PROBE_Q
#define PROBE_Q 500.f
#endif
#ifndef PROBE_OFF
#define PROBE_OFF 0.f
#endif
#ifndef REPK
#define REPK 0
#endif
#ifndef ATT_REP
#define ATT_REP 1
#endif
#ifndef PREP_REP
#define PREP_REP 1
#endif
#ifndef RWROLES
#define RWROLES 7
#endif
#ifndef PHMASK
#define PHMASK 0xFFFF
#endif
#define PHON(k) ((PHMASK >> (k)) & 1)
__global__ void __launch_bounds__(512, 2) fwd_megakernel(Args a) {
    extern __shared__ __attribute__((aligned(16))) unsigned char lds_raw[];
    LAS unsigned char* lds = (LAS unsigned char*)lds_raw;
    cg::grid_group grid = cg::this_grid();
    { volatile LAS unsigned* st0 = (volatile LAS unsigned*)(lds + 131072 + 128); if (threadIdx.x == 0) { st0[0] = 0u; st0[1] = 0u; } __syncthreads(); }
    XcdBarrier xbar = xcd_barrier_post((unsigned*)(a.ws + WS_CTL) + 4096, (volatile LAS unsigned*)(lds + 131072 + 128));
    const int G = gridDim.x, bid = blockIdx.x, NGW = G * 8;
    unsigned char* ws = a.ws;
    bf16_t* HN = (bf16_t*)(ws + WS_HN); bf16_t* Z = (bf16_t*)(ws + WS_Z); bf16_t* HID = Z; bf16_t* QX = Z; bf16_t* OX = Z + (size_t)TOK * 512;
#ifdef PROBE_GROUP
    LAS unsigned long long* prs = (LAS unsigned long long*)(lds + 131072 + 64);
    if (threadIdx.x == 0) { prs[0] = __builtin_amdgcn_s_memrealtime(); prs[1] = 0ull; prs[2] = 99ull; }
#endif
#ifdef PROBE_GROUP
    for (int ph = a.ph_lo; ph <= a.ph_hi; ++ph) {
#else
    for (int ph = a.ph_lo; ph < a.ph_hi; ++ph) {
#endif
        if (ph > 0) { const int l_ = (ph - 1) / 15, k_ = (ph - 1) % 15; if (k_ == 3 || k_ == 8 || k_ == 12 || (k_ == 0 && l_ > 0)) continue; }
        if (ph > a.ph_lo) { if (ph == a.ph_lo + 1 || MK_MULTI) grid.sync(); else xcd_barrier(xbar);
#ifdef SYNC_REP
            grid.sync(); grid.sync();
#endif
        }
#ifdef PROBE_GROUP
        if (threadIdx.x == 0) { const unsigned long long now = __builtin_amdgcn_s_memrealtime(); if (prs[2] == (unsigned long long)PROBE_GROUP) prs[1] += now - prs[0]; prs[0] = now;
          if (ph == a.ph_hi) { if (blockIdx.x == 0) { float us_ = (float)prs[1] * 0.01f;
#if PROBE_GROUP == 8
              us_ = (float)((volatile unsigned*)(ws + WS_CTL))[32 * 64] * 0.01f;
#endif
              a.out[0] = floorf((us_ + PROBE_OFF) / PROBE_Q) * PROBE_Q + 0.5f * PROBE_Q; } }
          const int k_ = (ph - 1) % 15; prs[2] = ph == 0 ? 0 : (k_ == 0 || k_ == 3 || k_ == 8 || k_ == 12) ? 1 : (k_ == 1 || k_ == 13) ? 2 : (k_ == 2 || k_ == 14 || k_ == 7 || k_ == 11) ? 3 : (k_ == 4 || k_ == 9) ? 4 : k_ == 5 ? 5 : k_ == 6 ? 6 : 7; }
        if (ph == a.ph_hi) break;
#endif
        int tidp = threadIdx.x; asm volatile("" : "+v"(tidp)); const int tid = tidp, lane = tid & 63, wid = __builtin_amdgcn_readfirstlane(tid >> 6), gw = bid * 8 + wid;
        if (ph == 0) { for (int rp_ = 0; rp_ < ((REPK >> 15) & 1) + 1; ++rp_) { if (PHON(15)) p0_prologue(a, lds, gw, NGW, wid, lane, tid); } continue; }
        const int l = (ph - 1) / 15, kind = (ph - 1) % 15;
        const unsigned char* wl = ws + WS_W + (size_t)l * WL_BYTES;
        float* SSQ = (float*)(ws + WS_SSQ);
        if (PHON(0) && kind == 0) prenorm_phase(a.in[0], a.in[3], HN, SSQ, TOK, gw, NGW, lane);
        if (PHON(1) && (kind == 1 || kind == 13)) {
            pg8::Gemm g{HN, (const bf16_t*)(wl + (kind == 1 ? OFF_F1I : OFF_F2I)), TOK, 2 * FF, DM, DM};
            pg8::StaticOrder S; S.init(TOK, 2 * FF, G, bid);
            pg8::EpiSwiglu E{HID, FF, SSQ};
            pg8::gemm_phase<pg8::EpiSwiglu, pg8::StaticOrder, true, true>(lds, g, S, E);
        }
        if (PHON(2) && (kind == 2 || kind == 14 || kind == 7 || kind == 11)) {
            pg8::Gemm g; pg8::EpiResid E; E.out = a.out; E.ldc = DM; g.M = TOK; g.N = DM;
            if (kind == 2 || kind == 14) { g.A = HID; g.lda = FF; g.K = FF; g.Bt = (const bf16_t*)(wl + (kind == 2 ? OFF_F1O : OFF_F2O)); E.scale = 0.5f; E.base = (l == 0 && kind == 2) ? a.in[0] : a.out; }
            else if (kind == 7) { g.A = Z; g.lda = ZP; g.K = DM; g.Bt = (const bf16_t*)(wl + OFF_MO); E.scale = 1.f; E.base = a.out; }
            else { g.A = OX; g.lda = 512; g.K = 512; g.Bt = (const bf16_t*)(wl + OFF_XO); E.scale = 1.f; E.base = a.out; }
            E.hn = HN; E.ssq = SSQ;
            E.gn = (kind == 2 ? a.in[6] + l * DM : kind == 7 ? a.in[25] + l * DM : kind == 11 ? a.in[32] + l * DM : a.in[3] + (l + 1) * DM);
            if (kind == 14 && l == NL - 1) { E.hn = nullptr; E.gn = a.in[3]; }
            pg8::StaticOrder S; S.init(TOK, DM, G, bid);
            const float sc_ = E.scale;
            for (int rp_ = ((REPK >> 2) & 1); rp_ >= 0; --rp_) { E.scale = rp_ ? 0.f : sc_;
            pg8::gemm_phase<pg8::EpiResid, pg8::StaticOrder, true, true>(lds, g, S, E); if (rp_) { __syncthreads(); } }
        }
        if (kind == 4 && l == 0) xkv_post(a, gw, NGW, lane);
        if (PHON(4) && (kind == 4 || kind == 9 || (kind == 0 && l == 0))) {
            const int ng = (kind == 0) ? NL : 1;
            for (int rp_ = 0; rp_ < ((REPK >> 4) & 1) + 1; ++rp_)
            for (int gi = 0; gi < ng; ++gi) {
                pg8::Gemm g; pg8::EpiBf16 E; int cidx = bid;
                if (kind == 4) { g.A = HN; g.lda = DM; g.K = DM; g.M = TOK; g.N = 3584; g.Bt = (const bf16_t*)(wl + OFF_MI); E.O = Z; E.ldc = ZP; E.ncols = ZC_VALID; E.halo = (bf16_t*)(ws + WS_ZHALO); E.ssq = SSQ; }
                else if (kind == 9) { g.A = HN; g.lda = DM; g.K = DM; g.M = TOK; g.N = 512; g.Bt = (const bf16_t*)(wl + OFF_XQ); E.O = QX; E.ldc = 512; E.ncols = 512; E.halo = nullptr; E.ssq = SSQ; }
                else { g.A = (const bf16_t*)(ws + WS_MEMN) + (size_t)gi * NB * MEMLEN * DM; g.lda = DM; g.K = DM; g.M = NB * MEMLEN; g.N = 1024;
                       g.Bt = (const bf16_t*)(ws + WS_W + (size_t)gi * WL_BYTES + OFF_XKV); E.O = (bf16_t*)(ws + WS_KVX) + (size_t)gi * NB * MEMLEN * 1024; E.ldc = 1024; E.ncols = 1024; E.halo = nullptr; E.ssq = nullptr;
                       cidx = (bid + gi * (G / 2)) % G; }
                pg8::StaticOrder S; S.init(g.M, g.N, G, cidx);
                pg8::gemm_phase<pg8::EpiBf16, pg8::StaticOrder, true, true>(lds, g, S, E);
            }
        }
        if (PHON(5) && kind == 5) { for (int rp_ = PREP_REP - 1; rp_ >= 0; --rp_) for (int tile = bid; tile < TOK / 64; tile += G) prep_tile(a, l, tile, lds, rp_ > 0); }
        if (PHON(6) && kind == 6) {
            unsigned* ctr = (unsigned*)(ws + WS_CTL) + 64 * (1 + l); LAS unsigned* qw = (LAS unsigned*)(lds + 131072);
            for (;;) {
                __syncthreads();
                if (tid == 0) *qw = atomicAdd(ctr, 1u);
                __syncthreads();
                const int item = __builtin_amdgcn_readfirstlane((int)*qw);
                if (item >= 64 + 1024) break;
                if (item < 64) {
                    if (tid < 16) ((LAS unsigned*)(lds + RW_FLG))[tid] = 0u;
                    __syncthreads();
                    if (PHON(7)) {
                        const int ub = item >> 3, uh = item & 7;
                        if (wid == 0 || wid == 4 || wid == 2 || wid == 6) { if (RWROLES & 1) rwkv_pre(a, ub, uh, lds, wid == 0 ? 0 : wid == 4 ? 1 : wid == 2 ? 2 : 3); }
                        else if (wid == 1) { if (RWROLES & 2) rwkv_main(lds); }
                        else if (wid == 3 || wid == 7) { if (RWROLES & 4) rwkv_post(a, l, ub, uh, lds, wid == 3 ? 0 : 1); }
                    }
                }
                else {
                    const int j = item - 64, qb = 15 - (j >> 6), kk = j & 63, type = kk >> 5, bh = kk & 31, b = bh >> 2, h = bh & 3;
                    bf16_t* Zb = Z + (size_t)b * SEQ * ZP;
                    for (int rp_ = ATT_REP - 1; rp_ >= 0; --rp_)
                    if (type == 0) { if (PHON(8)) attn_unit<0, 64>(lds, Zb + ZC_FQ + 64 * h, ZP, Zb + ZC_FK + 64 * h, ZP, (const bf16_t*)(ws + WS_VTF) + (size_t)bh * 64 * SEQ, SEQ, Zb + ZC_FQ + 64 * h, ZP,
                                                   256 * qb, 4 * (qb + 1), qb, (const float*)(ws + WS_LOGF) + (size_t)bh * SEQ, nullptr, rp_ > 0); }
                    else if (PHON(9)) attn_unit<1, 64>(lds, Zb + ZC_MQ + 64 * h, ZP, Zb + ZC_MK + 64 * h, ZP, (const bf16_t*)(ws + WS_VTM) + (size_t)bh * 64 * SEQ, SEQ, Zb + ZC_MQ + 64 * h, ZP,
                                          256 * qb, 4 * (qb + 1), qb, (const float*)(ws + WS_KMP) + (size_t)bh * 64 * 64, nullptr, rp_ > 0);
                }
            }
        }
        if (PHON(10) && kind == 10) {
            for (int rp_ = 0; rp_ < ((REPK >> 10) & 1) + 1; ++rp_)
            for (int u = bid; u < NB * 4 * 16; u += G) { const int b = u >> 6, hd = (u >> 4) & 3, qb = u & 15;
                bf16_t* qp = QX + (size_t)b * SEQ * 512 + hd * 128;
                attn_unit<2, 128>(lds, qp, 512, (const bf16_t*)(ws + WS_KVX) + ((size_t)l * NB + b) * MEMLEN * 1024 + hd * 128, 1024,
                                  (const bf16_t*)(ws + WS_VTX) + ((size_t)(l * NB + b) * 4 + hd) * 128 * MEMLEN, MEMLEN, OX + (size_t)b * SEQ * 512 + hd * 128, 512, 256 * qb, MEMLEN / 64, qb, nullptr, a.in[29] + l * 128); }
        }
    }
}

extern "C" void kernel_launch(void* const* d_in, const int* in_sizes, int n_in, void* d_out, int out_size, void* d_ws, size_t ws_size, hipStream_t stream) {
    static int grid_blocks = 0;
    if (grid_blocks == 0) {
        if (n_in != 35 || ws_size < WS_END) { fprintf(stderr, "kernel_launch: unexpected n_in %d / ws %zu\n", n_in, ws_size); grid_blocks = -1; return; }
        int dev = 0, cus = 0, per_cu = 0;
        hipGetDevice(&dev); hipDeviceGetAttribute(&cus, hipDeviceAttributeMultiprocessorCount, dev);
        if (hipFuncSetAttribute((const void*)fwd_megakernel, hipFuncAttributeMaxDynamicSharedMemorySize, LDS_BYTES) != hipSuccess) { fprintf(stderr, "kernel_launch: hipFuncSetAttribute failed\n"); grid_blocks = -1; return; }
        if (hipOccupancyMaxActiveBlocksPerMultiprocessor(&per_cu, (const void*)fwd_megakernel, 512, LDS_BYTES) != hipSuccess || per_cu < 1) { fprintf(stderr, "kernel_launch: occupancy query says %d\n", per_cu); per_cu = 1; }
        (void)hipGetLastError();
        grid_blocks = cus * per_cu;
    }
    if (grid_blocks < 0) return;
    Args a{};
    for (int i = 0; i < 35; ++i) a.in[i] = (const float*)d_in[i];
    a.out = (float*)d_out; a.ws = (unsigned char*)d_ws;
    if (hipMemsetAsync(d_ws, 0, 65536, stream) != hipSuccess) { fprintf(stderr, "kernel_launch: memset failed\n"); return; }
#if MK_MULTI
    for (int ph = 0; ph < N_PHASES; ++ph) { a.ph_lo = ph; a.ph_hi = ph + 1; hipLaunchKernelGGL(fwd_megakernel, dim3(grid_blocks), dim3(512), LDS_BYTES, stream, a); }
#else
    a.ph_lo = 0; a.ph_hi = N_PHASES;
    void* args[] = {&a};
    hipError_t e = hipLaunchCooperativeKernel((const void*)fwd_megakernel, dim3(grid_blocks), dim3(512), args, LDS_BYTES, stream);
    if (e != hipSuccess) fprintf(stderr, "cooperative launch failed: %s (grid %d)\n", hipGetErrorString(e), grid_blocks);
#endif
}
```

```cpp
#include <hip/hip_runtime.h>
#include <hip/hip_cooperative_groups.h>
#include <cstdio>
#include <cstdint>
namespace cg = cooperative_groups;
namespace pg8 {
#define PG8_LAS __attribute__((address_space(3)))
typedef unsigned short bf16_t;
typedef short bf16x8 __attribute__((ext_vector_type(8)));
typedef float f32x4 __attribute__((ext_vector_type(4)));
typedef unsigned u32x4 __attribute__((ext_vector_type(4)));
constexpr int BM = 256, BK = 64, HALF = 128, HTB = HALF * BK * 2  , STAGE_BYTES = 8 * HTB, NXCD = 8, WGM = 8;

__host__ __device__ __forceinline__ int lds_byte(int r, int c) { const int st = (r >> 4) * 2 + (c >> 5), rr = r & 15, cc = c & 31, ob = rr * 64 + cc * 2; return st * 1024 + (ob ^ (((ob >> 9) & 1) << 5)); }
__host__ __device__ __forceinline__ void stage_rc(int b, int& R, int& C) { const int st = b / 1024, sb = b % 1024, swz = sb ^ (((sb >> 9) & 1) << 5); R = (st >> 1) * 16 + swz / 64; C = (st & 1) * 32 + (swz % 64) / 2; }
__host__ __device__ __forceinline__ int perm32(int rho) { const int n = rho >> 4, i = rho & 15; return 8 * (i >> 2) + 4 * n + (i & 3); }

struct Unit { int pm, pn; };
struct Gemm { const bf16_t* A; const bf16_t* Bt; int M, N, K, lda; };

struct StaticOrder {
    int nM, nN, nwg, G, c;
    __host__ __device__ void init(int M, int N, int G_, int c_) { nM = M / BM; nN = N / BM; nwg = nM * nN; G = G_; c = c_; }
    __host__ __device__ bool next(int i, Unit& u) const {
        const long L = (long)i * G + c; if (L >= nwg) return false;
        int wgid = (int)L; { const int q = nwg / NXCD, r = nwg % NXCD, xcd = wgid % NXCD, off = wgid / NXCD; wgid = (xcd < r ? xcd * (q + 1) : r * (q + 1) + (xcd - r) * q) + off; }
        const int nig = WGM * nN, gid = wgid / nig, fm = gid * WGM, gsz = (nM - fm) < WGM ? (nM - fm) : WGM;
        u.pm = fm + ((wgid % nig) % gsz); u.pn = (wgid % nig) / gsz; return true;
    }
    __device__ __forceinline__ void a_ready(const Unit&) const {}
    __device__ __forceinline__ void done(const Unit&) const {}
};
__device__ __forceinline__ unsigned cvt_pk_bf16(float lo, float hi) { unsigned r; asm volatile("v_cvt_pk_bf16_f32 %0, %1, %2" : "=v"(r) : "v"(lo), "v"(hi)); return r; }
__device__ __forceinline__ float silu_f(float x) { return x * __builtin_amdgcn_rcpf(1.0f + __builtin_amdgcn_exp2f(-1.4426950408889634f * x)); }
struct EpiSwiglu {
    static constexpr bool PERM = true, AFTER_DRAIN = false;
    bf16_t* O; int ldc;
    __device__ __forceinline__ void operator()(const f32x4 (&acc)[2][2][4][2], const Unit& u, int wr, int wc, int fr, int fq) const {
        const int row0 = u.pm * BM + wr * 64 + fr, col0 = u.pn * HALF + wc * 32 + 8 * fq;
#pragma unroll
        for (int ai = 0; ai < 2; ++ai)
#pragma unroll
            for (int m = 0; m < 4; ++m) {
                const f32x4 g0 = acc[ai][0][m][0], g1 = acc[ai][0][m][1], u0 = acc[ai][1][m][0], u1 = acc[ai][1][m][1];
                u32x4 w;
                w.x = cvt_pk_bf16(silu_f(g0[0]) * u0[0], silu_f(g0[1]) * u0[1]); w.y = cvt_pk_bf16(silu_f(g0[2]) * u0[2], silu_f(g0[3]) * u0[3]);
                w.z = cvt_pk_bf16(silu_f(g1[0]) * u1[0], silu_f(g1[1]) * u1[1]); w.w = cvt_pk_bf16(silu_f(g1[2]) * u1[2], silu_f(g1[3]) * u1[3]);
                *(u32x4*)(O + (size_t)(row0 + ai * HALF + m * 16) * ldc + col0) = w;
            }
    }
};
struct EpiResid {
    static constexpr bool PERM = false, AFTER_DRAIN = false;
    const float* base; float* out; int ldc; float scale;
    __device__ __forceinline__ void operator()(const f32x4 (&acc)[2][2][4][2], const Unit& u, int wr, int wc, int fr, int fq) const {
        const int row0 = u.pm * BM + wr * 64 + fr, col0 = u.pn * BM + wc * 32 + 4 * fq;
#pragma unroll
        for (int ai = 0; ai < 2; ++ai)
#pragma unroll
            for (int m = 0; m < 4; ++m) { const size_t off = (size_t)(row0 + ai * HALF + m * 16) * ldc + col0;
#pragma unroll
                for (int bj = 0; bj < 2; ++bj)
#pragma unroll
                    for (int n = 0; n < 2; ++n) { const f32x4 b = *(const f32x4*)(base + off + bj * HALF + n * 16); *(f32x4*)(out + off + bj * HALF + n * 16) = b + acc[ai][bj][m][n] * scale; }
                asm volatile("" ::: "memory"); }
    }
};
struct EpiBf16 {
    static constexpr bool PERM = true, AFTER_DRAIN = false;
    bf16_t* O; int ldc; int ncols; bf16_t* halo;
    __device__ __forceinline__ void operator()(const f32x4 (&acc)[2][2][4][2], const Unit& u, int wr, int wc, int fr, int fq) const {
        const int row0 = u.pm * BM + wr * 64 + fr, col0 = u.pn * BM + wc * 32 + 8 * fq;
#pragma unroll
        for (int ai = 0; ai < 2; ++ai)
#pragma unroll
            for (int m = 0; m < 4; ++m) { const int row = row0 + ai * HALF + m * 16;
#pragma unroll
                for (int bj = 0; bj < 2; ++bj) { const int col = col0 + bj * HALF;
                    if (col < ncols) { const f32x4 v0 = acc[ai][bj][m][0], v1 = acc[ai][bj][m][1]; u32x4 w;
                        w.x = cvt_pk_bf16(v0[0], v0[1]); w.y = cvt_pk_bf16(v0[2], v0[3]); w.z = cvt_pk_bf16(v1[0], v1[1]); w.w = cvt_pk_bf16(v1[2], v1[3]);
                        *(u32x4*)(O + (size_t)row * ldc + col) = w;
                        if (halo && (row & 63) == 63) *(u32x4*)(halo + (size_t)(row >> 6) * ldc + col) = w; } } }
    }
};
template <class Epi, class Sched, bool ALIGN_EPI = false, bool SP2 = false>
__device__ __forceinline__ void gemm_phase(PG8_LAS unsigned char* lds, const Gemm g, const Sched& S, const Epi& E) {
    int tid_ = threadIdx.x; asm volatile("" : "+v"(tid_)); const int tid = tid_, wid = __builtin_amdgcn_readfirstlane(tid >> 6), lane = tid & 63, wr = wid >> 2, wc = wid & 3, fr = lane & 15, fq = lane >> 4;
    const int K = g.K, nt = K / BK;
    unsigned voffA[2], voffB[2];
#pragma unroll
    for (int i = 0; i < 2; ++i) { int R, C; stage_rc(tid * 16 + i * 8192, R, C); const int Rb = Epi::PERM ? ((R & ~31) + perm32(R & 31)) : R;
        voffA[i] = (unsigned)(R * g.lda + C) * 2u; voffB[i] = (unsigned)(Rb * K + C) * 2u; }
    const size_t kstep = (size_t)(BK * 2);
    const size_t hstep = (size_t)HALF * K * 2;
    const size_t tstep = 2 * hstep; const size_t hstepA = (size_t)HALF * g.lda * 2, tstepA = 2 * hstepA;
    const unsigned ldsw = (unsigned)wid * 1024u;
    const int aoff = lds_byte(wr * 64 + fr, fq * 8), boff = lds_byte(wc * 32 + fr, fq * 8);
#define PG8_SA(b, h) (((b) * 2 + (h)) * HTB)
#define PG8_SB(b, h) ((4 + (b) * 2 + (h)) * HTB)
#define PG8_STAGE(bufoff, gbase, voff) do { _Pragma("unroll") for (int _i = 0; _i < 2; ++_i) \
        __builtin_amdgcn_global_load_lds((const unsigned*)((const char*)(gbase) + (voff)[_i]), (PG8_LAS unsigned*)(lds + (bufoff) + ldsw + _i * 8192), 16, 0, 0); } while (0)
#define PG8_LDA(dst, b, h) do { _Pragma("unroll") for (int m = 0; m < 4; ++m) _Pragma("unroll") for (int k = 0; k < 2; ++k) dst[m][k] = *(const PG8_LAS bf16x8*)(lds + PG8_SA(b, h) + aoff + m * 2048 + k * 1024); } while (0)
#define PG8_LDB(dst, b, h) do { _Pragma("unroll") for (int n = 0; n < 2; ++n) _Pragma("unroll") for (int k = 0; k < 2; ++k) dst[n][k] = *(const PG8_LAS bf16x8*)(lds + PG8_SB(b, h) + boff + n * 2048 + k * 1024); } while (0)
#define PG8_MMA(ai, bj, At, Bt) do { __builtin_amdgcn_s_setprio(1); _Pragma("unroll") for (int m = 0; m < 4; ++m) _Pragma("unroll") for (int n = 0; n < 2; ++n) _Pragma("unroll") for (int k = 0; k < 2; ++k) \
        acc[ai][bj][m][n] = __builtin_amdgcn_mfma_f32_16x16x32_bf16(Bt[n][k], At[m][k], acc[ai][bj][m][n], 0, 0, 0); __builtin_amdgcn_s_setprio(0); } while (0)
#define PG8_WAIT_V(n) asm volatile("s_waitcnt vmcnt(" #n ")" ::: "memory")
#define PG8_WAIT_L(n) asm volatile("s_waitcnt lgkmcnt(" #n ")" ::: "memory")
#define PG8_BAR __builtin_amdgcn_s_barrier()
#define PG8_SCHED __builtin_amdgcn_sched_barrier(0)
    Unit cur, nxt; int ui = 0;
    if (!S.next(0, cur)) return;
    f32x4 acc[2][2][4][2];
#pragma unroll
    for (int a = 0; a < 2; ++a)
#pragma unroll
        for (int b = 0; b < 2; ++b)
#pragma unroll
            for (int m = 0; m < 4; ++m)
#pragma unroll
                for (int n = 0; n < 2; ++n) acc[a][b][m][n] = (f32x4){0.f, 0.f, 0.f, 0.f};
    bf16x8 At[4][2], B0[2][2], B1[2][2];
    const char* cA = (const char*)g.A + (size_t)cur.pm * tstepA; const char* cB = (const char*)g.Bt + (size_t)cur.pn * tstep;
    S.a_ready(cur);
    if constexpr (SP2) {
        PG8_STAGE(PG8_SB(0, 0), cB, voffB); PG8_STAGE(PG8_SB(0, 1), cB + hstep, voffB); PG8_STAGE(PG8_SA(0, 0), cA, voffA); PG8_STAGE(PG8_SA(0, 1), cA + hstepA, voffA);
        if (wr == 1) PG8_BAR;
        PG8_WAIT_V(2); PG8_BAR;
        PG8_STAGE(PG8_SB(1, 0), cB + kstep, voffB); PG8_STAGE(PG8_SA(1, 0), cA + kstep, voffA); PG8_STAGE(PG8_SB(1, 1), cB + hstep + kstep, voffB);
        PG8_WAIT_V(6); PG8_BAR;
    } else {
        PG8_STAGE(PG8_SB(0, 0), cB, voffB); PG8_STAGE(PG8_SA(0, 0), cA, voffA); PG8_STAGE(PG8_SB(0, 1), cB + hstep, voffB); PG8_STAGE(PG8_SA(0, 1), cA + hstepA, voffA);
        if (wr == 1) PG8_BAR;
        PG8_WAIT_V(4); PG8_BAR;
        PG8_STAGE(PG8_SB(1, 0), cB + kstep, voffB); PG8_STAGE(PG8_SA(1, 0), cA + kstep, voffA); PG8_STAGE(PG8_SB(1, 1), cB + hstep + kstep, voffB);
        PG8_WAIT_V(6); PG8_BAR;
    }
    for (;;) {
        const bool has_next = S.next(ui + 1, nxt);
        const char* nA = has_next ? (const char*)g.A + (size_t)nxt.pm * tstepA : cA; const char* nB = has_next ? (const char*)g.Bt + (size_t)nxt.pn * tstep : cB;
        for (int t = 0; t < nt; t += 2) {
            const bool last = (t == nt - 2);
            const char* a1 = cA + (size_t)(t + 1) * kstep;
            const char* a2 = last ? nA : cA + (size_t)(t + 2) * kstep; const char* b2 = last ? nB : cB + (size_t)(t + 2) * kstep;
            const char* a3 = a2 + kstep; const char* b3 = b2 + kstep;
            if (last && has_next) S.a_ready(nxt);
            if constexpr (SP2) {
            PG8_LDB(B0, 0, 0); PG8_LDB(B1, 0, 1); PG8_SCHED; PG8_LDA(At, 0, 0); PG8_STAGE(PG8_SA(1, 1), a1 + hstepA, voffA);
            PG8_WAIT_V(8); PG8_WAIT_L(0); PG8_BAR; PG8_MMA(0, 0, At, B0); PG8_MMA(0, 1, At, B1); PG8_BAR; PG8_SCHED;
            PG8_LDA(At, 0, 1); PG8_STAGE(PG8_SB(0, 0), b2, voffB); PG8_STAGE(PG8_SB(0, 1), b2 + hstep, voffB); PG8_STAGE(PG8_SA(0, 0), a2, voffA);
            PG8_WAIT_V(8); PG8_WAIT_L(0); PG8_BAR; PG8_MMA(1, 0, At, B0); PG8_MMA(1, 1, At, B1); PG8_BAR; PG8_SCHED;
            PG8_LDB(B0, 1, 0); PG8_LDB(B1, 1, 1); PG8_SCHED; PG8_LDA(At, 1, 0); PG8_STAGE(PG8_SA(0, 1), a2 + hstepA, voffA);
            PG8_WAIT_V(8); PG8_WAIT_L(0); PG8_BAR; PG8_MMA(0, 0, At, B0); PG8_MMA(0, 1, At, B1); PG8_BAR; PG8_SCHED;
            PG8_LDA(At, 1, 1); PG8_STAGE(PG8_SB(1, 0), b3, voffB); PG8_STAGE(PG8_SB(1, 1), b3 + hstep, voffB); PG8_STAGE(PG8_SA(1, 0), a3, voffA);
            PG8_WAIT_V(8); PG8_WAIT_L(0); PG8_BAR; PG8_MMA(1, 0, At, B0); PG8_MMA(1, 1, At, B1); PG8_BAR; PG8_SCHED;
            } else {
            PG8_LDB(B0, 0, 0); PG8_SCHED; PG8_LDA(At, 0, 0); PG8_STAGE(PG8_SA(1, 1), a1 + hstepA, voffA);
            PG8_WAIT_L(8); PG8_BAR; PG8_WAIT_L(0); PG8_MMA(0, 0, At, B0); PG8_BAR; PG8_SCHED;
            PG8_LDB(B1, 0, 1); PG8_STAGE(PG8_SB(0, 0), b2, voffB);
            PG8_BAR; PG8_WAIT_L(0); PG8_MMA(0, 1, At, B1); PG8_BAR;
            PG8_LDA(At, 0, 1); PG8_STAGE(PG8_SA(0, 0), a2, voffA);
            PG8_BAR; PG8_WAIT_L(0); PG8_MMA(1, 0, At, B0); PG8_BAR; PG8_SCHED;
            PG8_STAGE(PG8_SB(0, 1), b2 + hstep, voffB);
            PG8_WAIT_V(6); PG8_BAR; PG8_MMA(1, 1, At, B1); PG8_BAR;
            PG8_LDB(B0, 1, 0); PG8_SCHED; PG8_LDA(At, 1, 0); PG8_STAGE(PG8_SA(0, 1), a2 + hstepA, voffA);
            PG8_WAIT_L(8); PG8_BAR; PG8_WAIT_L(0); PG8_MMA(0, 0, At, B0); PG8_BAR; PG8_SCHED;
            PG8_LDB(B1, 1, 1); PG8_STAGE(PG8_SB(1, 0), b3, voffB);
            PG8_BAR; PG8_WAIT_L(0); PG8_MMA(0, 1, At, B1); PG8_BAR;
            PG8_LDA(At, 1, 1); PG8_STAGE(PG8_SA(1, 0), a3, voffA);
            PG8_BAR; PG8_WAIT_L(0); PG8_MMA(1, 0, At, B0); PG8_BAR; PG8_SCHED;
            PG8_STAGE(PG8_SB(1, 1), b3 + hstep, voffB);
            PG8_WAIT_V(6); PG8_BAR; PG8_MMA(1, 1, At, B1); PG8_BAR;
            }
        }
        if constexpr (ALIGN_EPI) { if (wr == 0) PG8_BAR; }
        if constexpr (!Epi::AFTER_DRAIN) { E(acc, cur, wr, wc, fr, fq); S.done(cur); }
        if (!has_next) break;
#pragma unroll
        for (int a = 0; a < 2; ++a)
#pragma unroll
            for (int b = 0; b < 2; ++b)
#pragma unroll
                for (int m = 0; m < 4; ++m)
#pragma unroll
                    for (int n = 0; n < 2; ++n) acc[a][b][m][n] = (f32x4){0.f, 0.f, 0.f, 0.f};
        cur = nxt; cA = nA; cB = nB; ++ui;
        if constexpr (ALIGN_EPI) { if (wr == 1) PG8_BAR; }
    }
    PG8_WAIT_V(0);
    if constexpr (!ALIGN_EPI) { if (wr == 0) PG8_BAR; }
    PG8_BAR;
    if constexpr (Epi::AFTER_DRAIN) { E.fused(acc, cur, wr, wc, fr, fq, lds, wid, lane); S.done(cur); }
#undef PG8_SA
#undef PG8_SB
#undef PG8_STAGE
#undef PG8_LDA
#undef PG8_LDB
#undef PG8_MMA
#undef PG8_WAIT_V
#undef PG8_WAIT_L
#undef PG8_BAR
#undef PG8_SCHED
}
}

#define LAS __attribute__((address_space(3)))
#define DEV __device__ __forceinline__
typedef unsigned short bf16_t;
typedef short bf16x8 __attribute__((ext_vector_type(8)));
typedef short s16x4 __attribute__((ext_vector_type(4)));
typedef float f32x4 __attribute__((ext_vector_type(4)));
typedef float f32x16 __attribute__((ext_vector_type(16)));
typedef unsigned u32x2 __attribute__((ext_vector_type(2)));
typedef unsigned u32x4 __attribute__((ext_vector_type(4)));
typedef unsigned u32x8 __attribute__((ext_vector_type(8)));

constexpr int NB = 8, SEQ = 4096, DM = 1024, TOK = NB * SEQ, FF = 2816, NL = 2, MEMLEN = 256;
constexpr int ZP = 3392;
constexpr int ZC_FQ = 0, ZC_RR = 256, ZC_MQ = 768, ZC_FK = 1024, ZC_FV = 1280, ZC_MK = 1536, ZC_MV = 1792, ZC_RK = 2048, ZC_RV = 2560, ZC_LO = 3072, ZC_FF = 3360, ZC_VALID = 3368;
constexpr float NORM_EPS = 1e-6f, GN_EPS = 64e-5f, LOG2E = 1.4426950408889634f;
constexpr float C2_64 = 0.125f * LOG2E, C2_128 = 0.08838834764831845f * LOG2E;
constexpr size_t MiB = 1u << 20;
constexpr size_t WS_CTL = 0;
constexpr size_t WS_W = 1 * MiB, WL_BYTES = 48 * MiB;
constexpr size_t OFF_F1I = 0, OFF_F1O = 11 * MiB, OFF_F2I = 17 * MiB, OFF_F2O = 28 * MiB, OFF_MI = 34 * MiB, OFF_MO = 41 * MiB, OFF_XQ = 43 * MiB, OFF_XKV = 44 * MiB, OFF_XO = 46 * MiB;
constexpr size_t OFF_W2T = 47 * MiB, OFF_A2T = OFF_W2T + 65536, OFF_G2T = OFF_A2T + 65536;
constexpr size_t WS_Z = 97 * MiB;
constexpr size_t WS_C = WS_Z + 212 * MiB;
constexpr size_t WS_HN = WS_C;
constexpr size_t WS_WD = WS_C, WS_KK = WS_C + 64 * MiB, WS_KA = WS_C + 96 * MiB;
constexpr size_t WS_VTF = WS_C + 128 * MiB, WS_VTM = WS_C + 144 * MiB;
constexpr size_t WS_LOGF = WS_C + 160 * MiB, WS_KMP = WS_LOGF + 512 * 1024, WS_ZHALO = WS_C + 161 * MiB;
constexpr size_t WS_KVX = WS_C + 165 * MiB, WS_VTX = WS_C + 173 * MiB, WS_MEMN = WS_C + 177 * MiB, WS_END = WS_C + 185 * MiB;
static_assert(WS_END <= 512 * MiB, "workspace map");
constexpr int LDS_BYTES = 131072 + 1024;

struct Args { const float* in[35]; float* out; unsigned char* ws; int ph_lo, ph_hi; };

DEV float bf2f(unsigned short b) { return __uint_as_float((unsigned)b << 16); }
typedef float f32x2_t __attribute__((ext_vector_type(2))); typedef __bf16 bf16x2_t __attribute__((ext_vector_type(2)));
DEV unsigned pk2(float lo, float hi) { const f32x2_t v = {lo, hi}; const bf16x2_t r = __builtin_convertvector(v, bf16x2_t); return __builtin_bit_cast(unsigned, r); }
DEV unsigned f2bf(float f) { return pk2(f, f) & 0xffffu; }
DEV float wave_sum(float v) {
#pragma unroll
    for (int o = 1; o < 64; o <<= 1) v += __shfl_xor(v, o);
    return v;
}
#define LDS_WAIT() asm volatile("s_waitcnt lgkmcnt(0)" ::: "memory")

struct MatInfo { const float* src; bf16_t* dst; int K, Ns, Nd, map; };
DEV MatInfo matinfo(const Args& a, int m) {
    const int l = m / 12, k = m % 12; unsigned char* wl = a.ws + WS_W + (size_t)l * WL_BYTES; MatInfo r;
    switch (k) {
    case 0:  r.src = a.in[4] + (size_t)l * DM * 2 * FF;  r.dst = (bf16_t*)(wl + OFF_F1I); r.K = DM; r.Ns = 2 * FF; r.Nd = 2 * FF; r.map = 1; break;
    case 1:  r.src = a.in[5] + (size_t)l * FF * DM;      r.dst = (bf16_t*)(wl + OFF_F1O); r.K = FF; r.Ns = DM; r.Nd = DM; r.map = 0; break;
    case 2:  r.src = a.in[33] + (size_t)l * DM * 2 * FF; r.dst = (bf16_t*)(wl + OFF_F2I); r.K = DM; r.Ns = 2 * FF; r.Nd = 2 * FF; r.map = 1; break;
    case 3:  r.src = a.in[34] + (size_t)l * FF * DM;     r.dst = (bf16_t*)(wl + OFF_F2O); r.K = FF; r.Ns = DM; r.Nd = DM; r.map = 0; break;
    case 4:  r.src = a.in[7] + (size_t)l * DM * 3364;    r.dst = (bf16_t*)(wl + OFF_MI);  r.K = DM; r.Ns = 3364; r.Nd = 3584; r.map = 2; break;
    case 5:  r.src = a.in[8] + (size_t)l * DM * DM;      r.dst = (bf16_t*)(wl + OFF_MO);  r.K = DM; r.Ns = DM; r.Nd = DM; r.map = 0; break;
    case 6:  r.src = a.in[27] + (size_t)l * DM * 512;    r.dst = (bf16_t*)(wl + OFF_XQ);  r.K = DM; r.Ns = 512; r.Nd = 512; r.map = 0; break;
    case 7:  r.src = a.in[28] + (size_t)l * DM * 1024;   r.dst = (bf16_t*)(wl + OFF_XKV); r.K = DM; r.Ns = 1024; r.Nd = 1024; r.map = 0; break;
    case 8:  r.src = a.in[31] + (size_t)l * 512 * DM;    r.dst = (bf16_t*)(wl + OFF_XO);  r.K = 512; r.Ns = DM; r.Nd = DM; r.map = 0; break;
    case 9:  r.src = a.in[16] + (size_t)l * 64 * 512;    r.dst = (bf16_t*)(wl + OFF_W2T); r.K = 64; r.Ns = 512; r.Nd = 512; r.map = 0; break;
    case 10: r.src = a.in[18] + (size_t)l * 64 * 512;    r.dst = (bf16_t*)(wl + OFF_A2T); r.K = 64; r.Ns = 512; r.Nd = 512; r.map = 0; break;
    default: r.src = a.in[19] + (size_t)l * 160 * 512;   r.dst = (bf16_t*)(wl + OFF_G2T); r.K = 160; r.Ns = 512; r.Nd = 512; r.map = 0; break;
    }
    return r;
}
DEV int srccol(int map, int n) {
    if (map == 0) return n;
    if (map == 1) { const int p = n >> 8, r = n & 255; return r < 128 ? p * 128 + r : FF + p * 128 + (r - 128); }
    if (n < 256) return n;
    if (n < 768) return 1540 + (n - 256);
    if (n < 1024) return 772 + (n - 768);
    if (n < 1280) return 256 + (n - 1024);
    if (n < 1536) return 512 + (n - 1280);
    if (n < 1792) return 1028 + (n - 1536);
    if (n < 2048) return 1284 + (n - 1792);
    if (n < 2560) return 2052 + (n - 2048);
    if (n < 3072) return 2564 + (n - 2560);
    if (n < 3360) return 3076 + (n - 3072);
    if (n < 3364) return 768 + (n - 3360);
    return -1;
}
DEV void transpose_item(const MatInfo& mi, LAS float* scr, int item, int lane) {
    const int nblk = mi.Nd / 32, kb = item / nblk, nb = item % nblk, k0 = 64 * kb, n0 = 32 * nb;
    const int sc = srccol(mi.map, n0 + (lane & 31));
#pragma unroll 8
    for (int i = 0; i < 32; ++i) { const int kk = 2 * i + (lane >> 5), k = k0 + kk;
        scr[kk * 33 + (lane & 31)] = (sc >= 0 && k < mi.K) ? mi.src[(size_t)k * mi.Ns + sc] : 0.f; }
    LDS_WAIT(); asm volatile("" ::: "memory");
    const int c = lane & 7;
#pragma unroll
    for (int j = 0; j < 4; ++j) { const int n = (lane >> 3) + 8 * j; const LAS float* s = scr + (8 * c) * 33 + n;
        u32x4 o; o.x = pk2(s[0 * 33], s[1 * 33]); o.y = pk2(s[2 * 33], s[3 * 33]); o.z = pk2(s[4 * 33], s[5 * 33]); o.w = pk2(s[6 * 33], s[7 * 33]);
        if (k0 + 8 * c < mi.K) *(u32x4*)(mi.dst + (size_t)(n0 + n) * mi.K + k0 + 8 * c) = o; }
    LDS_WAIT(); asm volatile("" ::: "memory");
}
DEV void norm_row(const float* xrow, const float* g, bf16_t* orow, int lane) {
    const f32x4* xr = (const f32x4*)xrow + lane; const f32x4* gr = (const f32x4*)g + lane;
    f32x4 v[4]; float s = 0.f;
#pragma unroll
    for (int j = 0; j < 4; ++j) { v[j] = xr[64 * j]; s += (v[j].x * v[j].x + v[j].y * v[j].y) + (v[j].z * v[j].z + v[j].w * v[j].w); }
    const float rstd = rsqrtf(wave_sum(s) * (1.f / DM) + NORM_EPS);
    u32x2* o8 = (u32x2*)orow + lane;
#pragma unroll
    for (int j = 0; j < 4; ++j) { const f32x4 gg = gr[64 * j]; u32x2 w; w.x = pk2(v[j].x * rstd * gg.x, v[j].y * rstd * gg.y); w.y = pk2(v[j].z * rstd * gg.z, v[j].w * rstd * gg.w); o8[64 * j] = w; }
}
DEV void norm_row2(const float* xa, const float* xb, const float* g, bf16_t* oa, bf16_t* ob, int lane) {
    const f32x4* xra = (const f32x4*)xa + lane; const f32x4* xrb = (const f32x4*)xb + lane; const f32x4* gr = (const f32x4*)g + lane;
    f32x4 va[4], vb[4]; float sa = 0.f, sb = 0.f;
#pragma unroll
    for (int j = 0; j < 4; ++j) { va[j] = xra[64 * j]; vb[j] = xrb[64 * j]; }
#pragma unroll
    for (int j = 0; j < 4; ++j) { sa += (va[j].x * va[j].x + va[j].y * va[j].y) + (va[j].z * va[j].z + va[j].w * va[j].w); sb += (vb[j].x * vb[j].x + vb[j].y * vb[j].y) + (vb[j].z * vb[j].z + vb[j].w * vb[j].w); }
#pragma unroll
    for (int o = 1; o < 64; o <<= 1) { sa += __shfl_xor(sa, o); sb += __shfl_xor(sb, o); }
    const float ra = rsqrtf(sa * (1.f / DM) + NORM_EPS), rb = rsqrtf(sb * (1.f / DM) + NORM_EPS);
    u32x2* o8a = (u32x2*)oa + lane; u32x2* o8b = (u32x2*)ob + lane;
#pragma unroll
    for (int j = 0; j < 4; ++j) { const f32x4 gg = gr[64 * j]; u32x2 w; w.x = pk2(va[j].x * ra * gg.x, va[j].y * ra * gg.y); w.y = pk2(va[j].z * ra * gg.z, va[j].w * ra * gg.w); o8a[64 * j] = w;
        w.x = pk2(vb[j].x * rb * gg.x, vb[j].y * rb * gg.y); w.y = pk2(vb[j].z * rb * gg.z, vb[j].w * rb * gg.w); o8b[64 * j] = w; }
}
DEV void norm_phase(const float* x, const float* g, bf16_t* out, int nrows, int gw, int NGW, int lane) {
    int m = gw;
    for (; m + NGW < nrows; m += 2 * NGW) norm_row2(x + (size_t)m * DM, x + (size_t)(m + NGW) * DM, g, out + (size_t)m * DM, out + (size_t)(m + NGW) * DM, lane);
    if (m < nrows) norm_row(x + (size_t)m * DM, g, out + (size_t)m * DM, lane);
}
DEV void p0_prologue(const Args& a, LAS unsigned char* lds, int gw, int NGW, int wid, int lane, int tid) {
    LAS float* scr = (LAS float*)(lds + wid * 8704);
    int base = 0;
    for (int m = 0; m < 24; ++m) {
        const MatInfo mi = matinfo(a, m); const int items = ((mi.K + 63) / 64) * (mi.Nd / 32);
        int first = gw - (base % NGW); if (first < 0) first += NGW;
        for (int it = first; it < items; it += NGW) transpose_item(mi, scr, it, lane);
        base += items;
    }
    for (int m = gw; m < NL * NB * MEMLEN; m += NGW) { const int l = m / (NB * MEMLEN), r = m % (NB * MEMLEN);
        norm_row(a.in[1] + (size_t)r * DM, a.in[26] + l * DM, (bf16_t*)(a.ws + WS_MEMN) + (size_t)m * DM, lane); }
    if (blockIdx.x == 0 && tid < 64) ((unsigned*)(a.ws + WS_CTL))[tid * 64] = 0u;
}
DEV void xkv_post(const Args& a, int gw, int NGW, int lane) {
    for (int it = gw; it < NL * NB * MEMLEN * 4; it += NGW) {
        const int hd = it & 3, row = (it >> 2) % (NB * MEMLEN), l = it / (4 * NB * MEMLEN), b = row / MEMLEN, m = row % MEMLEN;
        bf16_t* kr = (bf16_t*)(a.ws + WS_KVX) + ((size_t)l * NB * MEMLEN + row) * 1024 + hd * 128;
        const unsigned kv = *((const unsigned*)kr + lane); float k0 = bf2f(kv & 0xffff), k1 = bf2f(kv >> 16);
        const float rstd = rsqrtf(wave_sum(k0 * k0 + k1 * k1) * (1.f / 128) + NORM_EPS);
        const float* kg = a.in[30] + l * 128;
        *((unsigned*)kr + lane) = pk2(k0 * rstd * kg[2 * lane], k1 * rstd * kg[2 * lane + 1]);
        const unsigned vv = *((const unsigned*)(kr + 512) + lane);
        bf16_t* vt = (bf16_t*)(a.ws + WS_VTX) + (((size_t)(l * NB + b) * 4 + hd) * 128) * MEMLEN + m;
        vt[(size_t)(2 * lane) * MEMLEN] = (bf16_t)(vv & 0xffff); vt[(size_t)(2 * lane + 1) * MEMLEN] = (bf16_t)(vv >> 16);
    }
}

DEV float sigmoid_f(float x) { return __builtin_amdgcn_rcpf(1.0f + __builtin_amdgcn_exp2f(-LOG2E * x)); }
DEV float tanh_f(float x) { const float e = __builtin_amdgcn_exp2f(-2.f * LOG2E * fabsf(x)); const float t = (1.f - e) * __builtin_amdgcn_rcpf(1.f + e); return x < 0.f ? -t : t; }
DEV void unpack8(const u32x4 v, float (&f)[8]) {
    f[0] = __uint_as_float(v.x << 16); f[1] = __uint_as_float(v.x & 0xffff0000u); f[2] = __uint_as_float(v.y << 16); f[3] = __uint_as_float(v.y & 0xffff0000u);
    f[4] = __uint_as_float(v.z << 16); f[5] = __uint_as_float(v.z & 0xffff0000u); f[6] = __uint_as_float(v.w << 16); f[7] = __uint_as_float(v.w & 0xffff0000u);
}
DEV u32x4 pack8(const float (&f)[8]) { u32x4 o; o.x = pk2(f[0], f[1]); o.y = pk2(f[2], f[3]); o.z = pk2(f[4], f[5]); o.w = pk2(f[6], f[7]); return o; }
DEV int crow(int r, int hi) { return (r & 3) + 8 * (r >> 2) + 4 * hi; }

DEV void prep_tile(const Args& a, int l, int tile, LAS unsigned char* lds, bool dry = false) {
    int tid_ = threadIdx.x; asm volatile("" : "+v"(tid_)); const int tid = tid_, lane = tid & 63, wid = __builtin_amdgcn_readfirstlane(tid >> 6);
    const int row0 = tile * 64, b = row0 / SEQ, t0 = row0 % SEQ;
    bf16_t* Z = (bf16_t*)(a.ws + WS_Z) + (size_t)row0 * ZP;
    {
        const int ch = tid % 228, sub = tid / 228; const bool act = tid < 456;
        const int col = ch < 64 ? ZC_RR + 8 * ch : ZC_RK + 8 * (ch - 64), mi = ch < 64 ? 8 * ch : 512 + 8 * (ch - 64);
        const int ts = 32 * sub; float prev[8], mu[8];
#pragma unroll
        for (int i = 0; i < 8; ++i) { prev[i] = 0.f; mu[i] = 0.f; }
        if (act) {
            const float* mup = a.in[14] + l * 1824 + mi;
#pragma unroll
            for (int i = 0; i < 8; ++i) mu[i] = mup[i];
            if (sub == 1) unpack8(*(const u32x4*)(Z + (size_t)(ts - 1) * ZP + col), prev);
            else if (t0 != 0) unpack8(*(const u32x4*)((const bf16_t*)(a.ws + WS_ZHALO) + (size_t)(tile - 1) * ZP + col), prev);
        }
        __syncthreads();
        if (act) {
#pragma unroll 1
            for (int t8 = 0; t8 < 32; t8 += 8) { u32x4 raw[8];
#pragma unroll
                for (int tt = 0; tt < 8; ++tt) raw[tt] = *(const u32x4*)(Z + (size_t)(ts + t8 + tt) * ZP + col);
#pragma unroll
                for (int tt = 0; tt < 8; ++tt) { float cur[8], o[8]; unpack8(raw[tt], cur);
#pragma unroll
                    for (int i = 0; i < 8; ++i) { o[i] = cur[i] + (prev[i] - cur[i]) * mu[i]; prev[i] = cur[i]; }
                    if (!dry) *(u32x4*)(Z + (size_t)(ts + t8 + tt) * ZP + col) = pack8(o); } }
        }
    }
    LAS float* kbuf = (LAS float*)lds;
    {
        const float* gfq = a.in[10] + l * 64; const float* gfk = a.in[11] + l * 64; const float* gmq = a.in[12] + l * 64; const float* gmk = a.in[13] + l * 64;
        const int* pos = (const int*)a.in[2] + b * SEQ + t0;
#pragma unroll 2
        for (int it = 0; it < 16; ++it) {
            const int item = it * 512 + tid, g8 = item >> 3, sub8 = item & 7, slot = g8 >> 6, token = g8 & 63, h = slot & 3, kind = slot >> 2;
            const int cb = (kind == 0 ? ZC_FQ : kind == 1 ? ZC_FK : kind == 2 ? ZC_MQ : ZC_MK) + 64 * h + 8 * sub8;
            const float* gp = (kind == 0 ? gfq : kind == 1 ? gfk : kind == 2 ? gmq : gmk) + 8 * sub8;
            u32x4* p = (u32x4*)(Z + (size_t)token * ZP + cb); float v[8]; unpack8(*p, v);
            float ss = 0.f;
#pragma unroll
            for (int i = 0; i < 8; ++i) ss += v[i] * v[i];
            ss += __shfl_xor(ss, 1); ss += __shfl_xor(ss, 2); ss += __shfl_xor(ss, 4);
            const float rstd = rsqrtf(ss * (1.f / 64) + NORM_EPS);
#pragma unroll
            for (int i = 0; i < 8; ++i) v[i] = v[i] * rstd * gp[i];
            float pr[8];
#pragma unroll
            for (int i = 0; i < 8; ++i) pr[i] = __shfl_xor(v[i], 1);
            if (kind >= 2 && sub8 < 2) {
                const float posf = (float)pos[token];
#pragma unroll
                for (int i = 0; i < 8; ++i) {
                    const float invf = (float)__builtin_exp2(-(double)i * 0.125 * 18.931568569324174);
                    const float ang = posf * invf; const double rev = (double)ang * 0.15915494309189535; const float fr = (float)(rev - __builtin_floor(rev));
                    const float sn = __builtin_amdgcn_sinf(fr), cs = __builtin_amdgcn_cosf(fr);
                    v[i] = sub8 == 0 ? v[i] * cs - pr[i] * sn : v[i] * cs + pr[i] * sn; }
            }
            if (kind == 3) {
#pragma unroll
                for (int i = 0; i < 8; ++i) kbuf[(token * 4 + h) * 64 + 8 * sub8 + i] = v[i]; }
            if (kind == 0 || kind == 2) {
#pragma unroll
                for (int i = 0; i < 8; ++i) v[i] *= C2_64; }
            if (!dry) *p = pack8(v);
        }
    }
    __syncthreads();
    if (tid < 256) { const int h = tid >> 6, d = tid & 63; float s = 0.f;
        for (int t = 0; t < 64; ++t) s += kbuf[(t * 4 + h) * 64 + d];
        if (!dry) ((float*)(a.ws + WS_KMP))[(((size_t)(b * 4 + h) * 64) + (t0 >> 6)) * 64 + d] = s; }
#pragma unroll 2
    for (int it = 0; it < 8; ++it) {
        const int item = it * 512 + tid, which = item >> 11, rem = item & 2047, tg = rem >> 8, c = rem & 255;
        const bf16_t* src = Z + (size_t)(8 * tg) * ZP + (which ? ZC_MV : ZC_FV) + c; unsigned short e[8];
#pragma unroll
        for (int i = 0; i < 8; ++i) e[i] = src[(size_t)i * ZP];
        u32x4 o; o.x = e[0] | ((unsigned)e[1] << 16); o.y = e[2] | ((unsigned)e[3] << 16); o.z = e[4] | ((unsigned)e[5] << 16); o.w = e[6] | ((unsigned)e[7] << 16);
        bf16_t* vt = (bf16_t*)(a.ws + (which ? WS_VTM : WS_VTF)) + ((size_t)(b * 4 + (c >> 6)) * 64 + (c & 63)) * SEQ + t0 + 8 * tg;
        if (!dry) *(u32x4*)vt = o;
    }
    if (tid < 256) { const int token = tid >> 2, h = tid & 3; const float x = bf2f(Z[(size_t)token * ZP + ZC_FF + h]) + a.in[9][l * 4 + h];
        const float lf = fminf(x, 0.f) - __logf(1.f + __expf(-fabsf(x)));
        if (!dry) ((float*)(a.ws + WS_LOGF))[(size_t)(b * 4 + h) * SEQ + t0 + token] = lf; }
    __syncthreads();
    LAS bf16_t* al = (LAS bf16_t*)lds;
    for (int item = tid; item < 64 * 36; item += 512) { const int token = item / 36, c = item % 36; float v[8]; unpack8(*(const u32x4*)(Z + (size_t)token * ZP + ZC_LO + 8 * c), v);
        if (c < 8) {
#pragma unroll
            for (int i = 0; i < 8; ++i) v[i] = tanh_f(v[i]); }
        else if (c >= 16) {
#pragma unroll
            for (int i = 0; i < 8; ++i) v[i] = sigmoid_f(v[i]); }
        *(LAS u32x4*)(al + token * 296 + 8 * c) = pack8(v); }
    __syncthreads();
    const unsigned char* wl = a.ws + WS_W + (size_t)l * WL_BYTES;
    const bf16_t* w2t = (const bf16_t*)(wl + OFF_W2T); const bf16_t* a2t = (const bf16_t*)(wl + OFF_A2T); const bf16_t* g2t = (const bf16_t*)(wl + OFF_G2T);
    const int r32 = lane & 31, hi = lane >> 5;
    for (int uu = 0; uu < 2; ++uu) {
        const int u = wid + 8 * uu, h = u & 7, th = u >> 3, token = 32 * th + r32;
        f32x16 aw[2], aa[2], ag[2];
#pragma unroll
        for (int ct = 0; ct < 2; ++ct) { aw[ct] = f32x16{}; aa[ct] = f32x16{}; ag[ct] = f32x16{}; }
        const LAS bf16_t* arow = al + token * 296 + 8 * hi;
#pragma unroll 1
        for (int ks = 0; ks < 4; ++ks) { const bf16x8 bw = *(const LAS bf16x8*)(arow + 16 * ks), ba = *(const LAS bf16x8*)(arow + 64 + 16 * ks);
#pragma unroll
            for (int ct = 0; ct < 2; ++ct) { const int chn = 64 * h + 32 * ct + r32;
                aw[ct] = __builtin_amdgcn_mfma_f32_32x32x16_bf16(*(const bf16x8*)(w2t + chn * 64 + 16 * ks + 8 * hi), bw, aw[ct], 0, 0, 0);
                aa[ct] = __builtin_amdgcn_mfma_f32_32x32x16_bf16(*(const bf16x8*)(a2t + chn * 64 + 16 * ks + 8 * hi), ba, aa[ct], 0, 0, 0); } }
#pragma unroll 1
        for (int ks = 0; ks < 10; ++ks) { const bf16x8 bg = *(const LAS bf16x8*)(arow + 128 + 16 * ks);
#pragma unroll
            for (int ct = 0; ct < 2; ++ct) { const int chn = 64 * h + 32 * ct + r32;
                ag[ct] = __builtin_amdgcn_mfma_f32_32x32x16_bf16(*(const bf16x8*)(g2t + chn * 160 + 16 * ks + 8 * hi), bg, ag[ct], 0, 0, 0); } }
        bf16_t* zr = Z + (size_t)token * ZP; const size_t grow = (size_t)(row0 + token);
        float* wd = (float*)(a.ws + WS_WD) + grow * 512; bf16_t* kkp = (bf16_t*)(a.ws + WS_KK) + grow * 512; bf16_t* kap = (bf16_t*)(a.ws + WS_KA) + grow * 512;
        const float* w0 = a.in[15] + l * 512; const float* a0 = a.in[17] + l * 512; const float* k_k = a.in[20] + l * 512; const float* k_a = a.in[21] + l * 512;
        float ss = 0.f;
#pragma unroll
        for (int ct = 0; ct < 2; ++ct)
#pragma unroll
            for (int rg = 0; rg < 4; ++rg) { const int c0 = 64 * h + 32 * ct + 8 * rg + 4 * hi;
                const u32x2 kraw = *(const u32x2*)(zr + ZC_RK + c0); const f32x4 w04 = *(const f32x4*)(w0 + c0), a04 = *(const f32x4*)(a0 + c0), kk4 = *(const f32x4*)(k_k + c0);
                f32x4 dec; u32x2 gp; float gv[4];
#pragma unroll
                for (int i = 0; i < 4; ++i) { const int r = 4 * rg + i;
                    const float kv = (i < 2) ? __uint_as_float((i & 1) ? (kraw.x & 0xffff0000u) : (kraw.x << 16)) : __uint_as_float((i & 1) ? (kraw.y & 0xffff0000u) : (kraw.y << 16));
                    const float wr_ = w04[i] + aw[ct][r]; const float sp = fmaxf(-wr_, 0.f) + __logf(1.f + __expf(-fabsf(wr_)));
                    dec[i] = __expf(-__expf(-sp - 0.5f));
                    aa[ct][r] = sigmoid_f(a04[i] + aa[ct][r]);
                    gv[i] = ag[ct][r];
                    const float kkv = kv * kk4[i]; aw[ct][r] = kkv; ss += kkv * kkv; }
                if (!dry) *(f32x4*)(wd + c0) = dec;
                gp.x = pk2(gv[0], gv[1]); gp.y = pk2(gv[2], gv[3]);
                if (!dry) *(u32x2*)(zr + (c0 < 256 ? ZC_FV + c0 : ZC_MV + (c0 - 256))) = gp; __builtin_amdgcn_sched_barrier(0); }
        ss += __shfl_xor(ss, 32);
        const float inv = 1.f / fmaxf(sqrtf(ss), 1e-12f);
#pragma unroll
        for (int ct = 0; ct < 2; ++ct)
#pragma unroll
            for (int rg = 0; rg < 4; ++rg) { const int c0 = 64 * h + 32 * ct + 8 * rg + 4 * hi; const f32x4 ka4 = *(const f32x4*)(k_a + c0);
                const u32x2 kraw = *(const u32x2*)(zr + ZC_RK + c0); const float kf4[4] = {bf2f(kraw.x & 0xffff), __uint_as_float(kraw.x & 0xffff0000u), bf2f(kraw.y & 0xffff), __uint_as_float(kraw.y & 0xffff0000u)};
                float kk[4], ka[4], kp[4];
#pragma unroll
                for (int i = 0; i < 4; ++i) { const int r = 4 * rg + i; kk[i] = aw[ct][r] * inv; ka[i] = kk[i] * aa[ct][r]; kp[i] = kf4[i] * (1.f + (aa[ct][r] - 1.f) * ka4[i]); }
                u32x2 o; o.x = pk2(kk[0], kk[1]); o.y = pk2(kk[2], kk[3]); if (!dry) *(u32x2*)(kkp + c0) = o;
                o.x = pk2(ka[0], ka[1]); o.y = pk2(ka[2], ka[3]); if (!dry) *(u32x2*)(kap + c0) = o;
                o.x = pk2(kp[0], kp[1]); o.y = pk2(kp[2], kp[3]); if (!dry) *(u32x2*)(zr + ZC_RK + c0) = o; __builtin_amdgcn_sched_barrier(0); }
    }
    __syncthreads();
}

template <int MODE, int D>
DEV void attn_unit(LAS unsigned char* lds, const bf16_t* Qp, int ldq, const bf16_t* Kp, int ldk, const bf16_t* Vt, int ldv, bf16_t* Op, int ldo,
                   int q0, int ntiles, int qb, const float* aux, const float* qgain, bool dry = false) {
    constexpr int KP = D + 8, KBYTES = 64 * KP * 2, VP = 72, VBYTES = D * VP * 2, NLD = D / 64;
    int tid_ = threadIdx.x; asm volatile("" : "+v"(tid_)); const int tid = tid_, lane = tid & 63, wid = __builtin_amdgcn_readfirstlane(tid >> 6), r32 = lane & 31, hi = lane >> 5;
    LAS float* cl = (LAS float*)lds; LAS unsigned* selm = (LAS unsigned*)(lds + 8192);
    LAS unsigned char* kb = lds + 16384; LAS unsigned char* vb = kb + 2 * KBYTES;
    const int q = q0 + wid * 32 + r32;
    if (MODE == 0) {
        const int n = 64 * ntiles; float v[8]; float run = 0.f;
#pragma unroll
        for (int i = 0; i < 8; ++i) { const int idx = 8 * tid + i; v[i] = idx < n ? aux[idx] : 0.f; run += v[i]; v[i] = run; }
        float sc = run;
#pragma unroll
        for (int o = 1; o < 64; o <<= 1) { const float t = __shfl_up(sc, o); if (lane >= o) sc += t; }
        LAS float* wsum = (LAS float*)kb;
        if (lane == 63) wsum[wid] = sc;
        __syncthreads();
        float off = sc - run;
        for (int w = 0; w < wid; ++w) off += wsum[w];
#pragma unroll
        for (int i = 0; i < 8; ++i) cl[8 * tid + i] = (off + v[i]) * LOG2E;
    }
    if (MODE == 1) {
        LAS float* km = cl;
        for (int e = tid; e < 16 * 64; e += 512) { const int nblk = e >> 6, d = e & 63; const float* pp = aux + (size_t)(4 * nblk) * 64 + d;
            km[e] = ((pp[0] + pp[64]) + (pp[128] + pp[192])) * (1.f / 256); }
        __syncthreads();
        if (tid < 256) { const bf16_t* qr = Qp + (size_t)(q0 + tid) * ldq; float g[16];
#pragma unroll
            for (int nb = 0; nb < 16; ++nb) g[nb] = 0.f;
            for (int c = 0; c < 8; ++c) { float qv[8]; unpack8(*(const u32x4*)(qr + 8 * c), qv);
#pragma unroll
                for (int nb = 0; nb < 16; ++nb) {
#pragma unroll
                    for (int i = 0; i < 8; ++i) g[nb] += qv[i] * km[nb * 64 + 8 * c + i]; } }
            unsigned m = 0u;
#pragma unroll
            for (int pick = 0; pick < 3; ++pick) { float best = -INFINITY; int bi = -1;
#pragma unroll
                for (int nb = 0; nb < 16; ++nb) { if (nb < qb && !((m >> nb) & 1u) && g[nb] > best) { best = g[nb]; bi = nb; } }
                if (bi >= 0) m |= 1u << bi; }
            selm[tid] = m; }
    }
    bf16x8 qf[D / 16];
#pragma unroll
    for (int d0 = 0; d0 < D / 16; ++d0) qf[d0] = *(const bf16x8*)(Qp + (size_t)q * ldq + d0 * 16 + hi * 8);
    if (MODE == 2) {
        float ss = 0.f;
#pragma unroll
        for (int d0 = 0; d0 < D / 16; ++d0) { float qv[8]; unpack8(__builtin_bit_cast(u32x4, qf[d0]), qv);
#pragma unroll
            for (int i = 0; i < 8; ++i) ss += qv[i] * qv[i]; }
        ss += __shfl_xor(ss, 32);
        const float rstd = rsqrtf(ss * (1.f / D) + NORM_EPS) * C2_128;
#pragma unroll
        for (int d0 = 0; d0 < D / 16; ++d0) { float qv[8]; unpack8(__builtin_bit_cast(u32x4, qf[d0]), qv);
#pragma unroll
            for (int i = 0; i < 8; ++i) qv[i] = qv[i] * rstd * qgain[d0 * 16 + hi * 8 + i];
            qf[d0] = __builtin_bit_cast(bf16x8, pack8(qv)); __builtin_amdgcn_sched_barrier(0); }
    }
    float mrun = -INFINITY, lrun = 0.f; f32x16 o[D / 32];
#pragma unroll
    for (int dt = 0; dt < D / 32; ++dt) o[dt] = f32x16{};
    __syncthreads();
    const float cq = (MODE == 0) ? cl[q] : 0.f;
    const unsigned sel = (MODE == 1) ? selm[wid * 32 + r32] : 0u;
    u32x4 kreg[NLD], vreg[NLD];
#define ATT_LOAD(t) do { _Pragma("unroll") for (int i_ = 0; i_ < NLD; ++i_) { const int idx_ = tid + 512 * i_; \
        kreg[i_] = *(const u32x4*)(Kp + (size_t)(64 * (t) + idx_ / (D / 8)) * ldk + (idx_ % (D / 8)) * 8); \
        vreg[i_] = *(const u32x4*)(Vt + (size_t)(idx_ >> 3) * ldv + 64 * (t) + (idx_ & 7) * 8); } } while (0)
#define ATT_STORE(buf) do { _Pragma("unroll") for (int i_ = 0; i_ < NLD; ++i_) { const int idx_ = tid + 512 * i_; \
        *(LAS u32x4*)(kb + (buf) * KBYTES + ((idx_ / (D / 8)) * KP + (idx_ % (D / 8)) * 8) * 2) = kreg[i_]; \
        *(LAS u32x4*)(vb + (buf) * VBYTES + ((idx_ >> 3) * VP + (idx_ & 7) * 8) * 2) = vreg[i_]; } } while (0)
    ATT_LOAD(0); ATT_STORE(0);
    __syncthreads();
    for (int t = 0; t < ntiles; ++t) {
        const int buf = t & 1, key0 = 64 * t;
        if (t + 1 < ntiles) ATT_LOAD(t + 1);
        bool work = true; const int nblk = key0 >> 8;
        if (MODE == 0) work = key0 <= q0 + wid * 32 + 31;
        if (MODE == 1) work = (nblk == qb) ? (key0 <= q0 + wid * 32 + 31) : (__any((sel >> nblk) & 1u) != 0);
        if (work) {
            const LAS unsigned char* kt = kb + buf * KBYTES; const LAS unsigned char* vt = vb + buf * VBYTES;
            constexpr int NKH = (D == 64) ? 2 : 1;
#pragma unroll 1
            for (int ks = 0; ks < 2 / NKH; ++ks) {
            f32x16 p[NKH];
#pragma unroll
            for (int kh = 0; kh < NKH; ++kh) { p[kh] = f32x16{}; const int khh = ks * NKH + kh;
#pragma unroll
                for (int d0 = 0; d0 < D / 16; ++d0) { const bf16x8 kf = *(const LAS bf16x8*)(kt + ((32 * khh + r32) * KP + 16 * d0 + 8 * hi) * 2);
                    p[kh] = __builtin_amdgcn_mfma_f32_32x32x16_bf16(kf, qf[d0], p[kh], 0, 0, 0); } }
            if (MODE == 0) {
#pragma unroll
                for (int kh = 0; kh < NKH; ++kh)
#pragma unroll
                    for (int rg = 0; rg < 4; ++rg) { const int kk0 = key0 + 32 * (ks * NKH + kh) + 8 * rg + 4 * hi; const f32x4 ck = *(const LAS f32x4*)(cl + kk0);
#pragma unroll
                        for (int i = 0; i < 4; ++i) { const float s = p[kh][4 * rg + i] + (cq - ck[i]); p[kh][4 * rg + i] = (kk0 + i > q) ? -INFINITY : s; } }
            }
            if (MODE == 1) {
                if (nblk == qb) {
#pragma unroll
                    for (int kh = 0; kh < NKH; ++kh)
#pragma unroll
                        for (int r = 0; r < 16; ++r) { if (key0 + 32 * (ks * NKH + kh) + crow(r, hi) > q) p[kh][r] = -INFINITY; }
                } else if (!((sel >> nblk) & 1u)) {
#pragma unroll
                    for (int kh = 0; kh < NKH; ++kh)
#pragma unroll
                        for (int r = 0; r < 16; ++r) p[kh][r] = -INFINITY;
                }
            }
            float mx = p[0][0];
#pragma unroll
            for (int kh = 0; kh < NKH; ++kh)
#pragma unroll
                for (int r = 0; r < 16; ++r) mx = fmaxf(mx, p[kh][r]);
            mx = fmaxf(mx, __shfl_xor(mx, 32));
            const float mnew = fmaxf(mrun, mx), muse = (mnew == -INFINITY) ? 0.f : mnew;
            const float alpha = __builtin_amdgcn_exp2f(mrun - muse);
            mrun = mnew; lrun *= alpha;
            if (__any(alpha != 1.0f)) {
#pragma unroll
                for (int dt = 0; dt < D / 32; ++dt) o[dt] *= alpha; }
            float ps = 0.f;
#pragma unroll
            for (int kh = 0; kh < NKH; ++kh)
#pragma unroll
                for (int r = 0; r < 16; ++r) { p[kh][r] = __builtin_amdgcn_exp2f(p[kh][r] - muse); ps += p[kh][r]; }
            lrun += ps;
            bf16x8 pb[NKH][2];
#pragma unroll
            for (int kh = 0; kh < NKH; ++kh)
#pragma unroll
                for (int j = 0; j < 2; ++j) { u32x4 w; w.x = pk2(p[kh][8 * j + 0], p[kh][8 * j + 1]); w.y = pk2(p[kh][8 * j + 2], p[kh][8 * j + 3]); w.z = pk2(p[kh][8 * j + 4], p[kh][8 * j + 5]); w.w = pk2(p[kh][8 * j + 6], p[kh][8 * j + 7]);
                    pb[kh][j] = __builtin_bit_cast(bf16x8, w); }
#pragma unroll
            for (int dt = 0; dt < D / 32; ++dt)
#pragma unroll
                for (int kh = 0; kh < NKH; ++kh)
#pragma unroll
                    for (int j = 0; j < 2; ++j) { const LAS unsigned char* vp_ = vt + ((32 * dt + r32) * VP + 32 * (ks * NKH + kh) + 16 * j + 4 * hi) * 2;
                        const u32x2 lo = *(const LAS u32x2*)vp_, hh = *(const LAS u32x2*)(vp_ + 16); u32x4 w; w.x = lo.x; w.y = lo.y; w.z = hh.x; w.w = hh.y;
                        o[dt] = __builtin_amdgcn_mfma_f32_32x32x16_bf16(__builtin_bit_cast(bf16x8, w), pb[kh][j], o[dt], 0, 0, 0); }
            }
        }
        if (t + 1 < ntiles) ATT_STORE(buf ^ 1);
        __syncthreads();
    }
#undef ATT_LOAD
#undef ATT_STORE
    lrun += __shfl_xor(lrun, 32);
    const float inv = 1.f / lrun;
    bf16_t* orow = Op + (size_t)q * ldo;
    if (!dry)
#pragma unroll
    for (int dt = 0; dt < D / 32; ++dt)
#pragma unroll
        for (int rg = 0; rg < 4; ++rg) { u32x2 w; w.x = pk2(o[dt][4 * rg] * inv, o[dt][4 * rg + 1] * inv); w.y = pk2(o[dt][4 * rg + 2] * inv, o[dt][4 * rg + 3] * inv);
            *(u32x2*)(orow + 32 * dt + 8 * rg + 4 * hi) = w; }
    __syncthreads();
}

constexpr int RW_NCH = SEQ / 16;
constexpr int RW_ARP = 72, RW_BKTP = 32, RW_VTP = 24, RW_PMP = 24, RW_LP = 20;
constexpr int RW_NBUF = 4;
constexpr int RW_DB = 16640, RW_AR = 0, RW_BKT = 4608, RW_VT = 8704, RW_GC = 11776, RW_TM = 12032, RW_PM1 = 13568, RW_PM2 = 15104;
constexpr int RW_PRIV = RW_NBUF * RW_DB, RW_PRIV_BYTES = 5888, RW_PBK = 0, RW_PLAB = 4608;
constexpr int RW_YB = RW_PRIV + RW_NBUF * RW_PRIV_BYTES, RW_FLG = RW_YB + 2 * 4096, RW_SLOT_BYTES = RW_FLG + 64;
static_assert(RW_PM2 + 32 * RW_PMP * 2 == RW_DB && RW_TM + 32 * RW_PMP * 2 == RW_PM1 && RW_SLOT_BYTES <= 131072 && RW_DB % 16 == 0 && RW_PRIV_BYTES % 16 == 0, "rwkv lds map");
DEV bf16x8 pack_acc8(const f32x16& v, int base) { u32x4 w; w.x = pk2(v[base], v[base + 1]); w.y = pk2(v[base + 2], v[base + 3]); w.z = pk2(v[base + 4], v[base + 5]); w.w = pk2(v[base + 6], v[base + 7]); return __builtin_bit_cast(bf16x8, w); }
DEV int fresh_lane() { int l_; asm volatile("v_mbcnt_lo_u32_b32 %0, -1, 0\n\tv_mbcnt_hi_u32_b32 %0, -1, %0" : "=v"(l_)); return l_; }
DEV void rw_wait(volatile LAS unsigned* f, unsigned target) { while (*f < target) __builtin_amdgcn_s_sleep(1); asm volatile("" ::: "memory"); }
DEV void rw_post_flag(volatile LAS unsigned* f, unsigned v) { asm volatile("s_waitcnt vmcnt(0) lgkmcnt(0)" ::: "memory"); *f = v; }
DEV bf16x8 frag_perm(const LAS bf16_t* rowp, int hi) { const u32x2 lo = *(const LAS u32x2*)(rowp + 4 * hi), hh = *(const LAS u32x2*)(rowp + 8 + 4 * hi); u32x4 w; w.x = lo.x; w.y = lo.y; w.z = hh.x; w.w = hh.y; return __builtin_bit_cast(bf16x8, w); }

struct RwRaw { float w[16]; unsigned short kk[16], ka[16], kp[16], rr[16], vr[16]; };
DEV void rwkv_pre_load(RwRaw& R, int c, const float* WDp, const bf16_t* KKp, const bf16_t* KAp, const bf16_t* Zl) {
#pragma unroll
    for (int t = 0; t < 16; ++t) { const size_t ro = (size_t)(16 * c + t);
        R.w[t] = WDp[ro * 512]; R.kk[t] = KKp[ro * 512]; R.ka[t] = KAp[ro * 512]; R.kp[t] = Zl[ro * ZP + ZC_RK]; R.rr[t] = Zl[ro * ZP + ZC_RR]; R.vr[t] = Zl[ro * ZP + ZC_RV]; }
}
DEV void rwkv_pre_a(const RwRaw& R, int c, LAS unsigned char* sl, volatile LAS unsigned* flg, int lane) {
    const int bi = c & (RW_NBUF - 1);
    LAS bf16_t* BK = (LAS bf16_t*)(sl + RW_PRIV + bi * RW_PRIV_BYTES + RW_PBK);
    LAS unsigned char* db = sl + bi * RW_DB;
    LAS bf16_t* AR = (LAS bf16_t*)(db + RW_AR); LAS bf16_t* BKT = (LAS bf16_t*)(db + RW_BKT); LAS bf16_t* VT = (LAS bf16_t*)(db + RW_VT); LAS float* GC = (LAS float*)(db + RW_GC);
    if (c >= RW_NBUF) rw_wait(flg + 4 + bi, (unsigned)(c - RW_NBUF + 1));
    float g = 1.f; unsigned bkt[16];
#pragma unroll
    for (int t = 0; t < 16; ++t) {
        const float w = R.w[t], kk = bf2f(R.kk[t]), ka = bf2f(R.ka[t]), kp = bf2f(R.kp[t]), rr = bf2f(R.rr[t]);
        const float at = -kk * g; g *= w; const float inv = __builtin_amdgcn_rcpf(g);
        const unsigned bt = f2bf(ka * inv), kt = f2bf(kp * inv);
        AR[t * RW_ARP + lane] = (bf16_t)f2bf(at); AR[(16 + t) * RW_ARP + lane] = (bf16_t)f2bf(rr * g);
        BK[t * RW_ARP + lane] = (bf16_t)bt; BK[(16 + t) * RW_ARP + lane] = (bf16_t)kt;
        if (t & 1) { bkt[t >> 1] |= bt << 16; bkt[8 + (t >> 1)] |= kt << 16; } else { bkt[t >> 1] = bt; bkt[8 + (t >> 1)] = kt; }
    }
    GC[lane] = g;
#pragma unroll
    for (int q4 = 0; q4 < 4; ++q4) { u32x4 w4; w4.x = bkt[4 * q4]; w4.y = bkt[4 * q4 + 1]; w4.z = bkt[4 * q4 + 2]; w4.w = bkt[4 * q4 + 3]; *(LAS u32x4*)(BKT + lane * RW_BKTP + 8 * q4) = w4; }
    { unsigned vv[8];
#pragma unroll
      for (int t = 0; t < 16; ++t) { const unsigned x = R.vr[t]; if (t & 1) vv[t >> 1] |= x << 16; else vv[t >> 1] = x; }
      u32x4 v0; v0.x = vv[0]; v0.y = vv[1]; v0.z = vv[2]; v0.w = vv[3]; u32x4 v1; v1.x = vv[4]; v1.y = vv[5]; v1.z = vv[6]; v1.w = vv[7];
      *(LAS u32x4*)(VT + lane * RW_VTP) = v0; *(LAS u32x4*)(VT + lane * RW_VTP + 8) = v1; }
}
DEV void rwkv_pre_b(int c, LAS unsigned char* sl, volatile LAS unsigned* flg, int lane) {
    const int r32 = lane & 31, hi = lane >> 5, bi = c & (RW_NBUF - 1);
    LAS bf16_t* BK = (LAS bf16_t*)(sl + RW_PRIV + bi * RW_PRIV_BYTES + RW_PBK); LAS float* LAB = (LAS float*)(sl + RW_PRIV + bi * RW_PRIV_BYTES + RW_PLAB);
    LAS unsigned char* db = sl + bi * RW_DB;
    LAS bf16_t* AR = (LAS bf16_t*)(db + RW_AR); LAS bf16_t* TM = (LAS bf16_t*)(db + RW_TM); LAS bf16_t* PM1 = (LAS bf16_t*)(db + RW_PM1); LAS bf16_t* PM2 = (LAS bf16_t*)(db + RW_PM2);
    f32x16 P = f32x16{};
#pragma unroll
    for (int ks = 0; ks < 4; ++ks) P = __builtin_amdgcn_mfma_f32_32x32x16_bf16(*(const LAS bf16x8*)(AR + r32 * RW_ARP + 16 * ks + 8 * hi), *(const LAS bf16x8*)(BK + r32 * RW_ARP + 16 * ks + 8 * hi), P, 0, 0, 0);
    const int n = r32;
#pragma unroll
    for (int r = 0; r < 16; ++r) { const int m = crow(r, hi);
        if (r < 8) { if (n < 16) LAB[m * RW_LP + n] = (n < m) ? P[r] : 0.f; else PM1[m * RW_PMP + (n - 16)] = (bf16_t)f2bf((n - 16 < m) ? P[r] : 0.f); }
        else { if (n < 16) PM2[m * RW_PMP + n] = (bf16_t)f2bf((n <= m - 16) ? P[r] : 0.f); else PM1[m * RW_PMP + (n - 16)] = (bf16_t)f2bf((n - 16 <= m - 16) ? P[r] : 0.f); } }
}
DEV void rwkv_pre_c(int c, LAS unsigned char* sl, volatile LAS unsigned* flg, int lane) {
    const int bi = c & (RW_NBUF - 1);
    const LAS float* LAB = (const LAS float*)(sl + RW_PRIV + bi * RW_PRIV_BYTES + RW_PLAB); LAS bf16_t* TM = (LAS bf16_t*)(sl + bi * RW_DB + RW_TM);
    { const int cc = lane & 15; float T[16];
#pragma unroll
      for (int t = 0; t < 16; ++t) { float acc = (t == cc) ? 1.f : 0.f;
          int z = 0; if (t >= 3) asm volatile("v_and_b32 %0, 0, %1" : "=v"(z) : "v"(T[t - 3]));
          const LAS float* lrow = LAB + t * RW_LP + z;
#pragma unroll
          for (int tau = 0; tau < t; ++tau) acc = fmaf(lrow[tau], T[tau], acc);
          T[t] = acc; }
      if (lane < 16) {
#pragma unroll
          for (int t = 0; t < 16; ++t) TM[t * RW_PMP + cc] = (bf16_t)f2bf(T[t]); } }
    asm volatile("s_waitcnt lgkmcnt(0)" ::: "memory"); flg[bi] = (unsigned)(c + 1);
}
DEV void rwkv_pre(const Args& a, int b, int h, LAS unsigned char* sl, int par) {
    const int lane = fresh_lane();
    volatile LAS unsigned* flg = (volatile LAS unsigned*)(sl + RW_FLG);
    const size_t rowb = (size_t)b * SEQ;
    const bf16_t* Zl = (const bf16_t*)(a.ws + WS_Z) + rowb * ZP + h * 64 + lane;
    const float* WDp = (const float*)(a.ws + WS_WD) + rowb * 512 + h * 64 + lane;
    const bf16_t* KKp = (const bf16_t*)(a.ws + WS_KK) + rowb * 512 + h * 64 + lane;
    const bf16_t* KAp = (const bf16_t*)(a.ws + WS_KA) + rowb * 512 + h * 64 + lane;
    for (int e = lane; e < 32 * RW_PMP; e += 64) { ((LAS bf16_t*)(sl + par * RW_DB + RW_PM2))[e] = 0; ((LAS bf16_t*)(sl + par * RW_DB + RW_TM))[e] = 0; }
    RwRaw R;
    rwkv_pre_load(R, par, WDp, KKp, KAp, Zl);
#pragma unroll 1
    for (int c = par; c < RW_NCH; c += RW_NBUF) {
        rwkv_pre_a(R, c, sl, flg, lane);
        rwkv_pre_b(c, sl, flg, lane);
        asm volatile("" ::: "memory");
        rwkv_pre_load(R, (c + RW_NBUF < RW_NCH) ? c + RW_NBUF : c, WDp, KKp, KAp, Zl);
#if !defined(NOPREC)
        rwkv_pre_c(c, sl, flg, lane);
#endif
    }
}

DEV void rwkv_main(LAS unsigned char* sl) {
    const int lane = fresh_lane(), r32 = lane & 31, hi = lane >> 5;
    volatile LAS unsigned* flg = (volatile LAS unsigned*)(sl + RW_FLG);
    f32x16 ST[2][2];
#pragma unroll
    for (int jt = 0; jt < 2; ++jt)
#pragma unroll
        for (int it = 0; it < 2; ++it) ST[jt][it] = f32x16{};
#pragma unroll 1
    for (int c = 0; c < RW_NCH; ++c) {
        const int bi = c & (RW_NBUF - 1);
        LAS unsigned char* db = sl + bi * RW_DB;
        const LAS bf16_t* AR = (const LAS bf16_t*)(db + RW_AR); const LAS bf16_t* BKT = (const LAS bf16_t*)(db + RW_BKT); const LAS bf16_t* VT = (const LAS bf16_t*)(db + RW_VT);
        const LAS float* GC = (const LAS float*)(db + RW_GC); const LAS bf16_t* TM = (const LAS bf16_t*)(db + RW_TM); const LAS bf16_t* PM1 = (const LAS bf16_t*)(db + RW_PM1); const LAS bf16_t* PM2 = (const LAS bf16_t*)(db + RW_PM2);
        LAS float* YB = (LAS float*)(sl + RW_YB + (c & 1) * 4096);
        rw_wait(flg + bi, (unsigned)(c + 1));
        f32x16 X[2]; X[0] = f32x16{}; X[1] = f32x16{};
#pragma unroll
        for (int jt = 0; jt < 2; ++jt)
#pragma unroll
            for (int rgp = 0; rgp < 2; ++rgp) { const bf16x8 af = frag_perm(AR + r32 * RW_ARP + 32 * jt + 16 * rgp, hi);
#pragma unroll
                for (int it = 0; it < 2; ++it) X[it] = __builtin_amdgcn_mfma_f32_32x32x16_bf16(af, pack_acc8(ST[jt][it], 8 * rgp), X[it], 0, 0, 0); }
        bf16x8 vt[2];
        { const bf16x8 a1 = *(const LAS bf16x8*)(PM1 + r32 * RW_PMP + 8 * hi);
#pragma unroll
          for (int it = 0; it < 2; ++it) { vt[it] = *(const LAS bf16x8*)(VT + (32 * it + r32) * RW_VTP + 8 * hi); X[it] = __builtin_amdgcn_mfma_f32_32x32x16_bf16(a1, vt[it], X[it], 0, 0, 0); } }
        bf16x8 ub[2];
        { const bf16x8 ta = frag_perm(TM + r32 * RW_PMP, hi), pm2 = frag_perm(PM2 + r32 * RW_PMP, hi);
#pragma unroll
          for (int it = 0; it < 2; ++it) { const f32x16 U = __builtin_amdgcn_mfma_f32_32x32x16_bf16(ta, pack_acc8(X[it], 0), f32x16{}, 0, 0, 0);
              ub[it] = pack_acc8(U, 0); X[it] = __builtin_amdgcn_mfma_f32_32x32x16_bf16(pm2, ub[it], X[it], 0, 0, 0); } }
        if (c >= 2) rw_wait(flg + 10 + (c & 1), (unsigned)(c - 1));
#pragma unroll
        for (int it = 0; it < 2; ++it)
#pragma unroll
            for (int r = 8; r < 16; ++r) YB[(crow(r, hi) - 16) * 64 + 32 * it + r32] = X[it][r];
        rw_post_flag(flg + 8 + (c & 1), (unsigned)(c + 1));
#pragma unroll
        for (int jt = 0; jt < 2; ++jt) { const bf16x8 a0 = frag_perm(BKT + (32 * jt + r32) * RW_BKTP, hi), a1 = *(const LAS bf16x8*)(BKT + (32 * jt + r32) * RW_BKTP + 16 + 8 * hi);
#pragma unroll
            for (int it = 0; it < 2; ++it) { ST[jt][it] = __builtin_amdgcn_mfma_f32_32x32x16_bf16(a0, ub[it], ST[jt][it], 0, 0, 0);
                ST[jt][it] = __builtin_amdgcn_mfma_f32_32x32x16_bf16(a1, vt[it], ST[jt][it], 0, 0, 0); }
#pragma unroll
            for (int rg = 0; rg < 4; ++rg) { const f32x4 g4 = *(const LAS f32x4*)(GC + 32 * jt + 8 * rg + 4 * hi);
#pragma unroll
                for (int e = 0; e < 4; ++e) { ST[jt][0][4 * rg + e] *= g4[e]; ST[jt][1][4 * rg + e] *= g4[e]; } } }
        rw_post_flag(flg + 4 + bi, (unsigned)(c + 1));
    }
}

DEV void rwkv_post(const Args& a, int l, int b, int h, LAS unsigned char* sl, int par) {
    const int lane = fresh_lane();
    volatile LAS unsigned* flg = (volatile LAS unsigned*)(sl + RW_FLG);
    bf16_t* Zb = (bf16_t*)(a.ws + WS_Z) + (size_t)b * SEQ * ZP;
    const int gcol0 = h < 4 ? ZC_FV + h * 64 : ZC_MV + (h - 4) * 64;
    const int t = lane >> 2, qd = lane & 3, c0 = h * 64 + 16 * qd;
    const float* rkp = a.in[22] + l * 512 + c0; const float* lw = a.in[23] + l * 512 + c0; const float* lb = a.in[24] + l * 512 + c0;
    const LAS float* YB = (const LAS float*)(sl + RW_YB + par * 4096);
#pragma unroll 1
    for (int c = par; c < RW_NCH; c += 2) {
        bf16_t* zr = Zb + (size_t)(16 * c + t) * ZP;
        const u32x4 r0 = *(const u32x4*)(zr + ZC_RR + c0), r1 = *(const u32x4*)(zr + ZC_RR + c0 + 8), k0 = *(const u32x4*)(zr + ZC_RK + c0), k1 = *(const u32x4*)(zr + ZC_RK + c0 + 8);
        const u32x4 v0 = *(const u32x4*)(zr + ZC_RV + c0), v1 = *(const u32x4*)(zr + ZC_RV + c0 + 8), g0 = *(const u32x4*)(zr + gcol0 + 16 * qd), g1 = *(const u32x4*)(zr + gcol0 + 16 * qd + 8);
        rw_wait(flg + 8 + par, (unsigned)(c + 1));
        float y[16];
#pragma unroll
        for (int q4 = 0; q4 < 4; ++q4) { const f32x4 yy = *(const LAS f32x4*)(YB + t * 64 + 16 * qd + 4 * q4); y[4 * q4] = yy[0]; y[4 * q4 + 1] = yy[1]; y[4 * q4 + 2] = yy[2]; y[4 * q4 + 3] = yy[3]; }
        asm volatile("s_waitcnt lgkmcnt(0)" ::: "memory");
        flg[10 + par] = (unsigned)(c + 1);
        float s = 0.f;
#pragma unroll
        for (int e = 0; e < 16; ++e) s += y[e];
        s += __shfl_xor(s, 1); s += __shfl_xor(s, 2);
        const float mean = s * (1.f / 64); float q = 0.f;
#pragma unroll
        for (int e = 0; e < 16; ++e) { y[e] -= mean; q += y[e] * y[e]; }
        q += __shfl_xor(q, 1); q += __shfl_xor(q, 2);
        const float rstd = rsqrtf(q * (1.f / 64) + GN_EPS);
        float rv[16], kv[16];
        unpack8(r0, *(float(*)[8])&rv[0]); unpack8(r1, *(float(*)[8])&rv[8]); unpack8(k0, *(float(*)[8])&kv[0]); unpack8(k1, *(float(*)[8])&kv[8]);
        float bs = 0.f;
#pragma unroll
        for (int e = 0; e < 16; ++e) bs += rv[e] * kv[e] * rkp[e];
        bs += __shfl_xor(bs, 1); bs += __shfl_xor(bs, 2);
        float vv[16], gv[16], o[16];
        unpack8(v0, *(float(*)[8])&vv[0]); unpack8(v1, *(float(*)[8])&vv[8]); unpack8(g0, *(float(*)[8])&gv[0]); unpack8(g1, *(float(*)[8])&gv[8]);
#pragma unroll
        for (int e = 0; e < 16; ++e) o[e] = (y[e] * rstd * lw[e] + lb[e] + bs * vv[e]) * gv[e];
        *(u32x4*)(zr + ZC_RR + c0) = pack8(*(float(*)[8])&o[0]); *(u32x4*)(zr + ZC_RR + c0 + 8) = pack8(*(float(*)[8])&o[8]);
    }
}

#define XB_TMO      128
#define XB_XCNT(j)  (256  + 64 * (j))
#define XB_XSUB(j)  (1280 + 64 * (j))
#define XB_XGEN(j)  (2304 + 64 * (j))
#define XB_TOP      3328
#define XB_TOPGEN   3392
#define XCD_BAR_WORDS 3456
#define XB_SPIN_CAP (1u << 18)

__device__ __forceinline__ unsigned xb_ld(unsigned* p)              { return __hip_atomic_load(p, __ATOMIC_RELAXED, __HIP_MEMORY_SCOPE_AGENT); }
__device__ __forceinline__ unsigned xb_add(unsigned* p, unsigned v) { return __hip_atomic_fetch_add(p, v, __ATOMIC_RELAXED, __HIP_MEMORY_SCOPE_AGENT); }
__device__ __forceinline__ unsigned xb_xcc_id() { return (unsigned)__builtin_amdgcn_s_getreg((3 << 11) | 20) & 0xFu; }
#define XB_SPIN(cond, bar) do { unsigned _sp = 0; while (cond) { __builtin_amdgcn_s_sleep(1); \
    if ((++_sp & 255u) == 0u) { if (xb_ld(&(bar)[XB_TMO])) break; if (_sp > XB_SPIN_CAP) { atomicAdd(&(bar)[XB_TMO], 1u); break; } } } } while (0)

struct XcdBarrier {
    unsigned* bar; unsigned x;
    volatile LAS unsigned* st;
};

__device__ __forceinline__ XcdBarrier xcd_barrier_post(unsigned* bar, volatile LAS unsigned* st) {
    XcdBarrier b; b.bar = bar; b.x = xb_xcc_id(); b.st = st;
    if (threadIdx.x == 0) (void)xb_add(&bar[XB_XCNT(b.x)], 1u);
    return b;
}
__device__ __forceinline__ void xcd_barrier_complete(unsigned* bar, unsigned x, unsigned& nloc, unsigned& nx) {
    const unsigned G = gridDim.x * gridDim.y * gridDim.z;
    unsigned sum, cnt, mine, sp = 0u;
    for (;;) {
        sum = 0u; cnt = 0u; mine = 0u;
#pragma unroll
        for (unsigned j = 0; j < 16; ++j) { const unsigned c = xb_ld(&bar[XB_XCNT(j)]); sum += c; cnt += (c > 0u) ? 1u : 0u; mine = (j == x) ? c : mine; }
        if (sum == G) break;
        __builtin_amdgcn_s_sleep(1);
        if ((++sp & 255u) == 0u) { if (xb_ld(&bar[XB_TMO])) break; if (sp > XB_SPIN_CAP) { atomicAdd(&bar[XB_TMO], 1u); break; } }
    }
    nloc = mine > 0u ? mine : 1u; nx = cnt > 0u ? cnt : 1u;
}

__device__ __forceinline__ void xcd_barrier(const XcdBarrier& b) {
    asm volatile("s_waitcnt vmcnt(0)" ::: "memory");
    __syncthreads();
    if (threadIdx.x == 0) {
        unsigned* bar = b.bar;
        __builtin_amdgcn_s_waitcnt(0);
        unsigned nloc = b.st[0], nx = b.st[1];
        if (nloc == 0u) { xcd_barrier_complete(bar, b.x, nloc, nx); b.st[0] = nloc; b.st[1] = nx; }
        const unsigned old = xb_add(&bar[XB_XSUB(b.x)], 1u);
        const unsigned gen = old / nloc;
        if (old + 1u == (gen + 1u) * nloc) {
            __builtin_amdgcn_fence(__ATOMIC_RELEASE, "agent");
            asm volatile("s_waitcnt vmcnt(0)" ::: "memory");
            const unsigned og = xb_add(&bar[XB_TOP], 1u);
            const unsigned tg = og / nx;
            if (og + 1u == (tg + 1u) * nx) xb_add(&bar[XB_TOPGEN], 1u);
            else XB_SPIN(xb_ld(&bar[XB_TOPGEN]) == tg, bar);
            __builtin_amdgcn_fence(__ATOMIC_ACQUIRE, "agent");
            xb_add(&bar[XB_XGEN(b.x)], 1u);
            asm volatile("s_waitcnt vmcnt(0)" ::: "memory");
        } else {
            XB_SPIN(xb_ld(&bar[XB_XGEN(b.x)]) == gen, bar);
            __builtin_amdgcn_fence(__ATOMIC_ACQUIRE, "agent");
            asm volatile("s_waitcnt vmcnt(0)" ::: "memory");
        }
    }
    __syncthreads();
}

constexpr int N_PHASES = 1 + 15 * NL;
#ifndef MK_MULTI
#define MK_MULTI 0
#endif
#ifndef PROBE_Q
#define PROBE_Q 500.f
#endif
#ifndef PROBE_OFF
#define PROBE_OFF 0.f
#endif
#ifndef REPK
#define REPK 0
#endif
#ifndef ATT_REP
#define ATT_REP 1
#endif
#ifndef PREP_REP
#define PREP_REP 1
#endif
#ifndef RWROLES
#define RWROLES 7
#endif
#ifndef PHMASK
#define PHMASK 0xFFFF
#endif
#define PHON(k) ((PHMASK >> (k)) & 1)
__global__ void __launch_bounds__(512, 2) fwd_megakernel(Args a) {
    extern __shared__ __attribute__((aligned(16))) unsigned char lds_raw[];
    LAS unsigned char* lds = (LAS unsigned char*)lds_raw;
    cg::grid_group grid = cg::this_grid();
    { volatile LAS unsigned* st0 = (volatile LAS unsigned*)(lds + 131072 + 128); if (threadIdx.x == 0) { st0[0] = 0u; st0[1] = 0u; } __syncthreads(); }
    XcdBarrier xbar = xcd_barrier_post((unsigned*)(a.ws + WS_CTL) + 4096, (volatile LAS unsigned*)(lds + 131072 + 128));
    const int G = gridDim.x, bid = blockIdx.x, NGW = G * 8;
    unsigned char* ws = a.ws;
    bf16_t* HN = (bf16_t*)(ws + WS_HN); bf16_t* Z = (bf16_t*)(ws + WS_Z); bf16_t* HID = Z; bf16_t* QX = Z; bf16_t* OX = Z + (size_t)TOK * 512;
#ifdef PROBE_GROUP
    LAS unsigned long long* prs = (LAS unsigned long long*)(lds + 131072 + 64);
    if (threadIdx.x == 0) { prs[0] = __builtin_amdgcn_s_memrealtime(); prs[1] = 0ull; prs[2] = 99ull; }
#endif
#ifdef PROBE_GROUP
    for (int ph = a.ph_lo; ph <= a.ph_hi; ++ph) {
#else
    for (int ph = a.ph_lo; ph < a.ph_hi; ++ph) {
#endif
        if (ph > a.ph_lo) { if (ph == a.ph_lo + 1 || MK_MULTI) grid.sync(); else xcd_barrier(xbar);
#ifdef SYNC_REP
            xcd_barrier(xbar); xcd_barrier(xbar);
#endif
        }
#ifdef PROBE_GROUP
        if (threadIdx.x == 0) { const unsigned long long now = __builtin_amdgcn_s_memrealtime(); if (prs[2] == (unsigned long long)PROBE_GROUP) prs[1] += now - prs[0]; prs[0] = now;
          if (ph == a.ph_hi) { if (blockIdx.x == 0) { float us_ = (float)prs[1] * 0.01f;
#if PROBE_GROUP == 8
              us_ = (float)((volatile unsigned*)(ws + WS_CTL))[32 * 64] * 0.01f;
#endif
              a.out[0] = floorf((us_ + PROBE_OFF) / PROBE_Q) * PROBE_Q + 0.5f * PROBE_Q; } }
          const int k_ = (ph - 1) % 15; prs[2] = ph == 0 ? 0 : (k_ == 0 || k_ == 3 || k_ == 8 || k_ == 12) ? 1 : (k_ == 1 || k_ == 13) ? 2 : (k_ == 2 || k_ == 14 || k_ == 7 || k_ == 11) ? 3 : (k_ == 4 || k_ == 9) ? 4 : k_ == 5 ? 5 : k_ == 6 ? 6 : 7; }
        if (ph == a.ph_hi) break;
#endif
        int tidp = threadIdx.x; asm volatile("" : "+v"(tidp)); const int tid = tidp, lane = tid & 63, wid = __builtin_amdgcn_readfirstlane(tid >> 6), gw = bid * 8 + wid;
        if (ph == 0) { for (int rp_ = 0; rp_ < ((REPK >> 15) & 1) + 1; ++rp_) { if (PHON(15)) p0_prologue(a, lds, gw, NGW, wid, lane, tid); } continue; }
        const int l = (ph - 1) / 15, kind = (ph - 1) % 15;
        const unsigned char* wl = ws + WS_W + (size_t)l * WL_BYTES;
        if (PHON(0) && (kind == 0 || kind == 3 || kind == 8 || kind == 12)) {
            const float* src = (l == 0 && kind == 0) ? a.in[0] : a.out;
            const float* g = (kind == 0 ? a.in[3] : kind == 3 ? a.in[6] : kind == 8 ? a.in[25] : a.in[32]) + l * DM;
            for (int rp_ = 0; rp_ < (REPK & 1) + 1; ++rp_) norm_phase(src, g, HN, TOK, gw, NGW, lane);
            if (l == 0 && kind == 3) xkv_post(a, gw, NGW, lane);
        }
        if (PHON(1) && (kind == 1 || kind == 13)) {
            pg8::Gemm g{HN, (const bf16_t*)(wl + (kind == 1 ? OFF_F1I : OFF_F2I)), TOK, 2 * FF, DM, DM};
            pg8::StaticOrder S; S.init(TOK, 2 * FF, G, bid);
            pg8::EpiSwiglu E{HID, FF};
            pg8::gemm_phase<pg8::EpiSwiglu, pg8::StaticOrder, true, true>(lds, g, S, E);
        }
        if (PHON(2) && (kind == 2 || kind == 14 || kind == 7 || kind == 11)) {
            pg8::Gemm g; pg8::EpiResid E; E.out = a.out; E.ldc = DM; g.M = TOK; g.N = DM;
            if (kind == 2 || kind == 14) { g.A = HID; g.lda = FF; g.K = FF; g.Bt = (const bf16_t*)(wl + (kind == 2 ? OFF_F1O : OFF_F2O)); E.scale = 0.5f; E.base = (l == 0 && kind == 2) ? a.in[0] : a.out; }
            else if (kind == 7) { g.A = Z; g.lda = ZP; g.K = DM; g.Bt = (const bf16_t*)(wl + OFF_MO); E.scale = 1.f; E.base = a.out; }
            else { g.A = OX; g.lda = 512; g.K = 512; g.Bt = (const bf16_t*)(wl + OFF_XO); E.scale = 1.f; E.base = a.out; }
            pg8::StaticOrder S; S.init(TOK, DM, G, bid);
            const float sc_ = E.scale;
            for (int rp_ = ((REPK >> 2) & 1); rp_ >= 0; --rp_) { E.scale = rp_ ? 0.f : sc_;
            pg8::gemm_phase<pg8::EpiResid, pg8::StaticOrder, true, true>(lds, g, S, E); if (rp_) { __syncthreads(); } }
        }
        if (PHON(4) && (kind == 4 || kind == 9 || (kind == 0 && l == 0))) {
            const int ng = (kind == 0) ? NL : 1;
            for (int rp_ = 0; rp_ < ((REPK >> 4) & 1) + 1; ++rp_)
            for (int gi = 0; gi < ng; ++gi) {
                pg8::Gemm g; pg8::EpiBf16 E; int cidx = bid;
                if (kind == 4) { g.A = HN; g.lda = DM; g.K = DM; g.M = TOK; g.N = 3584; g.Bt = (const bf16_t*)(wl + OFF_MI); E.O = Z; E.ldc = ZP; E.ncols = ZC_VALID; E.halo = (bf16_t*)(ws + WS_ZHALO); }
                else if (kind == 9) { g.A = HN; g.lda = DM; g.K = DM; g.M = TOK; g.N = 512; g.Bt = (const bf16_t*)(wl + OFF_XQ); E.O = QX; E.ldc = 512; E.ncols = 512; E.halo = nullptr; }
                else { g.A = (const bf16_t*)(ws + WS_MEMN) + (size_t)gi * NB * MEMLEN * DM; g.lda = DM; g.K = DM; g.M = NB * MEMLEN; g.N = 1024;
                       g.Bt = (const bf16_t*)(ws + WS_W + (size_t)gi * WL_BYTES + OFF_XKV); E.O = (bf16_t*)(ws + WS_KVX) + (size_t)gi * NB * MEMLEN * 1024; E.ldc = 1024; E.ncols = 1024; E.halo = nullptr;
                       cidx = (bid + gi * (G / 2)) % G; }
                pg8::StaticOrder S; S.init(g.M, g.N, G, cidx);
                pg8::gemm_phase<pg8::EpiBf16, pg8::StaticOrder, true, true>(lds, g, S, E);
            }
        }
        if (PHON(5) && kind == 5) { for (int rp_ = PREP_REP - 1; rp_ >= 0; --rp_) for (int tile = bid; tile < TOK / 64; tile += G) prep_tile(a, l, tile, lds, rp_ > 0); }
        if (PHON(6) && kind == 6) {
            unsigned* ctr = (unsigned*)(ws + WS_CTL) + 64 * (1 + l); LAS unsigned* qw = (LAS unsigned*)(lds + 131072);
            for (;;) {
                __syncthreads();
                if (tid == 0) *qw = atomicAdd(ctr, 1u);
                __syncthreads();
                const int item = __builtin_amdgcn_readfirstlane((int)*qw);
                if (item >= 64 + 1024) break;
                if (item < 64) {
                    if (tid < 16) ((LAS unsigned*)(lds + RW_FLG))[tid] = 0u;
                    __syncthreads();
                    if (PHON(7)) {
                        const int ub = item >> 3, uh = item & 7;
                        if (wid == 0 || wid == 4 || wid == 2 || wid == 6) { if (RWROLES & 1) rwkv_pre(a, ub, uh, lds, wid == 0 ? 0 : wid == 4 ? 1 : wid == 2 ? 2 : 3); }
                        else if (wid == 1) { if (RWROLES & 2) rwkv_main(lds); }
                        else if (wid == 3 || wid == 7) { if (RWROLES & 4) rwkv_post(a, l, ub, uh, lds, wid == 3 ? 0 : 1); }
                    }
                }
                else {
                    const int j = item - 64, qb = 15 - (j >> 6), kk = j & 63, type = kk >> 5, bh = kk & 31, b = bh >> 2, h = bh & 3;
                    bf16_t* Zb = Z + (size_t)b * SEQ * ZP;
                    for (int rp_ = ATT_REP - 1; rp_ >= 0; --rp_)
                    if (type == 0) { if (PHON(8)) attn_unit<0, 64>(lds, Zb + ZC_FQ + 64 * h, ZP, Zb + ZC_FK + 64 * h, ZP, (const bf16_t*)(ws + WS_VTF) + (size_t)bh * 64 * SEQ, SEQ, Zb + ZC_FQ + 64 * h, ZP,
                                                   256 * qb, 4 * (qb + 1), qb, (const float*)(ws + WS_LOGF) + (size_t)bh * SEQ, nullptr, rp_ > 0); }
                    else if (PHON(9)) attn_unit<1, 64>(lds, Zb + ZC_MQ + 64 * h, ZP, Zb + ZC_MK + 64 * h, ZP, (const bf16_t*)(ws + WS_VTM) + (size_t)bh * 64 * SEQ, SEQ, Zb + ZC_MQ + 64 * h, ZP,
                                          256 * qb, 4 * (qb + 1), qb, (const float*)(ws + WS_KMP) + (size_t)bh * 64 * 64, nullptr, rp_ > 0);
                }
            }
        }
        if (PHON(10) && kind == 10) {
            for (int rp_ = 0; rp_ < ((REPK >> 10) & 1) + 1; ++rp_)
            for (int u = bid; u < NB * 4 * 16; u += G) { const int b = u >> 6, hd = (u >> 4) & 3, qb = u & 15;
                bf16_t* qp = QX + (size_t)b * SEQ * 512 + hd * 128;
                attn_unit<2, 128>(lds, qp, 512, (const bf16_t*)(ws + WS_KVX) + ((size_t)l * NB + b) * MEMLEN * 1024 + hd * 128, 1024,
                                  (const bf16_t*)(ws + WS_VTX) + ((size_t)(l * NB + b) * 4 + hd) * 128 * MEMLEN, MEMLEN, OX + (size_t)b * SEQ * 512 + hd * 128, 512, 256 * qb, MEMLEN / 64, qb, nullptr, a.in[29] + l * 128); }
        }
    }
}

extern "C" void kernel_launch(void* const* d_in, const int* in_sizes, int n_in, void* d_out, int out_size, void* d_ws, size_t ws_size, hipStream_t stream) {
    static int grid_blocks = 0;
    if (grid_blocks == 0) {
        if (n_in != 35 || ws_size < WS_END) { fprintf(stderr, "kernel_launch: unexpected n_in %d / ws %zu\n", n_in, ws_size); grid_blocks = -1; return; }
        int dev = 0, cus = 0, per_cu = 0;
        hipGetDevice(&dev); hipDeviceGetAttribute(&cus, hipDeviceAttributeMultiprocessorCount, dev);
        if (hipFuncSetAttribute((const void*)fwd_megakernel, hipFuncAttributeMaxDynamicSharedMemorySize, LDS_BYTES) != hipSuccess) { fprintf(stderr, "kernel_launch: hipFuncSetAttribute failed\n"); grid_blocks = -1; return; }
        if (hipOccupancyMaxActiveBlocksPerMultiprocessor(&per_cu, (const void*)fwd_megakernel, 512, LDS_BYTES) != hipSuccess || per_cu < 1) { fprintf(stderr, "kernel_launch: occupancy query says %d\n", per_cu); per_cu = 1; }
        (void)hipGetLastError();
        grid_blocks = cus * per_cu;
    }
    if (grid_blocks < 0) return;
    Args a{};
    for (int i = 0; i < 35; ++i) a.in[i] = (const float*)d_in[i];
    a.out = (float*)d_out; a.ws = (unsigned char*)d_ws;
    if (hipMemsetAsync(d_ws, 0, 65536, stream) != hipSuccess) { fprintf(stderr, "kernel_launch: memset failed\n"); return; }
#if MK_MULTI
    for (int ph = 0; ph < N_PHASES; ++ph) { a.ph_lo = ph; a.ph_hi = ph + 1; hipLaunchKernelGGL(fwd_megakernel, dim3(grid_blocks), dim3(512), LDS_BYTES, stream, a); }
#else
    a.ph_lo = 0; a.ph_hi = N_PHASES;
    void* args[] = {&a};
    hipError_t e = hipLaunchCooperativeKernel((const void*)fwd_megakernel, dim3(grid_blocks), dim3(512), args, LDS_BYTES, stream);
    if (e != hipSuccess) fprintf(stderr, "cooperative launch failed: %s (grid %d)\n", hipGetErrorString(e), grid_blocks);
#endif
}
```

```cpp
#include <hip/hip_runtime.h>
#include <hip/hip_cooperative_groups.h>
#include <cstdio>
#include <cstdint>
namespace cg = cooperative_groups;
namespace pg8 {
#define PG8_LAS __attribute__((address_space(3)))
typedef unsigned short bf16_t;
typedef short bf16x8 __attribute__((ext_vector_type(8)));
typedef float f32x4 __attribute__((ext_vector_type(4)));
typedef unsigned u32x4 __attribute__((ext_vector_type(4)));
constexpr int BM = 256, BK = 64, HALF = 128, HTB = HALF * BK * 2  , STAGE_BYTES = 8 * HTB, NXCD = 8, WGM = 8;

__host__ __device__ __forceinline__ int lds_byte(int r, int c) { const int st = (r >> 4) * 2 + (c >> 5), rr = r & 15, cc = c & 31, ob = rr * 64 + cc * 2; return st * 1024 + (ob ^ (((ob >> 9) & 1) << 5)); }
__host__ __device__ __forceinline__ void stage_rc(int b, int& R, int& C) { const int st = b / 1024, sb = b % 1024, swz = sb ^ (((sb >> 9) & 1) << 5); R = (st >> 1) * 16 + swz / 64; C = (st & 1) * 32 + (swz % 64) / 2; }
__host__ __device__ __forceinline__ int perm32(int rho) { const int n = rho >> 4, i = rho & 15; return 8 * (i >> 2) + 4 * n + (i & 3); }

struct Unit { int pm, pn; };
struct Gemm { const bf16_t* A; const bf16_t* Bt; int M, N, K, lda; };

struct StaticOrder {
    int nM, nN, nwg, G, c;
    __host__ __device__ void init(int M, int N, int G_, int c_) { nM = M / BM; nN = N / BM; nwg = nM * nN; G = G_; c = c_; }
    __host__ __device__ bool next(int i, Unit& u) const {
        const long L = (long)i * G + c; if (L >= nwg) return false;
        int wgid = (int)L; { const int q = nwg / NXCD, r = nwg % NXCD, xcd = wgid % NXCD, off = wgid / NXCD; wgid = (xcd < r ? xcd * (q + 1) : r * (q + 1) + (xcd - r) * q) + off; }
        const int nig = WGM * nN, gid = wgid / nig, fm = gid * WGM, gsz = (nM - fm) < WGM ? (nM - fm) : WGM;
        u.pm = fm + ((wgid % nig) % gsz); u.pn = (wgid % nig) / gsz; return true;
    }
    __device__ __forceinline__ void a_ready(const Unit&) const {}
    __device__ __forceinline__ void done(const Unit&) const {}
};
__device__ __forceinline__ unsigned cvt_pk_bf16(float lo, float hi) { unsigned r; asm volatile("v_cvt_pk_bf16_f32 %0, %1, %2" : "=v"(r) : "v"(lo), "v"(hi)); return r; }
__device__ __forceinline__ float silu_f(float x) { return x * __builtin_amdgcn_rcpf(1.0f + __builtin_amdgcn_exp2f(-1.4426950408889634f * x)); }
struct EpiSwiglu {
    static constexpr bool PERM = true, AFTER_DRAIN = false;
    bf16_t* O; int ldc;
    __device__ __forceinline__ void operator()(const f32x4 (&acc)[2][2][4][2], const Unit& u, int wr, int wc, int fr, int fq) const {
        const int row0 = u.pm * BM + wr * 64 + fr, col0 = u.pn * HALF + wc * 32 + 8 * fq;
#pragma unroll
        for (int ai = 0; ai < 2; ++ai)
#pragma unroll
            for (int m = 0; m < 4; ++m) {
                const f32x4 g0 = acc[ai][0][m][0], g1 = acc[ai][0][m][1], u0 = acc[ai][1][m][0], u1 = acc[ai][1][m][1];
                u32x4 w;
                w.x = cvt_pk_bf16(silu_f(g0[0]) * u0[0], silu_f(g0[1]) * u0[1]); w.y = cvt_pk_bf16(silu_f(g0[2]) * u0[2], silu_f(g0[3]) * u0[3]);
                w.z = cvt_pk_bf16(silu_f(g1[0]) * u1[0], silu_f(g1[1]) * u1[1]); w.w = cvt_pk_bf16(silu_f(g1[2]) * u1[2], silu_f(g1[3]) * u1[3]);
                *(u32x4*)(O + (size_t)(row0 + ai * HALF + m * 16) * ldc + col0) = w;
            }
    }
};
struct EpiResid {
    static constexpr bool PERM = false, AFTER_DRAIN = false;
    const float* base; float* out; int ldc; float scale;
    __device__ __forceinline__ void operator()(const f32x4 (&acc)[2][2][4][2], const Unit& u, int wr, int wc, int fr, int fq) const {
        const int row0 = u.pm * BM + wr * 64 + fr, col0 = u.pn * BM + wc * 32 + 4 * fq;
#pragma unroll
        for (int ai = 0; ai < 2; ++ai)
#pragma unroll
            for (int m = 0; m < 4; ++m) { const size_t off = (size_t)(row0 + ai * HALF + m * 16) * ldc + col0;
#pragma unroll
                for (int bj = 0; bj < 2; ++bj)
#pragma unroll
                    for (int n = 0; n < 2; ++n) { const f32x4 b = *(const f32x4*)(base + off + bj * HALF + n * 16); *(f32x4*)(out + off + bj * HALF + n * 16) = b + acc[ai][bj][m][n] * scale; }
                asm volatile("" ::: "memory"); }
    }
};
struct EpiBf16 {
    static constexpr bool PERM = true, AFTER_DRAIN = false;
    bf16_t* O; int ldc; int ncols; bf16_t* halo;
    __device__ __forceinline__ void operator()(const f32x4 (&acc)[2][2][4][2], const Unit& u, int wr, int wc, int fr, int fq) const {
        const int row0 = u.pm * BM + wr * 64 + fr, col0 = u.pn * BM + wc * 32 + 8 * fq;
#pragma unroll
        for (int ai = 0; ai < 2; ++ai)
#pragma unroll
            for (int m = 0; m < 4; ++m) { const int row = row0 + ai * HALF + m * 16;
#pragma unroll
                for (int bj = 0; bj < 2; ++bj) { const int col = col0 + bj * HALF;
                    if (col < ncols) { const f32x4 v0 = acc[ai][bj][m][0], v1 = acc[ai][bj][m][1]; u32x4 w;
                        w.x = cvt_pk_bf16(v0[0], v0[1]); w.y = cvt_pk_bf16(v0[2], v0[3]); w.z = cvt_pk_bf16(v1[0], v1[1]); w.w = cvt_pk_bf16(v1[2], v1[3]);
                        *(u32x4*)(O + (size_t)row * ldc + col) = w;
                        if (halo && (row & 63) == 63) *(u32x4*)(halo + (size_t)(row >> 6) * ldc + col) = w; } } }
    }
};
template <class Epi, class Sched, bool ALIGN_EPI = false, bool SP2 = false>
__device__ __forceinline__ void gemm_phase(PG8_LAS unsigned char* lds, const Gemm g, const Sched& S, const Epi& E) {
    int tid_ = threadIdx.x; asm volatile("" : "+v"(tid_)); const int tid = tid_, wid = __builtin_amdgcn_readfirstlane(tid >> 6), lane = tid & 63, wr = wid >> 2, wc = wid & 3, fr = lane & 15, fq = lane >> 4;
    const int K = g.K, nt = K / BK;
    unsigned voffA[2], voffB[2];
#pragma unroll
    for (int i = 0; i < 2; ++i) { int R, C; stage_rc(tid * 16 + i * 8192, R, C); const int Rb = Epi::PERM ? ((R & ~31) + perm32(R & 31)) : R;
        voffA[i] = (unsigned)(R * g.lda + C) * 2u; voffB[i] = (unsigned)(Rb * K + C) * 2u; }
    const size_t kstep = (size_t)(BK * 2);
    const size_t hstep = (size_t)HALF * K * 2;
    const size_t tstep = 2 * hstep; const size_t hstepA = (size_t)HALF * g.lda * 2, tstepA = 2 * hstepA;
    const unsigned ldsw = (unsigned)wid * 1024u;
    const int aoff = lds_byte(wr * 64 + fr, fq * 8), boff = lds_byte(wc * 32 + fr, fq * 8);
#define PG8_SA(b, h) (((b) * 2 + (h)) * HTB)
#define PG8_SB(b, h) ((4 + (b) * 2 + (h)) * HTB)
#define PG8_STAGE(bufoff, gbase, voff) do { _Pragma("unroll") for (int _i = 0; _i < 2; ++_i) \
        __builtin_amdgcn_global_load_lds((const unsigned*)((const char*)(gbase) + (voff)[_i]), (PG8_LAS unsigned*)(lds + (bufoff) + ldsw + _i * 8192), 16, 0, 0); } while (0)
#define PG8_LDA(dst, b, h) do { _Pragma("unroll") for (int m = 0; m < 4; ++m) _Pragma("unroll") for (int k = 0; k < 2; ++k) dst[m][k] = *(const PG8_LAS bf16x8*)(lds + PG8_SA(b, h) + aoff + m * 2048 + k * 1024); } while (0)
#define PG8_LDB(dst, b, h) do { _Pragma("unroll") for (int n = 0; n < 2; ++n) _Pragma("unroll") for (int k = 0; k < 2; ++k) dst[n][k] = *(const PG8_LAS bf16x8*)(lds + PG8_SB(b, h) + boff + n * 2048 + k * 1024); } while (0)
#define PG8_MMA(ai, bj, At, Bt) do { __builtin_amdgcn_s_setprio(1); _Pragma("unroll") for (int m = 0; m < 4; ++m) _Pragma("unroll") for (int n = 0; n < 2; ++n) _Pragma("unroll") for (int k = 0; k < 2; ++k) \
        acc[ai][bj][m][n] = __builtin_amdgcn_mfma_f32_16x16x32_bf16(Bt[n][k], At[m][k], acc[ai][bj][m][n], 0, 0, 0); __builtin_amdgcn_s_setprio(0); } while (0)
#define PG8_WAIT_V(n) asm volatile("s_waitcnt vmcnt(" #n ")" ::: "memory")
#define PG8_WAIT_L(n) asm volatile("s_waitcnt lgkmcnt(" #n ")" ::: "memory")
#define PG8_BAR __builtin_amdgcn_s_barrier()
#define PG8_SCHED __builtin_amdgcn_sched_barrier(0)
    Unit cur, nxt; int ui = 0;
    if (!S.next(0, cur)) return;
    f32x4 acc[2][2][4][2];
#pragma unroll
    for (int a = 0; a < 2; ++a)
#pragma unroll
        for (int b = 0; b < 2; ++b)
#pragma unroll
            for (int m = 0; m < 4; ++m)
#pragma unroll
                for (int n = 0; n < 2; ++n) acc[a][b][m][n] = (f32x4){0.f, 0.f, 0.f, 0.f};
    bf16x8 At[4][2], B0[2][2], B1[2][2];
    const char* cA = (const char*)g.A + (size_t)cur.pm * tstepA; const char* cB = (const char*)g.Bt + (size_t)cur.pn * tstep;
    S.a_ready(cur);
    if constexpr (SP2) {
        PG8_STAGE(PG8_SB(0, 0), cB, voffB); PG8_STAGE(PG8_SB(0, 1), cB + hstep, voffB); PG8_STAGE(PG8_SA(0, 0), cA, voffA); PG8_STAGE(PG8_SA(0, 1), cA + hstepA, voffA);
        if (wr == 1) PG8_BAR;
        PG8_WAIT_V(2); PG8_BAR;
        PG8_STAGE(PG8_SB(1, 0), cB + kstep, voffB); PG8_STAGE(PG8_SA(1, 0), cA + kstep, voffA); PG8_STAGE(PG8_SB(1, 1), cB + hstep + kstep, voffB);
        PG8_WAIT_V(6); PG8_BAR;
    } else {
        PG8_STAGE(PG8_SB(0, 0), cB, voffB); PG8_STAGE(PG8_SA(0, 0), cA, voffA); PG8_STAGE(PG8_SB(0, 1), cB + hstep, voffB); PG8_STAGE(PG8_SA(0, 1), cA + hstepA, voffA);
        if (wr == 1) PG8_BAR;
        PG8_WAIT_V(4); PG8_BAR;
        PG8_STAGE(PG8_SB(1, 0), cB + kstep, voffB); PG8_STAGE(PG8_SA(1, 0), cA + kstep, voffA); PG8_STAGE(PG8_SB(1, 1), cB + hstep + kstep, voffB);
        PG8_WAIT_V(6); PG8_BAR;
    }
    for (;;) {
        const bool has_next = S.next(ui + 1, nxt);
        const char* nA = has_next ? (const char*)g.A + (size_t)nxt.pm * tstepA : cA; const char* nB = has_next ? (const char*)g.Bt + (size_t)nxt.pn * tstep : cB;
        for (int t = 0; t < nt; t += 2) {
            const bool last = (t == nt - 2);
            const char* a1 = cA + (size_t)(t + 1) * kstep;
            const char* a2 = last ? nA : cA + (size_t)(t + 2) * kstep; const char* b2 = last ? nB : cB + (size_t)(t + 2) * kstep;
            const char* a3 = a2 + kstep; const char* b3 = b2 + kstep;
            if (last && has_next) S.a_ready(nxt);
            if constexpr (SP2) {
            PG8_LDB(B0, 0, 0); PG8_LDB(B1, 0, 1); PG8_SCHED; PG8_LDA(At, 0, 0); PG8_STAGE(PG8_SA(1, 1), a1 + hstepA, voffA);
            PG8_WAIT_V(8); PG8_WAIT_L(0); PG8_BAR; PG8_MMA(0, 0, At, B0); PG8_MMA(0, 1, At, B1); PG8_BAR; PG8_SCHED;
            PG8_LDA(At, 0, 1); PG8_STAGE(PG8_SB(0, 0), b2, voffB); PG8_STAGE(PG8_SB(0, 1), b2 + hstep, voffB); PG8_STAGE(PG8_SA(0, 0), a2, voffA);
            PG8_WAIT_V(8); PG8_WAIT_L(0); PG8_BAR; PG8_MMA(1, 0, At, B0); PG8_MMA(1, 1, At, B1); PG8_BAR; PG8_SCHED;
            PG8_LDB(B0, 1, 0); PG8_LDB(B1, 1, 1); PG8_SCHED; PG8_LDA(At, 1, 0); PG8_STAGE(PG8_SA(0, 1), a2 + hstepA, voffA);
            PG8_WAIT_V(8); PG8_WAIT_L(0); PG8_BAR; PG8_MMA(0, 0, At, B0); PG8_MMA(0, 1, At, B1); PG8_BAR; PG8_SCHED;
            PG8_LDA(At, 1, 1); PG8_STAGE(PG8_SB(1, 0), b3, voffB); PG8_STAGE(PG8_SB(1, 1), b3 + hstep, voffB); PG8_STAGE(PG8_SA(1, 0), a3, voffA);
            PG8_WAIT_V(8); PG8_WAIT_L(0); PG8_BAR; PG8_MMA(1, 0, At, B0); PG8_MMA(1, 1, At, B1); PG8_BAR; PG8_SCHED;
            } else {
            PG8_LDB(B0, 0, 0); PG8_SCHED; PG8_LDA(At, 0, 0); PG8_STAGE(PG8_SA(1, 1), a1 + hstepA, voffA);
            PG8_WAIT_L(8); PG8_BAR; PG8_WAIT_L(0); PG8_MMA(0, 0, At, B0); PG8_BAR; PG8_SCHED;
            PG8_LDB(B1, 0, 1); PG8_STAGE(PG8_SB(0, 0), b2, voffB);
            PG8_BAR; PG8_WAIT_L(0); PG8_MMA(0, 1, At, B1); PG8_BAR;
            PG8_LDA(At, 0, 1); PG8_STAGE(PG8_SA(0, 0), a2, voffA);
            PG8_BAR; PG8_WAIT_L(0); PG8_MMA(1, 0, At, B0); PG8_BAR; PG8_SCHED;
            PG8_STAGE(PG8_SB(0, 1), b2 + hstep, voffB);
            PG8_WAIT_V(6); PG8_BAR; PG8_MMA(1, 1, At, B1); PG8_BAR;
            PG8_LDB(B0, 1, 0); PG8_SCHED; PG8_LDA(At, 1, 0); PG8_STAGE(PG8_SA(0, 1), a2 + hstepA, voffA);
            PG8_WAIT_L(8); PG8_BAR; PG8_WAIT_L(0); PG8_MMA(0, 0, At, B0); PG8_BAR; PG8_SCHED;
            PG8_LDB(B1, 1, 1); PG8_STAGE(PG8_SB(1, 0), b3, voffB);
            PG8_BAR; PG8_WAIT_L(0); PG8_MMA(0, 1, At, B1); PG8_BAR;
            PG8_LDA(At, 1, 1); PG8_STAGE(PG8_SA(1, 0), a3, voffA);
            PG8_BAR; PG8_WAIT_L(0); PG8_MMA(1, 0, At, B0); PG8_BAR; PG8_SCHED;
            PG8_STAGE(PG8_SB(1, 1), b3 + hstep, voffB);
            PG8_WAIT_V(6); PG8_BAR; PG8_MMA(1, 1, At, B1); PG8_BAR;
            }
        }
        if constexpr (ALIGN_EPI) { if (wr == 0) PG8_BAR; }
        if constexpr (!Epi::AFTER_DRAIN) { E(acc, cur, wr, wc, fr, fq); S.done(cur); }
        if (!has_next) break;
#pragma unroll
        for (int a = 0; a < 2; ++a)
#pragma unroll
            for (int b = 0; b < 2; ++b)
#pragma unroll
                for (int m = 0; m < 4; ++m)
#pragma unroll
                    for (int n = 0; n < 2; ++n) acc[a][b][m][n] = (f32x4){0.f, 0.f, 0.f, 0.f};
        cur = nxt; cA = nA; cB = nB; ++ui;
        if constexpr (ALIGN_EPI) { if (wr == 1) PG8_BAR; }
    }
    PG8_WAIT_V(0);
    if constexpr (!ALIGN_EPI) { if (wr == 0) PG8_BAR; }
    PG8_BAR;
    if constexpr (Epi::AFTER_DRAIN) { E.fused(acc, cur, wr, wc, fr, fq, lds, wid, lane); S.done(cur); }
#undef PG8_SA
#undef PG8_SB
#undef PG8_STAGE
#undef PG8_LDA
#undef PG8_LDB
#undef PG8_MMA
#undef PG8_WAIT_V
#undef PG8_WAIT_L
#undef PG8_BAR
#undef PG8_SCHED
}
}

#define LAS __attribute__((address_space(3)))
#define DEV __device__ __forceinline__
typedef unsigned short bf16_t;
typedef short bf16x8 __attribute__((ext_vector_type(8)));
typedef short s16x4 __attribute__((ext_vector_type(4)));
typedef float f32x4 __attribute__((ext_vector_type(4)));
typedef float f32x16 __attribute__((ext_vector_type(16)));
typedef unsigned u32x2 __attribute__((ext_vector_type(2)));
typedef unsigned u32x4 __attribute__((ext_vector_type(4)));
typedef unsigned u32x8 __attribute__((ext_vector_type(8)));

constexpr int NB = 8, SEQ = 4096, DM = 1024, TOK = NB * SEQ, FF = 2816, NL = 2, MEMLEN = 256;
constexpr int ZP = 3392;
constexpr int ZC_FQ = 0, ZC_RR = 256, ZC_MQ = 768, ZC_FK = 1024, ZC_FV = 1280, ZC_MK = 1536, ZC_MV = 1792, ZC_RK = 2048, ZC_RV = 2560, ZC_LO = 3072, ZC_FF = 3360, ZC_VALID = 3368;
constexpr float NORM_EPS = 1e-6f, GN_EPS = 64e-5f, LOG2E = 1.4426950408889634f;
constexpr float C2_64 = 0.125f * LOG2E, C2_128 = 0.08838834764831845f * LOG2E;
constexpr size_t MiB = 1u << 20;
constexpr size_t WS_CTL = 0;
constexpr size_t WS_W = 1 * MiB, WL_BYTES = 48 * MiB;
constexpr size_t OFF_F1I = 0, OFF_F1O = 11 * MiB, OFF_F2I = 17 * MiB, OFF_F2O = 28 * MiB, OFF_MI = 34 * MiB, OFF_MO = 41 * MiB, OFF_XQ = 43 * MiB, OFF_XKV = 44 * MiB, OFF_XO = 46 * MiB;
constexpr size_t OFF_W2T = 47 * MiB, OFF_A2T = OFF_W2T + 65536, OFF_G2T = OFF_A2T + 65536;
constexpr size_t WS_Z = 97 * MiB;
constexpr size_t WS_C = WS_Z + 212 * MiB;
constexpr size_t WS_HN = WS_C;
constexpr size_t WS_WD = WS_C, WS_KK = WS_C + 64 * MiB, WS_KA = WS_C + 96 * MiB;
constexpr size_t WS_VTF = WS_C + 128 * MiB, WS_VTM = WS_C + 144 * MiB;
constexpr size_t WS_LOGF = WS_C + 160 * MiB, WS_KMP = WS_LOGF + 512 * 1024, WS_ZHALO = WS_C + 161 * MiB;
constexpr size_t WS_KVX = WS_C + 165 * MiB, WS_VTX = WS_C + 173 * MiB, WS_MEMN = WS_C + 177 * MiB, WS_END = WS_C + 185 * MiB;
static_assert(WS_END <= 512 * MiB, "workspace map");
constexpr int LDS_BYTES = 131072 + 1024;

struct Args { const float* in[35]; float* out; unsigned char* ws; int ph_lo, ph_hi; };

DEV float bf2f(unsigned short b) { return __uint_as_float((unsigned)b << 16); }
typedef float f32x2_t __attribute__((ext_vector_type(2))); typedef __bf16 bf16x2_t __attribute__((ext_vector_type(2)));
DEV unsigned pk2(float lo, float hi) { const f32x2_t v = {lo, hi}; const bf16x2_t r = __builtin_convertvector(v, bf16x2_t); return __builtin_bit_cast(unsigned, r); }
DEV unsigned f2bf(float f) { return pk2(f, f) & 0xffffu; }
DEV float wave_sum(float v) {
#pragma unroll
    for (int o = 1; o < 64; o <<= 1) v += __shfl_xor(v, o);
    return v;
}
#define LDS_WAIT() asm volatile("s_waitcnt lgkmcnt(0)" ::: "memory")

struct MatInfo { const float* src; bf16_t* dst; int K, Ns, Nd, map; };
DEV MatInfo matinfo(const Args& a, int m) {
    const int l = m / 12, k = m % 12; unsigned char* wl = a.ws + WS_W + (size_t)l * WL_BYTES; MatInfo r;
    switch (k) {
    case 0:  r.src = a.in[4] + (size_t)l * DM * 2 * FF;  r.dst = (bf16_t*)(wl + OFF_F1I); r.K = DM; r.Ns = 2 * FF; r.Nd = 2 * FF; r.map = 1; break;
    case 1:  r.src = a.in[5] + (size_t)l * FF * DM;      r.dst = (bf16_t*)(wl + OFF_F1O); r.K = FF; r.Ns = DM; r.Nd = DM; r.map = 0; break;
    case 2:  r.src = a.in[33] + (size_t)l * DM * 2 * FF; r.dst = (bf16_t*)(wl + OFF_F2I); r.K = DM; r.Ns = 2 * FF; r.Nd = 2 * FF; r.map = 1; break;
    case 3:  r.src = a.in[34] + (size_t)l * FF * DM;     r.dst = (bf16_t*)(wl + OFF_F2O); r.K = FF; r.Ns = DM; r.Nd = DM; r.map = 0; break;
    case 4:  r.src = a.in[7] + (size_t)l * DM * 3364;    r.dst = (bf16_t*)(wl + OFF_MI);  r.K = DM; r.Ns = 3364; r.Nd = 3584; r.map = 2; break;
    case 5:  r.src = a.in[8] + (size_t)l * DM * DM;      r.dst = (bf16_t*)(wl + OFF_MO);  r.K = DM; r.Ns = DM; r.Nd = DM; r.map = 0; break;
    case 6:  r.src = a.in[27] + (size_t)l * DM * 512;    r.dst = (bf16_t*)(wl + OFF_XQ);  r.K = DM; r.Ns = 512; r.Nd = 512; r.map = 0; break;
    case 7:  r.src = a.in[28] + (size_t)l * DM * 1024;   r.dst = (bf16_t*)(wl + OFF_XKV); r.K = DM; r.Ns = 1024; r.Nd = 1024; r.map = 0; break;
    case 8:  r.src = a.in[31] + (size_t)l * 512 * DM;    r.dst = (bf16_t*)(wl + OFF_XO);  r.K = 512; r.Ns = DM; r.Nd = DM; r.map = 0; break;
    case 9:  r.src = a.in[16] + (size_t)l * 64 * 512;    r.dst = (bf16_t*)(wl + OFF_W2T); r.K = 64; r.Ns = 512; r.Nd = 512; r.map = 0; break;
    case 10: r.src = a.in[18] + (size_t)l * 64 * 512;    r.dst = (bf16_t*)(wl + OFF_A2T); r.K = 64; r.Ns = 512; r.Nd = 512; r.map = 0; break;
    default: r.src = a.in[19] + (size_t)l * 160 * 512;   r.dst = (bf16_t*)(wl + OFF_G2T); r.K = 160; r.Ns = 512; r.Nd = 512; r.map = 0; break;
    }
    return r;
}
DEV int srccol(int map, int n) {
    if (map == 0) return n;
    if (map == 1) { const int p = n >> 8, r = n & 255; return r < 128 ? p * 128 + r : FF + p * 128 + (r - 128); }
    if (n < 256) return n;
    if (n < 768) return 1540 + (n - 256);
    if (n < 1024) return 772 + (n - 768);
    if (n < 1280) return 256 + (n - 1024);
    if (n < 1536) return 512 + (n - 1280);
    if (n < 1792) return 1028 + (n - 1536);
    if (n < 2048) return 1284 + (n - 1792);
    if (n < 2560) return 2052 + (n - 2048);
    if (n < 3072) return 2564 + (n - 2560);
    if (n < 3360) return 3076 + (n - 3072);
    if (n < 3364) return 768 + (n - 3360);
    return -1;
}
DEV void transpose_item(const MatInfo& mi, LAS float* scr, int item, int lane) {
    const int nblk = mi.Nd / 32, kb = item / nblk, nb = item % nblk, k0 = 64 * kb, n0 = 32 * nb;
    const int n4 = (lane & 7) * 4, sc = srccol(mi.map, n0 + n4);
#pragma unroll
    for (int i = 0; i < 8; ++i) { const int kk = 8 * i + (lane >> 3), k = k0 + kk;
        const f32x4 v = (sc >= 0 && k < mi.K) ? *(const f32x4*)(mi.src + (size_t)k * mi.Ns + sc) : (f32x4){0.f, 0.f, 0.f, 0.f};
        LAS float* d = scr + kk * 33 + n4; d[0] = v[0]; d[1] = v[1]; d[2] = v[2]; d[3] = v[3]; }
    LDS_WAIT(); asm volatile("" ::: "memory");
    const int c = lane & 7;
#pragma unroll
    for (int j = 0; j < 4; ++j) { const int n = (lane >> 3) + 8 * j; const LAS float* s = scr + (8 * c) * 33 + n;
        u32x4 o; o.x = pk2(s[0 * 33], s[1 * 33]); o.y = pk2(s[2 * 33], s[3 * 33]); o.z = pk2(s[4 * 33], s[5 * 33]); o.w = pk2(s[6 * 33], s[7 * 33]);
        if (k0 + 8 * c < mi.K) *(u32x4*)(mi.dst + (size_t)(n0 + n) * mi.K + k0 + 8 * c) = o; }
    LDS_WAIT(); asm volatile("" ::: "memory");
}
DEV void norm_row(const float* xrow, const float* g, bf16_t* orow, int lane) {
    const f32x4* xr = (const f32x4*)xrow + lane; const f32x4* gr = (const f32x4*)g + lane;
    f32x4 v[4]; float s = 0.f;
#pragma unroll
    for (int j = 0; j < 4; ++j) { v[j] = xr[64 * j]; s += (v[j].x * v[j].x + v[j].y * v[j].y) + (v[j].z * v[j].z + v[j].w * v[j].w); }
    const float rstd = rsqrtf(wave_sum(s) * (1.f / DM) + NORM_EPS);
    u32x2* o8 = (u32x2*)orow + lane;
#pragma unroll
    for (int j = 0; j < 4; ++j) { const f32x4 gg = gr[64 * j]; u32x2 w; w.x = pk2(v[j].x * rstd * gg.x, v[j].y * rstd * gg.y); w.y = pk2(v[j].z * rstd * gg.z, v[j].w * rstd * gg.w); o8[64 * j] = w; }
}
DEV void norm_row2(const float* xa, const float* xb, const float* g, bf16_t* oa, bf16_t* ob, int lane) {
    const f32x4* xra = (const f32x4*)xa + lane; const f32x4* xrb = (const f32x4*)xb + lane; const f32x4* gr = (const f32x4*)g + lane;
    f32x4 va[4], vb[4]; float sa = 0.f, sb = 0.f;
#pragma unroll
    for (int j = 0; j < 4; ++j) { va[j] = xra[64 * j]; vb[j] = xrb[64 * j]; }
#pragma unroll
    for (int j = 0; j < 4; ++j) { sa += (va[j].x * va[j].x + va[j].y * va[j].y) + (va[j].z * va[j].z + va[j].w * va[j].w); sb += (vb[j].x * vb[j].x + vb[j].y * vb[j].y) + (vb[j].z * vb[j].z + vb[j].w * vb[j].w); }
#pragma unroll
    for (int o = 1; o < 64; o <<= 1) { sa += __shfl_xor(sa, o); sb += __shfl_xor(sb, o); }
    const float ra = rsqrtf(sa * (1.f / DM) + NORM_EPS), rb = rsqrtf(sb * (1.f / DM) + NORM_EPS);
    u32x2* o8a = (u32x2*)oa + lane; u32x2* o8b = (u32x2*)ob + lane;
#pragma unroll
    for (int j = 0; j < 4; ++j) { const f32x4 gg = gr[64 * j]; u32x2 w; w.x = pk2(va[j].x * ra * gg.x, va[j].y * ra * gg.y); w.y = pk2(va[j].z * ra * gg.z, va[j].w * ra * gg.w); o8a[64 * j] = w;
        w.x = pk2(vb[j].x * rb * gg.x, vb[j].y * rb * gg.y); w.y = pk2(vb[j].z * rb * gg.z, vb[j].w * rb * gg.w); o8b[64 * j] = w; }
}
DEV void norm_phase(const float* x, const float* g, bf16_t* out, int nrows, int gw, int NGW, int lane) {
    int m = gw;
    for (; m + NGW < nrows; m += 2 * NGW) norm_row2(x + (size_t)m * DM, x + (size_t)(m + NGW) * DM, g, out + (size_t)m * DM, out + (size_t)(m + NGW) * DM, lane);
    if (m < nrows) norm_row(x + (size_t)m * DM, g, out + (size_t)m * DM, lane);
}
DEV void p0_prologue(const Args& a, LAS unsigned char* lds, int gw, int NGW, int wid, int lane, int tid) {
    LAS float* scr = (LAS float*)(lds + wid * 8704);
    int base = 0;
    for (int m = 0; m < 24; ++m) {
        const MatInfo mi = matinfo(a, m); const int items = ((mi.K + 63) / 64) * (mi.Nd / 32);
        int first = gw - (base % NGW); if (first < 0) first += NGW;
        for (int it = first; it < items; it += NGW) transpose_item(mi, scr, it, lane);
        base += items;
    }
    for (int m = gw; m < NL * NB * MEMLEN; m += NGW) { const int l = m / (NB * MEMLEN), r = m % (NB * MEMLEN);
        norm_row(a.in[1] + (size_t)r * DM, a.in[26] + l * DM, (bf16_t*)(a.ws + WS_MEMN) + (size_t)m * DM, lane); }
    if (blockIdx.x == 0 && tid < 64) ((unsigned*)(a.ws + WS_CTL))[tid * 64] = 0u;
}
DEV void xkv_post(const Args& a, int gw, int NGW, int lane) {
    for (int it = gw; it < NL * NB * MEMLEN * 4; it += NGW) {
        const int hd = it & 3, row = (it >> 2) % (NB * MEMLEN), l = it / (4 * NB * MEMLEN), b = row / MEMLEN, m = row % MEMLEN;
        bf16_t* kr = (bf16_t*)(a.ws + WS_KVX) + ((size_t)l * NB * MEMLEN + row) * 1024 + hd * 128;
        const unsigned kv = *((const unsigned*)kr + lane); float k0 = bf2f(kv & 0xffff), k1 = bf2f(kv >> 16);
        const float rstd = rsqrtf(wave_sum(k0 * k0 + k1 * k1) * (1.f / 128) + NORM_EPS);
        const float* kg = a.in[30] + l * 128;
        *((unsigned*)kr + lane) = pk2(k0 * rstd * kg[2 * lane], k1 * rstd * kg[2 * lane + 1]);
        const unsigned vv = *((const unsigned*)(kr + 512) + lane);
        bf16_t* vt = (bf16_t*)(a.ws + WS_VTX) + (((size_t)(l * NB + b) * 4 + hd) * 128) * MEMLEN + m;
        vt[(size_t)(2 * lane) * MEMLEN] = (bf16_t)(vv & 0xffff); vt[(size_t)(2 * lane + 1) * MEMLEN] = (bf16_t)(vv >> 16);
    }
}

DEV float sigmoid_f(float x) { return __builtin_amdgcn_rcpf(1.0f + __builtin_amdgcn_exp2f(-LOG2E * x)); }
DEV float tanh_f(float x) { const float e = __builtin_amdgcn_exp2f(-2.f * LOG2E * fabsf(x)); const float t = (1.f - e) * __builtin_amdgcn_rcpf(1.f + e); return x < 0.f ? -t : t; }
DEV void unpack8(const u32x4 v, float (&f)[8]) {
    f[0] = __uint_as_float(v.x << 16); f[1] = __uint_as_float(v.x & 0xffff0000u); f[2] = __uint_as_float(v.y << 16); f[3] = __uint_as_float(v.y & 0xffff0000u);
    f[4] = __uint_as_float(v.z << 16); f[5] = __uint_as_float(v.z & 0xffff0000u); f[6] = __uint_as_float(v.w << 16); f[7] = __uint_as_float(v.w & 0xffff0000u);
}
DEV u32x4 pack8(const float (&f)[8]) { u32x4 o; o.x = pk2(f[0], f[1]); o.y = pk2(f[2], f[3]); o.z = pk2(f[4], f[5]); o.w = pk2(f[6], f[7]); return o; }
DEV int crow(int r, int hi) { return (r & 3) + 8 * (r >> 2) + 4 * hi; }

DEV void prep_tile(const Args& a, int l, int tile, LAS unsigned char* lds, bool dry = false) {
    int tid_ = threadIdx.x; asm volatile("" : "+v"(tid_)); const int tid = tid_, lane = tid & 63, wid = __builtin_amdgcn_readfirstlane(tid >> 6);
    const int row0 = tile * 64, b = row0 / SEQ, t0 = row0 % SEQ;
    bf16_t* Z = (bf16_t*)(a.ws + WS_Z) + (size_t)row0 * ZP;
    {
        const int ch = tid % 228, sub = tid / 228; const bool act = tid < 456;
        const int col = ch < 64 ? ZC_RR + 8 * ch : ZC_RK + 8 * (ch - 64), mi = ch < 64 ? 8 * ch : 512 + 8 * (ch - 64);
        const int ts = 32 * sub; float prev[8], mu[8];
#pragma unroll
        for (int i = 0; i < 8; ++i) { prev[i] = 0.f; mu[i] = 0.f; }
        if (act) {
            const float* mup = a.in[14] + l * 1824 + mi;
#pragma unroll
            for (int i = 0; i < 8; ++i) mu[i] = mup[i];
            if (sub == 1) unpack8(*(const u32x4*)(Z + (size_t)(ts - 1) * ZP + col), prev);
            else if (t0 != 0) unpack8(*(const u32x4*)((const bf16_t*)(a.ws + WS_ZHALO) + (size_t)(tile - 1) * ZP + col), prev);
        }
        __syncthreads();
        if (act) {
#pragma unroll 1
            for (int t8 = 0; t8 < 32; t8 += 8) { u32x4 raw[8];
#pragma unroll
                for (int tt = 0; tt < 8; ++tt) raw[tt] = *(const u32x4*)(Z + (size_t)(ts + t8 + tt) * ZP + col);
#pragma unroll
                for (int tt = 0; tt < 8; ++tt) { float cur[8], o[8]; unpack8(raw[tt], cur);
#pragma unroll
                    for (int i = 0; i < 8; ++i) { o[i] = cur[i] + (prev[i] - cur[i]) * mu[i]; prev[i] = cur[i]; }
                    if (!dry) *(u32x4*)(Z + (size_t)(ts + t8 + tt) * ZP + col) = pack8(o); } }
        }
    }
    LAS float* kbuf = (LAS float*)lds;
    {
        const float* gfq = a.in[10] + l * 64; const float* gfk = a.in[11] + l * 64; const float* gmq = a.in[12] + l * 64; const float* gmk = a.in[13] + l * 64;
        const int* pos = (const int*)a.in[2] + b * SEQ + t0;
#pragma unroll 2
        for (int it = 0; it < 16; ++it) {
            const int item = it * 512 + tid, g8 = item >> 3, sub8 = item & 7, slot = g8 >> 6, token = g8 & 63, h = slot & 3, kind = slot >> 2;
            const int cb = (kind == 0 ? ZC_FQ : kind == 1 ? ZC_FK : kind == 2 ? ZC_MQ : ZC_MK) + 64 * h + 8 * sub8;
            const float* gp = (kind == 0 ? gfq : kind == 1 ? gfk : kind == 2 ? gmq : gmk) + 8 * sub8;
            u32x4* p = (u32x4*)(Z + (size_t)token * ZP + cb); float v[8]; unpack8(*p, v);
            float ss = 0.f;
#pragma unroll
            for (int i = 0; i < 8; ++i) ss += v[i] * v[i];
            ss += __shfl_xor(ss, 1); ss += __shfl_xor(ss, 2); ss += __shfl_xor(ss, 4);
            const float rstd = rsqrtf(ss * (1.f / 64) + NORM_EPS);
#pragma unroll
            for (int i = 0; i < 8; ++i) v[i] = v[i] * rstd * gp[i];
            float pr[8];
#pragma unroll
            for (int i = 0; i < 8; ++i) pr[i] = __shfl_xor(v[i], 1);
            if (kind >= 2 && sub8 < 2) {
                const float posf = (float)pos[token];
#pragma unroll
                for (int i = 0; i < 8; ++i) {
                    const float invf = (float)__builtin_exp2(-(double)i * 0.125 * 18.931568569324174);
                    const float ang = posf * invf; const double rev = (double)ang * 0.15915494309189535; const float fr = (float)(rev - __builtin_floor(rev));
                    const float sn = __builtin_amdgcn_sinf(fr), cs = __builtin_amdgcn_cosf(fr);
                    v[i] = sub8 == 0 ? v[i] * cs - pr[i] * sn : v[i] * cs + pr[i] * sn; }
            }
            if (kind == 3) {
#pragma unroll
                for (int i = 0; i < 8; ++i) kbuf[(token * 4 + h) * 64 + 8 * sub8 + i] = v[i]; }
            if (kind == 0 || kind == 2) {
#pragma unroll
                for (int i = 0; i < 8; ++i) v[i] *= C2_64; }
            if (!dry) *p = pack8(v);
        }
    }
    __syncthreads();
    if (tid < 256) { const int h = tid >> 6, d = tid & 63; float s = 0.f;
        for (int t = 0; t < 64; ++t) s += kbuf[(t * 4 + h) * 64 + d];
        if (!dry) ((float*)(a.ws + WS_KMP))[(((size_t)(b * 4 + h) * 64) + (t0 >> 6)) * 64 + d] = s; }
#pragma unroll 2
    for (int it = 0; it < 8; ++it) {
        const int item = it * 512 + tid, which = item >> 11, rem = item & 2047, tg = rem >> 8, c = rem & 255;
        const bf16_t* src = Z + (size_t)(8 * tg) * ZP + (which ? ZC_MV : ZC_FV) + c; unsigned short e[8];
#pragma unroll
        for (int i = 0; i < 8; ++i) e[i] = src[(size_t)i * ZP];
        u32x4 o; o.x = e[0] | ((unsigned)e[1] << 16); o.y = e[2] | ((unsigned)e[3] << 16); o.z = e[4] | ((unsigned)e[5] << 16); o.w = e[6] | ((unsigned)e[7] << 16);
        bf16_t* vt = (bf16_t*)(a.ws + (which ? WS_VTM : WS_VTF)) + ((size_t)(b * 4 + (c >> 6)) * 64 + (c & 63)) * SEQ + t0 + 8 * tg;
        if (!dry) *(u32x4*)vt = o;
    }
    if (tid < 256) { const int token = tid >> 2, h = tid & 3; const float x = bf2f(Z[(size_t)token * ZP + ZC_FF + h]) + a.in[9][l * 4 + h];
        const float lf = fminf(x, 0.f) - __logf(1.f + __expf(-fabsf(x)));
        if (!dry) ((float*)(a.ws + WS_LOGF))[(size_t)(b * 4 + h) * SEQ + t0 + token] = lf; }
    __syncthreads();
    LAS bf16_t* al = (LAS bf16_t*)lds;
    for (int item = tid; item < 64 * 36; item += 512) { const int token = item / 36, c = item % 36; float v[8]; unpack8(*(const u32x4*)(Z + (size_t)token * ZP + ZC_LO + 8 * c), v);
        if (c < 8) {
#pragma unroll
            for (int i = 0; i < 8; ++i) v[i] = tanh_f(v[i]); }
        else if (c >= 16) {
#pragma unroll
            for (int i = 0; i < 8; ++i) v[i] = sigmoid_f(v[i]); }
        *(LAS u32x4*)(al + token * 296 + 8 * c) = pack8(v); }
    __syncthreads();
    const unsigned char* wl = a.ws + WS_W + (size_t)l * WL_BYTES;
    const bf16_t* w2t = (const bf16_t*)(wl + OFF_W2T); const bf16_t* a2t = (const bf16_t*)(wl + OFF_A2T); const bf16_t* g2t = (const bf16_t*)(wl + OFF_G2T);
    const int r32 = lane & 31, hi = lane >> 5;
    for (int uu = 0; uu < 2; ++uu) {
        const int u = wid + 8 * uu, h = u & 7, th = u >> 3, token = 32 * th + r32;
        f32x16 aw[2], aa[2], ag[2];
#pragma unroll
        for (int ct = 0; ct < 2; ++ct) { aw[ct] = f32x16{}; aa[ct] = f32x16{}; ag[ct] = f32x16{}; }
        const LAS bf16_t* arow = al + token * 296 + 8 * hi;
#pragma unroll 1
        for (int ks = 0; ks < 4; ++ks) { const bf16x8 bw = *(const LAS bf16x8*)(arow + 16 * ks), ba = *(const LAS bf16x8*)(arow + 64 + 16 * ks);
#pragma unroll
            for (int ct = 0; ct < 2; ++ct) { const int chn = 64 * h + 32 * ct + r32;
                aw[ct] = __builtin_amdgcn_mfma_f32_32x32x16_bf16(*(const bf16x8*)(w2t + chn * 64 + 16 * ks + 8 * hi), bw, aw[ct], 0, 0, 0);
                aa[ct] = __builtin_amdgcn_mfma_f32_32x32x16_bf16(*(const bf16x8*)(a2t + chn * 64 + 16 * ks + 8 * hi), ba, aa[ct], 0, 0, 0); } }
#pragma unroll 1
        for (int ks = 0; ks < 10; ++ks) { const bf16x8 bg = *(const LAS bf16x8*)(arow + 128 + 16 * ks);
#pragma unroll
            for (int ct = 0; ct < 2; ++ct) { const int chn = 64 * h + 32 * ct + r32;
                ag[ct] = __builtin_amdgcn_mfma_f32_32x32x16_bf16(*(const bf16x8*)(g2t + chn * 160 + 16 * ks + 8 * hi), bg, ag[ct], 0, 0, 0); } }
        bf16_t* zr = Z + (size_t)token * ZP; const size_t grow = (size_t)(row0 + token);
        float* wd = (float*)(a.ws + WS_WD) + grow * 512; bf16_t* kkp = (bf16_t*)(a.ws + WS_KK) + grow * 512; bf16_t* kap = (bf16_t*)(a.ws + WS_KA) + grow * 512;
        const float* w0 = a.in[15] + l * 512; const float* a0 = a.in[17] + l * 512; const float* k_k = a.in[20] + l * 512; const float* k_a = a.in[21] + l * 512;
        float ss = 0.f;
#pragma unroll
        for (int ct = 0; ct < 2; ++ct)
#pragma unroll
            for (int rg = 0; rg < 4; ++rg) { const int c0 = 64 * h + 32 * ct + 8 * rg + 4 * hi;
                const u32x2 kraw = *(const u32x2*)(zr + ZC_RK + c0); const f32x4 w04 = *(const f32x4*)(w0 + c0), a04 = *(const f32x4*)(a0 + c0), kk4 = *(const f32x4*)(k_k + c0);
                f32x4 dec; u32x2 gp; float gv[4];
#pragma unroll
                for (int i = 0; i < 4; ++i) { const int r = 4 * rg + i;
                    const float kv = (i < 2) ? __uint_as_float((i & 1) ? (kraw.x & 0xffff0000u) : (kraw.x << 16)) : __uint_as_float((i & 1) ? (kraw.y & 0xffff0000u) : (kraw.y << 16));
                    const float wr_ = w04[i] + aw[ct][r]; const float sp = fmaxf(-wr_, 0.f) + __logf(1.f + __expf(-fabsf(wr_)));
                    dec[i] = __expf(-__expf(-sp - 0.5f));
                    aa[ct][r] = sigmoid_f(a04[i] + aa[ct][r]);
                    gv[i] = ag[ct][r];
                    const float kkv = kv * kk4[i]; aw[ct][r] = kkv; ss += kkv * kkv; }
                if (!dry) *(f32x4*)(wd + c0) = dec;
                gp.x = pk2(gv[0], gv[1]); gp.y = pk2(gv[2], gv[3]);
                if (!dry) *(u32x2*)(zr + (c0 < 256 ? ZC_FV + c0 : ZC_MV + (c0 - 256))) = gp; __builtin_amdgcn_sched_barrier(0); }
        ss += __shfl_xor(ss, 32);
        const float inv = 1.f / fmaxf(sqrtf(ss), 1e-12f);
#pragma unroll
        for (int ct = 0; ct < 2; ++ct)
#pragma unroll
            for (int rg = 0; rg < 4; ++rg) { const int c0 = 64 * h + 32 * ct + 8 * rg + 4 * hi; const f32x4 ka4 = *(const f32x4*)(k_a + c0);
                const u32x2 kraw = *(const u32x2*)(zr + ZC_RK + c0); const float kf4[4] = {bf2f(kraw.x & 0xffff), __uint_as_float(kraw.x & 0xffff0000u), bf2f(kraw.y & 0xffff), __uint_as_float(kraw.y & 0xffff0000u)};
                float kk[4], ka[4], kp[4];
#pragma unroll
                for (int i = 0; i < 4; ++i) { const int r = 4 * rg + i; kk[i] = aw[ct][r] * inv; ka[i] = kk[i] * aa[ct][r]; kp[i] = kf4[i] * (1.f + (aa[ct][r] - 1.f) * ka4[i]); }
                u32x2 o; o.x = pk2(kk[0], kk[1]); o.y = pk2(kk[2], kk[3]); if (!dry) *(u32x2*)(kkp + c0) = o;
                o.x = pk2(ka[0], ka[1]); o.y = pk2(ka[2], ka[3]); if (!dry) *(u32x2*)(kap + c0) = o;
                o.x = pk2(kp[0], kp[1]); o.y = pk2(kp[2], kp[3]); if (!dry) *(u32x2*)(zr + ZC_RK + c0) = o; __builtin_amdgcn_sched_barrier(0); }
    }
    __syncthreads();
}

template <int MODE, int D>
DEV void attn_unit(LAS unsigned char* lds, const bf16_t* Qp, int ldq, const bf16_t* Kp, int ldk, const bf16_t* Vt, int ldv, bf16_t* Op, int ldo,
                   int q0, int ntiles, int qb, const float* aux, const float* qgain, bool dry = false) {
    constexpr int KP = D + 8, KBYTES = 64 * KP * 2, VP = 72, VBYTES = D * VP * 2, NLD = D / 64;
    int tid_ = threadIdx.x; asm volatile("" : "+v"(tid_)); const int tid = tid_, lane = tid & 63, wid = __builtin_amdgcn_readfirstlane(tid >> 6), r32 = lane & 31, hi = lane >> 5;
    LAS float* cl = (LAS float*)lds; LAS unsigned* selm = (LAS unsigned*)(lds + 8192);
    LAS unsigned char* kb = lds + 16384; LAS unsigned char* vb = kb + 2 * KBYTES;
    const int q = q0 + wid * 32 + r32;
    if (MODE == 0) {
        const int n = 64 * ntiles; float v[8]; float run = 0.f;
#pragma unroll
        for (int i = 0; i < 8; ++i) { const int idx = 8 * tid + i; v[i] = idx < n ? aux[idx] : 0.f; run += v[i]; v[i] = run; }
        float sc = run;
#pragma unroll
        for (int o = 1; o < 64; o <<= 1) { const float t = __shfl_up(sc, o); if (lane >= o) sc += t; }
        LAS float* wsum = (LAS float*)kb;
        if (lane == 63) wsum[wid] = sc;
        __syncthreads();
        float off = sc - run;
        for (int w = 0; w < wid; ++w) off += wsum[w];
#pragma unroll
        for (int i = 0; i < 8; ++i) cl[8 * tid + i] = (off + v[i]) * LOG2E;
    }
    if (MODE == 1) {
        LAS float* km = cl;
        for (int e = tid; e < 16 * 64; e += 512) { const int nblk = e >> 6, d = e & 63; const float* pp = aux + (size_t)(4 * nblk) * 64 + d;
            km[e] = ((pp[0] + pp[64]) + (pp[128] + pp[192])) * (1.f / 256); }
        __syncthreads();
        if (tid < 256) { const bf16_t* qr = Qp + (size_t)(q0 + tid) * ldq; float g[16];
#pragma unroll
            for (int nb = 0; nb < 16; ++nb) g[nb] = 0.f;
            for (int c = 0; c < 8; ++c) { float qv[8]; unpack8(*(const u32x4*)(qr + 8 * c), qv);
#pragma unroll
                for (int nb = 0; nb < 16; ++nb) {
#pragma unroll
                    for (int i = 0; i < 8; ++i) g[nb] += qv[i] * km[nb * 64 + 8 * c + i]; } }
            unsigned m = 0u;
#pragma unroll
            for (int pick = 0; pick < 3; ++pick) { float best = -INFINITY; int bi = -1;
#pragma unroll
                for (int nb = 0; nb < 16; ++nb) { if (nb < qb && !((m >> nb) & 1u) && g[nb] > best) { best = g[nb]; bi = nb; } }
                if (bi >= 0) m |= 1u << bi; }
            selm[tid] = m; }
    }
    bf16x8 qf[D / 16];
#pragma unroll
    for (int d0 = 0; d0 < D / 16; ++d0) qf[d0] = *(const bf16x8*)(Qp + (size_t)q * ldq + d0 * 16 + hi * 8);
    if (MODE == 2) {
        float ss = 0.f;
#pragma unroll
        for (int d0 = 0; d0 < D / 16; ++d0) { float qv[8]; unpack8(__builtin_bit_cast(u32x4, qf[d0]), qv);
#pragma unroll
            for (int i = 0; i < 8; ++i) ss += qv[i] * qv[i]; }
        ss += __shfl_xor(ss, 32);
        const float rstd = rsqrtf(ss * (1.f / D) + NORM_EPS) * C2_128;
#pragma unroll
        for (int d0 = 0; d0 < D / 16; ++d0) { float qv[8]; unpack8(__builtin_bit_cast(u32x4, qf[d0]), qv);
#pragma unroll
            for (int i = 0; i < 8; ++i) qv[i] = qv[i] * rstd * qgain[d0 * 16 + hi * 8 + i];
            qf[d0] = __builtin_bit_cast(bf16x8, pack8(qv)); __builtin_amdgcn_sched_barrier(0); }
    }
    float mrun = -INFINITY, lrun = 0.f; f32x16 o[D / 32];
#pragma unroll
    for (int dt = 0; dt < D / 32; ++dt) o[dt] = f32x16{};
    __syncthreads();
    const float cq = (MODE == 0) ? cl[q] : 0.f;
    const unsigned sel = (MODE == 1) ? selm[wid * 32 + r32] : 0u;
    u32x4 kreg[NLD], vreg[NLD];
#define ATT_LOAD(t) do { _Pragma("unroll") for (int i_ = 0; i_ < NLD; ++i_) { const int idx_ = tid + 512 * i_; \
        kreg[i_] = *(const u32x4*)(Kp + (size_t)(64 * (t) + idx_ / (D / 8)) * ldk + (idx_ % (D / 8)) * 8); \
        vreg[i_] = *(const u32x4*)(Vt + (size_t)(idx_ >> 3) * ldv + 64 * (t) + (idx_ & 7) * 8); } } while (0)
#define ATT_STORE(buf) do { _Pragma("unroll") for (int i_ = 0; i_ < NLD; ++i_) { const int idx_ = tid + 512 * i_; \
        *(LAS u32x4*)(kb + (buf) * KBYTES + ((idx_ / (D / 8)) * KP + (idx_ % (D / 8)) * 8) * 2) = kreg[i_]; \
        *(LAS u32x4*)(vb + (buf) * VBYTES + ((idx_ >> 3) * VP + (idx_ & 7) * 8) * 2) = vreg[i_]; } } while (0)
    ATT_LOAD(0); ATT_STORE(0);
    __syncthreads();
    for (int t = 0; t < ntiles; ++t) {
        const int buf = t & 1, key0 = 64 * t;
        if (t + 1 < ntiles) ATT_LOAD(t + 1);
        bool work = true; const int nblk = key0 >> 8;
        if (MODE == 0) work = key0 <= q0 + wid * 32 + 31;
        if (MODE == 1) work = (nblk == qb) ? (key0 <= q0 + wid * 32 + 31) : (__any((sel >> nblk) & 1u) != 0);
        if (work) {
            const LAS unsigned char* kt = kb + buf * KBYTES; const LAS unsigned char* vt = vb + buf * VBYTES;
            constexpr int NKH = (D == 64) ? 2 : 1;
#pragma unroll 1
            for (int ks = 0; ks < 2 / NKH; ++ks) {
            f32x16 p[NKH];
#pragma unroll
            for (int kh = 0; kh < NKH; ++kh) { p[kh] = f32x16{}; const int khh = ks * NKH + kh;
#pragma unroll
                for (int d0 = 0; d0 < D / 16; ++d0) { const bf16x8 kf = *(const LAS bf16x8*)(kt + ((32 * khh + r32) * KP + 16 * d0 + 8 * hi) * 2);
                    p[kh] = __builtin_amdgcn_mfma_f32_32x32x16_bf16(kf, qf[d0], p[kh], 0, 0, 0); } }
            if (MODE == 0) {
#pragma unroll
                for (int kh = 0; kh < NKH; ++kh)
#pragma unroll
                    for (int rg = 0; rg < 4; ++rg) { const int kk0 = key0 + 32 * (ks * NKH + kh) + 8 * rg + 4 * hi; const f32x4 ck = *(const LAS f32x4*)(cl + kk0);
#pragma unroll
                        for (int i = 0; i < 4; ++i) { const float s = p[kh][4 * rg + i] + (cq - ck[i]); p[kh][4 * rg + i] = (kk0 + i > q) ? -INFINITY : s; } }
            }
            if (MODE == 1) {
                if (nblk == qb) {
#pragma unroll
                    for (int kh = 0; kh < NKH; ++kh)
#pragma unroll
                        for (int r = 0; r < 16; ++r) { if (key0 + 32 * (ks * NKH + kh) + crow(r, hi) > q) p[kh][r] = -INFINITY; }
                } else if (!((sel >> nblk) & 1u)) {
#pragma unroll
                    for (int kh = 0; kh < NKH; ++kh)
#pragma unroll
                        for (int r = 0; r < 16; ++r) p[kh][r] = -INFINITY;
                }
            }
            float mx = p[0][0];
#pragma unroll
            for (int kh = 0; kh < NKH; ++kh)
#pragma unroll
                for (int r = 0; r < 16; ++r) mx = fmaxf(mx, p[kh][r]);
            mx = fmaxf(mx, __shfl_xor(mx, 32));
            const float mnew = fmaxf(mrun, mx), muse = (mnew == -INFINITY) ? 0.f : mnew;
            const float alpha = __builtin_amdgcn_exp2f(mrun - muse);
            mrun = mnew; lrun *= alpha;
            if (__any(alpha != 1.0f)) {
#pragma unroll
                for (int dt = 0; dt < D / 32; ++dt) o[dt] *= alpha; }
            float ps = 0.f;
#pragma unroll
            for (int kh = 0; kh < NKH; ++kh)
#pragma unroll
                for (int r = 0; r < 16; ++r) { p[kh][r] = __builtin_amdgcn_exp2f(p[kh][r] - muse); ps += p[kh][r]; }
            lrun += ps;
            bf16x8 pb[NKH][2];
#pragma unroll
            for (int kh = 0; kh < NKH; ++kh)
#pragma unroll
                for (int j = 0; j < 2; ++j) { u32x4 w; w.x = pk2(p[kh][8 * j + 0], p[kh][8 * j + 1]); w.y = pk2(p[kh][8 * j + 2], p[kh][8 * j + 3]); w.z = pk2(p[kh][8 * j + 4], p[kh][8 * j + 5]); w.w = pk2(p[kh][8 * j + 6], p[kh][8 * j + 7]);
                    pb[kh][j] = __builtin_bit_cast(bf16x8, w); }
#pragma unroll
            for (int dt = 0; dt < D / 32; ++dt)
#pragma unroll
                for (int kh = 0; kh < NKH; ++kh)
#pragma unroll
                    for (int j = 0; j < 2; ++j) { const LAS unsigned char* vp_ = vt + ((32 * dt + r32) * VP + 32 * (ks * NKH + kh) + 16 * j + 4 * hi) * 2;
                        const u32x2 lo = *(const LAS u32x2*)vp_, hh = *(const LAS u32x2*)(vp_ + 16); u32x4 w; w.x = lo.x; w.y = lo.y; w.z = hh.x; w.w = hh.y;
                        o[dt] = __builtin_amdgcn_mfma_f32_32x32x16_bf16(__builtin_bit_cast(bf16x8, w), pb[kh][j], o[dt], 0, 0, 0); }
            }
        }
        if (t + 1 < ntiles) ATT_STORE(buf ^ 1);
        __syncthreads();
    }
#undef ATT_LOAD
#undef ATT_STORE
    lrun += __shfl_xor(lrun, 32);
    const float inv = 1.f / lrun;
    bf16_t* orow = Op + (size_t)q * ldo;
    if (!dry)
#pragma unroll
    for (int dt = 0; dt < D / 32; ++dt)
#pragma unroll
        for (int rg = 0; rg < 4; ++rg) { u32x2 w; w.x = pk2(o[dt][4 * rg] * inv, o[dt][4 * rg + 1] * inv); w.y = pk2(o[dt][4 * rg + 2] * inv, o[dt][4 * rg + 3] * inv);
            *(u32x2*)(orow + 32 * dt + 8 * rg + 4 * hi) = w; }
    __syncthreads();
}

constexpr int RW_NCH = SEQ / 16;
constexpr int RW_ARP = 72, RW_BKTP = 32, RW_VTP = 24, RW_PMP = 24, RW_LP = 20;
constexpr int RW_NBUF = 4;
constexpr int RW_DB = 16640, RW_AR = 0, RW_BKT = 4608, RW_VT = 8704, RW_GC = 11776, RW_TM = 12032, RW_PM1 = 13568, RW_PM2 = 15104;
constexpr int RW_PRIV = RW_NBUF * RW_DB, RW_PRIV_BYTES = 5888, RW_PBK = 0, RW_PLAB = 4608;
constexpr int RW_YB = RW_PRIV + RW_NBUF * RW_PRIV_BYTES, RW_FLG = RW_YB + 2 * 4096, RW_SLOT_BYTES = RW_FLG + 64;
static_assert(RW_PM2 + 32 * RW_PMP * 2 == RW_DB && RW_TM + 32 * RW_PMP * 2 == RW_PM1 && RW_SLOT_BYTES <= 131072 && RW_DB % 16 == 0 && RW_PRIV_BYTES % 16 == 0, "rwkv lds map");
DEV bf16x8 pack_acc8(const f32x16& v, int base) { u32x4 w; w.x = pk2(v[base], v[base + 1]); w.y = pk2(v[base + 2], v[base + 3]); w.z = pk2(v[base + 4], v[base + 5]); w.w = pk2(v[base + 6], v[base + 7]); return __builtin_bit_cast(bf16x8, w); }
DEV int fresh_lane() { int l_; asm volatile("v_mbcnt_lo_u32_b32 %0, -1, 0\n\tv_mbcnt_hi_u32_b32 %0, -1, %0" : "=v"(l_)); return l_; }
DEV void rw_wait(volatile LAS unsigned* f, unsigned target) { while (*f < target) __builtin_amdgcn_s_sleep(1); asm volatile("" ::: "memory"); }
DEV void rw_post_flag(volatile LAS unsigned* f, unsigned v) { asm volatile("s_waitcnt vmcnt(0) lgkmcnt(0)" ::: "memory"); *f = v; }
DEV bf16x8 frag_perm(const LAS bf16_t* rowp, int hi) { const u32x2 lo = *(const LAS u32x2*)(rowp + 4 * hi), hh = *(const LAS u32x2*)(rowp + 8 + 4 * hi); u32x4 w; w.x = lo.x; w.y = lo.y; w.z = hh.x; w.w = hh.y; return __builtin_bit_cast(bf16x8, w); }

struct RwRaw { float w[16]; unsigned short kk[16], ka[16], kp[16], rr[16], vr[16]; };
DEV void rwkv_pre_load(RwRaw& R, int c, const float* WDp, const bf16_t* KKp, const bf16_t* KAp, const bf16_t* Zl) {
#pragma unroll
    for (int t = 0; t < 16; ++t) { const size_t ro = (size_t)(16 * c + t);
        R.w[t] = WDp[ro * 512]; R.kk[t] = KKp[ro * 512]; R.ka[t] = KAp[ro * 512]; R.kp[t] = Zl[ro * ZP + ZC_RK]; R.rr[t] = Zl[ro * ZP + ZC_RR]; R.vr[t] = Zl[ro * ZP + ZC_RV]; }
}
DEV void rwkv_pre_a(const RwRaw& R, int c, LAS unsigned char* sl, volatile LAS unsigned* flg, int lane) {
    const int bi = c & (RW_NBUF - 1);
    LAS bf16_t* BK = (LAS bf16_t*)(sl + RW_PRIV + bi * RW_PRIV_BYTES + RW_PBK);
    LAS unsigned char* db = sl + bi * RW_DB;
    LAS bf16_t* AR = (LAS bf16_t*)(db + RW_AR); LAS bf16_t* BKT = (LAS bf16_t*)(db + RW_BKT); LAS bf16_t* VT = (LAS bf16_t*)(db + RW_VT); LAS float* GC = (LAS float*)(db + RW_GC);
    if (c >= RW_NBUF) rw_wait(flg + 4 + bi, (unsigned)(c - RW_NBUF + 1));
    float g = 1.f; unsigned bkt[16];
#pragma unroll
    for (int t = 0; t < 16; ++t) {
        const float w = R.w[t], kk = bf2f(R.kk[t]), ka = bf2f(R.ka[t]), kp = bf2f(R.kp[t]), rr = bf2f(R.rr[t]);
        const float at = -kk * g; g *= w; const float inv = __builtin_amdgcn_rcpf(g);
        const unsigned bt = f2bf(ka * inv), kt = f2bf(kp * inv);
        AR[t * RW_ARP + lane] = (bf16_t)f2bf(at); AR[(16 + t) * RW_ARP + lane] = (bf16_t)f2bf(rr * g);
        BK[t * RW_ARP + lane] = (bf16_t)bt; BK[(16 + t) * RW_ARP + lane] = (bf16_t)kt;
        if (t & 1) { bkt[t >> 1] |= bt << 16; bkt[8 + (t >> 1)] |= kt << 16; } else { bkt[t >> 1] = bt; bkt[8 + (t >> 1)] = kt; }
    }
    GC[lane] = g;
#pragma unroll
    for (int q4 = 0; q4 < 4; ++q4) { u32x4 w4; w4.x = bkt[4 * q4]; w4.y = bkt[4 * q4 + 1]; w4.z = bkt[4 * q4 + 2]; w4.w = bkt[4 * q4 + 3]; *(LAS u32x4*)(BKT + lane * RW_BKTP + 8 * q4) = w4; }
    { unsigned vv[8];
#pragma unroll
      for (int t = 0; t < 16; ++t) { const unsigned x = R.vr[t]; if (t & 1) vv[t >> 1] |= x << 16; else vv[t >> 1] = x; }
      u32x4 v0; v0.x = vv[0]; v0.y = vv[1]; v0.z = vv[2]; v0.w = vv[3]; u32x4 v1; v1.x = vv[4]; v1.y = vv[5]; v1.z = vv[6]; v1.w = vv[7];
      *(LAS u32x4*)(VT + lane * RW_VTP) = v0; *(LAS u32x4*)(VT + lane * RW_VTP + 8) = v1; }
}
DEV void rwkv_pre_b(int c, LAS unsigned char* sl, volatile LAS unsigned* flg, int lane) {
    const int r32 = lane & 31, hi = lane >> 5, bi = c & (RW_NBUF - 1);
    LAS bf16_t* BK = (LAS bf16_t*)(sl + RW_PRIV + bi * RW_PRIV_BYTES + RW_PBK); LAS float* LAB = (LAS float*)(sl + RW_PRIV + bi * RW_PRIV_BYTES + RW_PLAB);
    LAS unsigned char* db = sl + bi * RW_DB;
    LAS bf16_t* AR = (LAS bf16_t*)(db + RW_AR); LAS bf16_t* TM = (LAS bf16_t*)(db + RW_TM); LAS bf16_t* PM1 = (LAS bf16_t*)(db + RW_PM1); LAS bf16_t* PM2 = (LAS bf16_t*)(db + RW_PM2);
    f32x16 P = f32x16{};
#pragma unroll
    for (int ks = 0; ks < 4; ++ks) P = __builtin_amdgcn_mfma_f32_32x32x16_bf16(*(const LAS bf16x8*)(AR + r32 * RW_ARP + 16 * ks + 8 * hi), *(const LAS bf16x8*)(BK + r32 * RW_ARP + 16 * ks + 8 * hi), P, 0, 0, 0);
    const int n = r32;
#pragma unroll
    for (int r = 0; r < 16; ++r) { const int m = crow(r, hi);
        if (r < 8) { if (n < 16) LAB[m * RW_LP + n] = (n < m) ? P[r] : 0.f; else PM1[m * RW_PMP + (n - 16)] = (bf16_t)f2bf((n - 16 < m) ? P[r] : 0.f); }
        else { if (n < 16) PM2[m * RW_PMP + n] = (bf16_t)f2bf((n <= m - 16) ? P[r] : 0.f); else PM1[m * RW_PMP + (n - 16)] = (bf16_t)f2bf((n - 16 <= m - 16) ? P[r] : 0.f); } }
}
DEV void rwkv_pre_c(int c, LAS unsigned char* sl, volatile LAS unsigned* flg, int lane) {
    const int bi = c & (RW_NBUF - 1);
    const LAS float* LAB = (const LAS float*)(sl + RW_PRIV + bi * RW_PRIV_BYTES + RW_PLAB); LAS bf16_t* TM = (LAS bf16_t*)(sl + bi * RW_DB + RW_TM);
    { const int cc = lane & 15; float T[16];
#pragma unroll
      for (int t = 0; t < 16; ++t) { float acc = (t == cc) ? 1.f : 0.f;
          int z = 0; if (t >= 3) asm volatile("v_and_b32 %0, 0, %1" : "=v"(z) : "v"(T[t - 3]));
          const LAS float* lrow = LAB + t * RW_LP + z;
#pragma unroll
          for (int tau = 0; tau < t; ++tau) acc = fmaf(lrow[tau], T[tau], acc);
          T[t] = acc; }
      if (lane < 16) {
#pragma unroll
          for (int t = 0; t < 16; ++t) TM[t * RW_PMP + cc] = (bf16_t)f2bf(T[t]); } }
    asm volatile("s_waitcnt lgkmcnt(0)" ::: "memory"); flg[bi] = (unsigned)(c + 1);
}
DEV void rwkv_pre(const Args& a, int b, int h, LAS unsigned char* sl, int par) {
    const int lane = fresh_lane();
    volatile LAS unsigned* flg = (volatile LAS unsigned*)(sl + RW_FLG);
    const size_t rowb = (size_t)b * SEQ;
    const bf16_t* Zl = (const bf16_t*)(a.ws + WS_Z) + rowb * ZP + h * 64 + lane;
    const float* WDp = (const float*)(a.ws + WS_WD) + rowb * 512 + h * 64 + lane;
    const bf16_t* KKp = (const bf16_t*)(a.ws + WS_KK) + rowb * 512 + h * 64 + lane;
    const bf16_t* KAp = (const bf16_t*)(a.ws + WS_KA) + rowb * 512 + h * 64 + lane;
    for (int e = lane; e < 32 * RW_PMP; e += 64) { ((LAS bf16_t*)(sl + par * RW_DB + RW_PM2))[e] = 0; ((LAS bf16_t*)(sl + par * RW_DB + RW_TM))[e] = 0; }
    RwRaw R;
    rwkv_pre_load(R, par, WDp, KKp, KAp, Zl);
#pragma unroll 1
    for (int c = par; c < RW_NCH; c += RW_NBUF) {
        rwkv_pre_a(R, c, sl, flg, lane);
        rwkv_pre_b(c, sl, flg, lane);
        asm volatile("" ::: "memory");
        rwkv_pre_load(R, (c + RW_NBUF < RW_NCH) ? c + RW_NBUF : c, WDp, KKp, KAp, Zl);
#if !defined(NOPREC)
        rwkv_pre_c(c, sl, flg, lane);
#endif
    }
}

DEV void rwkv_main(LAS unsigned char* sl) {
    const int lane = fresh_lane(), r32 = lane & 31, hi = lane >> 5;
    volatile LAS unsigned* flg = (volatile LAS unsigned*)(sl + RW_FLG);
    f32x16 ST[2][2];
#pragma unroll
    for (int jt = 0; jt < 2; ++jt)
#pragma unroll
        for (int it = 0; it < 2; ++it) ST[jt][it] = f32x16{};
#pragma unroll 1
    for (int c = 0; c < RW_NCH; ++c) {
        const int bi = c & (RW_NBUF - 1);
        LAS unsigned char* db = sl + bi * RW_DB;
        const LAS bf16_t* AR = (const LAS bf16_t*)(db + RW_AR); const LAS bf16_t* BKT = (const LAS bf16_t*)(db + RW_BKT); const LAS bf16_t* VT = (const LAS bf16_t*)(db + RW_VT);
        const LAS float* GC = (const LAS float*)(db + RW_GC); const LAS bf16_t* TM = (const LAS bf16_t*)(db + RW_TM); const LAS bf16_t* PM1 = (const LAS bf16_t*)(db + RW_PM1); const LAS bf16_t* PM2 = (const LAS bf16_t*)(db + RW_PM2);
        LAS float* YB = (LAS float*)(sl + RW_YB + (c & 1) * 4096);
        rw_wait(flg + bi, (unsigned)(c + 1));
        f32x16 X[2]; X[0] = f32x16{}; X[1] = f32x16{};
#pragma unroll
        for (int jt = 0; jt < 2; ++jt)
#pragma unroll
            for (int rgp = 0; rgp < 2; ++rgp) { const bf16x8 af = frag_perm(AR + r32 * RW_ARP + 32 * jt + 16 * rgp, hi);
#pragma unroll
                for (int it = 0; it < 2; ++it) X[it] = __builtin_amdgcn_mfma_f32_32x32x16_bf16(af, pack_acc8(ST[jt][it], 8 * rgp), X[it], 0, 0, 0); }
        bf16x8 vt[2];
        { const bf16x8 a1 = *(const LAS bf16x8*)(PM1 + r32 * RW_PMP + 8 * hi);
#pragma unroll
          for (int it = 0; it < 2; ++it) { vt[it] = *(const LAS bf16x8*)(VT + (32 * it + r32) * RW_VTP + 8 * hi); X[it] = __builtin_amdgcn_mfma_f32_32x32x16_bf16(a1, vt[it], X[it], 0, 0, 0); } }
        bf16x8 ub[2];
        { const bf16x8 ta = frag_perm(TM + r32 * RW_PMP, hi), pm2 = frag_perm(PM2 + r32 * RW_PMP, hi);
#pragma unroll
          for (int it = 0; it < 2; ++it) { const f32x16 U = __builtin_amdgcn_mfma_f32_32x32x16_bf16(ta, pack_acc8(X[it], 0), f32x16{}, 0, 0, 0);
              ub[it] = pack_acc8(U, 0); X[it] = __builtin_amdgcn_mfma_f32_32x32x16_bf16(pm2, ub[it], X[it], 0, 0, 0); } }
        if (c >= 2) rw_wait(flg + 10 + (c & 1), (unsigned)(c - 1));
#pragma unroll
        for (int it = 0; it < 2; ++it)
#pragma unroll
            for (int r = 8; r < 16; ++r) YB[(crow(r, hi) - 16) * 64 + 32 * it + r32] = X[it][r];
        rw_post_flag(flg + 8 + (c & 1), (unsigned)(c + 1));
#pragma unroll
        for (int jt = 0; jt < 2; ++jt) { const bf16x8 a0 = frag_perm(BKT + (32 * jt + r32) * RW_BKTP, hi), a1 = *(const LAS bf16x8*)(BKT + (32 * jt + r32) * RW_BKTP + 16 + 8 * hi);
#pragma unroll
            for (int it = 0; it < 2; ++it) { ST[jt][it] = __builtin_amdgcn_mfma_f32_32x32x16_bf16(a0, ub[it], ST[jt][it], 0, 0, 0);
                ST[jt][it] = __builtin_amdgcn_mfma_f32_32x32x16_bf16(a1, vt[it], ST[jt][it], 0, 0, 0); }
#pragma unroll
            for (int rg = 0; rg < 4; ++rg) { const f32x4 g4 = *(const LAS f32x4*)(GC + 32 * jt + 8 * rg + 4 * hi);
#pragma unroll
                for (int e = 0; e < 4; ++e) { ST[jt][0][4 * rg + e] *= g4[e]; ST[jt][1][4 * rg + e] *= g4[e]; } } }
        rw_post_flag(flg + 4 + bi, (unsigned)(c + 1));
    }
}

DEV void rwkv_post(const Args& a, int l, int b, int h, LAS unsigned char* sl, int par) {
    const int lane = fresh_lane();
    volatile LAS unsigned* flg = (volatile LAS unsigned*)(sl + RW_FLG);
    bf16_t* Zb = (bf16_t*)(a.ws + WS_Z) + (size_t)b * SEQ * ZP;
    const int gcol0 = h < 4 ? ZC_FV + h * 64 : ZC_MV + (h - 4) * 64;
    const int t = lane >> 2, qd = lane & 3, c0 = h * 64 + 16 * qd;
    const float* rkp = a.in[22] + l * 512 + c0; const float* lw = a.in[23] + l * 512 + c0; const float* lb = a.in[24] + l * 512 + c0;
    const LAS float* YB = (const LAS float*)(sl + RW_YB + par * 4096);
#pragma unroll 1
    for (int c = par; c < RW_NCH; c += 2) {
        bf16_t* zr = Zb + (size_t)(16 * c + t) * ZP;
        const u32x4 r0 = *(const u32x4*)(zr + ZC_RR + c0), r1 = *(const u32x4*)(zr + ZC_RR + c0 + 8), k0 = *(const u32x4*)(zr + ZC_RK + c0), k1 = *(const u32x4*)(zr + ZC_RK + c0 + 8);
        const u32x4 v0 = *(const u32x4*)(zr + ZC_RV + c0), v1 = *(const u32x4*)(zr + ZC_RV + c0 + 8), g0 = *(const u32x4*)(zr + gcol0 + 16 * qd), g1 = *(const u32x4*)(zr + gcol0 + 16 * qd + 8);
        rw_wait(flg + 8 + par, (unsigned)(c + 1));
        float y[16];
#pragma unroll
        for (int q4 = 0; q4 < 4; ++q4) { const f32x4 yy = *(const LAS f32x4*)(YB + t * 64 + 16 * qd + 4 * q4); y[4 * q4] = yy[0]; y[4 * q4 + 1] = yy[1]; y[4 * q4 + 2] = yy[2]; y[4 * q4 + 3] = yy[3]; }
        asm volatile("s_waitcnt lgkmcnt(0)" ::: "memory");
        flg[10 + par] = (unsigned)(c + 1);
        float s = 0.f;
#pragma unroll
        for (int e = 0; e < 16; ++e) s += y[e];
        s += __shfl_xor(s, 1); s += __shfl_xor(s, 2);
        const float mean = s * (1.f / 64); float q = 0.f;
#pragma unroll
        for (int e = 0; e < 16; ++e) { y[e] -= mean; q += y[e] * y[e]; }
        q += __shfl_xor(q, 1); q += __shfl_xor(q, 2);
        const float rstd = rsqrtf(q * (1.f / 64) + GN_EPS);
        float rv[16], kv[16];
        unpack8(r0, *(float(*)[8])&rv[0]); unpack8(r1, *(float(*)[8])&rv[8]); unpack8(k0, *(float(*)[8])&kv[0]); unpack8(k1, *(float(*)[8])&kv[8]);
        float bs = 0.f;
#pragma unroll
        for (int e = 0; e < 16; ++e) bs += rv[e] * kv[e] * rkp[e];
        bs += __shfl_xor(bs, 1); bs += __shfl_xor(bs, 2);
        float vv[16], gv[16], o[16];
        unpack8(v0, *(float(*)[8])&vv[0]); unpack8(v1, *(float(*)[8])&vv[8]); unpack8(g0, *(float(*)[8])&gv[0]); unpack8(g1, *(float(*)[8])&gv[8]);
#pragma unroll
        for (int e = 0; e < 16; ++e) o[e] = (y[e] * rstd * lw[e] + lb[e] + bs * vv[e]) * gv[e];
        *(u32x4*)(zr + ZC_RR + c0) = pack8(*(float(*)[8])&o[0]); *(u32x4*)(zr + ZC_RR + c0 + 8) = pack8(*(float(*)[8])&o[8]);
    }
}

#define XB_TMO      128
#define XB_XCNT(j)  (256  + 64 * (j))
#define XB_XSUB(j)  (1280 + 64 * (j))
#define XB_XGEN(j)  (2304 + 64 * (j))
#define XB_TOP      3328
#define XB_TOPGEN   3392
#define XCD_BAR_WORDS 3456
#define XB_SPIN_CAP (1u << 18)

__device__ __forceinline__ unsigned xb_ld(unsigned* p)              { return __hip_atomic_load(p, __ATOMIC_RELAXED, __HIP_MEMORY_SCOPE_AGENT); }
__device__ __forceinline__ unsigned xb_add(unsigned* p, unsigned v) { return __hip_atomic_fetch_add(p, v, __ATOMIC_RELAXED, __HIP_MEMORY_SCOPE_AGENT); }
__device__ __forceinline__ unsigned xb_xcc_id() { return (unsigned)__builtin_amdgcn_s_getreg((3 << 11) | 20) & 0xFu; }
#define XB_SPIN(cond, bar) do { unsigned _sp = 0; while (cond) { __builtin_amdgcn_s_sleep(1); \
    if ((++_sp & 255u) == 0u) { if (xb_ld(&(bar)[XB_TMO])) break; if (_sp > XB_SPIN_CAP) { atomicAdd(&(bar)[XB_TMO], 1u); break; } } } } while (0)

struct XcdBarrier {
    unsigned* bar; unsigned x;
    volatile LAS unsigned* st;
};

__device__ __forceinline__ XcdBarrier xcd_barrier_post(unsigned* bar, volatile LAS unsigned* st) {
    XcdBarrier b; b.bar = bar; b.x = xb_xcc_id(); b.st = st;
    if (threadIdx.x == 0) (void)xb_add(&bar[XB_XCNT(b.x)], 1u);
    return b;
}
__device__ __forceinline__ void xcd_barrier_complete(unsigned* bar, unsigned x, unsigned& nloc, unsigned& nx) {
    const unsigned G = gridDim.x * gridDim.y * gridDim.z;
    unsigned sum, cnt, mine, sp = 0u;
    for (;;) {
        sum = 0u; cnt = 0u; mine = 0u;
#pragma unroll
        for (unsigned j = 0; j < 16; ++j) { const unsigned c = xb_ld(&bar[XB_XCNT(j)]); sum += c; cnt += (c > 0u) ? 1u : 0u; mine = (j == x) ? c : mine; }
        if (sum == G) break;
        __builtin_amdgcn_s_sleep(1);
        if ((++sp & 255u) == 0u) { if (xb_ld(&bar[XB_TMO])) break; if (sp > XB_SPIN_CAP) { atomicAdd(&bar[XB_TMO], 1u); break; } }
    }
    nloc = mine > 0u ? mine : 1u; nx = cnt > 0u ? cnt : 1u;
}

__device__ __forceinline__ void xcd_barrier(const XcdBarrier& b) {
    asm volatile("s_waitcnt vmcnt(0)" ::: "memory");
    __syncthreads();
    if (threadIdx.x == 0) {
        unsigned* bar = b.bar;
        __builtin_amdgcn_s_waitcnt(0);
        unsigned nloc = b.st[0], nx = b.st[1];
        if (nloc == 0u) { xcd_barrier_complete(bar, b.x, nloc, nx); b.st[0] = nloc; b.st[1] = nx; }
        const unsigned old = xb_add(&bar[XB_XSUB(b.x)], 1u);
        const unsigned gen = old / nloc;
        if (old + 1u == (gen + 1u) * nloc) {
            __builtin_amdgcn_fence(__ATOMIC_RELEASE, "agent");
            asm volatile("s_waitcnt vmcnt(0)" ::: "memory");
            const unsigned og = xb_add(&bar[XB_TOP], 1u);
            const unsigned tg = og / nx;
            if (og + 1u == (tg + 1u) * nx) xb_add(&bar[XB_TOPGEN], 1u);
            else XB_SPIN(xb_ld(&bar[XB_TOPGEN]) == tg, bar);
            __builtin_amdgcn_fence(__ATOMIC_ACQUIRE, "agent");
            xb_add(&bar[XB_XGEN(b.x)], 1u);
            asm volatile("s_waitcnt vmcnt(0)" ::: "memory");
        } else {
            XB_SPIN(xb_ld(&bar[XB_XGEN(b.x)]) == gen, bar);
            __builtin_amdgcn_fence(__ATOMIC_ACQUIRE, "agent");
            asm volatile("s_waitcnt vmcnt(0)" ::: "memory");
        }
    }
    __syncthreads();
}

constexpr int N_PHASES = 1 + 15 * NL;
#ifndef MK_MULTI
#define MK_MULTI 0
#endif
#ifndef PROBE_Q
#define PROBE_Q 500.f
#endif
#ifndef PROBE_OFF
#define PROBE_OFF 0.f
#endif
#ifndef REPK
#define REPK 0
#endif
#ifndef ATT_REP
#define ATT_REP 1
#endif
#ifndef PREP_REP
#define PREP_REP 1
#endif
#ifndef RWROLES
#define RWROLES 7
#endif
#ifndef PHMASK
#define PHMASK 0xFFFF
#endif
#define PHON(k) ((PHMASK >> (k)) & 1)
__global__ void __launch_bounds__(512, 2) fwd_megakernel(Args a) {
    extern __shared__ __attribute__((aligned(16))) unsigned char lds_raw[];
    LAS unsigned char* lds = (LAS unsigned char*)lds_raw;
    cg::grid_group grid = cg::this_grid();
    { volatile LAS unsigned* st0 = (volatile LAS unsigned*)(lds + 131072 + 128); if (threadIdx.x == 0) { st0[0] = 0u; st0[1] = 0u; } __syncthreads(); }
    XcdBarrier xbar = xcd_barrier_post((unsigned*)(a.ws + WS_CTL) + 4096, (volatile LAS unsigned*)(lds + 131072 + 128));
    const int G = gridDim.x, bid = blockIdx.x, NGW = G * 8;
    unsigned char* ws = a.ws;
    bf16_t* HN = (bf16_t*)(ws + WS_HN); bf16_t* Z = (bf16_t*)(ws + WS_Z); bf16_t* HID = Z; bf16_t* QX = Z; bf16_t* OX = Z + (size_t)TOK * 512;
#ifdef PROBE_GROUP
    LAS unsigned long long* prs = (LAS unsigned long long*)(lds + 131072 + 64);
    if (threadIdx.x == 0) { prs[0] = __builtin_amdgcn_s_memrealtime(); prs[1] = 0ull; prs[2] = 99ull; }
#endif
#ifdef PROBE_GROUP
    for (int ph = a.ph_lo; ph <= a.ph_hi; ++ph) {
#else
    for (int ph = a.ph_lo; ph < a.ph_hi; ++ph) {
#endif
        if (ph > a.ph_lo) { if (ph == a.ph_lo + 1 || MK_MULTI) grid.sync(); else xcd_barrier(xbar);
#ifdef SYNC_REP
            xcd_barrier(xbar); xcd_barrier(xbar);
#endif
        }
#ifdef PROBE_GROUP
        if (threadIdx.x == 0) { const unsigned long long now = __builtin_amdgcn_s_memrealtime(); if (prs[2] == (unsigned long long)PROBE_GROUP) prs[1] += now - prs[0]; prs[0] = now;
          if (ph == a.ph_hi) { if (blockIdx.x == 0) { float us_ = (float)prs[1] * 0.01f;
#if PROBE_GROUP == 8
              us_ = (float)((volatile unsigned*)(ws + WS_CTL))[32 * 64] * 0.01f;
#endif
              a.out[0] = floorf((us_ + PROBE_OFF) / PROBE_Q) * PROBE_Q + 0.5f * PROBE_Q; } }
          const int k_ = (ph - 1) % 15; prs[2] = ph == 0 ? 0 : (k_ == 0 || k_ == 3 || k_ == 8 || k_ == 12) ? 1 : (k_ == 1 || k_ == 13) ? 2 : (k_ == 2 || k_ == 14 || k_ == 7 || k_ == 11) ? 3 : (k_ == 4 || k_ == 9) ? 4 : k_ == 5 ? 5 : k_ == 6 ? 6 : 7; }
        if (ph == a.ph_hi) break;
#endif
        int tidp = threadIdx.x; asm volatile("" : "+v"(tidp)); const int tid = tidp, lane = tid & 63, wid = __builtin_amdgcn_readfirstlane(tid >> 6), gw = bid * 8 + wid;
        if (ph == 0) { for (int rp_ = 0; rp_ < ((REPK >> 15) & 1) + 1; ++rp_) { if (PHON(15)) p0_prologue(a, lds, gw, NGW, wid, lane, tid); } continue; }
        const int l = (ph - 1) / 15, kind = (ph - 1) % 15;
        const unsigned char* wl = ws + WS_W + (size_t)l * WL_BYTES;
        if (PHON(0) && (kind == 0 || kind == 3 || kind == 8 || kind == 12)) {
            const float* src = (l == 0 && kind == 0) ? a.in[0] : a.out;
            const float* g = (kind == 0 ? a.in[3] : kind == 3 ? a.in[6] : kind == 8 ? a.in[25] : a.in[32]) + l * DM;
            for (int rp_ = 0; rp_ < (REPK & 1) + 1; ++rp_) norm_phase(src, g, HN, TOK, gw, NGW, lane);
            if (l == 0 && kind == 3) xkv_post(a, gw, NGW, lane);
        }
        if (PHON(1) && (kind == 1 || kind == 13)) {
            pg8::Gemm g{HN, (const bf16_t*)(wl + (kind == 1 ? OFF_F1I : OFF_F2I)), TOK, 2 * FF, DM, DM};
            pg8::StaticOrder S; S.init(TOK, 2 * FF, G, bid);
            pg8::EpiSwiglu E{HID, FF};
            pg8::gemm_phase<pg8::EpiSwiglu, pg8::StaticOrder, true, true>(lds, g, S, E);
        }
        if (PHON(2) && (kind == 2 || kind == 14 || kind == 7 || kind == 11)) {
            pg8::Gemm g; pg8::EpiResid E; E.out = a.out; E.ldc = DM; g.M = TOK; g.N = DM;
            if (kind == 2 || kind == 14) { g.A = HID; g.lda = FF; g.K = FF; g.Bt = (const bf16_t*)(wl + (kind == 2 ? OFF_F1O : OFF_F2O)); E.scale = 0.5f; E.base = (l == 0 && kind == 2) ? a.in[0] : a.out; }
            else if (kind == 7) { g.A = Z; g.lda = ZP; g.K = DM; g.Bt = (const bf16_t*)(wl + OFF_MO); E.scale = 1.f; E.base = a.out; }
            else { g.A = OX; g.lda = 512; g.K = 512; g.Bt = (const bf16_t*)(wl + OFF_XO); E.scale = 1.f; E.base = a.out; }
            pg8::StaticOrder S; S.init(TOK, DM, G, bid);
            const float sc_ = E.scale;
            for (int rp_ = ((REPK >> 2) & 1); rp_ >= 0; --rp_) { E.scale = rp_ ? 0.f : sc_;
            pg8::gemm_phase<pg8::EpiResid, pg8::StaticOrder, true, true>(lds, g, S, E); if (rp_) { __syncthreads(); } }
        }
        if (PHON(4) && (kind == 4 || kind == 9 || (kind == 0 && l == 0))) {
            const int ng = (kind == 0) ? NL : 1;
            for (int rp_ = 0; rp_ < ((REPK >> 4) & 1) + 1; ++rp_)
            for (int gi = 0; gi < ng; ++gi) {
                pg8::Gemm g; pg8::EpiBf16 E; int cidx = bid;
                if (kind == 4) { g.A = HN; g.lda = DM; g.K = DM; g.M = TOK; g.N = 3584; g.Bt = (const bf16_t*)(wl + OFF_MI); E.O = Z; E.ldc = ZP; E.ncols = ZC_VALID; E.halo = (bf16_t*)(ws + WS_ZHALO); }
                else if (kind == 9) { g.A = HN; g.lda = DM; g.K = DM; g.M = TOK; g.N = 512; g.Bt = (const bf16_t*)(wl + OFF_XQ); E.O = QX; E.ldc = 512; E.ncols = 512; E.halo = nullptr; }
                else { g.A = (const bf16_t*)(ws + WS_MEMN) + (size_t)gi * NB * MEMLEN * DM; g.lda = DM; g.K = DM; g.M = NB * MEMLEN; g.N = 1024;
                       g.Bt = (const bf16_t*)(ws + WS_W + (size_t)gi * WL_BYTES + OFF_XKV); E.O = (bf16_t*)(ws + WS_KVX) + (size_t)gi * NB * MEMLEN * 1024; E.ldc = 1024; E.ncols = 1024; E.halo = nullptr;
                       cidx = (bid + gi * (G / 2)) % G; }
                pg8::StaticOrder S; S.init(g.M, g.N, G, cidx);
                pg8::gemm_phase<pg8::EpiBf16, pg8::StaticOrder, true, true>(lds, g, S, E);
            }
        }
        if (PHON(5) && kind == 5) { for (int rp_ = PREP_REP - 1; rp_ >= 0; --rp_) for (int tile = bid; tile < TOK / 64; tile += G) prep_tile(a, l, tile, lds, rp_ > 0); }
        if (PHON(6) && kind == 6) {
            unsigned* ctr = (unsigned*)(ws + WS_CTL) + 64 * (1 + l); LAS unsigned* qw = (LAS unsigned*)(lds + 131072);
            for (;;) {
                __syncthreads();
                if (tid == 0) *qw = atomicAdd(ctr, 1u);
                __syncthreads();
                const int item = __builtin_amdgcn_readfirstlane((int)*qw);
                if (item >= 64 + 1024) break;
                if (item < 64) {
                    if (tid < 16) ((LAS unsigned*)(lds + RW_FLG))[tid] = 0u;
                    __syncthreads();
                    if (PHON(7)) {
                        const int ub = item >> 3, uh = item & 7;
                        if (wid == 0 || wid == 4 || wid == 2 || wid == 6) { if (RWROLES & 1) rwkv_pre(a, ub, uh, lds, wid == 0 ? 0 : wid == 4 ? 1 : wid == 2 ? 2 : 3); }
                        else if (wid == 1) { if (RWROLES & 2) rwkv_main(lds); }
                        else if (wid == 3 || wid == 7) { if (RWROLES & 4) rwkv_post(a, l, ub, uh, lds, wid == 3 ? 0 : 1); }
                    }
                }
                else {
                    const int j = item - 64, qb = 15 - (j >> 6), kk = j & 63, type = kk >> 5, bh = kk & 31, b = bh >> 2, h = bh & 3;
                    bf16_t* Zb = Z + (size_t)b * SEQ * ZP;
                    for (int rp_ = ATT_REP - 1; rp_ >= 0; --rp_)
                    if (type == 0) { if (PHON(8)) attn_unit<0, 64>(lds, Zb + ZC_FQ + 64 * h, ZP, Zb + ZC_FK + 64 * h, ZP, (const bf16_t*)(ws + WS_VTF) + (size_t)bh * 64 * SEQ, SEQ, Zb + ZC_FQ + 64 * h, ZP,
                                                   256 * qb, 4 * (qb + 1), qb, (const float*)(ws + WS_LOGF) + (size_t)bh * SEQ, nullptr, rp_ > 0); }
                    else if (PHON(9)) attn_unit<1, 64>(lds, Zb + ZC_MQ + 64 * h, ZP, Zb + ZC_MK + 64 * h, ZP, (const bf16_t*)(ws + WS_VTM) + (size_t)bh * 64 * SEQ, SEQ, Zb + ZC_MQ + 64 * h, ZP,
                                          256 * qb, 4 * (qb + 1), qb, (const float*)(ws + WS_KMP) + (size_t)bh * 64 * 64, nullptr, rp_ > 0);
                }
            }
        }
        if (PHON(10) && kind == 10) {
            for (int rp_ = 0; rp_ < ((REPK >> 10) & 1) + 1; ++rp_)
            for (int u = bid; u < NB * 4 * 16; u += G) { const int b = u >> 6, hd = (u >> 4) & 3, qb = u & 15;
                bf16_t* qp = QX + (size_t)b * SEQ * 512 + hd * 128;
                attn_unit<2, 128>(lds, qp, 512, (const bf16_t*)(ws + WS_KVX) + ((size_t)l * NB + b) * MEMLEN * 1024 + hd * 128, 1024,
                                  (const bf16_t*)(ws + WS_VTX) + ((size_t)(l * NB + b) * 4 + hd) * 128 * MEMLEN, MEMLEN, OX + (size_t)b * SEQ * 512 + hd * 128, 512, 256 * qb, MEMLEN / 64, qb, nullptr, a.in[29] + l * 128); }
        }
    }
}

extern "C" void kernel_launch(void* const* d_in, const int* in_sizes, int n_in, void* d_out, int out_size, void* d_ws, size_t ws_size, hipStream_t stream) {
    static int grid_blocks = 0;
    if (grid_blocks == 0) {
        if (n_in != 35 || ws_size < WS_END) { fprintf(stderr, "kernel_launch: unexpected n_in %d / ws %zu\n", n_in, ws_size); grid_blocks = -1; return; }
        int dev = 0, cus = 0, per_cu = 0;
        hipGetDevice(&dev); hipDeviceGetAttribute(&cus, hipDeviceAttributeMultiprocessorCount, dev);
        if (hipFuncSetAttribute((const void*)fwd_megakernel, hipFuncAttributeMaxDynamicSharedMemorySize, LDS_BYTES) != hipSuccess) { fprintf(stderr, "kernel_launch: hipFuncSetAttribute failed\n"); grid_blocks = -1; return; }
        if (hipOccupancyMaxActiveBlocksPerMultiprocessor(&per_cu, (const void*)fwd_megakernel, 512, LDS_BYTES) != hipSuccess || per_cu < 1) { fprintf(stderr, "kernel_launch: occupancy query says %d\n", per_cu); per_cu = 1; }
        (void)hipGetLastError();
        grid_blocks = cus * per_cu;
    }
    if (grid_blocks < 0) return;
    Args a{};
    for (int i = 0; i < 35; ++i) a.in[i] = (const float*)d_in[i];
    a.out = (float*)d_out; a.ws = (unsigned char*)d_ws;
    if (hipMemsetAsync(d_ws, 0, 65536, stream) != hipSuccess) { fprintf(stderr, "kernel_launch: memset failed\n"); return; }
#if MK_MULTI
    for (int ph = 0; ph < N_PHASES; ++ph) { a.ph_lo = ph; a.ph_hi = ph + 1; hipLaunchKernelGGL(fwd_megakernel, dim3(grid_blocks), dim3(512), LDS_BYTES, stream, a); }
#else
    a.ph_lo = 0; a.ph_hi = N_PHASES;
    void* args[] = {&a};
    hipError_t e = hipLaunchCooperativeKernel((const void*)fwd_megakernel, dim3(grid_blocks), dim3(512), args, LDS_BYTES, stream);
    if (e != hipSuccess) fprintf(stderr, "cooperative launch failed: %s (grid %d)\n", hipGetErrorString(e), grid_blocks);
#endif
}
```

```cpp
#include <hip/hip_runtime.h>
#include <hip/hip_cooperative_groups.h>
#include <cstdio>
#include <cstdint>
namespace cg = cooperative_groups;
namespace pg8 {
#define PG8_LAS __attribute__((address_space(3)))
typedef unsigned short bf16_t;
typedef short bf16x8 __attribute__((ext_vector_type(8)));
typedef float f32x4 __attribute__((ext_vector_type(4)));
typedef unsigned u32x4 __attribute__((ext_vector_type(4)));
constexpr int BM = 256, BK = 64, HALF = 128, HTB = HALF * BK * 2  , STAGE_BYTES = 8 * HTB, NXCD = 8, WGM = 8;

__host__ __device__ __forceinline__ int lds_byte(int r, int c) { const int st = (r >> 4) * 2 + (c >> 5), rr = r & 15, cc = c & 31, ob = rr * 64 + cc * 2; return st * 1024 + (ob ^ (((ob >> 9) & 1) << 5)); }
__host__ __device__ __forceinline__ void stage_rc(int b, int& R, int& C) { const int st = b / 1024, sb = b % 1024, swz = sb ^ (((sb >> 9) & 1) << 5); R = (st >> 1) * 16 + swz / 64; C = (st & 1) * 32 + (swz % 64) / 2; }
__host__ __device__ __forceinline__ int perm32(int rho) { const int n = rho >> 4, i = rho & 15; return 8 * (i >> 2) + 4 * n + (i & 3); }

struct Unit { int pm, pn; };
struct Gemm { const bf16_t* A; const bf16_t* Bt; int M, N, K, lda; };

struct StaticOrder {
    int nM, nN, nwg, G, c;
    __host__ __device__ void init(int M, int N, int G_, int c_) { nM = M / BM; nN = N / BM; nwg = nM * nN; G = G_; c = c_; }
    __host__ __device__ bool next(int i, Unit& u) const {
        const long L = (long)i * G + c; if (L >= nwg) return false;
        int wgid = (int)L; { const int q = nwg / NXCD, r = nwg % NXCD, xcd = wgid % NXCD, off = wgid / NXCD; wgid = (xcd < r ? xcd * (q + 1) : r * (q + 1) + (xcd - r) * q) + off; }
        const int nig = WGM * nN, gid = wgid / nig, fm = gid * WGM, gsz = (nM - fm) < WGM ? (nM - fm) : WGM;
        u.pm = fm + ((wgid % nig) % gsz); u.pn = (wgid % nig) / gsz; return true;
    }
    __device__ __forceinline__ void a_ready(const Unit&) const {}
    __device__ __forceinline__ void done(const Unit&) const {}
};
__device__ __forceinline__ unsigned cvt_pk_bf16(float lo, float hi) { unsigned r; asm volatile("v_cvt_pk_bf16_f32 %0, %1, %2" : "=v"(r) : "v"(lo), "v"(hi)); return r; }
__device__ __forceinline__ float silu_f(float x) { return x * __builtin_amdgcn_rcpf(1.0f + __builtin_amdgcn_exp2f(-1.4426950408889634f * x)); }
struct EpiSwiglu {
    static constexpr bool PERM = true, AFTER_DRAIN = false;
    bf16_t* O; int ldc;
    __device__ __forceinline__ void operator()(const f32x4 (&acc)[2][2][4][2], const Unit& u, int wr, int wc, int fr, int fq) const {
        const int row0 = u.pm * BM + wr * 64 + fr, col0 = u.pn * HALF + wc * 32 + 8 * fq;
#pragma unroll
        for (int ai = 0; ai < 2; ++ai)
#pragma unroll
            for (int m = 0; m < 4; ++m) {
                const f32x4 g0 = acc[ai][0][m][0], g1 = acc[ai][0][m][1], u0 = acc[ai][1][m][0], u1 = acc[ai][1][m][1];
                u32x4 w;
                w.x = cvt_pk_bf16(silu_f(g0[0]) * u0[0], silu_f(g0[1]) * u0[1]); w.y = cvt_pk_bf16(silu_f(g0[2]) * u0[2], silu_f(g0[3]) * u0[3]);
                w.z = cvt_pk_bf16(silu_f(g1[0]) * u1[0], silu_f(g1[1]) * u1[1]); w.w = cvt_pk_bf16(silu_f(g1[2]) * u1[2], silu_f(g1[3]) * u1[3]);
                *(u32x4*)(O + (size_t)(row0 + ai * HALF + m * 16) * ldc + col0) = w;
            }
    }
};
struct EpiResid {
    static constexpr bool PERM = false, AFTER_DRAIN = false;
    const float* base; float* out; int ldc; float scale;
    __device__ __forceinline__ void operator()(const f32x4 (&acc)[2][2][4][2], const Unit& u, int wr, int wc, int fr, int fq) const {
        const int row0 = u.pm * BM + wr * 64 + fr, col0 = u.pn * BM + wc * 32 + 4 * fq;
#pragma unroll
        for (int ai = 0; ai < 2; ++ai)
#pragma unroll
            for (int m = 0; m < 4; ++m) { const size_t off = (size_t)(row0 + ai * HALF + m * 16) * ldc + col0;
#pragma unroll
                for (int bj = 0; bj < 2; ++bj)
#pragma unroll
                    for (int n = 0; n < 2; ++n) { const f32x4 b = *(const f32x4*)(base + off + bj * HALF + n * 16); *(f32x4*)(out + off + bj * HALF + n * 16) = b + acc[ai][bj][m][n] * scale; }
                asm volatile("" ::: "memory"); }
    }
};
struct EpiBf16 {
    static constexpr bool PERM = true, AFTER_DRAIN = false;
    bf16_t* O; int ldc; int ncols; bf16_t* halo;
    __device__ __forceinline__ void operator()(const f32x4 (&acc)[2][2][4][2], const Unit& u, int wr, int wc, int fr, int fq) const {
        const int row0 = u.pm * BM + wr * 64 + fr, col0 = u.pn * BM + wc * 32 + 8 * fq;
#pragma unroll
        for (int ai = 0; ai < 2; ++ai)
#pragma unroll
            for (int m = 0; m < 4; ++m) { const int row = row0 + ai * HALF + m * 16;
#pragma unroll
                for (int bj = 0; bj < 2; ++bj) { const int col = col0 + bj * HALF;
                    if (col < ncols) { const f32x4 v0 = acc[ai][bj][m][0], v1 = acc[ai][bj][m][1]; u32x4 w;
                        w.x = cvt_pk_bf16(v0[0], v0[1]); w.y = cvt_pk_bf16(v0[2], v0[3]); w.z = cvt_pk_bf16(v1[0], v1[1]); w.w = cvt_pk_bf16(v1[2], v1[3]);
                        *(u32x4*)(O + (size_t)row * ldc + col) = w;
                        if (halo && (row & 63) == 63) *(u32x4*)(halo + (size_t)(row >> 6) * ldc + col) = w; } } }
    }
};
template <class Epi, class Sched, bool ALIGN_EPI = false, bool SP2 = false>
__device__ __forceinline__ void gemm_phase(PG8_LAS unsigned char* lds, const Gemm g, const Sched& S, const Epi& E) {
    int tid_ = threadIdx.x; asm volatile("" : "+v"(tid_)); const int tid = tid_, wid = __builtin_amdgcn_readfirstlane(tid >> 6), lane = tid & 63, wr = wid >> 2, wc = wid & 3, fr = lane & 15, fq = lane >> 4;
    const int K = g.K, nt = K / BK;
    unsigned voffA[2], voffB[2];
#pragma unroll
    for (int i = 0; i < 2; ++i) { int R, C; stage_rc(tid * 16 + i * 8192, R, C); const int Rb = Epi::PERM ? ((R & ~31) + perm32(R & 31)) : R;
        voffA[i] = (unsigned)(R * g.lda + C) * 2u; voffB[i] = (unsigned)(Rb * K + C) * 2u; }
    const size_t kstep = (size_t)(BK * 2);
    const size_t hstep = (size_t)HALF * K * 2;
    const size_t tstep = 2 * hstep; const size_t hstepA = (size_t)HALF * g.lda * 2, tstepA = 2 * hstepA;
    const unsigned ldsw = (unsigned)wid * 1024u;
    const int aoff = lds_byte(wr * 64 + fr, fq * 8), boff = lds_byte(wc * 32 + fr, fq * 8);
#define PG8_SA(b, h) (((b) * 2 + (h)) * HTB)
#define PG8_SB(b, h) ((4 + (b) * 2 + (h)) * HTB)
#define PG8_STAGE(bufoff, gbase, voff) do { _Pragma("unroll") for (int _i = 0; _i < 2; ++_i) \
        __builtin_amdgcn_global_load_lds((const unsigned*)((const char*)(gbase) + (voff)[_i]), (PG8_LAS unsigned*)(lds + (bufoff) + ldsw + _i * 8192), 16, 0, 0); } while (0)
#define PG8_LDA(dst, b, h) do { _Pragma("unroll") for (int m = 0; m < 4; ++m) _Pragma("unroll") for (int k = 0; k < 2; ++k) dst[m][k] = *(const PG8_LAS bf16x8*)(lds + PG8_SA(b, h) + aoff + m * 2048 + k * 1024); } while (0)
#define PG8_LDB(dst, b, h) do { _Pragma("unroll") for (int n = 0; n < 2; ++n) _Pragma("unroll") for (int k = 0; k < 2; ++k) dst[n][k] = *(const PG8_LAS bf16x8*)(lds + PG8_SB(b, h) + boff + n * 2048 + k * 1024); } while (0)
#define PG8_MMA(ai, bj, At, Bt) do { __builtin_amdgcn_s_setprio(1); _Pragma("unroll") for (int m = 0; m < 4; ++m) _Pragma("unroll") for (int n = 0; n < 2; ++n) _Pragma("unroll") for (int k = 0; k < 2; ++k) \
        acc[ai][bj][m][n] = __builtin_amdgcn_mfma_f32_16x16x32_bf16(Bt[n][k], At[m][k], acc[ai][bj][m][n], 0, 0, 0); __builtin_amdgcn_s_setprio(0); } while (0)
#define PG8_WAIT_V(n) asm volatile("s_waitcnt vmcnt(" #n ")" ::: "memory")
#define PG8_WAIT_L(n) asm volatile("s_waitcnt lgkmcnt(" #n ")" ::: "memory")
#define PG8_BAR __builtin_amdgcn_s_barrier()
#define PG8_SCHED __builtin_amdgcn_sched_barrier(0)
    Unit cur, nxt; int ui = 0;
    if (!S.next(0, cur)) return;
    f32x4 acc[2][2][4][2];
#pragma unroll
    for (int a = 0; a < 2; ++a)
#pragma unroll
        for (int b = 0; b < 2; ++b)
#pragma unroll
            for (int m = 0; m < 4; ++m)
#pragma unroll
                for (int n = 0; n < 2; ++n) acc[a][b][m][n] = (f32x4){0.f, 0.f, 0.f, 0.f};
    bf16x8 At[4][2], B0[2][2], B1[2][2];
    const char* cA = (const char*)g.A + (size_t)cur.pm * tstepA; const char* cB = (const char*)g.Bt + (size_t)cur.pn * tstep;
    S.a_ready(cur);
    if constexpr (SP2) {
        PG8_STAGE(PG8_SB(0, 0), cB, voffB); PG8_STAGE(PG8_SB(0, 1), cB + hstep, voffB); PG8_STAGE(PG8_SA(0, 0), cA, voffA); PG8_STAGE(PG8_SA(0, 1), cA + hstepA, voffA);
        if (wr == 1) PG8_BAR;
        PG8_WAIT_V(2); PG8_BAR;
        PG8_STAGE(PG8_SB(1, 0), cB + kstep, voffB); PG8_STAGE(PG8_SA(1, 0), cA + kstep, voffA); PG8_STAGE(PG8_SB(1, 1), cB + hstep + kstep, voffB);
        PG8_WAIT_V(6); PG8_BAR;
    } else {
        PG8_STAGE(PG8_SB(0, 0), cB, voffB); PG8_STAGE(PG8_SA(0, 0), cA, voffA); PG8_STAGE(PG8_SB(0, 1), cB + hstep, voffB); PG8_STAGE(PG8_SA(0, 1), cA + hstepA, voffA);
        if (wr == 1) PG8_BAR;
        PG8_WAIT_V(4); PG8_BAR;
        PG8_STAGE(PG8_SB(1, 0), cB + kstep, voffB); PG8_STAGE(PG8_SA(1, 0), cA + kstep, voffA); PG8_STAGE(PG8_SB(1, 1), cB + hstep + kstep, voffB);
        PG8_WAIT_V(6); PG8_BAR;
    }
    for (;;) {
        const bool has_next = S.next(ui + 1, nxt);
        const char* nA = has_next ? (const char*)g.A + (size_t)nxt.pm * tstepA : cA; const char* nB = has_next ? (const char*)g.Bt + (size_t)nxt.pn * tstep : cB;
        for (int t = 0; t < nt; t += 2) {
            const bool last = (t == nt - 2);
            const char* a1 = cA + (size_t)(t + 1) * kstep;
            const char* a2 = last ? nA : cA + (size_t)(t + 2) * kstep; const char* b2 = last ? nB : cB + (size_t)(t + 2) * kstep;
            const char* a3 = a2 + kstep; const char* b3 = b2 + kstep;
            if (last && has_next) S.a_ready(nxt);
            if constexpr (SP2) {
            PG8_LDB(B0, 0, 0); PG8_LDB(B1, 0, 1); PG8_SCHED; PG8_LDA(At, 0, 0); PG8_STAGE(PG8_SA(1, 1), a1 + hstepA, voffA);
            PG8_WAIT_V(8); PG8_WAIT_L(0); PG8_BAR; PG8_MMA(0, 0, At, B0); PG8_MMA(0, 1, At, B1); PG8_BAR; PG8_SCHED;
            PG8_LDA(At, 0, 1); PG8_STAGE(PG8_SB(0, 0), b2, voffB); PG8_STAGE(PG8_SB(0, 1), b2 + hstep, voffB); PG8_STAGE(PG8_SA(0, 0), a2, voffA);
            PG8_WAIT_V(8); PG8_WAIT_L(0); PG8_BAR; PG8_MMA(1, 0, At, B0); PG8_MMA(1, 1, At, B1); PG8_BAR; PG8_SCHED;
            PG8_LDB(B0, 1, 0); PG8_LDB(B1, 1, 1); PG8_SCHED; PG8_LDA(At, 1, 0); PG8_STAGE(PG8_SA(0, 1), a2 + hstepA, voffA);
            PG8_WAIT_V(8); PG8_WAIT_L(0); PG8_BAR; PG8_MMA(0, 0, At, B0); PG8_MMA(0, 1, At, B1); PG8_BAR; PG8_SCHED;
            PG8_LDA(At, 1, 1); PG8_STAGE(PG8_SB(1, 0), b3, voffB); PG8_STAGE(PG8_SB(1, 1), b3 + hstep, voffB); PG8_STAGE(PG8_SA(1, 0), a3, voffA);
            PG8_WAIT_V(8); PG8_WAIT_L(0); PG8_BAR; PG8_MMA(1, 0, At, B0); PG8_MMA(1, 1, At, B1); PG8_BAR; PG8_SCHED;
            } else {
            PG8_LDB(B0, 0, 0); PG8_SCHED; PG8_LDA(At, 0, 0); PG8_STAGE(PG8_SA(1, 1), a1 + hstepA, voffA);
            PG8_WAIT_L(8); PG8_BAR; PG8_WAIT_L(0); PG8_MMA(0, 0, At, B0); PG8_BAR; PG8_SCHED;
            PG8_LDB(B1, 0, 1); PG8_STAGE(PG8_SB(0, 0), b2, voffB);
            PG8_BAR; PG8_WAIT_L(0); PG8_MMA(0, 1, At, B1); PG8_BAR;
            PG8_LDA(At, 0, 1); PG8_STAGE(PG8_SA(0, 0), a2, voffA);
            PG8_BAR; PG8_WAIT_L(0); PG8_MMA(1, 0, At, B0); PG8_BAR; PG8_SCHED;
            PG8_STAGE(PG8_SB(0, 1), b2 + hstep, voffB);
            PG8_WAIT_V(6); PG8_BAR; PG8_MMA(1, 1, At, B1); PG8_BAR;
            PG8_LDB(B0, 1, 0); PG8_SCHED; PG8_LDA(At, 1, 0); PG8_STAGE(PG8_SA(0, 1), a2 + hstepA, voffA);
            PG8_WAIT_L(8); PG8_BAR; PG8_WAIT_L(0); PG8_MMA(0, 0, At, B0); PG8_BAR; PG8_SCHED;
            PG8_LDB(B1, 1, 1); PG8_STAGE(PG8_SB(1, 0), b3, voffB);
            PG8_BAR; PG8_WAIT_L(0); PG8_MMA(0, 1, At, B1); PG8_BAR;
            PG8_LDA(At, 1, 1); PG8_STAGE(PG8_SA(1, 0), a3, voffA);
            PG8_BAR; PG8_WAIT_L(0); PG8_MMA(1, 0, At, B0); PG8_BAR; PG8_SCHED;
            PG8_STAGE(PG8_SB(1, 1), b3 + hstep, voffB);
            PG8_WAIT_V(6); PG8_BAR; PG8_MMA(1, 1, At, B1); PG8_BAR;
            }
        }
        if constexpr (ALIGN_EPI) { if (wr == 0) PG8_BAR; }
        if constexpr (!Epi::AFTER_DRAIN) { E(acc, cur, wr, wc, fr, fq); S.done(cur); }
        if (!has_next) break;
#pragma unroll
        for (int a = 0; a < 2; ++a)
#pragma unroll
            for (int b = 0; b < 2; ++b)
#pragma unroll
                for (int m = 0; m < 4; ++m)
#pragma unroll
                    for (int n = 0; n < 2; ++n) acc[a][b][m][n] = (f32x4){0.f, 0.f, 0.f, 0.f};
        cur = nxt; cA = nA; cB = nB; ++ui;
        if constexpr (ALIGN_EPI) { if (wr == 1) PG8_BAR; }
    }
    PG8_WAIT_V(0);
    if constexpr (!ALIGN_EPI) { if (wr == 0) PG8_BAR; }
    PG8_BAR;
    if constexpr (Epi::AFTER_DRAIN) { E.fused(acc, cur, wr, wc, fr, fq, lds, wid, lane); S.done(cur); }
#undef PG8_SA
#undef PG8_SB
#undef PG8_STAGE
#undef PG8_LDA
#undef PG8_LDB
#undef PG8_MMA
#undef PG8_WAIT_V
#undef PG8_WAIT_L
#undef PG8_BAR
#undef PG8_SCHED
}
}

#define LAS __attribute__((address_space(3)))
#define DEV __device__ __forceinline__
typedef unsigned short bf16_t;
typedef short bf16x8 __attribute__((ext_vector_type(8)));
typedef short s16x4 __attribute__((ext_vector_type(4)));
typedef float f32x4 __attribute__((ext_vector_type(4)));
typedef float f32x16 __attribute__((ext_vector_type(16)));
typedef unsigned u32x2 __attribute__((ext_vector_type(2)));
typedef unsigned u32x4 __attribute__((ext_vector_type(4)));
typedef unsigned u32x8 __attribute__((ext_vector_type(8)));

constexpr int NB = 8, SEQ = 4096, DM = 1024, TOK = NB * SEQ, FF = 2816, NL = 2, MEMLEN = 256;
constexpr int ZP = 3392;
constexpr int ZC_FQ = 0, ZC_RR = 256, ZC_MQ = 768, ZC_FK = 1024, ZC_FV = 1280, ZC_MK = 1536, ZC_MV = 1792, ZC_RK = 2048, ZC_RV = 2560, ZC_LO = 3072, ZC_FF = 3360, ZC_VALID = 3368;
constexpr float NORM_EPS = 1e-6f, GN_EPS = 64e-5f, LOG2E = 1.4426950408889634f;
constexpr float C2_64 = 0.125f * LOG2E, C2_128 = 0.08838834764831845f * LOG2E;
constexpr size_t MiB = 1u << 20;
constexpr size_t WS_CTL = 0;
constexpr size_t WS_W = 1 * MiB, WL_BYTES = 48 * MiB;
constexpr size_t OFF_F1I = 0, OFF_F1O = 11 * MiB, OFF_F2I = 17 * MiB, OFF_F2O = 28 * MiB, OFF_MI = 34 * MiB, OFF_MO = 41 * MiB, OFF_XQ = 43 * MiB, OFF_XKV = 44 * MiB, OFF_XO = 46 * MiB;
constexpr size_t OFF_W2T = 47 * MiB, OFF_A2T = OFF_W2T + 65536, OFF_G2T = OFF_A2T + 65536;
constexpr size_t WS_Z = 97 * MiB;
constexpr size_t WS_C = WS_Z + 212 * MiB;
constexpr size_t WS_HN = WS_C;
constexpr size_t WS_WD = WS_C, WS_KK = WS_C + 64 * MiB, WS_KA = WS_C + 96 * MiB;
constexpr size_t WS_VTF = WS_C + 128 * MiB, WS_VTM = WS_C + 144 * MiB;
constexpr size_t WS_LOGF = WS_C + 160 * MiB, WS_KMP = WS_LOGF + 512 * 1024, WS_ZHALO = WS_C + 161 * MiB;
constexpr size_t WS_KVX = WS_C + 165 * MiB, WS_VTX = WS_C + 173 * MiB, WS_MEMN = WS_C + 177 * MiB, WS_END = WS_C + 185 * MiB;
static_assert(WS_END <= 512 * MiB, "workspace map");
constexpr int LDS_BYTES = 131072 + 1024;

struct Args { const float* in[35]; float* out; unsigned char* ws; int ph_lo, ph_hi; };

DEV float bf2f(unsigned short b) { return __uint_as_float((unsigned)b << 16); }
typedef float f32x2_t __attribute__((ext_vector_type(2))); typedef __bf16 bf16x2_t __attribute__((ext_vector_type(2)));
DEV unsigned pk2(float lo, float hi) { const f32x2_t v = {lo, hi}; const bf16x2_t r = __builtin_convertvector(v, bf16x2_t); return __builtin_bit_cast(unsigned, r); }
DEV unsigned f2bf(float f) { return pk2(f, f) & 0xffffu; }
DEV float wave_sum(float v) {
#pragma unroll
    for (int o = 1; o < 64; o <<= 1) v += __shfl_xor(v, o);
    return v;
}
#define LDS_WAIT() asm volatile("s_waitcnt lgkmcnt(0)" ::: "memory")

struct MatInfo { const float* src; bf16_t* dst; int K, Ns, Nd, map; };
DEV MatInfo matinfo(const Args& a, int m) {
    const int l = m / 12, k = m % 12; unsigned char* wl = a.ws + WS_W + (size_t)l * WL_BYTES; MatInfo r;
    switch (k) {
    case 0:  r.src = a.in[4] + (size_t)l * DM * 2 * FF;  r.dst = (bf16_t*)(wl + OFF_F1I); r.K = DM; r.Ns = 2 * FF; r.Nd = 2 * FF; r.map = 1; break;
    case 1:  r.src = a.in[5] + (size_t)l * FF * DM;      r.dst = (bf16_t*)(wl + OFF_F1O); r.K = FF; r.Ns = DM; r.Nd = DM; r.map = 0; break;
    case 2:  r.src = a.in[33] + (size_t)l * DM * 2 * FF; r.dst = (bf16_t*)(wl + OFF_F2I); r.K = DM; r.Ns = 2 * FF; r.Nd = 2 * FF; r.map = 1; break;
    case 3:  r.src = a.in[34] + (size_t)l * FF * DM;     r.dst = (bf16_t*)(wl + OFF_F2O); r.K = FF; r.Ns = DM; r.Nd = DM; r.map = 0; break;
    case 4:  r.src = a.in[7] + (size_t)l * DM * 3364;    r.dst = (bf16_t*)(wl + OFF_MI);  r.K = DM; r.Ns = 3364; r.Nd = 3584; r.map = 2; break;
    case 5:  r.src = a.in[8] + (size_t)l * DM * DM;      r.dst = (bf16_t*)(wl + OFF_MO);  r.K = DM; r.Ns = DM; r.Nd = DM; r.map = 0; break;
    case 6:  r.src = a.in[27] + (size_t)l * DM * 512;    r.dst = (bf16_t*)(wl + OFF_XQ);  r.K = DM; r.Ns = 512; r.Nd = 512; r.map = 0; break;
    case 7:  r.src = a.in[28] + (size_t)l * DM * 1024;   r.dst = (bf16_t*)(wl + OFF_XKV); r.K = DM; r.Ns = 1024; r.Nd = 1024; r.map = 0; break;
    case 8:  r.src = a.in[31] + (size_t)l * 512 * DM;    r.dst = (bf16_t*)(wl + OFF_XO);  r.K = 512; r.Ns = DM; r.Nd = DM; r.map = 0; break;
    case 9:  r.src = a.in[16] + (size_t)l * 64 * 512;    r.dst = (bf16_t*)(wl + OFF_W2T); r.K = 64; r.Ns = 512; r.Nd = 512; r.map = 0; break;
    case 10: r.src = a.in[18] + (size_t)l * 64 * 512;    r.dst = (bf16_t*)(wl + OFF_A2T); r.K = 64; r.Ns = 512; r.Nd = 512; r.map = 0; break;
    default: r.src = a.in[19] + (size_t)l * 160 * 512;   r.dst = (bf16_t*)(wl + OFF_G2T); r.K = 160; r.Ns = 512; r.Nd = 512; r.map = 0; break;
    }
    return r;
}
DEV int srccol(int map, int n) {
    if (map == 0) return n;
    if (map == 1) { const int p = n >> 8, r = n & 255; return r < 128 ? p * 128 + r : FF + p * 128 + (r - 128); }
    if (n < 256) return n;
    if (n < 768) return 1540 + (n - 256);
    if (n < 1024) return 772 + (n - 768);
    if (n < 1280) return 256 + (n - 1024);
    if (n < 1536) return 512 + (n - 1280);
    if (n < 1792) return 1028 + (n - 1536);
    if (n < 2048) return 1284 + (n - 1792);
    if (n < 2560) return 2052 + (n - 2048);
    if (n < 3072) return 2564 + (n - 2560);
    if (n < 3360) return 3076 + (n - 3072);
    if (n < 3364) return 768 + (n - 3360);
    return -1;
}
DEV void transpose_item(const MatInfo& mi, LAS float* scr, int item, int lane) {
    const int nblk = mi.Nd / 32, kb = item / nblk, nb = item % nblk, k0 = 64 * kb, n0 = 32 * nb;
    const int n4 = (lane & 7) * 4, sc = srccol(mi.map, n0 + n4);
#pragma unroll
    for (int i = 0; i < 8; ++i) { const int kk = 8 * i + (lane >> 3), k = k0 + kk;
        const f32x4 v = (sc >= 0 && k < mi.K) ? *(const f32x4*)(mi.src + (size_t)k * mi.Ns + sc) : (f32x4){0.f, 0.f, 0.f, 0.f};
        LAS float* d = scr + kk * 33 + n4; d[0] = v[0]; d[1] = v[1]; d[2] = v[2]; d[3] = v[3]; }
    LDS_WAIT(); asm volatile("" ::: "memory");
    const int c = lane & 7;
#pragma unroll
    for (int j = 0; j < 4; ++j) { const int n = (lane >> 3) + 8 * j; const LAS float* s = scr + (8 * c) * 33 + n;
        u32x4 o; o.x = pk2(s[0 * 33], s[1 * 33]); o.y = pk2(s[2 * 33], s[3 * 33]); o.z = pk2(s[4 * 33], s[5 * 33]); o.w = pk2(s[6 * 33], s[7 * 33]);
        if (k0 + 8 * c < mi.K) *(u32x4*)(mi.dst + (size_t)(n0 + n) * mi.K + k0 + 8 * c) = o; }
    LDS_WAIT(); asm volatile("" ::: "memory");
}
DEV void norm_row(const float* xrow, const float* g, bf16_t* orow, int lane) {
    const f32x4* xr = (const f32x4*)xrow + lane; const f32x4* gr = (const f32x4*)g + lane;
    f32x4 v[4]; float s = 0.f;
#pragma unroll
    for (int j = 0; j < 4; ++j) { v[j] = xr[64 * j]; s += (v[j].x * v[j].x + v[j].y * v[j].y) + (v[j].z * v[j].z + v[j].w * v[j].w); }
    const float rstd = rsqrtf(wave_sum(s) * (1.f / DM) + NORM_EPS);
    u32x2* o8 = (u32x2*)orow + lane;
#pragma unroll
    for (int j = 0; j < 4; ++j) { const f32x4 gg = gr[64 * j]; u32x2 w; w.x = pk2(v[j].x * rstd * gg.x, v[j].y * rstd * gg.y); w.y = pk2(v[j].z * rstd * gg.z, v[j].w * rstd * gg.w); o8[64 * j] = w; }
}
DEV void norm_row2(const float* xa, const float* xb, const float* g, bf16_t* oa, bf16_t* ob, int lane) {
    const f32x4* xra = (const f32x4*)xa + lane; const f32x4* xrb = (const f32x4*)xb + lane; const f32x4* gr = (const f32x4*)g + lane;
    f32x4 va[4], vb[4]; float sa = 0.f, sb = 0.f;
#pragma unroll
    for (int j = 0; j < 4; ++j) { va[j] = xra[64 * j]; vb[j] = xrb[64 * j]; }
#pragma unroll
    for (int j = 0; j < 4; ++j) { sa += (va[j].x * va[j].x + va[j].y * va[j].y) + (va[j].z * va[j].z + va[j].w * va[j].w); sb += (vb[j].x * vb[j].x + vb[j].y * vb[j].y) + (vb[j].z * vb[j].z + vb[j].w * vb[j].w); }
#pragma unroll
    for (int o = 1; o < 64; o <<= 1) { sa += __shfl_xor(sa, o); sb += __shfl_xor(sb, o); }
    const float ra = rsqrtf(sa * (1.f / DM) + NORM_EPS), rb = rsqrtf(sb * (1.f / DM) + NORM_EPS);
    u32x2* o8a = (u32x2*)oa + lane; u32x2* o8b = (u32x2*)ob + lane;
#pragma unroll
    for (int j = 0; j < 4; ++j) { const f32x4 gg = gr[64 * j]; u32x2 w; w.x = pk2(va[j].x * ra * gg.x, va[j].y * ra * gg.y); w.y = pk2(va[j].z * ra * gg.z, va[j].w * ra * gg.w); o8a[64 * j] = w;
        w.x = pk2(vb[j].x * rb * gg.x, vb[j].y * rb * gg.y); w.y = pk2(vb[j].z * rb * gg.z, vb[j].w * rb * gg.w); o8b[64 * j] = w; }
}
DEV void norm_phase(const float* x, const float* g, bf16_t* out, int nrows, int gw, int NGW, int lane) {
    int m = gw;
    for (; m + NGW < nrows; m += 2 * NGW) norm_row2(x + (size_t)m * DM, x + (size_t)(m + NGW) * DM, g, out + (size_t)m * DM, out + (size_t)(m + NGW) * DM, lane);
    if (m < nrows) norm_row(x + (size_t)m * DM, g, out + (size_t)m * DM, lane);
}
DEV void p0_prologue(const Args& a, LAS unsigned char* lds, int gw, int NGW, int wid, int lane, int tid) {
    LAS float* scr = (LAS float*)(lds + wid * 8704);
    int base = 0;
    for (int m = 0; m < 24; ++m) {
        const MatInfo mi = matinfo(a, m); const int items = ((mi.K + 63) / 64) * (mi.Nd / 32);
        int first = gw - (base % NGW); if (first < 0) first += NGW;
        for (int it = first; it < items; it += NGW) transpose_item(mi, scr, it, lane);
        base += items;
    }
    for (int m = gw; m < NL * NB * MEMLEN; m += NGW) { const int l = m / (NB * MEMLEN), r = m % (NB * MEMLEN);
        norm_row(a.in[1] + (size_t)r * DM, a.in[26] + l * DM, (bf16_t*)(a.ws + WS_MEMN) + (size_t)m * DM, lane); }
    if (blockIdx.x == 0 && tid < 64) ((unsigned*)(a.ws + WS_CTL))[tid * 64] = 0u;
}
DEV void xkv_post(const Args& a, int gw, int NGW, int lane) {
    for (int it = gw; it < NL * NB * MEMLEN * 4; it += NGW) {
        const int hd = it & 3, row = (it >> 2) % (NB * MEMLEN), l = it / (4 * NB * MEMLEN), b = row / MEMLEN, m = row % MEMLEN;
        bf16_t* kr = (bf16_t*)(a.ws + WS_KVX) + ((size_t)l * NB * MEMLEN + row) * 1024 + hd * 128;
        const unsigned kv = *((const unsigned*)kr + lane); float k0 = bf2f(kv & 0xffff), k1 = bf2f(kv >> 16);
        const float rstd = rsqrtf(wave_sum(k0 * k0 + k1 * k1) * (1.f / 128) + NORM_EPS);
        const float* kg = a.in[30] + l * 128;
        *((unsigned*)kr + lane) = pk2(k0 * rstd * kg[2 * lane], k1 * rstd * kg[2 * lane + 1]);
        const unsigned vv = *((const unsigned*)(kr + 512) + lane);
        bf16_t* vt = (bf16_t*)(a.ws + WS_VTX) + (((size_t)(l * NB + b) * 4 + hd) * 128) * MEMLEN + m;
        vt[(size_t)(2 * lane) * MEMLEN] = (bf16_t)(vv & 0xffff); vt[(size_t)(2 * lane + 1) * MEMLEN] = (bf16_t)(vv >> 16);
    }
}

DEV float sigmoid_f(float x) { return __builtin_amdgcn_rcpf(1.0f + __builtin_amdgcn_exp2f(-LOG2E * x)); }
DEV float tanh_f(float x) { const float e = __builtin_amdgcn_exp2f(-2.f * LOG2E * fabsf(x)); const float t = (1.f - e) * __builtin_amdgcn_rcpf(1.f + e); return x < 0.f ? -t : t; }
DEV void unpack8(const u32x4 v, float (&f)[8]) {
    f[0] = __uint_as_float(v.x << 16); f[1] = __uint_as_float(v.x & 0xffff0000u); f[2] = __uint_as_float(v.y << 16); f[3] = __uint_as_float(v.y & 0xffff0000u);
    f[4] = __uint_as_float(v.z << 16); f[5] = __uint_as_float(v.z & 0xffff0000u); f[6] = __uint_as_float(v.w << 16); f[7] = __uint_as_float(v.w & 0xffff0000u);
}
DEV u32x4 pack8(const float (&f)[8]) { u32x4 o; o.x = pk2(f[0], f[1]); o.y = pk2(f[2], f[3]); o.z = pk2(f[4], f[5]); o.w = pk2(f[6], f[7]); return o; }
DEV int crow(int r, int hi) { return (r & 3) + 8 * (r >> 2) + 4 * hi; }

DEV void prep_tile(const Args& a, int l, int tile, LAS unsigned char* lds, bool dry = false) {
    int tid_ = threadIdx.x; asm volatile("" : "+v"(tid_)); const int tid = tid_, lane = tid & 63, wid = __builtin_amdgcn_readfirstlane(tid >> 6);
    const int row0 = tile * 64, b = row0 / SEQ, t0 = row0 % SEQ;
    bf16_t* Z = (bf16_t*)(a.ws + WS_Z) + (size_t)row0 * ZP;
    {
        const int ch = tid % 228, sub = tid / 228; const bool act = tid < 456;
        const int col = ch < 64 ? ZC_RR + 8 * ch : ZC_RK + 8 * (ch - 64), mi = ch < 64 ? 8 * ch : 512 + 8 * (ch - 64);
        const int ts = 32 * sub; float prev[8], mu[8];
#pragma unroll
        for (int i = 0; i < 8; ++i) { prev[i] = 0.f; mu[i] = 0.f; }
        if (act) {
            const float* mup = a.in[14] + l * 1824 + mi;
#pragma unroll
            for (int i = 0; i < 8; ++i) mu[i] = mup[i];
            if (sub == 1) unpack8(*(const u32x4*)(Z + (size_t)(ts - 1) * ZP + col), prev);
            else if (t0 != 0) unpack8(*(const u32x4*)((const bf16_t*)(a.ws + WS_ZHALO) + (size_t)(tile - 1) * ZP + col), prev);
        }
        __syncthreads();
        if (act) {
#pragma unroll 1
            for (int t8 = 0; t8 < 32; t8 += 8) { u32x4 raw[8];
#pragma unroll
                for (int tt = 0; tt < 8; ++tt) raw[tt] = *(const u32x4*)(Z + (size_t)(ts + t8 + tt) * ZP + col);
#pragma unroll
                for (int tt = 0; tt < 8; ++tt) { float cur[8], o[8]; unpack8(raw[tt], cur);
#pragma unroll
                    for (int i = 0; i < 8; ++i) { o[i] = cur[i] + (prev[i] - cur[i]) * mu[i]; prev[i] = cur[i]; }
                    if (!dry) *(u32x4*)(Z + (size_t)(ts + t8 + tt) * ZP + col) = pack8(o); } }
        }
    }
    LAS float* kbuf = (LAS float*)lds;
    {
        const float* gfq = a.in[10] + l * 64; const float* gfk = a.in[11] + l * 64; const float* gmq = a.in[12] + l * 64; const float* gmk = a.in[13] + l * 64;
        const int* pos = (const int*)a.in[2] + b * SEQ + t0;
#pragma unroll 2
        for (int it = 0; it < 16; ++it) {
            const int item = it * 512 + tid, g8 = item >> 3, sub8 = item & 7, slot = g8 >> 6, token = g8 & 63, h = slot & 3, kind = slot >> 2;
            const int cb = (kind == 0 ? ZC_FQ : kind == 1 ? ZC_FK : kind == 2 ? ZC_MQ : ZC_MK) + 64 * h + 8 * sub8;
            const float* gp = (kind == 0 ? gfq : kind == 1 ? gfk : kind == 2 ? gmq : gmk) + 8 * sub8;
            u32x4* p = (u32x4*)(Z + (size_t)token * ZP + cb); float v[8]; unpack8(*p, v);
            float ss = 0.f;
#pragma unroll
            for (int i = 0; i < 8; ++i) ss += v[i] * v[i];
            ss += __shfl_xor(ss, 1); ss += __shfl_xor(ss, 2); ss += __shfl_xor(ss, 4);
            const float rstd = rsqrtf(ss * (1.f / 64) + NORM_EPS);
#pragma unroll
            for (int i = 0; i < 8; ++i) v[i] = v[i] * rstd * gp[i];
            float pr[8];
#pragma unroll
            for (int i = 0; i < 8; ++i) pr[i] = __shfl_xor(v[i], 1);
            if (kind >= 2 && sub8 < 2) {
                const float posf = (float)pos[token];
#pragma unroll
                for (int i = 0; i < 8; ++i) {
                    const float invf = (float)__builtin_exp2(-(double)i * 0.125 * 18.931568569324174);
                    const float ang = posf * invf; const double rev = (double)ang * 0.15915494309189535; const float fr = (float)(rev - __builtin_floor(rev));
                    const float sn = __builtin_amdgcn_sinf(fr), cs = __builtin_amdgcn_cosf(fr);
                    v[i] = sub8 == 0 ? v[i] * cs - pr[i] * sn : v[i] * cs + pr[i] * sn; }
            }
            if (kind == 3) {
#pragma unroll
                for (int i = 0; i < 8; ++i) kbuf[(token * 4 + h) * 64 + 8 * sub8 + i] = v[i]; }
            if (kind == 0 || kind == 2) {
#pragma unroll
                for (int i = 0; i < 8; ++i) v[i] *= C2_64; }
            if (!dry) *p = pack8(v);
        }
    }
    __syncthreads();
    if (tid < 256) { const int h = tid >> 6, d = tid & 63; float s = 0.f;
        for (int t = 0; t < 64; ++t) s += kbuf[(t * 4 + h) * 64 + d];
        if (!dry) ((float*)(a.ws + WS_KMP))[(((size_t)(b * 4 + h) * 64) + (t0 >> 6)) * 64 + d] = s; }
#pragma unroll 2
    for (int it = 0; it < 8; ++it) {
        const int item = it * 512 + tid, which = item >> 11, rem = item & 2047, tg = rem >> 8, c = rem & 255;
        const bf16_t* src = Z + (size_t)(8 * tg) * ZP + (which ? ZC_MV : ZC_FV) + c; unsigned short e[8];
#pragma unroll
        for (int i = 0; i < 8; ++i) e[i] = src[(size_t)i * ZP];
        u32x4 o; o.x = e[0] | ((unsigned)e[1] << 16); o.y = e[2] | ((unsigned)e[3] << 16); o.z = e[4] | ((unsigned)e[5] << 16); o.w = e[6] | ((unsigned)e[7] << 16);
        bf16_t* vt = (bf16_t*)(a.ws + (which ? WS_VTM : WS_VTF)) + ((size_t)(b * 4 + (c >> 6)) * 64 + (c & 63)) * SEQ + t0 + 8 * tg;
        if (!dry) *(u32x4*)vt = o;
    }
    if (tid < 256) { const int token = tid >> 2, h = tid & 3; const float x = bf2f(Z[(size_t)token * ZP + ZC_FF + h]) + a.in[9][l * 4 + h];
        const float lf = fminf(x, 0.f) - __logf(1.f + __expf(-fabsf(x)));
        if (!dry) ((float*)(a.ws + WS_LOGF))[(size_t)(b * 4 + h) * SEQ + t0 + token] = lf; }
    __syncthreads();
    LAS bf16_t* al = (LAS bf16_t*)lds;
    for (int item = tid; item < 64 * 36; item += 512) { const int token = item / 36, c = item % 36; float v[8]; unpack8(*(const u32x4*)(Z + (size_t)token * ZP + ZC_LO + 8 * c), v);
        if (c < 8) {
#pragma unroll
            for (int i = 0; i < 8; ++i) v[i] = tanh_f(v[i]); }
        else if (c >= 16) {
#pragma unroll
            for (int i = 0; i < 8; ++i) v[i] = sigmoid_f(v[i]); }
        *(LAS u32x4*)(al + token * 296 + 8 * c) = pack8(v); }
    __syncthreads();
    const unsigned char* wl = a.ws + WS_W + (size_t)l * WL_BYTES;
    const bf16_t* w2t = (const bf16_t*)(wl + OFF_W2T); const bf16_t* a2t = (const bf16_t*)(wl + OFF_A2T); const bf16_t* g2t = (const bf16_t*)(wl + OFF_G2T);
    const int r32 = lane & 31, hi = lane >> 5;
    for (int uu = 0; uu < 2; ++uu) {
        const int u = wid + 8 * uu, h = u & 7, th = u >> 3, token = 32 * th + r32;
        f32x16 aw[2], aa[2], ag[2];
#pragma unroll
        for (int ct = 0; ct < 2; ++ct) { aw[ct] = f32x16{}; aa[ct] = f32x16{}; ag[ct] = f32x16{}; }
        const LAS bf16_t* arow = al + token * 296 + 8 * hi;
#pragma unroll 1
        for (int ks = 0; ks < 4; ++ks) { const bf16x8 bw = *(const LAS bf16x8*)(arow + 16 * ks), ba = *(const LAS bf16x8*)(arow + 64 + 16 * ks);
#pragma unroll
            for (int ct = 0; ct < 2; ++ct) { const int chn = 64 * h + 32 * ct + r32;
                aw[ct] = __builtin_amdgcn_mfma_f32_32x32x16_bf16(*(const bf16x8*)(w2t + chn * 64 + 16 * ks + 8 * hi), bw, aw[ct], 0, 0, 0);
                aa[ct] = __builtin_amdgcn_mfma_f32_32x32x16_bf16(*(const bf16x8*)(a2t + chn * 64 + 16 * ks + 8 * hi), ba, aa[ct], 0, 0, 0); } }
#pragma unroll 1
        for (int ks = 0; ks < 10; ++ks) { const bf16x8 bg = *(const LAS bf16x8*)(arow + 128 + 16 * ks);
#pragma unroll
            for (int ct = 0; ct < 2; ++ct) { const int chn = 64 * h + 32 * ct + r32;
                ag[ct] = __builtin_amdgcn_mfma_f32_32x32x16_bf16(*(const bf16x8*)(g2t + chn * 160 + 16 * ks + 8 * hi), bg, ag[ct], 0, 0, 0); } }
        bf16_t* zr = Z + (size_t)token * ZP; const size_t grow = (size_t)(row0 + token);
        float* wd = (float*)(a.ws + WS_WD) + grow * 512; bf16_t* kkp = (bf16_t*)(a.ws + WS_KK) + grow * 512; bf16_t* kap = (bf16_t*)(a.ws + WS_KA) + grow * 512;
        const float* w0 = a.in[15] + l * 512; const float* a0 = a.in[17] + l * 512; const float* k_k = a.in[20] + l * 512; const float* k_a = a.in[21] + l * 512;
        float ss = 0.f;
#pragma unroll
        for (int ct = 0; ct < 2; ++ct)
#pragma unroll
            for (int rg = 0; rg < 4; ++rg) { const int c0 = 64 * h + 32 * ct + 8 * rg + 4 * hi;
                const u32x2 kraw = *(const u32x2*)(zr + ZC_RK + c0); const f32x4 w04 = *(const f32x4*)(w0 + c0), a04 = *(const f32x4*)(a0 + c0), kk4 = *(const f32x4*)(k_k + c0);
                f32x4 dec; u32x2 gp; float gv[4];
#pragma unroll
                for (int i = 0; i < 4; ++i) { const int r = 4 * rg + i;
                    const float kv = (i < 2) ? __uint_as_float((i & 1) ? (kraw.x & 0xffff0000u) : (kraw.x << 16)) : __uint_as_float((i & 1) ? (kraw.y & 0xffff0000u) : (kraw.y << 16));
                    const float wr_ = w04[i] + aw[ct][r]; const float sp = fmaxf(-wr_, 0.f) + __logf(1.f + __expf(-fabsf(wr_)));
                    dec[i] = __expf(-__expf(-sp - 0.5f));
                    aa[ct][r] = sigmoid_f(a04[i] + aa[ct][r]);
                    gv[i] = ag[ct][r];
                    const float kkv = kv * kk4[i]; aw[ct][r] = kkv; ss += kkv * kkv; }
                if (!dry) *(f32x4*)(wd + c0) = dec;
                gp.x = pk2(gv[0], gv[1]); gp.y = pk2(gv[2], gv[3]);
                if (!dry) *(u32x2*)(zr + (c0 < 256 ? ZC_FV + c0 : ZC_MV + (c0 - 256))) = gp; __builtin_amdgcn_sched_barrier(0); }
        ss += __shfl_xor(ss, 32);
        const float inv = 1.f / fmaxf(sqrtf(ss), 1e-12f);
#pragma unroll
        for (int ct = 0; ct < 2; ++ct)
#pragma unroll
            for (int rg = 0; rg < 4; ++rg) { const int c0 = 64 * h + 32 * ct + 8 * rg + 4 * hi; const f32x4 ka4 = *(const f32x4*)(k_a + c0);
                const u32x2 kraw = *(const u32x2*)(zr + ZC_RK + c0); const float kf4[4] = {bf2f(kraw.x & 0xffff), __uint_as_float(kraw.x & 0xffff0000u), bf2f(kraw.y & 0xffff), __uint_as_float(kraw.y & 0xffff0000u)};
                float kk[4], ka[4], kp[4];
#pragma unroll
                for (int i = 0; i < 4; ++i) { const int r = 4 * rg + i; kk[i] = aw[ct][r] * inv; ka[i] = kk[i] * aa[ct][r]; kp[i] = kf4[i] * (1.f + (aa[ct][r] - 1.f) * ka4[i]); }
                u32x2 o; o.x = pk2(kk[0], kk[1]); o.y = pk2(kk[2], kk[3]); if (!dry) *(u32x2*)(kkp + c0) = o;
                o.x = pk2(ka[0], ka[1]); o.y = pk2(ka[2], ka[3]); if (!dry) *(u32x2*)(kap + c0) = o;
                o.x = pk2(kp[0], kp[1]); o.y = pk2(kp[2], kp[3]); if (!dry) *(u32x2*)(zr + ZC_RK + c0) = o; __builtin_amdgcn_sched_barrier(0); }
    }
    __syncthreads();
}

template <int MODE, int D>
DEV void attn_unit(LAS unsigned char* lds, const bf16_t* Qp, int ldq, const bf16_t* Kp, int ldk, const bf16_t* Vt, int ldv, bf16_t* Op, int ldo,
                   int q0, int ntiles, int qb, const float* aux, const float* qgain, bool dry = false) {
    constexpr int KP = D + 8, KBYTES = 64 * KP * 2, VP = 72, VBYTES = D * VP * 2, NLD = D / 64;
    int tid_ = threadIdx.x; asm volatile("" : "+v"(tid_)); const int tid = tid_, lane = tid & 63, wid = __builtin_amdgcn_readfirstlane(tid >> 6), r32 = lane & 31, hi = lane >> 5;
    LAS float* cl = (LAS float*)lds; LAS unsigned* selm = (LAS unsigned*)(lds + 8192);
    LAS unsigned char* kb = lds + 16384; LAS unsigned char* vb = kb + 2 * KBYTES;
    const int q = q0 + wid * 32 + r32;
    if (MODE == 0) {
        const int n = 64 * ntiles; float v[8]; float run = 0.f;
#pragma unroll
        for (int i = 0; i < 8; ++i) { const int idx = 8 * tid + i; v[i] = idx < n ? aux[idx] : 0.f; run += v[i]; v[i] = run; }
        float sc = run;
#pragma unroll
        for (int o = 1; o < 64; o <<= 1) { const float t = __shfl_up(sc, o); if (lane >= o) sc += t; }
        LAS float* wsum = (LAS float*)kb;
        if (lane == 63) wsum[wid] = sc;
        __syncthreads();
        float off = sc - run;
        for (int w = 0; w < wid; ++w) off += wsum[w];
#pragma unroll
        for (int i = 0; i < 8; ++i) cl[8 * tid + i] = (off + v[i]) * LOG2E;
    }
    if (MODE == 1) {
        LAS float* km = cl;
        for (int e = tid; e < 16 * 64; e += 512) { const int nblk = e >> 6, d = e & 63; const float* pp = aux + (size_t)(4 * nblk) * 64 + d;
            km[e] = ((pp[0] + pp[64]) + (pp[128] + pp[192])) * (1.f / 256); }
        __syncthreads();
        if (tid < 256) { const bf16_t* qr = Qp + (size_t)(q0 + tid) * ldq; float g[16];
#pragma unroll
            for (int nb = 0; nb < 16; ++nb) g[nb] = 0.f;
            for (int c = 0; c < 8; ++c) { float qv[8]; unpack8(*(const u32x4*)(qr + 8 * c), qv);
#pragma unroll
                for (int nb = 0; nb < 16; ++nb) {
#pragma unroll
                    for (int i = 0; i < 8; ++i) g[nb] += qv[i] * km[nb * 64 + 8 * c + i]; } }
            unsigned m = 0u;
#pragma unroll
            for (int pick = 0; pick < 3; ++pick) { float best = -INFINITY; int bi = -1;
#pragma unroll
                for (int nb = 0; nb < 16; ++nb) { if (nb < qb && !((m >> nb) & 1u) && g[nb] > best) { best = g[nb]; bi = nb; } }
                if (bi >= 0) m |= 1u << bi; }
            selm[tid] = m; }
    }
    bf16x8 qf[D / 16];
#pragma unroll
    for (int d0 = 0; d0 < D / 16; ++d0) qf[d0] = *(const bf16x8*)(Qp + (size_t)q * ldq + d0 * 16 + hi * 8);
    if (MODE == 2) {
        float ss = 0.f;
#pragma unroll
        for (int d0 = 0; d0 < D / 16; ++d0) { float qv[8]; unpack8(__builtin_bit_cast(u32x4, qf[d0]), qv);
#pragma unroll
            for (int i = 0; i < 8; ++i) ss += qv[i] * qv[i]; }
        ss += __shfl_xor(ss, 32);
        const float rstd = rsqrtf(ss * (1.f / D) + NORM_EPS) * C2_128;
#pragma unroll
        for (int d0 = 0; d0 < D / 16; ++d0) { float qv[8]; unpack8(__builtin_bit_cast(u32x4, qf[d0]), qv);
#pragma unroll
            for (int i = 0; i < 8; ++i) qv[i] = qv[i] * rstd * qgain[d0 * 16 + hi * 8 + i];
            qf[d0] = __builtin_bit_cast(bf16x8, pack8(qv)); __builtin_amdgcn_sched_barrier(0); }
    }
    float mrun = -INFINITY, lrun = 0.f; f32x16 o[D / 32];
#pragma unroll
    for (int dt = 0; dt < D / 32; ++dt) o[dt] = f32x16{};
    __syncthreads();
    const float cq = (MODE == 0) ? cl[q] : 0.f;
    const unsigned sel = (MODE == 1) ? selm[wid * 32 + r32] : 0u;
    u32x4 kreg[NLD], vreg[NLD];
#define ATT_LOAD(t) do { _Pragma("unroll") for (int i_ = 0; i_ < NLD; ++i_) { const int idx_ = tid + 512 * i_; \
        kreg[i_] = *(const u32x4*)(Kp + (size_t)(64 * (t) + idx_ / (D / 8)) * ldk + (idx_ % (D / 8)) * 8); \
        vreg[i_] = *(const u32x4*)(Vt + (size_t)(idx_ >> 3) * ldv + 64 * (t) + (idx_ & 7) * 8); } } while (0)
#define ATT_STORE(buf) do { _Pragma("unroll") for (int i_ = 0; i_ < NLD; ++i_) { const int idx_ = tid + 512 * i_; \
        *(LAS u32x4*)(kb + (buf) * KBYTES + ((idx_ / (D / 8)) * KP + (idx_ % (D / 8)) * 8) * 2) = kreg[i_]; \
        *(LAS u32x4*)(vb + (buf) * VBYTES + ((idx_ >> 3) * VP + (idx_ & 7) * 8) * 2) = vreg[i_]; } } while (0)
    ATT_LOAD(0); ATT_STORE(0);
    __syncthreads();
    for (int t = 0; t < ntiles; ++t) {
        const int buf = t & 1, key0 = 64 * t;
        if (t + 1 < ntiles) ATT_LOAD(t + 1);
        bool work = true; const int nblk = key0 >> 8;
        if (MODE == 0) work = key0 <= q0 + wid * 32 + 31;
        if (MODE == 1) work = (nblk == qb) ? (key0 <= q0 + wid * 32 + 31) : (__any((sel >> nblk) & 1u) != 0);
        if (work) {
            const LAS unsigned char* kt = kb + buf * KBYTES; const LAS unsigned char* vt = vb + buf * VBYTES;
            constexpr int NKH = (D == 64) ? 2 : 1;
#pragma unroll 1
            for (int ks = 0; ks < 2 / NKH; ++ks) {
            f32x16 p[NKH];
#pragma unroll
            for (int kh = 0; kh < NKH; ++kh) { p[kh] = f32x16{}; const int khh = ks * NKH + kh;
#pragma unroll
                for (int d0 = 0; d0 < D / 16; ++d0) { const bf16x8 kf = *(const LAS bf16x8*)(kt + ((32 * khh + r32) * KP + 16 * d0 + 8 * hi) * 2);
                    p[kh] = __builtin_amdgcn_mfma_f32_32x32x16_bf16(kf, qf[d0], p[kh], 0, 0, 0); } }
            if (MODE == 0) {
#pragma unroll
                for (int kh = 0; kh < NKH; ++kh)
#pragma unroll
                    for (int rg = 0; rg < 4; ++rg) { const int kk0 = key0 + 32 * (ks * NKH + kh) + 8 * rg + 4 * hi; const f32x4 ck = *(const LAS f32x4*)(cl + kk0);
#pragma unroll
                        for (int i = 0; i < 4; ++i) { const float s = p[kh][4 * rg + i] + (cq - ck[i]); p[kh][4 * rg + i] = (kk0 + i > q) ? -INFINITY : s; } }
            }
            if (MODE == 1) {
                if (nblk == qb) {
#pragma unroll
                    for (int kh = 0; kh < NKH; ++kh)
#pragma unroll
                        for (int r = 0; r < 16; ++r) { if (key0 + 32 * (ks * NKH + kh) + crow(r, hi) > q) p[kh][r] = -INFINITY; }
                } else if (!((sel >> nblk) & 1u)) {
#pragma unroll
                    for (int kh = 0; kh < NKH; ++kh)
#pragma unroll
                        for (int r = 0; r < 16; ++r) p[kh][r] = -INFINITY;
                }
            }
            float mx = p[0][0];
#pragma unroll
            for (int kh = 0; kh < NKH; ++kh)
#pragma unroll
                for (int r = 0; r < 16; ++r) mx = fmaxf(mx, p[kh][r]);
            mx = fmaxf(mx, __shfl_xor(mx, 32));
            const float mnew = fmaxf(mrun, mx), muse = (mnew == -INFINITY) ? 0.f : mnew;
            const float alpha = __builtin_amdgcn_exp2f(mrun - muse);
            mrun = mnew; lrun *= alpha;
            if (__any(alpha != 1.0f)) {
#pragma unroll
                for (int dt = 0; dt < D / 32; ++dt) o[dt] *= alpha; }
            float ps = 0.f;
#pragma unroll
            for (int kh = 0; kh < NKH; ++kh)
#pragma unroll
                for (int r = 0; r < 16; ++r) { p[kh][r] = __builtin_amdgcn_exp2f(p[kh][r] - muse); ps += p[kh][r]; }
            lrun += ps;
            bf16x8 pb[NKH][2];
#pragma unroll
            for (int kh = 0; kh < NKH; ++kh)
#pragma unroll
                for (int j = 0; j < 2; ++j) { u32x4 w; w.x = pk2(p[kh][8 * j + 0], p[kh][8 * j + 1]); w.y = pk2(p[kh][8 * j + 2], p[kh][8 * j + 3]); w.z = pk2(p[kh][8 * j + 4], p[kh][8 * j + 5]); w.w = pk2(p[kh][8 * j + 6], p[kh][8 * j + 7]);
                    pb[kh][j] = __builtin_bit_cast(bf16x8, w); }
#pragma unroll
            for (int dt = 0; dt < D / 32; ++dt)
#pragma unroll
                for (int kh = 0; kh < NKH; ++kh)
#pragma unroll
                    for (int j = 0; j < 2; ++j) { const LAS unsigned char* vp_ = vt + ((32 * dt + r32) * VP + 32 * (ks * NKH + kh) + 16 * j + 4 * hi) * 2;
                        const u32x2 lo = *(const LAS u32x2*)vp_, hh = *(const LAS u32x2*)(vp_ + 16); u32x4 w; w.x = lo.x; w.y = lo.y; w.z = hh.x; w.w = hh.y;
                        o[dt] = __builtin_amdgcn_mfma_f32_32x32x16_bf16(__builtin_bit_cast(bf16x8, w), pb[kh][j], o[dt], 0, 0, 0); }
            }
        }
        if (t + 1 < ntiles) ATT_STORE(buf ^ 1);
        __syncthreads();
    }
#undef ATT_LOAD
#undef ATT_STORE
    lrun += __shfl_xor(lrun, 32);
    const float inv = 1.f / lrun;
    bf16_t* orow = Op + (size_t)q * ldo;
    if (!dry)
#pragma unroll
    for (int dt = 0; dt < D / 32; ++dt)
#pragma unroll
        for (int rg = 0; rg < 4; ++rg) { u32x2 w; w.x = pk2(o[dt][4 * rg] * inv, o[dt][4 * rg + 1] * inv); w.y = pk2(o[dt][4 * rg + 2] * inv, o[dt][4 * rg + 3] * inv);
            *(u32x2*)(orow + 32 * dt + 8 * rg + 4 * hi) = w; }
    __syncthreads();
}

constexpr int RW_NCH = SEQ / 16;
constexpr int RW_ARP = 72, RW_BKTP = 32, RW_VTP = 24, RW_PMP = 16, RW_LP = 20;
constexpr int RW_NBUF = 6, RW_NPRE = 4;
constexpr int RW_DB = 15104, RW_AR = 0, RW_BKT = 4608, RW_VT = 8704, RW_GC = 11776, RW_TM = 12032, RW_PM1 = 13056, RW_PM2 = 14080;
constexpr int RW_PRIV = RW_NBUF * RW_DB, RW_PRIV_BYTES = 5888, RW_PBK = 0, RW_PLAB = 4608;
constexpr int RW_YB = RW_PRIV + RW_NPRE * RW_PRIV_BYTES, RW_FLG = RW_YB + 2 * 4096, RW_SLOT_BYTES = RW_FLG + 64;
static_assert(RW_PM2 + 32 * RW_PMP * 2 == RW_DB && RW_TM + 32 * RW_PMP * 2 == RW_PM1 && RW_SLOT_BYTES <= 131072 && RW_DB % 16 == 0 && RW_PRIV_BYTES % 16 == 0, "rwkv lds map");
DEV bf16x8 pack_acc8(const f32x16& v, int base) { u32x4 w; w.x = pk2(v[base], v[base + 1]); w.y = pk2(v[base + 2], v[base + 3]); w.z = pk2(v[base + 4], v[base + 5]); w.w = pk2(v[base + 6], v[base + 7]); return __builtin_bit_cast(bf16x8, w); }
DEV int fresh_lane() { int l_; asm volatile("v_mbcnt_lo_u32_b32 %0, -1, 0\n\tv_mbcnt_hi_u32_b32 %0, -1, %0" : "=v"(l_)); return l_; }
DEV void rw_wait(volatile LAS unsigned* f, unsigned target) { while (*f < target) __builtin_amdgcn_s_sleep(1); asm volatile("" ::: "memory"); }
DEV void rw_post_flag(volatile LAS unsigned* f, unsigned v) { asm volatile("s_waitcnt vmcnt(0) lgkmcnt(0)" ::: "memory"); *f = v; }
DEV bf16x8 frag_perm(const LAS bf16_t* rowp, int hi) { const u32x2 lo = *(const LAS u32x2*)(rowp + 4 * hi), hh = *(const LAS u32x2*)(rowp + 8 + 4 * hi); u32x4 w; w.x = lo.x; w.y = lo.y; w.z = hh.x; w.w = hh.y; return __builtin_bit_cast(bf16x8, w); }

struct RwRaw { float w[16]; unsigned short kk[16], ka[16], kp[16], rr[16], vr[16]; };
DEV void rwkv_pre_load(RwRaw& R, int c, const float* WDp, const bf16_t* KKp, const bf16_t* KAp, const bf16_t* Zl) {
#pragma unroll
    for (int t = 0; t < 16; ++t) { const size_t ro = (size_t)(16 * c + t);
        R.w[t] = WDp[ro * 512]; R.kk[t] = KKp[ro * 512]; R.ka[t] = KAp[ro * 512]; R.kp[t] = Zl[ro * ZP + ZC_RK]; R.rr[t] = Zl[ro * ZP + ZC_RR]; R.vr[t] = Zl[ro * ZP + ZC_RV]; }
}
DEV void rwkv_pre_a(const RwRaw& R, int c, LAS unsigned char* sl, volatile LAS unsigned* flg, int lane) {
    const int bi = c % RW_NBUF, pw = c % RW_NPRE;
    LAS bf16_t* BK = (LAS bf16_t*)(sl + RW_PRIV + pw * RW_PRIV_BYTES + RW_PBK);
    LAS unsigned char* db = sl + bi * RW_DB;
    LAS bf16_t* AR = (LAS bf16_t*)(db + RW_AR); LAS bf16_t* BKT = (LAS bf16_t*)(db + RW_BKT); LAS bf16_t* VT = (LAS bf16_t*)(db + RW_VT); LAS float* GC = (LAS float*)(db + RW_GC);
    if (c >= RW_NBUF) rw_wait(flg + 6 + bi, (unsigned)(c - RW_NBUF + 1));
    float g = 1.f; unsigned bkt[16];
#pragma unroll
    for (int t = 0; t < 16; ++t) {
        const float w = R.w[t], kk = bf2f(R.kk[t]), ka = bf2f(R.ka[t]), kp = bf2f(R.kp[t]), rr = bf2f(R.rr[t]);
        const float at = -kk * g; g *= w; const float inv = __builtin_amdgcn_rcpf(g);
        const unsigned bt = f2bf(ka * inv), kt = f2bf(kp * inv);
        AR[t * RW_ARP + lane] = (bf16_t)f2bf(at); AR[(16 + t) * RW_ARP + lane] = (bf16_t)f2bf(rr * g);
        BK[t * RW_ARP + lane] = (bf16_t)bt; BK[(16 + t) * RW_ARP + lane] = (bf16_t)kt;
        if (t & 1) { bkt[t >> 1] |= bt << 16; bkt[8 + (t >> 1)] |= kt << 16; } else { bkt[t >> 1] = bt; bkt[8 + (t >> 1)] = kt; }
    }
    GC[lane] = g;
#pragma unroll
    for (int q4 = 0; q4 < 4; ++q4) { u32x4 w4; w4.x = bkt[4 * q4]; w4.y = bkt[4 * q4 + 1]; w4.z = bkt[4 * q4 + 2]; w4.w = bkt[4 * q4 + 3]; *(LAS u32x4*)(BKT + lane * RW_BKTP + 8 * q4) = w4; }
    { unsigned vv[8];
#pragma unroll
      for (int t = 0; t < 16; ++t) { const unsigned x = R.vr[t]; if (t & 1) vv[t >> 1] |= x << 16; else vv[t >> 1] = x; }
      u32x4 v0; v0.x = vv[0]; v0.y = vv[1]; v0.z = vv[2]; v0.w = vv[3]; u32x4 v1; v1.x = vv[4]; v1.y = vv[5]; v1.z = vv[6]; v1.w = vv[7];
      *(LAS u32x4*)(VT + lane * RW_VTP) = v0; *(LAS u32x4*)(VT + lane * RW_VTP + 8) = v1; }
}
DEV void rwkv_pre_b(int c, LAS unsigned char* sl, volatile LAS unsigned* flg, int lane) {
    const int r32 = lane & 31, hi = lane >> 5, bi = c % RW_NBUF, pw = c % RW_NPRE;
    LAS bf16_t* BK = (LAS bf16_t*)(sl + RW_PRIV + pw * RW_PRIV_BYTES + RW_PBK); LAS float* LAB = (LAS float*)(sl + RW_PRIV + pw * RW_PRIV_BYTES + RW_PLAB);
    LAS unsigned char* db = sl + bi * RW_DB;
    LAS bf16_t* AR = (LAS bf16_t*)(db + RW_AR); LAS bf16_t* TM = (LAS bf16_t*)(db + RW_TM); LAS bf16_t* PM1 = (LAS bf16_t*)(db + RW_PM1); LAS bf16_t* PM2 = (LAS bf16_t*)(db + RW_PM2);
    f32x16 P = f32x16{};
#pragma unroll
    for (int ks = 0; ks < 4; ++ks) P = __builtin_amdgcn_mfma_f32_32x32x16_bf16(*(const LAS bf16x8*)(AR + r32 * RW_ARP + 16 * ks + 8 * hi), *(const LAS bf16x8*)(BK + r32 * RW_ARP + 16 * ks + 8 * hi), P, 0, 0, 0);
    const int n = r32;
#pragma unroll
    for (int r = 0; r < 16; ++r) { const int m = crow(r, hi);
        if (r < 8) { if (n < 16) LAB[m * RW_LP + n] = (n < m) ? P[r] : 0.f; else PM1[m * RW_PMP + (n - 16)] = (bf16_t)f2bf((n - 16 < m) ? P[r] : 0.f); }
        else { if (n < 16) PM2[m * RW_PMP + n] = (bf16_t)f2bf((n <= m - 16) ? P[r] : 0.f); else PM1[m * RW_PMP + (n - 16)] = (bf16_t)f2bf((n - 16 <= m - 16) ? P[r] : 0.f); } }
}
DEV void rwkv_pre_c(int c, LAS unsigned char* sl, volatile LAS unsigned* flg, int lane) {
    const int bi = c % RW_NBUF, pw = c % RW_NPRE;
    const LAS float* LAB = (const LAS float*)(sl + RW_PRIV + pw * RW_PRIV_BYTES + RW_PLAB); LAS bf16_t* TM = (LAS bf16_t*)(sl + bi * RW_DB + RW_TM);
    { const int cc = lane & 15; float T[16];
#pragma unroll
      for (int t = 0; t < 16; ++t) { float acc = (t == cc) ? 1.f : 0.f;
          int z = 0; if (t >= 3) asm volatile("v_and_b32 %0, 0, %1" : "=v"(z) : "v"(T[t - 3]));
          const LAS float* lrow = LAB + t * RW_LP + z;
#pragma unroll
          for (int tau = 0; tau < t; ++tau) acc = fmaf(lrow[tau], T[tau], acc);
          T[t] = acc; }
      if (lane < 16) {
#pragma unroll
          for (int t = 0; t < 16; ++t) TM[t * RW_PMP + cc] = (bf16_t)f2bf(T[t]); } }
    asm volatile("s_waitcnt lgkmcnt(0)" ::: "memory"); flg[bi] = (unsigned)(c + 1);
}
DEV void rwkv_pre(const Args& a, int b, int h, LAS unsigned char* sl, int par) {
    const int lane = fresh_lane();
    volatile LAS unsigned* flg = (volatile LAS unsigned*)(sl + RW_FLG);
    const size_t rowb = (size_t)b * SEQ;
    const bf16_t* Zl = (const bf16_t*)(a.ws + WS_Z) + rowb * ZP + h * 64 + lane;
    const float* WDp = (const float*)(a.ws + WS_WD) + rowb * 512 + h * 64 + lane;
    const bf16_t* KKp = (const bf16_t*)(a.ws + WS_KK) + rowb * 512 + h * 64 + lane;
    const bf16_t* KAp = (const bf16_t*)(a.ws + WS_KA) + rowb * 512 + h * 64 + lane;
    for (int bz = par; bz < RW_NBUF; bz += RW_NPRE) for (int e = lane; e < 32 * RW_PMP; e += 64) { ((LAS bf16_t*)(sl + bz * RW_DB + RW_PM2))[e] = 0; ((LAS bf16_t*)(sl + bz * RW_DB + RW_TM))[e] = 0; }
    RwRaw R;
    rwkv_pre_load(R, par, WDp, KKp, KAp, Zl);
#pragma unroll 1
    for (int c = par; c < RW_NCH; c += RW_NPRE) {
        rwkv_pre_a(R, c, sl, flg, lane);
        rwkv_pre_b(c, sl, flg, lane);
        asm volatile("" ::: "memory");
        rwkv_pre_load(R, (c + RW_NPRE < RW_NCH) ? c + RW_NPRE : c, WDp, KKp, KAp, Zl);
#if !defined(NOPREC)
        rwkv_pre_c(c, sl, flg, lane);
#endif
    }
}

DEV void rwkv_main(LAS unsigned char* sl) {
    const int lane = fresh_lane(), r32 = lane & 31, hi = lane >> 5;
    volatile LAS unsigned* flg = (volatile LAS unsigned*)(sl + RW_FLG);
    f32x16 ST[2][2];
#pragma unroll
    for (int jt = 0; jt < 2; ++jt)
#pragma unroll
        for (int it = 0; it < 2; ++it) ST[jt][it] = f32x16{};
#pragma unroll 1
    for (int c = 0; c < RW_NCH; ++c) {
        const int bi = c % RW_NBUF;
        LAS unsigned char* db = sl + bi * RW_DB;
        const LAS bf16_t* AR = (const LAS bf16_t*)(db + RW_AR); const LAS bf16_t* BKT = (const LAS bf16_t*)(db + RW_BKT); const LAS bf16_t* VT = (const LAS bf16_t*)(db + RW_VT);
        const LAS float* GC = (const LAS float*)(db + RW_GC); const LAS bf16_t* TM = (const LAS bf16_t*)(db + RW_TM); const LAS bf16_t* PM1 = (const LAS bf16_t*)(db + RW_PM1); const LAS bf16_t* PM2 = (const LAS bf16_t*)(db + RW_PM2);
        LAS float* YB = (LAS float*)(sl + RW_YB + (c & 1) * 4096);
        rw_wait(flg + bi, (unsigned)(c + 1));
        f32x16 X[2]; X[0] = f32x16{}; X[1] = f32x16{};
#pragma unroll
        for (int jt = 0; jt < 2; ++jt)
#pragma unroll
            for (int rgp = 0; rgp < 2; ++rgp) { const bf16x8 af = frag_perm(AR + r32 * RW_ARP + 32 * jt + 16 * rgp, hi);
#pragma unroll
                for (int it = 0; it < 2; ++it) X[it] = __builtin_amdgcn_mfma_f32_32x32x16_bf16(af, pack_acc8(ST[jt][it], 8 * rgp), X[it], 0, 0, 0); }
        bf16x8 vt[2];
        { const bf16x8 a1 = *(const LAS bf16x8*)(PM1 + r32 * RW_PMP + 8 * hi);
#pragma unroll
          for (int it = 0; it < 2; ++it) { vt[it] = *(const LAS bf16x8*)(VT + (32 * it + r32) * RW_VTP + 8 * hi); X[it] = __builtin_amdgcn_mfma_f32_32x32x16_bf16(a1, vt[it], X[it], 0, 0, 0); } }
        bf16x8 ub[2];
        { const bf16x8 ta = frag_perm(TM + r32 * RW_PMP, hi), pm2 = frag_perm(PM2 + r32 * RW_PMP, hi);
#pragma unroll
          for (int it = 0; it < 2; ++it) { const f32x16 U = __builtin_amdgcn_mfma_f32_32x32x16_bf16(ta, pack_acc8(X[it], 0), f32x16{}, 0, 0, 0);
              ub[it] = pack_acc8(U, 0); X[it] = __builtin_amdgcn_mfma_f32_32x32x16_bf16(pm2, ub[it], X[it], 0, 0, 0); } }
        if (c >= 2) rw_wait(flg + 14 + (c & 1), (unsigned)(c - 1));
#pragma unroll
        for (int it = 0; it < 2; ++it)
#pragma unroll
            for (int r = 8; r < 16; ++r) YB[(crow(r, hi) - 16) * 64 + 32 * it + r32] = X[it][r];
        rw_post_flag(flg + 12 + (c & 1), (unsigned)(c + 1));
#pragma unroll
        for (int jt = 0; jt < 2; ++jt) { const bf16x8 a0 = frag_perm(BKT + (32 * jt + r32) * RW_BKTP, hi), a1 = *(const LAS bf16x8*)(BKT + (32 * jt + r32) * RW_BKTP + 16 + 8 * hi);
#pragma unroll
            for (int it = 0; it < 2; ++it) { ST[jt][it] = __builtin_amdgcn_mfma_f32_32x32x16_bf16(a0, ub[it], ST[jt][it], 0, 0, 0);
                ST[jt][it] = __builtin_amdgcn_mfma_f32_32x32x16_bf16(a1, vt[it], ST[jt][it], 0, 0, 0); }
#pragma unroll
            for (int rg = 0; rg < 4; ++rg) { const f32x4 g4 = *(const LAS f32x4*)(GC + 32 * jt + 8 * rg + 4 * hi);
#pragma unroll
                for (int e = 0; e < 4; ++e) { ST[jt][0][4 * rg + e] *= g4[e]; ST[jt][1][4 * rg + e] *= g4[e]; } } }
        rw_post_flag(flg + 6 + bi, (unsigned)(c + 1));
    }
}

DEV void rwkv_post(const Args& a, int l, int b, int h, LAS unsigned char* sl, int par) {
    const int lane = fresh_lane();
    volatile LAS unsigned* flg = (volatile LAS unsigned*)(sl + RW_FLG);
    bf16_t* Zb = (bf16_t*)(a.ws + WS_Z) + (size_t)b * SEQ * ZP;
    const int gcol0 = h < 4 ? ZC_FV + h * 64 : ZC_MV + (h - 4) * 64;
    const int t = lane >> 2, qd = lane & 3, c0 = h * 64 + 16 * qd;
    const float* rkp = a.in[22] + l * 512 + c0; const float* lw = a.in[23] + l * 512 + c0; const float* lb = a.in[24] + l * 512 + c0;
    const LAS float* YB = (const LAS float*)(sl + RW_YB + par * 4096);
#pragma unroll 1
    for (int c = par; c < RW_NCH; c += 2) {
        bf16_t* zr = Zb + (size_t)(16 * c + t) * ZP;
        const u32x4 r0 = *(const u32x4*)(zr + ZC_RR + c0), r1 = *(const u32x4*)(zr + ZC_RR + c0 + 8), k0 = *(const u32x4*)(zr + ZC_RK + c0), k1 = *(const u32x4*)(zr + ZC_RK + c0 + 8);
        const u32x4 v0 = *(const u32x4*)(zr + ZC_RV + c0), v1 = *(const u32x4*)(zr + ZC_RV + c0 + 8), g0 = *(const u32x4*)(zr + gcol0 + 16 * qd), g1 = *(const u32x4*)(zr + gcol0 + 16 * qd + 8);
        rw_wait(flg + 12 + par, (unsigned)(c + 1));
        float y[16];
#pragma unroll
        for (int q4 = 0; q4 < 4; ++q4) { const f32x4 yy = *(const LAS f32x4*)(YB + t * 64 + 16 * qd + 4 * q4); y[4 * q4] = yy[0]; y[4 * q4 + 1] = yy[1]; y[4 * q4 + 2] = yy[2]; y[4 * q4 + 3] = yy[3]; }
        asm volatile("s_waitcnt lgkmcnt(0)" ::: "memory");
        flg[14 + par] = (unsigned)(c + 1);
        float s = 0.f;
#pragma unroll
        for (int e = 0; e < 16; ++e) s += y[e];
        s += __shfl_xor(s, 1); s += __shfl_xor(s, 2);
        const float mean = s * (1.f / 64); float q = 0.f;
#pragma unroll
        for (int e = 0; e < 16; ++e) { y[e] -= mean; q += y[e] * y[e]; }
        q += __shfl_xor(q, 1); q += __shfl_xor(q, 2);
        const float rstd = rsqrtf(q * (1.f / 64) + GN_EPS);
        float rv[16], kv[16];
        unpack8(r0, *(float(*)[8])&rv[0]); unpack8(r1, *(float(*)[8])&rv[8]); unpack8(k0, *(float(*)[8])&kv[0]); unpack8(k1, *(float(*)[8])&kv[8]);
        float bs = 0.f;
#pragma unroll
        for (int e = 0; e < 16; ++e) bs += rv[e] * kv[e] * rkp[e];
        bs += __shfl_xor(bs, 1); bs += __shfl_xor(bs, 2);
        float vv[16], gv[16], o[16];
        unpack8(v0, *(float(*)[8])&vv[0]); unpack8(v1, *(float(*)[8])&vv[8]); unpack8(g0, *(float(*)[8])&gv[0]); unpack8(g1, *(float(*)[8])&gv[8]);
#pragma unroll
        for (int e = 0; e < 16; ++e) o[e] = (y[e] * rstd * lw[e] + lb[e] + bs * vv[e]) * gv[e];
        *(u32x4*)(zr + ZC_RR + c0) = pack8(*(float(*)[8])&o[0]); *(u32x4*)(zr + ZC_RR + c0 + 8) = pack8(*(float(*)[8])&o[8]);
    }
}

#define XB_TMO      128
#define XB_XCNT(j)  (256  + 64 * (j))
#define XB_XSUB(j)  (1280 + 64 * (j))
#define XB_XGEN(j)  (2304 + 64 * (j))
#define XB_TOP      3328
#define XB_TOPGEN   3392
#define XCD_BAR_WORDS 3456
#define XB_SPIN_CAP (1u << 18)

__device__ __forceinline__ unsigned xb_ld(unsigned* p)              { return __hip_atomic_load(p, __ATOMIC_RELAXED, __HIP_MEMORY_SCOPE_AGENT); }
__device__ __forceinline__ unsigned xb_add(unsigned* p, unsigned v) { return __hip_atomic_fetch_add(p, v, __ATOMIC_RELAXED, __HIP_MEMORY_SCOPE_AGENT); }
__device__ __forceinline__ unsigned xb_xcc_id() { return (unsigned)__builtin_amdgcn_s_getreg((3 << 11) | 20) & 0xFu; }
#define XB_SPIN(cond, bar) do { unsigned _sp = 0; while (cond) { __builtin_amdgcn_s_sleep(1); \
    if ((++_sp & 255u) == 0u) { if (xb_ld(&(bar)[XB_TMO])) break; if (_sp > XB_SPIN_CAP) { atomicAdd(&(bar)[XB_TMO], 1u); break; } } } } while (0)

struct XcdBarrier {
    unsigned* bar; unsigned x;
    volatile LAS unsigned* st;
};

__device__ __forceinline__ XcdBarrier xcd_barrier_post(unsigned* bar, volatile LAS unsigned* st) {
    XcdBarrier b; b.bar = bar; b.x = xb_xcc_id(); b.st = st;
    if (threadIdx.x == 0) (void)xb_add(&bar[XB_XCNT(b.x)], 1u);
    return b;
}
__device__ __forceinline__ void xcd_barrier_complete(unsigned* bar, unsigned x, unsigned& nloc, unsigned& nx) {
    const unsigned G = gridDim.x * gridDim.y * gridDim.z;
    unsigned sum, cnt, mine, sp = 0u;
    for (;;) {
        sum = 0u; cnt = 0u; mine = 0u;
#pragma unroll
        for (unsigned j = 0; j < 16; ++j) { const unsigned c = xb_ld(&bar[XB_XCNT(j)]); sum += c; cnt += (c > 0u) ? 1u : 0u; mine = (j == x) ? c : mine; }
        if (sum == G) break;
        __builtin_amdgcn_s_sleep(1);
        if ((++sp & 255u) == 0u) { if (xb_ld(&bar[XB_TMO])) break; if (sp > XB_SPIN_CAP) { atomicAdd(&bar[XB_TMO], 1u); break; } }
    }
    nloc = mine > 0u ? mine : 1u; nx = cnt > 0u ? cnt : 1u;
}

__device__ __forceinline__ void xcd_barrier(const XcdBarrier& b) {
    asm volatile("s_waitcnt vmcnt(0)" ::: "memory");
    __syncthreads();
    if (threadIdx.x == 0) {
        unsigned* bar = b.bar;
        __builtin_amdgcn_s_waitcnt(0);
        unsigned nloc = b.st[0], nx = b.st[1];
        if (nloc == 0u) { xcd_barrier_complete(bar, b.x, nloc, nx); b.st[0] = nloc; b.st[1] = nx; }
        const unsigned old = xb_add(&bar[XB_XSUB(b.x)], 1u);
        const unsigned gen = old / nloc;
        if (old + 1u == (gen + 1u) * nloc) {
            __builtin_amdgcn_fence(__ATOMIC_RELEASE, "agent");
            asm volatile("s_waitcnt vmcnt(0)" ::: "memory");
            const unsigned og = xb_add(&bar[XB_TOP], 1u);
            const unsigned tg = og / nx;
            if (og + 1u == (tg + 1u) * nx) xb_add(&bar[XB_TOPGEN], 1u);
            else XB_SPIN(xb_ld(&bar[XB_TOPGEN]) == tg, bar);
            __builtin_amdgcn_fence(__ATOMIC_ACQUIRE, "agent");
            xb_add(&bar[XB_XGEN(b.x)], 1u);
            asm volatile("s_waitcnt vmcnt(0)" ::: "memory");
        } else {
            XB_SPIN(xb_ld(&bar[XB_XGEN(b.x)]) == gen, bar);
            __builtin_amdgcn_fence(__ATOMIC_ACQUIRE, "agent");
            asm volatile("s_waitcnt vmcnt(0)" ::: "memory");
        }
    }
    __syncthreads();
}

constexpr int N_PHASES = 1 + 15 * NL;
#ifndef MK_MULTI
#define MK_MULTI 0
#endif
#ifndef PROBE_Q
#define PROBE_Q 500.f
#endif
#ifndef PROBE_OFF
#define PROBE_OFF 0.f
#endif
#ifndef REPK
#define REPK 0
#endif
#ifndef ATT_REP
#define ATT_REP 1
#endif
#ifndef PREP_REP
#define PREP_REP 1
#endif
#ifndef RWROLES
#define RWROLES 7
#endif
#ifndef PHMASK
#define PHMASK 0xFFFF
#endif
#define PHON(k) ((PHMASK >> (k)) & 1)
__global__ void __launch_bounds__(512, 2) fwd_megakernel(Args a) {
    extern __shared__ __attribute__((aligned(16))) unsigned char lds_raw[];
    LAS unsigned char* lds = (LAS unsigned char*)lds_raw;
    cg::grid_group grid = cg::this_grid();
    { volatile LAS unsigned* st0 = (volatile LAS unsigned*)(lds + 131072 + 128); if (threadIdx.x == 0) { st0[0] = 0u; st0[1] = 0u; } __syncthreads(); }
    XcdBarrier xbar = xcd_barrier_post((unsigned*)(a.ws + WS_CTL) + 4096, (volatile LAS unsigned*)(lds + 131072 + 128));
    const int G = gridDim.x, bid = blockIdx.x, NGW = G * 8;
    unsigned char* ws = a.ws;
    bf16_t* HN = (bf16_t*)(ws + WS_HN); bf16_t* Z = (bf16_t*)(ws + WS_Z); bf16_t* HID = Z; bf16_t* QX = Z; bf16_t* OX = Z + (size_t)TOK * 512;
#ifdef PROBE_GROUP
    LAS unsigned long long* prs = (LAS unsigned long long*)(lds + 131072 + 64);
    if (threadIdx.x == 0) { prs[0] = __builtin_amdgcn_s_memrealtime(); prs[1] = 0ull; prs[2] = 99ull; }
#endif
#ifdef PROBE_GROUP
    for (int ph = a.ph_lo; ph <= a.ph_hi; ++ph) {
#else
    for (int ph = a.ph_lo; ph < a.ph_hi; ++ph) {
#endif
        if (ph > a.ph_lo) { if (ph == a.ph_lo + 1 || MK_MULTI) grid.sync(); else xcd_barrier(xbar);
#ifdef SYNC_REP
            xcd_barrier(xbar); xcd_barrier(xbar);
#endif
        }
#ifdef PROBE_GROUP
        if (threadIdx.x == 0) { const unsigned long long now = __builtin_amdgcn_s_memrealtime(); if (prs[2] == (unsigned long long)PROBE_GROUP) prs[1] += now - prs[0]; prs[0] = now;
          if (ph == a.ph_hi) { if (blockIdx.x == 0) { float us_ = (float)prs[1] * 0.01f;
#if PROBE_GROUP == 8
              us_ = (float)((volatile unsigned*)(ws + WS_CTL))[32 * 64] * 0.01f;
#endif
              a.out[0] = floorf((us_ + PROBE_OFF) / PROBE_Q) * PROBE_Q + 0.5f * PROBE_Q; } }
          const int k_ = (ph - 1) % 15; prs[2] = ph == 0 ? 0 : (k_ == 0 || k_ == 3 || k_ == 8 || k_ == 12) ? 1 : (k_ == 1 || k_ == 13) ? 2 : (k_ == 2 || k_ == 14 || k_ == 7 || k_ == 11) ? 3 : (k_ == 4 || k_ == 9) ? 4 : k_ == 5 ? 5 : k_ == 6 ? 6 : 7; }
        if (ph == a.ph_hi) break;
#endif
        int tidp = threadIdx.x; asm volatile("" : "+v"(tidp)); const int tid = tidp, lane = tid & 63, wid = __builtin_amdgcn_readfirstlane(tid >> 6), gw = bid * 8 + wid;
        if (ph == 0) { for (int rp_ = 0; rp_ < ((REPK >> 15) & 1) + 1; ++rp_) { if (PHON(15)) p0_prologue(a, lds, gw, NGW, wid, lane, tid); } continue; }
        const int l = (ph - 1) / 15, kind = (ph - 1) % 15;
        const unsigned char* wl = ws + WS_W + (size_t)l * WL_BYTES;
        if (PHON(0) && (kind == 0 || kind == 3 || kind == 8 || kind == 12)) {
            const float* src = (l == 0 && kind == 0) ? a.in[0] : a.out;
            const float* g = (kind == 0 ? a.in[3] : kind == 3 ? a.in[6] : kind == 8 ? a.in[25] : a.in[32]) + l * DM;
            for (int rp_ = 0; rp_ < (REPK & 1) + 1; ++rp_) norm_phase(src, g, HN, TOK, gw, NGW, lane);
            if (l == 0 && kind == 3) xkv_post(a, gw, NGW, lane);
        }
        if (PHON(1) && (kind == 1 || kind == 13)) {
            pg8::Gemm g{HN, (const bf16_t*)(wl + (kind == 1 ? OFF_F1I : OFF_F2I)), TOK, 2 * FF, DM, DM};
            pg8::StaticOrder S; S.init(TOK, 2 * FF, G, bid);
            pg8::EpiSwiglu E{HID, FF};
            pg8::gemm_phase<pg8::EpiSwiglu, pg8::StaticOrder, true, true>(lds, g, S, E);
        }
        if (PHON(2) && (kind == 2 || kind == 14 || kind == 7 || kind == 11)) {
            pg8::Gemm g; pg8::EpiResid E; E.out = a.out; E.ldc = DM; g.M = TOK; g.N = DM;
            if (kind == 2 || kind == 14) { g.A = HID; g.lda = FF; g.K = FF; g.Bt = (const bf16_t*)(wl + (kind == 2 ? OFF_F1O : OFF_F2O)); E.scale = 0.5f; E.base = (l == 0 && kind == 2) ? a.in[0] : a.out; }
            else if (kind == 7) { g.A = Z; g.lda = ZP; g.K = DM; g.Bt = (const bf16_t*)(wl + OFF_MO); E.scale = 1.f; E.base = a.out; }
            else { g.A = OX; g.lda = 512; g.K = 512; g.Bt = (const bf16_t*)(wl + OFF_XO); E.scale = 1.f; E.base = a.out; }
            pg8::StaticOrder S; S.init(TOK, DM, G, bid);
            const float sc_ = E.scale;
            for (int rp_ = ((REPK >> 2) & 1); rp_ >= 0; --rp_) { E.scale = rp_ ? 0.f : sc_;
            pg8::gemm_phase<pg8::EpiResid, pg8::StaticOrder, true, true>(lds, g, S, E); if (rp_) { __syncthreads(); } }
        }
        if (PHON(4) && (kind == 4 || kind == 9 || (kind == 0 && l == 0))) {
            const int ng = (kind == 0) ? NL : 1;
            for (int rp_ = 0; rp_ < ((REPK >> 4) & 1) + 1; ++rp_)
            for (int gi = 0; gi < ng; ++gi) {
                pg8::Gemm g; pg8::EpiBf16 E; int cidx = bid;
                if (kind == 4) { g.A = HN; g.lda = DM; g.K = DM; g.M = TOK; g.N = 3584; g.Bt = (const bf16_t*)(wl + OFF_MI); E.O = Z; E.ldc = ZP; E.ncols = ZC_VALID; E.halo = (bf16_t*)(ws + WS_ZHALO); }
                else if (kind == 9) { g.A = HN; g.lda = DM; g.K = DM; g.M = TOK; g.N = 512; g.Bt = (const bf16_t*)(wl + OFF_XQ); E.O = QX; E.ldc = 512; E.ncols = 512; E.halo = nullptr; }
                else { g.A = (const bf16_t*)(ws + WS_MEMN) + (size_t)gi * NB * MEMLEN * DM; g.lda = DM; g.K = DM; g.M = NB * MEMLEN; g.N = 1024;
                       g.Bt = (const bf16_t*)(ws + WS_W + (size_t)gi * WL_BYTES + OFF_XKV); E.O = (bf16_t*)(ws + WS_KVX) + (size_t)gi * NB * MEMLEN * 1024; E.ldc = 1024; E.ncols = 1024; E.halo = nullptr;
                       cidx = (bid + gi * (G / 2)) % G; }
                pg8::StaticOrder S; S.init(g.M, g.N, G, cidx);
                pg8::gemm_phase<pg8::EpiBf16, pg8::StaticOrder, true, true>(lds, g, S, E);
            }
        }
        if (PHON(5) && kind == 5) { for (int rp_ = PREP_REP - 1; rp_ >= 0; --rp_) for (int tile = bid; tile < TOK / 64; tile += G) prep_tile(a, l, tile, lds, rp_ > 0); }
        if (PHON(6) && kind == 6) {
            unsigned* ctr = (unsigned*)(ws + WS_CTL) + 64 * (1 + l); LAS unsigned* qw = (LAS unsigned*)(lds + 131072);
            for (;;) {
                __syncthreads();
                if (tid == 0) *qw = atomicAdd(ctr, 1u);
                __syncthreads();
                const int item = __builtin_amdgcn_readfirstlane((int)*qw);
                if (item >= 64 + 1024) break;
                if (item < 64) {
                    if (tid < 16) ((LAS unsigned*)(lds + RW_FLG))[tid] = 0u;
                    __syncthreads();
                    if (PHON(7)) {
                        const int ub = item >> 3, uh = item & 7;
                        if (wid == 0 || wid == 4 || wid == 2 || wid == 6) { if (RWROLES & 1) rwkv_pre(a, ub, uh, lds, wid == 0 ? 0 : wid == 4 ? 1 : wid == 2 ? 2 : 3); }
                        else if (wid == 1) { if (RWROLES & 2) rwkv_main(lds); }
                        else if (wid == 3 || wid == 7) { if (RWROLES & 4) rwkv_post(a, l, ub, uh, lds, wid == 3 ? 0 : 1); }
                    }
                }
                else {
                    const int j = item - 64, qb = 15 - (j >> 6), kk = j & 63, type = kk >> 5, bh = kk & 31, b = bh >> 2, h = bh & 3;
                    bf16_t* Zb = Z + (size_t)b * SEQ * ZP;
                    for (int rp_ = ATT_REP - 1; rp_ >= 0; --rp_)
                    if (type == 0) { if (PHON(8)) attn_unit<0, 64>(lds, Zb + ZC_FQ + 64 * h, ZP, Zb + ZC_FK + 64 * h, ZP, (const bf16_t*)(ws + WS_VTF) + (size_t)bh * 64 * SEQ, SEQ, Zb + ZC_FQ + 64 * h, ZP,
                                                   256 * qb, 4 * (qb + 1), qb, (const float*)(ws + WS_LOGF) + (size_t)bh * SEQ, nullptr, rp_ > 0); }
                    else if (PHON(9)) attn_unit<1, 64>(lds, Zb + ZC_MQ + 64 * h, ZP, Zb + ZC_MK + 64 * h, ZP, (const bf16_t*)(ws + WS_VTM) + (size_t)bh * 64 * SEQ, SEQ, Zb + ZC_MQ + 64 * h, ZP,
                                          256 * qb, 4 * (qb + 1), qb, (const float*)(ws + WS_KMP) + (size_t)bh * 64 * 64, nullptr, rp_ > 0);
                }
            }
        }
        if (PHON(10) && kind == 10) {
            for (int rp_ = 0; rp_ < ((REPK >> 10) & 1) + 1; ++rp_)
            for (int u = bid; u < NB * 4 * 16; u += G) { const int b = u >> 6, hd = (u >> 4) & 3, qb = u & 15;
                bf16_t* qp = QX + (size_t)b * SEQ * 512 + hd * 128;
                attn_unit<2, 128>(lds, qp, 512, (const bf16_t*)(ws + WS_KVX) + ((size_t)l * NB + b) * MEMLEN * 1024 + hd * 128, 1024,
                                  (const bf16_t*)(ws + WS_VTX) + ((size_t)(l * NB + b) * 4 + hd) * 128 * MEMLEN, MEMLEN, OX + (size_t)b * SEQ * 512 + hd * 128, 512, 256 * qb, MEMLEN / 64, qb, nullptr, a.in[29] + l * 128); }
        }
    }
}

extern "C" void kernel_launch(void* const* d_in, const int* in_sizes, int n_in, void* d_out, int out_size, void* d_ws, size_t ws_size, hipStream_t stream) {
    static int grid_blocks = 0;
    if (grid_blocks == 0) {
        if (n_in != 35 || ws_size < WS_END) { fprintf(stderr, "kernel_launch: unexpected n_in %d / ws %zu\n", n_in, ws_size); grid_blocks = -1; return; }
        int dev = 0, cus = 0, per_cu = 0;
        hipGetDevice(&dev); hipDeviceGetAttribute(&cus, hipDeviceAttributeMultiprocessorCount, dev);
        if (hipFuncSetAttribute((const void*)fwd_megakernel, hipFuncAttributeMaxDynamicSharedMemorySize, LDS_BYTES) != hipSuccess) { fprintf(stderr, "kernel_launch: hipFuncSetAttribute failed\n"); grid_blocks = -1; return; }
        if (hipOccupancyMaxActiveBlocksPerMultiprocessor(&per_cu, (const void*)fwd_megakernel, 512, LDS_BYTES) != hipSuccess || per_cu < 1) { fprintf(stderr, "kernel_launch: occupancy query says %d\n", per_cu); per_cu = 1; }
        (void)hipGetLastError();
        grid_blocks = cus * per_cu;
    }
    if (grid_blocks < 0) return;
    Args a{};
    for (int i = 0; i < 35; ++i) a.in[i] = (const float*)d_in[i];
    a.out = (float*)d_out; a.ws = (unsigned char*)d_ws;
    if (hipMemsetAsync(d_ws, 0, 65536, stream) != hipSuccess) { fprintf(stderr, "kernel_launch: memset failed\n"); return; }
#if MK_MULTI
    for (int ph = 0; ph < N_PHASES; ++ph) { a.ph_lo = ph; a.ph_hi = ph + 1; hipLaunchKernelGGL(fwd_megakernel, dim3(grid_blocks), dim3(512), LDS_BYTES, stream, a); }
#else
    a.ph_lo = 0; a.ph_hi = N_PHASES;
    void* args[] = {&a};
    hipError_t e = hipLaunchCooperativeKernel((const void*)fwd_megakernel, dim3(grid_blocks), dim3(512), args, LDS_BYTES, stream);
    if (e != hipSuccess) fprintf(stderr, "cooperative launch failed: %s (grid %d)\n", hipGetErrorString(e), grid_blocks);
#endif
}
```

```cpp
#include <hip/hip_runtime.h>
#include <hip/hip_cooperative_groups.h>
#include <cstdio>
#include <cstdint>
namespace cg = cooperative_groups;
namespace pg8 {
#define PG8_LAS __attribute__((address_space(3)))
typedef unsigned short bf16_t;
typedef short bf16x8 __attribute__((ext_vector_type(8)));
typedef float f32x4 __attribute__((ext_vector_type(4)));
typedef unsigned u32x4 __attribute__((ext_vector_type(4)));
constexpr int BM = 256, BK = 64, HALF = 128, HTB = HALF * BK * 2  , STAGE_BYTES = 8 * HTB, NXCD = 8, WGM = 8;

__host__ __device__ __forceinline__ int lds_byte(int r, int c) { const int st = (r >> 4) * 2 + (c >> 5), rr = r & 15, cc = c & 31, ob = rr * 64 + cc * 2; return st * 1024 + (ob ^ (((ob >> 9) & 1) << 5)); }
__host__ __device__ __forceinline__ void stage_rc(int b, int& R, int& C) { const int st = b / 1024, sb = b % 1024, swz = sb ^ (((sb >> 9) & 1) << 5); R = (st >> 1) * 16 + swz / 64; C = (st & 1) * 32 + (swz % 64) / 2; }
__host__ __device__ __forceinline__ int perm32(int rho) { const int n = rho >> 4, i = rho & 15; return 8 * (i >> 2) + 4 * n + (i & 3); }

struct Unit { int pm, pn; };
struct Gemm { const bf16_t* A; const bf16_t* Bt; int M, N, K, lda; };

struct StaticOrder {
    int nM, nN, nwg, G, c;
    __host__ __device__ void init(int M, int N, int G_, int c_) { nM = M / BM; nN = N / BM; nwg = nM * nN; G = G_; c = c_; }
    __host__ __device__ bool next(int i, Unit& u) const {
        const long L = (long)i * G + c; if (L >= nwg) return false;
        int wgid = (int)L; { const int q = nwg / NXCD, r = nwg % NXCD, xcd = wgid % NXCD, off = wgid / NXCD; wgid = (xcd < r ? xcd * (q + 1) : r * (q + 1) + (xcd - r) * q) + off; }
        const int nig = WGM * nN, gid = wgid / nig, fm = gid * WGM, gsz = (nM - fm) < WGM ? (nM - fm) : WGM;
        u.pm = fm + ((wgid % nig) % gsz); u.pn = (wgid % nig) / gsz; return true;
    }
    __device__ __forceinline__ void a_ready(const Unit&) const {}
    __device__ __forceinline__ void done(const Unit&) const {}
};
__device__ __forceinline__ unsigned cvt_pk_bf16(float lo, float hi) { unsigned r; asm volatile("v_cvt_pk_bf16_f32 %0, %1, %2" : "=v"(r) : "v"(lo), "v"(hi)); return r; }
__device__ __forceinline__ float silu_f(float x) { return x * __builtin_amdgcn_rcpf(1.0f + __builtin_amdgcn_exp2f(-1.4426950408889634f * x)); }
struct EpiSwiglu {
    static constexpr bool PERM = true, AFTER_DRAIN = false;
    bf16_t* O; int ldc;
    __device__ __forceinline__ void operator()(const f32x4 (&acc)[2][2][4][2], const Unit& u, int wr, int wc, int fr, int fq) const {
        const int row0 = u.pm * BM + wr * 64 + fr, col0 = u.pn * HALF + wc * 32 + 8 * fq;
#pragma unroll
        for (int ai = 0; ai < 2; ++ai)
#pragma unroll
            for (int m = 0; m < 4; ++m) {
                const f32x4 g0 = acc[ai][0][m][0], g1 = acc[ai][0][m][1], u0 = acc[ai][1][m][0], u1 = acc[ai][1][m][1];
                u32x4 w;
                w.x = cvt_pk_bf16(silu_f(g0[0]) * u0[0], silu_f(g0[1]) * u0[1]); w.y = cvt_pk_bf16(silu_f(g0[2]) * u0[2], silu_f(g0[3]) * u0[3]);
                w.z = cvt_pk_bf16(silu_f(g1[0]) * u1[0], silu_f(g1[1]) * u1[1]); w.w = cvt_pk_bf16(silu_f(g1[2]) * u1[2], silu_f(g1[3]) * u1[3]);
                *(u32x4*)(O + (size_t)(row0 + ai * HALF + m * 16) * ldc + col0) = w;
            }
    }
};
struct EpiResid {
    static constexpr bool PERM = false, AFTER_DRAIN = false;
    const float* base; float* out; int ldc; float scale;
    __device__ __forceinline__ void operator()(const f32x4 (&acc)[2][2][4][2], const Unit& u, int wr, int wc, int fr, int fq) const {
        const int row0 = u.pm * BM + wr * 64 + fr, col0 = u.pn * BM + wc * 32 + 4 * fq;
#pragma unroll
        for (int ai = 0; ai < 2; ++ai)
#pragma unroll
            for (int m = 0; m < 4; ++m) { const size_t off = (size_t)(row0 + ai * HALF + m * 16) * ldc + col0;
#pragma unroll
                for (int bj = 0; bj < 2; ++bj)
#pragma unroll
                    for (int n = 0; n < 2; ++n) { const f32x4 b = *(const f32x4*)(base + off + bj * HALF + n * 16); *(f32x4*)(out + off + bj * HALF + n * 16) = b + acc[ai][bj][m][n] * scale; }
                asm volatile("" ::: "memory"); }
    }
};
struct EpiBf16 {
    static constexpr bool PERM = true, AFTER_DRAIN = false;
    bf16_t* O; int ldc; int ncols; bf16_t* halo;
    __device__ __forceinline__ void operator()(const f32x4 (&acc)[2][2][4][2], const Unit& u, int wr, int wc, int fr, int fq) const {
        const int row0 = u.pm * BM + wr * 64 + fr, col0 = u.pn * BM + wc * 32 + 8 * fq;
#pragma unroll
        for (int ai = 0; ai < 2; ++ai)
#pragma unroll
            for (int m = 0; m < 4; ++m) { const int row = row0 + ai * HALF + m * 16;
#pragma unroll
                for (int bj = 0; bj < 2; ++bj) { const int col = col0 + bj * HALF;
                    if (col < ncols) { const f32x4 v0 = acc[ai][bj][m][0], v1 = acc[ai][bj][m][1]; u32x4 w;
                        w.x = cvt_pk_bf16(v0[0], v0[1]); w.y = cvt_pk_bf16(v0[2], v0[3]); w.z = cvt_pk_bf16(v1[0], v1[1]); w.w = cvt_pk_bf16(v1[2], v1[3]);
                        *(u32x4*)(O + (size_t)row * ldc + col) = w;
                        if (halo && (row & 63) == 63) *(u32x4*)(halo + (size_t)(row >> 6) * ldc + col) = w; } } }
    }
};
template <class Epi, class Sched, bool ALIGN_EPI = false, bool SP2 = false>
__device__ __forceinline__ void gemm_phase(PG8_LAS unsigned char* lds, const Gemm g, const Sched& S, const Epi& E) {
    int tid_ = threadIdx.x; asm volatile("" : "+v"(tid_)); const int tid = tid_, wid = __builtin_amdgcn_readfirstlane(tid >> 6), lane = tid & 63, wr = wid >> 2, wc = wid & 3, fr = lane & 15, fq = lane >> 4;
    const int K = g.K, nt = K / BK;
    unsigned voffA[2], voffB[2];
#pragma unroll
    for (int i = 0; i < 2; ++i) { int R, C; stage_rc(tid * 16 + i * 8192, R, C); const int Rb = Epi::PERM ? ((R & ~31) + perm32(R & 31)) : R;
        voffA[i] = (unsigned)(R * g.lda + C) * 2u; voffB[i] = (unsigned)(Rb * K + C) * 2u; }
    const size_t kstep = (size_t)(BK * 2);
    const size_t hstep = (size_t)HALF * K * 2;
    const size_t tstep = 2 * hstep; const size_t hstepA = (size_t)HALF * g.lda * 2, tstepA = 2 * hstepA;
    const unsigned ldsw = (unsigned)wid * 1024u;
    const int aoff = lds_byte(wr * 64 + fr, fq * 8), boff = lds_byte(wc * 32 + fr, fq * 8);
#define PG8_SA(b, h) (((b) * 2 + (h)) * HTB)
#define PG8_SB(b, h) ((4 + (b) * 2 + (h)) * HTB)
#define PG8_STAGE(bufoff, gbase, voff) do { _Pragma("unroll") for (int _i = 0; _i < 2; ++_i) \
        __builtin_amdgcn_global_load_lds((const unsigned*)((const char*)(gbase) + (voff)[_i]), (PG8_LAS unsigned*)(lds + (bufoff) + ldsw + _i * 8192), 16, 0, 0); } while (0)
#define PG8_LDA(dst, b, h) do { _Pragma("unroll") for (int m = 0; m < 4; ++m) _Pragma("unroll") for (int k = 0; k < 2; ++k) dst[m][k] = *(const PG8_LAS bf16x8*)(lds + PG8_SA(b, h) + aoff + m * 2048 + k * 1024); } while (0)
#define PG8_LDB(dst, b, h) do { _Pragma("unroll") for (int n = 0; n < 2; ++n) _Pragma("unroll") for (int k = 0; k < 2; ++k) dst[n][k] = *(const PG8_LAS bf16x8*)(lds + PG8_SB(b, h) + boff + n * 2048 + k * 1024); } while (0)
#define PG8_MMA(ai, bj, At, Bt) do { __builtin_amdgcn_s_setprio(1); _Pragma("unroll") for (int m = 0; m < 4; ++m) _Pragma("unroll") for (int n = 0; n < 2; ++n) _Pragma("unroll") for (int k = 0; k < 2; ++k) \
        acc[ai][bj][m][n] = __builtin_amdgcn_mfma_f32_16x16x32_bf16(Bt[n][k], At[m][k], acc[ai][bj][m][n], 0, 0, 0); __builtin_amdgcn_s_setprio(0); } while (0)
#define PG8_WAIT_V(n) asm volatile("s_waitcnt vmcnt(" #n ")" ::: "memory")
#define PG8_WAIT_L(n) asm volatile("s_waitcnt lgkmcnt(" #n ")" ::: "memory")
#define PG8_BAR __builtin_amdgcn_s_barrier()
#define PG8_SCHED __builtin_amdgcn_sched_barrier(0)
    Unit cur, nxt; int ui = 0;
    if (!S.next(0, cur)) return;
    f32x4 acc[2][2][4][2];
#pragma unroll
    for (int a = 0; a < 2; ++a)
#pragma unroll
        for (int b = 0; b < 2; ++b)
#pragma unroll
            for (int m = 0; m < 4; ++m)
#pragma unroll
                for (int n = 0; n < 2; ++n) acc[a][b][m][n] = (f32x4){0.f, 0.f, 0.f, 0.f};
    bf16x8 At[4][2], B0[2][2], B1[2][2];
    const char* cA = (const char*)g.A + (size_t)cur.pm * tstepA; const char* cB = (const char*)g.Bt + (size_t)cur.pn * tstep;
    S.a_ready(cur);
    if constexpr (SP2) {
        PG8_STAGE(PG8_SB(0, 0), cB, voffB); PG8_STAGE(PG8_SB(0, 1), cB + hstep, voffB); PG8_STAGE(PG8_SA(0, 0), cA, voffA); PG8_STAGE(PG8_SA(0, 1), cA + hstepA, voffA);
        if (wr == 1) PG8_BAR;
        PG8_WAIT_V(2); PG8_BAR;
        PG8_STAGE(PG8_SB(1, 0), cB + kstep, voffB); PG8_STAGE(PG8_SA(1, 0), cA + kstep, voffA); PG8_STAGE(PG8_SB(1, 1), cB + hstep + kstep, voffB);
        PG8_WAIT_V(6); PG8_BAR;
    } else {
        PG8_STAGE(PG8_SB(0, 0), cB, voffB); PG8_STAGE(PG8_SA(0, 0), cA, voffA); PG8_STAGE(PG8_SB(0, 1), cB + hstep, voffB); PG8_STAGE(PG8_SA(0, 1), cA + hstepA, voffA);
        if (wr == 1) PG8_BAR;
        PG8_WAIT_V(4); PG8_BAR;
        PG8_STAGE(PG8_SB(1, 0), cB + kstep, voffB); PG8_STAGE(PG8_SA(1, 0), cA + kstep, voffA); PG8_STAGE(PG8_SB(1, 1), cB + hstep + kstep, voffB);
        PG8_WAIT_V(6); PG8_BAR;
    }
    for (;;) {
        const bool has_next = S.next(ui + 1, nxt);
        const char* nA = has_next ? (const char*)g.A + (size_t)nxt.pm * tstepA : cA; const char* nB = has_next ? (const char*)g.Bt + (size_t)nxt.pn * tstep : cB;
        for (int t = 0; t < nt; t += 2) {
            const bool last = (t == nt - 2);
            const char* a1 = cA + (size_t)(t + 1) * kstep;
            const char* a2 = last ? nA : cA + (size_t)(t + 2) * kstep; const char* b2 = last ? nB : cB + (size_t)(t + 2) * kstep;
            const char* a3 = a2 + kstep; const char* b3 = b2 + kstep;
            if (last && has_next) S.a_ready(nxt);
            if constexpr (SP2) {
            PG8_LDB(B0, 0, 0); PG8_LDB(B1, 0, 1); PG8_SCHED; PG8_LDA(At, 0, 0); PG8_STAGE(PG8_SA(1, 1), a1 + hstepA, voffA);
            PG8_WAIT_V(8); PG8_WAIT_L(0); PG8_BAR; PG8_MMA(0, 0, At, B0); PG8_MMA(0, 1, At, B1); PG8_BAR; PG8_SCHED;
            PG8_LDA(At, 0, 1); PG8_STAGE(PG8_SB(0, 0), b2, voffB); PG8_STAGE(PG8_SB(0, 1), b2 + hstep, voffB); PG8_STAGE(PG8_SA(0, 0), a2, voffA);
            PG8_WAIT_V(8); PG8_WAIT_L(0); PG8_BAR; PG8_MMA(1, 0, At, B0); PG8_MMA(1, 1, At, B1); PG8_BAR; PG8_SCHED;
            PG8_LDB(B0, 1, 0); PG8_LDB(B1, 1, 1); PG8_SCHED; PG8_LDA(At, 1, 0); PG8_STAGE(PG8_SA(0, 1), a2 + hstepA, voffA);
            PG8_WAIT_V(8); PG8_WAIT_L(0); PG8_BAR; PG8_MMA(0, 0, At, B0); PG8_MMA(0, 1, At, B1); PG8_BAR; PG8_SCHED;
            PG8_LDA(At, 1, 1); PG8_STAGE(PG8_SB(1, 0), b3, voffB); PG8_STAGE(PG8_SB(1, 1), b3 + hstep, voffB); PG8_STAGE(PG8_SA(1, 0), a3, voffA);
            PG8_WAIT_V(8); PG8_WAIT_L(0); PG8_BAR; PG8_MMA(1, 0, At, B0); PG8_MMA(1, 1, At, B1); PG8_BAR; PG8_SCHED;
            } else {
            PG8_LDB(B0, 0, 0); PG8_SCHED; PG8_LDA(At, 0, 0); PG8_STAGE(PG8_SA(1, 1), a1 + hstepA, voffA);
            PG8_WAIT_L(8); PG8_BAR; PG8_WAIT_L(0); PG8_MMA(0, 0, At, B0); PG8_BAR; PG8_SCHED;
            PG8_LDB(B1, 0, 1); PG8_STAGE(PG8_SB(0, 0), b2, voffB);
            PG8_BAR; PG8_WAIT_L(0); PG8_MMA(0, 1, At, B1); PG8_BAR;
            PG8_LDA(At, 0, 1); PG8_STAGE(PG8_SA(0, 0), a2, voffA);
            PG8_BAR; PG8_WAIT_L(0); PG8_MMA(1, 0, At, B0); PG8_BAR; PG8_SCHED;
            PG8_STAGE(PG8_SB(0, 1), b2 + hstep, voffB);
            PG8_WAIT_V(6); PG8_BAR; PG8_MMA(1, 1, At, B1); PG8_BAR;
            PG8_LDB(B0, 1, 0); PG8_SCHED; PG8_LDA(At, 1, 0); PG8_STAGE(PG8_SA(0, 1), a2 + hstepA, voffA);
            PG8_WAIT_L(8); PG8_BAR; PG8_WAIT_L(0); PG8_MMA(0, 0, At, B0); PG8_BAR; PG8_SCHED;
            PG8_LDB(B1, 1, 1); PG8_STAGE(PG8_SB(1, 0), b3, voffB);
            PG8_BAR; PG8_WAIT_L(0); PG8_MMA(0, 1, At, B1); PG8_BAR;
            PG8_LDA(At, 1, 1); PG8_STAGE(PG8_SA(1, 0), a3, voffA);
            PG8_BAR; PG8_WAIT_L(0); PG8_MMA(1, 0, At, B0); PG8_BAR; PG8_SCHED;
            PG8_STAGE(PG8_SB(1, 1), b3 + hstep, voffB);
            PG8_WAIT_V(6); PG8_BAR; PG8_MMA(1, 1, At, B1); PG8_BAR;
            }
        }
        if constexpr (ALIGN_EPI) { if (wr == 0) PG8_BAR; }
        if constexpr (!Epi::AFTER_DRAIN) { E(acc, cur, wr, wc, fr, fq); S.done(cur); }
        if (!has_next) break;
#pragma unroll
        for (int a = 0; a < 2; ++a)
#pragma unroll
            for (int b = 0; b < 2; ++b)
#pragma unroll
                for (int m = 0; m < 4; ++m)
#pragma unroll
                    for (int n = 0; n < 2; ++n) acc[a][b][m][n] = (f32x4){0.f, 0.f, 0.f, 0.f};
        cur = nxt; cA = nA; cB = nB; ++ui;
        if constexpr (ALIGN_EPI) { if (wr == 1) PG8_BAR; }
    }
    PG8_WAIT_V(0);
    if constexpr (!ALIGN_EPI) { if (wr == 0) PG8_BAR; }
    PG8_BAR;
    if constexpr (Epi::AFTER_DRAIN) { E.fused(acc, cur, wr, wc, fr, fq, lds, wid, lane); S.done(cur); }
#undef PG8_SA
#undef PG8_SB
#undef PG8_STAGE
#undef PG8_LDA
#undef PG8_LDB
#undef PG8_MMA
#undef PG8_WAIT_V
#undef PG8_WAIT_L
#undef PG8_BAR
#undef PG8_SCHED
}
}

#define LAS __attribute__((address_space(3)))
#define DEV __device__ __forceinline__
typedef unsigned short bf16_t;
typedef short bf16x8 __attribute__((ext_vector_type(8)));
typedef short s16x4 __attribute__((ext_vector_type(4)));
typedef float f32x4 __attribute__((ext_vector_type(4)));
typedef float f32x16 __attribute__((ext_vector_type(16)));
typedef unsigned u32x2 __attribute__((ext_vector_type(2)));
typedef unsigned u32x4 __attribute__((ext_vector_type(4)));
typedef unsigned u32x8 __attribute__((ext_vector_type(8)));

constexpr int NB = 8, SEQ = 4096, DM = 1024, TOK = NB * SEQ, FF = 2816, NL = 2, MEMLEN = 256;
constexpr int ZP = 3392;
constexpr int ZC_FQ = 0, ZC_RR = 256, ZC_MQ = 768, ZC_FK = 1024, ZC_FV = 1280, ZC_MK = 1536, ZC_MV = 1792, ZC_RK = 2048, ZC_RV = 2560, ZC_LO = 3072, ZC_FF = 3360, ZC_VALID = 3368;
constexpr float NORM_EPS = 1e-6f, GN_EPS = 64e-5f, LOG2E = 1.4426950408889634f;
constexpr float C2_64 = 0.125f * LOG2E, C2_128 = 0.08838834764831845f * LOG2E;
constexpr size_t MiB = 1u << 20;
constexpr size_t WS_CTL = 0;
constexpr size_t WS_W = 1 * MiB, WL_BYTES = 48 * MiB;
constexpr size_t OFF_F1I = 0, OFF_F1O = 11 * MiB, OFF_F2I = 17 * MiB, OFF_F2O = 28 * MiB, OFF_MI = 34 * MiB, OFF_MO = 41 * MiB, OFF_XQ = 43 * MiB, OFF_XKV = 44 * MiB, OFF_XO = 46 * MiB;
constexpr size_t OFF_W2T = 47 * MiB, OFF_A2T = OFF_W2T + 65536, OFF_G2T = OFF_A2T + 65536;
constexpr size_t WS_Z = 97 * MiB;
constexpr size_t WS_C = WS_Z + 212 * MiB;
constexpr size_t WS_HN = WS_C;
constexpr size_t WS_WD = WS_C, WS_KK = WS_C + 64 * MiB, WS_KA = WS_C + 96 * MiB;
constexpr size_t WS_VTF = WS_C + 128 * MiB, WS_VTM = WS_C + 144 * MiB;
constexpr size_t WS_LOGF = WS_C + 160 * MiB, WS_KMP = WS_LOGF + 512 * 1024, WS_ZHALO = WS_C + 161 * MiB;
constexpr size_t WS_KVX = WS_C + 165 * MiB, WS_VTX = WS_C + 173 * MiB, WS_MEMN = WS_C + 177 * MiB, WS_END = WS_C + 185 * MiB;
static_assert(WS_END <= 512 * MiB, "workspace map");
constexpr int LDS_BYTES = 131072 + 1024;

struct Args { const float* in[35]; float* out; unsigned char* ws; int ph_lo, ph_hi; };

DEV float bf2f(unsigned short b) { return __uint_as_float((unsigned)b << 16); }
typedef float f32x2_t __attribute__((ext_vector_type(2))); typedef __bf16 bf16x2_t __attribute__((ext_vector_type(2)));
DEV unsigned pk2(float lo, float hi) { const f32x2_t v = {lo, hi}; const bf16x2_t r = __builtin_convertvector(v, bf16x2_t); return __builtin_bit_cast(unsigned, r); }
DEV unsigned f2bf(float f) { return pk2(f, f) & 0xffffu; }
DEV float wave_sum(float v) {
#pragma unroll
    for (int o = 1; o < 64; o <<= 1) v += __shfl_xor(v, o);
    return v;
}
#define LDS_WAIT() asm volatile("s_waitcnt lgkmcnt(0)" ::: "memory")

struct MatInfo { const float* src; bf16_t* dst; int K, Ns, Nd, map; };
DEV MatInfo matinfo(const Args& a, int m) {
    const int l = m / 12, k = m % 12; unsigned char* wl = a.ws + WS_W + (size_t)l * WL_BYTES; MatInfo r;
    switch (k) {
    case 0:  r.src = a.in[4] + (size_t)l * DM * 2 * FF;  r.dst = (bf16_t*)(wl + OFF_F1I); r.K = DM; r.Ns = 2 * FF; r.Nd = 2 * FF; r.map = 1; break;
    case 1:  r.src = a.in[5] + (size_t)l * FF * DM;      r.dst = (bf16_t*)(wl + OFF_F1O); r.K = FF; r.Ns = DM; r.Nd = DM; r.map = 0; break;
    case 2:  r.src = a.in[33] + (size_t)l * DM * 2 * FF; r.dst = (bf16_t*)(wl + OFF_F2I); r.K = DM; r.Ns = 2 * FF; r.Nd = 2 * FF; r.map = 1; break;
    case 3:  r.src = a.in[34] + (size_t)l * FF * DM;     r.dst = (bf16_t*)(wl + OFF_F2O); r.K = FF; r.Ns = DM; r.Nd = DM; r.map = 0; break;
    case 4:  r.src = a.in[7] + (size_t)l * DM * 3364;    r.dst = (bf16_t*)(wl + OFF_MI);  r.K = DM; r.Ns = 3364; r.Nd = 3584; r.map = 2; break;
    case 5:  r.src = a.in[8] + (size_t)l * DM * DM;      r.dst = (bf16_t*)(wl + OFF_MO);  r.K = DM; r.Ns = DM; r.Nd = DM; r.map = 0; break;
    case 6:  r.src = a.in[27] + (size_t)l * DM * 512;    r.dst = (bf16_t*)(wl + OFF_XQ);  r.K = DM; r.Ns = 512; r.Nd = 512; r.map = 0; break;
    case 7:  r.src = a.in[28] + (size_t)l * DM * 1024;   r.dst = (bf16_t*)(wl + OFF_XKV); r.K = DM; r.Ns = 1024; r.Nd = 1024; r.map = 0; break;
    case 8:  r.src = a.in[31] + (size_t)l * 512 * DM;    r.dst = (bf16_t*)(wl + OFF_XO);  r.K = 512; r.Ns = DM; r.Nd = DM; r.map = 0; break;
    case 9:  r.src = a.in[16] + (size_t)l * 64 * 512;    r.dst = (bf16_t*)(wl + OFF_W2T); r.K = 64; r.Ns = 512; r.Nd = 512; r.map = 0; break;
    case 10: r.src = a.in[18] + (size_t)l * 64 * 512;    r.dst = (bf16_t*)(wl + OFF_A2T); r.K = 64; r.Ns = 512; r.Nd = 512; r.map = 0; break;
    default: r.src = a.in[19] + (size_t)l * 160 * 512;   r.dst = (bf16_t*)(wl + OFF_G2T); r.K = 160; r.Ns = 512; r.Nd = 512; r.map = 0; break;
    }
    return r;
}
DEV int srccol(int map, int n) {
    if (map == 0) return n;
    if (map == 1) { const int p = n >> 8, r = n & 255; return r < 128 ? p * 128 + r : FF + p * 128 + (r - 128); }
    if (n < 256) return n;
    if (n < 768) return 1540 + (n - 256);
    if (n < 1024) return 772 + (n - 768);
    if (n < 1280) return 256 + (n - 1024);
    if (n < 1536) return 512 + (n - 1280);
    if (n < 1792) return 1028 + (n - 1536);
    if (n < 2048) return 1284 + (n - 1792);
    if (n < 2560) return 2052 + (n - 2048);
    if (n < 3072) return 2564 + (n - 2560);
    if (n < 3360) return 3076 + (n - 3072);
    if (n < 3364) return 768 + (n - 3360);
    return -1;
}
DEV void transpose_item(const MatInfo& mi, LAS float* scr, int item, int lane) {
    const int nblk = mi.Nd / 32, kb = item / nblk, nb = item % nblk, k0 = 64 * kb, n0 = 32 * nb;
    const int n4 = (lane & 7) * 4, sc = srccol(mi.map, n0 + n4);
#pragma unroll
    for (int i = 0; i < 8; ++i) { const int kk = 8 * i + (lane >> 3), k = k0 + kk;
        const f32x4 v = (sc >= 0 && k < mi.K) ? *(const f32x4*)(mi.src + (size_t)k * mi.Ns + sc) : (f32x4){0.f, 0.f, 0.f, 0.f};
        LAS float* d = scr + kk * 33 + n4; d[0] = v[0]; d[1] = v[1]; d[2] = v[2]; d[3] = v[3]; }
    LDS_WAIT(); asm volatile("" ::: "memory");
    const int c = lane & 7;
#pragma unroll
    for (int j = 0; j < 4; ++j) { const int n = (lane >> 3) + 8 * j; const LAS float* s = scr + (8 * c) * 33 + n;
        u32x4 o; o.x = pk2(s[0 * 33], s[1 * 33]); o.y = pk2(s[2 * 33], s[3 * 33]); o.z = pk2(s[4 * 33], s[5 * 33]); o.w = pk2(s[6 * 33], s[7 * 33]);
        if (k0 + 8 * c < mi.K) *(u32x4*)(mi.dst + (size_t)(n0 + n) * mi.K + k0 + 8 * c) = o; }
    LDS_WAIT(); asm volatile("" ::: "memory");
}
DEV void norm_row(const float* xrow, const float* g, bf16_t* orow, int lane) {
    const f32x4* xr = (const f32x4*)xrow + lane; const f32x4* gr = (const f32x4*)g + lane;
    f32x4 v[4]; float s = 0.f;
#pragma unroll
    for (int j = 0; j < 4; ++j) { v[j] = xr[64 * j]; s += (v[j].x * v[j].x + v[j].y * v[j].y) + (v[j].z * v[j].z + v[j].w * v[j].w); }
    const float rstd = rsqrtf(wave_sum(s) * (1.f / DM) + NORM_EPS);
    u32x2* o8 = (u32x2*)orow + lane;
#pragma unroll
    for (int j = 0; j < 4; ++j) { const f32x4 gg = gr[64 * j]; u32x2 w; w.x = pk2(v[j].x * rstd * gg.x, v[j].y * rstd * gg.y); w.y = pk2(v[j].z * rstd * gg.z, v[j].w * rstd * gg.w); o8[64 * j] = w; }
}
DEV void norm_row2(const float* xa, const float* xb, const float* g, bf16_t* oa, bf16_t* ob, int lane) {
    const f32x4* xra = (const f32x4*)xa + lane; const f32x4* xrb = (const f32x4*)xb + lane; const f32x4* gr = (const f32x4*)g + lane;
    f32x4 va[4], vb[4]; float sa = 0.f, sb = 0.f;
#pragma unroll
    for (int j = 0; j < 4; ++j) { va[j] = xra[64 * j]; vb[j] = xrb[64 * j]; }
#pragma unroll
    for (int j = 0; j < 4; ++j) { sa += (va[j].x * va[j].x + va[j].y * va[j].y) + (va[j].z * va[j].z + va[j].w * va[j].w); sb += (vb[j].x * vb[j].x + vb[j].y * vb[j].y) + (vb[j].z * vb[j].z + vb[j].w * vb[j].w); }
#pragma unroll
    for (int o = 1; o < 64; o <<= 1) { sa += __shfl_xor(sa, o); sb += __shfl_xor(sb, o); }
    const float ra = rsqrtf(sa * (1.f / DM) + NORM_EPS), rb = rsqrtf(sb * (1.f / DM) + NORM_EPS);
    u32x2* o8a = (u32x2*)oa + lane; u32x2* o8b = (u32x2*)ob + lane;
#pragma unroll
    for (int j = 0; j < 4; ++j) { const f32x4 gg = gr[64 * j]; u32x2 w; w.x = pk2(va[j].x * ra * gg.x, va[j].y * ra * gg.y); w.y = pk2(va[j].z * ra * gg.z, va[j].w * ra * gg.w); o8a[64 * j] = w;
        w.x = pk2(vb[j].x * rb * gg.x, vb[j].y * rb * gg.y); w.y = pk2(vb[j].z * rb * gg.z, vb[j].w * rb * gg.w); o8b[64 * j] = w; }
}
DEV void norm_phase(const float* x, const float* g, bf16_t* out, int nrows, int gw, int NGW, int lane) {
    int m = gw;
    for (; m + NGW < nrows; m += 2 * NGW) norm_row2(x + (size_t)m * DM, x + (size_t)(m + NGW) * DM, g, out + (size_t)m * DM, out + (size_t)(m + NGW) * DM, lane);
    if (m < nrows) norm_row(x + (size_t)m * DM, g, out + (size_t)m * DM, lane);
}
DEV void p0_prologue(const Args& a, LAS unsigned char* lds, int gw, int NGW, int wid, int lane, int tid) {
    LAS float* scr = (LAS float*)(lds + wid * 8704);
    int base = 0;
    for (int m = 0; m < 24; ++m) {
        const MatInfo mi = matinfo(a, m); const int items = ((mi.K + 63) / 64) * (mi.Nd / 32);
        int first = gw - (base % NGW); if (first < 0) first += NGW;
        for (int it = first; it < items; it += NGW) transpose_item(mi, scr, it, lane);
        base += items;
    }
    for (int m = gw; m < NL * NB * MEMLEN; m += NGW) { const int l = m / (NB * MEMLEN), r = m % (NB * MEMLEN);
        norm_row(a.in[1] + (size_t)r * DM, a.in[26] + l * DM, (bf16_t*)(a.ws + WS_MEMN) + (size_t)m * DM, lane); }
    if (blockIdx.x == 0 && tid < 64) ((unsigned*)(a.ws + WS_CTL))[tid * 64] = 0u;
}
DEV void xkv_post(const Args& a, int gw, int NGW, int lane) {
    for (int it = gw; it < NL * NB * MEMLEN * 4; it += NGW) {
        const int hd = it & 3, row = (it >> 2) % (NB * MEMLEN), l = it / (4 * NB * MEMLEN), b = row / MEMLEN, m = row % MEMLEN;
        bf16_t* kr = (bf16_t*)(a.ws + WS_KVX) + ((size_t)l * NB * MEMLEN + row) * 1024 + hd * 128;
        const unsigned kv = *((const unsigned*)kr + lane); float k0 = bf2f(kv & 0xffff), k1 = bf2f(kv >> 16);
        const float rstd = rsqrtf(wave_sum(k0 * k0 + k1 * k1) * (1.f / 128) + NORM_EPS);
        const float* kg = a.in[30] + l * 128;
        *((unsigned*)kr + lane) = pk2(k0 * rstd * kg[2 * lane], k1 * rstd * kg[2 * lane + 1]);
        const unsigned vv = *((const unsigned*)(kr + 512) + lane);
        bf16_t* vt = (bf16_t*)(a.ws + WS_VTX) + (((size_t)(l * NB + b) * 4 + hd) * 128) * MEMLEN + m;
        vt[(size_t)(2 * lane) * MEMLEN] = (bf16_t)(vv & 0xffff); vt[(size_t)(2 * lane + 1) * MEMLEN] = (bf16_t)(vv >> 16);
    }
}

DEV float sigmoid_f(float x) { return __builtin_amdgcn_rcpf(1.0f + __builtin_amdgcn_exp2f(-LOG2E * x)); }
DEV float tanh_f(float x) { const float e = __builtin_amdgcn_exp2f(-2.f * LOG2E * fabsf(x)); const float t = (1.f - e) * __builtin_amdgcn_rcpf(1.f + e); return x < 0.f ? -t : t; }
DEV void unpack8(const u32x4 v, float (&f)[8]) {
    f[0] = __uint_as_float(v.x << 16); f[1] = __uint_as_float(v.x & 0xffff0000u); f[2] = __uint_as_float(v.y << 16); f[3] = __uint_as_float(v.y & 0xffff0000u);
    f[4] = __uint_as_float(v.z << 16); f[5] = __uint_as_float(v.z & 0xffff0000u); f[6] = __uint_as_float(v.w << 16); f[7] = __uint_as_float(v.w & 0xffff0000u);
}
DEV u32x4 pack8(const float (&f)[8]) { u32x4 o; o.x = pk2(f[0], f[1]); o.y = pk2(f[2], f[3]); o.z = pk2(f[4], f[5]); o.w = pk2(f[6], f[7]); return o; }
DEV int crow(int r, int hi) { return (r & 3) + 8 * (r >> 2) + 4 * hi; }

DEV void prep_tile(const Args& a, int l, int tile, LAS unsigned char* lds, bool dry = false) {
    int tid_ = threadIdx.x; asm volatile("" : "+v"(tid_)); const int tid = tid_, lane = tid & 63, wid = __builtin_amdgcn_readfirstlane(tid >> 6);
    const int row0 = tile * 64, b = row0 / SEQ, t0 = row0 % SEQ;
    bf16_t* Z = (bf16_t*)(a.ws + WS_Z) + (size_t)row0 * ZP;
    {
        const int ch = tid % 228, sub = tid / 228; const bool act = tid < 456;
        const int col = ch < 64 ? ZC_RR + 8 * ch : ZC_RK + 8 * (ch - 64), mi = ch < 64 ? 8 * ch : 512 + 8 * (ch - 64);
        const int ts = 32 * sub; float prev[8], mu[8];
#pragma unroll
        for (int i = 0; i < 8; ++i) { prev[i] = 0.f; mu[i] = 0.f; }
        if (act) {
            const float* mup = a.in[14] + l * 1824 + mi;
#pragma unroll
            for (int i = 0; i < 8; ++i) mu[i] = mup[i];
            if (sub == 1) unpack8(*(const u32x4*)(Z + (size_t)(ts - 1) * ZP + col), prev);
            else if (t0 != 0) unpack8(*(const u32x4*)((const bf16_t*)(a.ws + WS_ZHALO) + (size_t)(tile - 1) * ZP + col), prev);
        }
        __syncthreads();
        if (act) {
#pragma unroll 1
            for (int t8 = 0; t8 < 32; t8 += 8) { u32x4 raw[8];
#pragma unroll
                for (int tt = 0; tt < 8; ++tt) raw[tt] = *(const u32x4*)(Z + (size_t)(ts + t8 + tt) * ZP + col);
#pragma unroll
                for (int tt = 0; tt < 8; ++tt) { float cur[8], o[8]; unpack8(raw[tt], cur);
#pragma unroll
                    for (int i = 0; i < 8; ++i) { o[i] = cur[i] + (prev[i] - cur[i]) * mu[i]; prev[i] = cur[i]; }
                    if (!dry) *(u32x4*)(Z + (size_t)(ts + t8 + tt) * ZP + col) = pack8(o); } }
        }
    }
    LAS float* kbuf = (LAS float*)lds;
    {
        const float* gfq = a.in[10] + l * 64; const float* gfk = a.in[11] + l * 64; const float* gmq = a.in[12] + l * 64; const float* gmk = a.in[13] + l * 64;
        const int* pos = (const int*)a.in[2] + b * SEQ + t0;
#pragma unroll 2
        for (int it = 0; it < 16; ++it) {
            const int item = it * 512 + tid, g8 = item >> 3, sub8 = item & 7, slot = g8 >> 6, token = g8 & 63, h = slot & 3, kind = slot >> 2;
            const int cb = (kind == 0 ? ZC_FQ : kind == 1 ? ZC_FK : kind == 2 ? ZC_MQ : ZC_MK) + 64 * h + 8 * sub8;
            const float* gp = (kind == 0 ? gfq : kind == 1 ? gfk : kind == 2 ? gmq : gmk) + 8 * sub8;
            u32x4* p = (u32x4*)(Z + (size_t)token * ZP + cb); float v[8]; unpack8(*p, v);
            float ss = 0.f;
#pragma unroll
            for (int i = 0; i < 8; ++i) ss += v[i] * v[i];
            ss += __shfl_xor(ss, 1); ss += __shfl_xor(ss, 2); ss += __shfl_xor(ss, 4);
            const float rstd = rsqrtf(ss * (1.f / 64) + NORM_EPS);
#pragma unroll
            for (int i = 0; i < 8; ++i) v[i] = v[i] * rstd * gp[i];
            float pr[8];
#pragma unroll
            for (int i = 0; i < 8; ++i) pr[i] = __shfl_xor(v[i], 1);
            if (kind >= 2 && sub8 < 2) {
                const float posf = (float)pos[token];
#pragma unroll
                for (int i = 0; i < 8; ++i) {
                    const float invf = (float)__builtin_exp2(-(double)i * 0.125 * 18.931568569324174);
                    const float ang = posf * invf; const double rev = (double)ang * 0.15915494309189535; const float fr = (float)(rev - __builtin_floor(rev));
                    const float sn = __builtin_amdgcn_sinf(fr), cs = __builtin_amdgcn_cosf(fr);
                    v[i] = sub8 == 0 ? v[i] * cs - pr[i] * sn : v[i] * cs + pr[i] * sn; }
            }
            if (kind == 3) {
#pragma unroll
                for (int i = 0; i < 8; ++i) kbuf[(token * 4 + h) * 64 + 8 * sub8 + i] = v[i]; }
            if (kind == 0 || kind == 2) {
#pragma unroll
                for (int i = 0; i < 8; ++i) v[i] *= C2_64; }
            if (!dry) *p = pack8(v);
        }
    }
    __syncthreads();
    if (tid < 256) { const int h = tid >> 6, d = tid & 63; float s = 0.f;
        for (int t = 0; t < 64; ++t) s += kbuf[(t * 4 + h) * 64 + d];
        if (!dry) ((float*)(a.ws + WS_KMP))[(((size_t)(b * 4 + h) * 64) + (t0 >> 6)) * 64 + d] = s; }
#pragma unroll 2
    for (int it = 0; it < 8; ++it) {
        const int item = it * 512 + tid, which = item >> 11, rem = item & 2047, tg = rem >> 8, c = rem & 255;
        const bf16_t* src = Z + (size_t)(8 * tg) * ZP + (which ? ZC_MV : ZC_FV) + c; unsigned short e[8];
#pragma unroll
        for (int i = 0; i < 8; ++i) e[i] = src[(size_t)i * ZP];
        u32x4 o; o.x = e[0] | ((unsigned)e[1] << 16); o.y = e[2] | ((unsigned)e[3] << 16); o.z = e[4] | ((unsigned)e[5] << 16); o.w = e[6] | ((unsigned)e[7] << 16);
        bf16_t* vt = (bf16_t*)(a.ws + (which ? WS_VTM : WS_VTF)) + ((size_t)(b * 4 + (c >> 6)) * 64 + (c & 63)) * SEQ + t0 + 8 * tg;
        if (!dry) *(u32x4*)vt = o;
    }
    if (tid < 256) { const int token = tid >> 2, h = tid & 3; const float x = bf2f(Z[(size_t)token * ZP + ZC_FF + h]) + a.in[9][l * 4 + h];
        const float lf = fminf(x, 0.f) - __logf(1.f + __expf(-fabsf(x)));
        if (!dry) ((float*)(a.ws + WS_LOGF))[(size_t)(b * 4 + h) * SEQ + t0 + token] = lf; }
    __syncthreads();
    LAS bf16_t* al = (LAS bf16_t*)lds;
    for (int item = tid; item < 64 * 36; item += 512) { const int token = item / 36, c = item % 36; float v[8]; unpack8(*(const u32x4*)(Z + (size_t)token * ZP + ZC_LO + 8 * c), v);
        if (c < 8) {
#pragma unroll
            for (int i = 0; i < 8; ++i) v[i] = tanh_f(v[i]); }
        else if (c >= 16) {
#pragma unroll
            for (int i = 0; i < 8; ++i) v[i] = sigmoid_f(v[i]); }
        *(LAS u32x4*)(al + token * 296 + 8 * c) = pack8(v); }
    __syncthreads();
    const unsigned char* wl = a.ws + WS_W + (size_t)l * WL_BYTES;
    const bf16_t* w2t = (const bf16_t*)(wl + OFF_W2T); const bf16_t* a2t = (const bf16_t*)(wl + OFF_A2T); const bf16_t* g2t = (const bf16_t*)(wl + OFF_G2T);
    const int r32 = lane & 31, hi = lane >> 5;
    for (int uu = 0; uu < 2; ++uu) {
        const int u = wid + 8 * uu, h = u & 7, th = u >> 3, token = 32 * th + r32;
        f32x16 aw[2], aa[2], ag[2];
#pragma unroll
        for (int ct = 0; ct < 2; ++ct) { aw[ct] = f32x16{}; aa[ct] = f32x16{}; ag[ct] = f32x16{}; }
        const LAS bf16_t* arow = al + token * 296 + 8 * hi;
#pragma unroll 1
        for (int ks = 0; ks < 4; ++ks) { const bf16x8 bw = *(const LAS bf16x8*)(arow + 16 * ks), ba = *(const LAS bf16x8*)(arow + 64 + 16 * ks);
#pragma unroll
            for (int ct = 0; ct < 2; ++ct) { const int chn = 64 * h + 32 * ct + r32;
                aw[ct] = __builtin_amdgcn_mfma_f32_32x32x16_bf16(*(const bf16x8*)(w2t + chn * 64 + 16 * ks + 8 * hi), bw, aw[ct], 0, 0, 0);
                aa[ct] = __builtin_amdgcn_mfma_f32_32x32x16_bf16(*(const bf16x8*)(a2t + chn * 64 + 16 * ks + 8 * hi), ba, aa[ct], 0, 0, 0); } }
#pragma unroll 1
        for (int ks = 0; ks < 10; ++ks) { const bf16x8 bg = *(const LAS bf16x8*)(arow + 128 + 16 * ks);
#pragma unroll
            for (int ct = 0; ct < 2; ++ct) { const int chn = 64 * h + 32 * ct + r32;
                ag[ct] = __builtin_amdgcn_mfma_f32_32x32x16_bf16(*(const bf16x8*)(g2t + chn * 160 + 16 * ks + 8 * hi), bg, ag[ct], 0, 0, 0); } }
        bf16_t* zr = Z + (size_t)token * ZP; const size_t grow = (size_t)(row0 + token);
        float* wd = (float*)(a.ws + WS_WD) + grow * 512; bf16_t* kkp = (bf16_t*)(a.ws + WS_KK) + grow * 512; bf16_t* kap = (bf16_t*)(a.ws + WS_KA) + grow * 512;
        const float* w0 = a.in[15] + l * 512; const float* a0 = a.in[17] + l * 512; const float* k_k = a.in[20] + l * 512; const float* k_a = a.in[21] + l * 512;
        float ss = 0.f;
#pragma unroll
        for (int ct = 0; ct < 2; ++ct)
#pragma unroll
            for (int rg = 0; rg < 4; ++rg) { const int c0 = 64 * h + 32 * ct + 8 * rg + 4 * hi;
                const u32x2 kraw = *(const u32x2*)(zr + ZC_RK + c0); const f32x4 w04 = *(const f32x4*)(w0 + c0), a04 = *(const f32x4*)(a0 + c0), kk4 = *(const f32x4*)(k_k + c0);
                f32x4 dec; u32x2 gp; float gv[4];
#pragma unroll
                for (int i = 0; i < 4; ++i) { const int r = 4 * rg + i;
                    const float kv = (i < 2) ? __uint_as_float((i & 1) ? (kraw.x & 0xffff0000u) : (kraw.x << 16)) : __uint_as_float((i & 1) ? (kraw.y & 0xffff0000u) : (kraw.y << 16));
                    const float wr_ = w04[i] + aw[ct][r]; const float sp = fmaxf(-wr_, 0.f) + __logf(1.f + __expf(-fabsf(wr_)));
                    dec[i] = __expf(-__expf(-sp - 0.5f));
                    aa[ct][r] = sigmoid_f(a04[i] + aa[ct][r]);
                    gv[i] = ag[ct][r];
                    const float kkv = kv * kk4[i]; aw[ct][r] = kkv; ss += kkv * kkv; }
                if (!dry) *(f32x4*)(wd + c0) = dec;
                gp.x = pk2(gv[0], gv[1]); gp.y = pk2(gv[2], gv[3]);
                if (!dry) *(u32x2*)(zr + (c0 < 256 ? ZC_FV + c0 : ZC_MV + (c0 - 256))) = gp; __builtin_amdgcn_sched_barrier(0); }
        ss += __shfl_xor(ss, 32);
        const float inv = 1.f / fmaxf(sqrtf(ss), 1e-12f);
#pragma unroll
        for (int ct = 0; ct < 2; ++ct)
#pragma unroll
            for (int rg = 0; rg < 4; ++rg) { const int c0 = 64 * h + 32 * ct + 8 * rg + 4 * hi; const f32x4 ka4 = *(const f32x4*)(k_a + c0);
                const u32x2 kraw = *(const u32x2*)(zr + ZC_RK + c0); const float kf4[4] = {bf2f(kraw.x & 0xffff), __uint_as_float(kraw.x & 0xffff0000u), bf2f(kraw.y & 0xffff), __uint_as_float(kraw.y & 0xffff0000u)};
                float kk[4], ka[4], kp[4];
#pragma unroll
                for (int i = 0; i < 4; ++i) { const int r = 4 * rg + i; kk[i] = aw[ct][r] * inv; ka[i] = kk[i] * aa[ct][r]; kp[i] = kf4[i] * (1.f + (aa[ct][r] - 1.f) * ka4[i]); }
                u32x2 o; o.x = pk2(kk[0], kk[1]); o.y = pk2(kk[2], kk[3]); if (!dry) *(u32x2*)(kkp + c0) = o;
                o.x = pk2(ka[0], ka[1]); o.y = pk2(ka[2], ka[3]); if (!dry) *(u32x2*)(kap + c0) = o;
                o.x = pk2(kp[0], kp[1]); o.y = pk2(kp[2], kp[3]); if (!dry) *(u32x2*)(zr + ZC_RK + c0) = o; __builtin_amdgcn_sched_barrier(0); }
    }
    __syncthreads();
}

template <int MODE, int D>
DEV void attn_unit(LAS unsigned char* lds, const bf16_t* Qp, int ldq, const bf16_t* Kp, int ldk, const bf16_t* Vt, int ldv, bf16_t* Op, int ldo,
                   int q0, int ntiles, int qb, const float* aux, const float* qgain, bool dry = false) {
    constexpr int KP = D + 8, KBYTES = 64 * KP * 2, VP = 72, VBYTES = D * VP * 2, NLD = D / 64;
    int tid_ = threadIdx.x; asm volatile("" : "+v"(tid_)); const int tid = tid_, lane = tid & 63, wid = __builtin_amdgcn_readfirstlane(tid >> 6), r32 = lane & 31, hi = lane >> 5;
    LAS float* cl = (LAS float*)lds; LAS unsigned* selm = (LAS unsigned*)(lds + 8192);
    LAS unsigned char* kb = lds + 16384; LAS unsigned char* vb = kb + 2 * KBYTES;
    const int q = q0 + wid * 32 + r32;
    if (MODE == 0) {
        const int n = 64 * ntiles; float v[8]; float run = 0.f;
#pragma unroll
        for (int i = 0; i < 8; ++i) { const int idx = 8 * tid + i; v[i] = idx < n ? aux[idx] : 0.f; run += v[i]; v[i] = run; }
        float sc = run;
#pragma unroll
        for (int o = 1; o < 64; o <<= 1) { const float t = __shfl_up(sc, o); if (lane >= o) sc += t; }
        LAS float* wsum = (LAS float*)kb;
        if (lane == 63) wsum[wid] = sc;
        __syncthreads();
        float off = sc - run;
        for (int w = 0; w < wid; ++w) off += wsum[w];
#pragma unroll
        for (int i = 0; i < 8; ++i) cl[8 * tid + i] = (off + v[i]) * LOG2E;
    }
    if (MODE == 1) {
        LAS float* km = cl;
        for (int e = tid; e < 16 * 64; e += 512) { const int nblk = e >> 6, d = e & 63; const float* pp = aux + (size_t)(4 * nblk) * 64 + d;
            km[e] = ((pp[0] + pp[64]) + (pp[128] + pp[192])) * (1.f / 256); }
        __syncthreads();
        if (tid < 256) { const bf16_t* qr = Qp + (size_t)(q0 + tid) * ldq; float g[16];
#pragma unroll
            for (int nb = 0; nb < 16; ++nb) g[nb] = 0.f;
            for (int c = 0; c < 8; ++c) { float qv[8]; unpack8(*(const u32x4*)(qr + 8 * c), qv);
#pragma unroll
                for (int nb = 0; nb < 16; ++nb) {
#pragma unroll
                    for (int i = 0; i < 8; ++i) g[nb] += qv[i] * km[nb * 64 + 8 * c + i]; } }
            unsigned m = 0u;
#pragma unroll
            for (int pick = 0; pick < 3; ++pick) { float best = -INFINITY; int bi = -1;
#pragma unroll
                for (int nb = 0; nb < 16; ++nb) { if (nb < qb && !((m >> nb) & 1u) && g[nb] > best) { best = g[nb]; bi = nb; } }
                if (bi >= 0) m |= 1u << bi; }
            selm[tid] = m; }
    }
    bf16x8 qf[D / 16];
#pragma unroll
    for (int d0 = 0; d0 < D / 16; ++d0) qf[d0] = *(const bf16x8*)(Qp + (size_t)q * ldq + d0 * 16 + hi * 8);
    if (MODE == 2) {
        float ss = 0.f;
#pragma unroll
        for (int d0 = 0; d0 < D / 16; ++d0) { float qv[8]; unpack8(__builtin_bit_cast(u32x4, qf[d0]), qv);
#pragma unroll
            for (int i = 0; i < 8; ++i) ss += qv[i] * qv[i]; }
        ss += __shfl_xor(ss, 32);
        const float rstd = rsqrtf(ss * (1.f / D) + NORM_EPS) * C2_128;
#pragma unroll
        for (int d0 = 0; d0 < D / 16; ++d0) { float qv[8]; unpack8(__builtin_bit_cast(u32x4, qf[d0]), qv);
#pragma unroll
            for (int i = 0; i < 8; ++i) qv[i] = qv[i] * rstd * qgain[d0 * 16 + hi * 8 + i];
            qf[d0] = __builtin_bit_cast(bf16x8, pack8(qv)); __builtin_amdgcn_sched_barrier(0); }
    }
    float mrun = -INFINITY, lrun = 0.f; f32x16 o[D / 32];
#pragma unroll
    for (int dt = 0; dt < D / 32; ++dt) o[dt] = f32x16{};
    __syncthreads();
    const float cq = (MODE == 0) ? cl[q] : 0.f;
    const unsigned sel = (MODE == 1) ? selm[wid * 32 + r32] : 0u;
    u32x4 kreg[NLD], vreg[NLD];
#define ATT_LOAD(t) do { _Pragma("unroll") for (int i_ = 0; i_ < NLD; ++i_) { const int idx_ = tid + 512 * i_; \
        kreg[i_] = *(const u32x4*)(Kp + (size_t)(64 * (t) + idx_ / (D / 8)) * ldk + (idx_ % (D / 8)) * 8); \
        vreg[i_] = *(const u32x4*)(Vt + (size_t)(idx_ >> 3) * ldv + 64 * (t) + (idx_ & 7) * 8); } } while (0)
#define ATT_STORE(buf) do { _Pragma("unroll") for (int i_ = 0; i_ < NLD; ++i_) { const int idx_ = tid + 512 * i_; \
        *(LAS u32x4*)(kb + (buf) * KBYTES + ((idx_ / (D / 8)) * KP + (idx_ % (D / 8)) * 8) * 2) = kreg[i_]; \
        *(LAS u32x4*)(vb + (buf) * VBYTES + ((idx_ >> 3) * VP + (idx_ & 7) * 8) * 2) = vreg[i_]; } } while (0)
    ATT_LOAD(0); ATT_STORE(0);
    __syncthreads();
    for (int t = 0; t < ntiles; ++t) {
        const int buf = t & 1, key0 = 64 * t;
        if (t + 1 < ntiles) ATT_LOAD(t + 1);
        bool work = true; const int nblk = key0 >> 8;
        if (MODE == 0) work = key0 <= q0 + wid * 32 + 31;
        if (MODE == 1) work = (nblk == qb) ? (key0 <= q0 + wid * 32 + 31) : (__any((sel >> nblk) & 1u) != 0);
        if (work) {
            const LAS unsigned char* kt = kb + buf * KBYTES; const LAS unsigned char* vt = vb + buf * VBYTES;
            constexpr int NKH = (D == 64) ? 2 : 1;
#pragma unroll 1
            for (int ks = 0; ks < 2 / NKH; ++ks) {
            f32x16 p[NKH];
#pragma unroll
            for (int kh = 0; kh < NKH; ++kh) { p[kh] = f32x16{}; const int khh = ks * NKH + kh;
#pragma unroll
                for (int d0 = 0; d0 < D / 16; ++d0) { const bf16x8 kf = *(const LAS bf16x8*)(kt + ((32 * khh + r32) * KP + 16 * d0 + 8 * hi) * 2);
                    p[kh] = __builtin_amdgcn_mfma_f32_32x32x16_bf16(kf, qf[d0], p[kh], 0, 0, 0); } }
            if (MODE == 0) {
#pragma unroll
                for (int kh = 0; kh < NKH; ++kh)
#pragma unroll
                    for (int rg = 0; rg < 4; ++rg) { const int kk0 = key0 + 32 * (ks * NKH + kh) + 8 * rg + 4 * hi; const f32x4 ck = *(const LAS f32x4*)(cl + kk0);
#pragma unroll
                        for (int i = 0; i < 4; ++i) { const float s = p[kh][4 * rg + i] + (cq - ck[i]); p[kh][4 * rg + i] = (kk0 + i > q) ? -INFINITY : s; } }
            }
            if (MODE == 1) {
                if (nblk == qb) {
#pragma unroll
                    for (int kh = 0; kh < NKH; ++kh)
#pragma unroll
                        for (int r = 0; r < 16; ++r) { if (key0 + 32 * (ks * NKH + kh) + crow(r, hi) > q) p[kh][r] = -INFINITY; }
                } else if (!((sel >> nblk) & 1u)) {
#pragma unroll
                    for (int kh = 0; kh < NKH; ++kh)
#pragma unroll
                        for (int r = 0; r < 16; ++r) p[kh][r] = -INFINITY;
                }
            }
            float mx = p[0][0];
#pragma unroll
            for (int kh = 0; kh < NKH; ++kh)
#pragma unroll
                for (int r = 0; r < 16; ++r) mx = fmaxf(mx, p[kh][r]);
            mx = fmaxf(mx, __shfl_xor(mx, 32));
            const float mnew = fmaxf(mrun, mx), muse = (mnew == -INFINITY) ? 0.f : mnew;
            const float alpha = __builtin_amdgcn_exp2f(mrun - muse);
            mrun = mnew; lrun *= alpha;
            if (__any(alpha != 1.0f)) {
#pragma unroll
                for (int dt = 0; dt < D / 32; ++dt) o[dt] *= alpha; }
            float ps = 0.f;
#pragma unroll
            for (int kh = 0; kh < NKH; ++kh)
#pragma unroll
                for (int r = 0; r < 16; ++r) { p[kh][r] = __builtin_amdgcn_exp2f(p[kh][r] - muse); ps += p[kh][r]; }
            lrun += ps;
            bf16x8 pb[NKH][2];
#pragma unroll
            for (int kh = 0; kh < NKH; ++kh)
#pragma unroll
                for (int j = 0; j < 2; ++j) { u32x4 w; w.x = pk2(p[kh][8 * j + 0], p[kh][8 * j + 1]); w.y = pk2(p[kh][8 * j + 2], p[kh][8 * j + 3]); w.z = pk2(p[kh][8 * j + 4], p[kh][8 * j + 5]); w.w = pk2(p[kh][8 * j + 6], p[kh][8 * j + 7]);
                    pb[kh][j] = __builtin_bit_cast(bf16x8, w); }
#pragma unroll
            for (int dt = 0; dt < D / 32; ++dt)
#pragma unroll
                for (int kh = 0; kh < NKH; ++kh)
#pragma unroll
                    for (int j = 0; j < 2; ++j) { const LAS unsigned char* vp_ = vt + ((32 * dt + r32) * VP + 32 * (ks * NKH + kh) + 16 * j + 4 * hi) * 2;
                        const u32x2 lo = *(const LAS u32x2*)vp_, hh = *(const LAS u32x2*)(vp_ + 16); u32x4 w; w.x = lo.x; w.y = lo.y; w.z = hh.x; w.w = hh.y;
                        o[dt] = __builtin_amdgcn_mfma_f32_32x32x16_bf16(__builtin_bit_cast(bf16x8, w), pb[kh][j], o[dt], 0, 0, 0); }
            }
        }
        if (t + 1 < ntiles) ATT_STORE(buf ^ 1);
        __syncthreads();
    }
#undef ATT_LOAD
#undef ATT_STORE
    lrun += __shfl_xor(lrun, 32);
    const float inv = 1.f / lrun;
    bf16_t* orow = Op + (size_t)q * ldo;
    if (!dry)
#pragma unroll
    for (int dt = 0; dt < D / 32; ++dt)
#pragma unroll
        for (int rg = 0; rg < 4; ++rg) { u32x2 w; w.x = pk2(o[dt][4 * rg] * inv, o[dt][4 * rg + 1] * inv); w.y = pk2(o[dt][4 * rg + 2] * inv, o[dt][4 * rg + 3] * inv);
            *(u32x2*)(orow + 32 * dt + 8 * rg + 4 * hi) = w; }
    __syncthreads();
}

constexpr int RW_NCH = SEQ / 16;
constexpr int RW_ARP = 72, RW_BKTP = 32, RW_VTP = 24, RW_PMP = 16, RW_LP = 20;
constexpr int RW_NBUF = 6, RW_NPRE = 4;
constexpr int RW_DB = 15104, RW_AR = 0, RW_BKT = 4608, RW_VT = 8704, RW_GC = 11776, RW_TM = 12032, RW_PM1 = 13056, RW_PM2 = 14080;
constexpr int RW_PRIV = RW_NBUF * RW_DB, RW_PRIV_BYTES = 5888, RW_PBK = 0, RW_PLAB = 4608;
constexpr int RW_NYB = 4;
constexpr int RW_YB = RW_PRIV + RW_NPRE * RW_PRIV_BYTES, RW_FLG = RW_YB + RW_NYB * 4096, RW_SLOT_BYTES = RW_FLG + 128;
static_assert(RW_PM2 + 32 * RW_PMP * 2 == RW_DB && RW_TM + 32 * RW_PMP * 2 == RW_PM1 && RW_SLOT_BYTES <= 131072 && RW_DB % 16 == 0 && RW_PRIV_BYTES % 16 == 0, "rwkv lds map");
DEV bf16x8 pack_acc8(const f32x16& v, int base) { u32x4 w; w.x = pk2(v[base], v[base + 1]); w.y = pk2(v[base + 2], v[base + 3]); w.z = pk2(v[base + 4], v[base + 5]); w.w = pk2(v[base + 6], v[base + 7]); return __builtin_bit_cast(bf16x8, w); }
DEV int fresh_lane() { int l_; asm volatile("v_mbcnt_lo_u32_b32 %0, -1, 0\n\tv_mbcnt_hi_u32_b32 %0, -1, %0" : "=v"(l_)); return l_; }
DEV void rw_wait(volatile LAS unsigned* f, unsigned target) { while (*f < target) __builtin_amdgcn_s_sleep(1); asm volatile("" ::: "memory"); }
DEV void rw_post_flag(volatile LAS unsigned* f, unsigned v) { asm volatile("s_waitcnt vmcnt(0) lgkmcnt(0)" ::: "memory"); *f = v; }
DEV bf16x8 frag_perm(const LAS bf16_t* rowp, int hi) { const u32x2 lo = *(const LAS u32x2*)(rowp + 4 * hi), hh = *(const LAS u32x2*)(rowp + 8 + 4 * hi); u32x4 w; w.x = lo.x; w.y = lo.y; w.z = hh.x; w.w = hh.y; return __builtin_bit_cast(bf16x8, w); }

struct RwRaw { float w[16]; unsigned short kk[16], ka[16], kp[16], rr[16], vr[16]; };
DEV void rwkv_pre_load(RwRaw& R, int c, const float* WDp, const bf16_t* KKp, const bf16_t* KAp, const bf16_t* Zl) {
#pragma unroll
    for (int t = 0; t < 16; ++t) { const size_t ro = (size_t)(16 * c + t);
        R.w[t] = WDp[ro * 512]; R.kk[t] = KKp[ro * 512]; R.ka[t] = KAp[ro * 512]; R.kp[t] = Zl[ro * ZP + ZC_RK]; R.rr[t] = Zl[ro * ZP + ZC_RR]; R.vr[t] = Zl[ro * ZP + ZC_RV]; }
}
DEV void rwkv_pre_a(const RwRaw& R, int c, LAS unsigned char* sl, volatile LAS unsigned* flg, int lane) {
    const int bi = c % RW_NBUF, pw = c % RW_NPRE;
    LAS bf16_t* BK = (LAS bf16_t*)(sl + RW_PRIV + pw * RW_PRIV_BYTES + RW_PBK);
    LAS unsigned char* db = sl + bi * RW_DB;
    LAS bf16_t* AR = (LAS bf16_t*)(db + RW_AR); LAS bf16_t* BKT = (LAS bf16_t*)(db + RW_BKT); LAS bf16_t* VT = (LAS bf16_t*)(db + RW_VT); LAS float* GC = (LAS float*)(db + RW_GC);
    if (c >= RW_NBUF) rw_wait(flg + 6 + bi, (unsigned)(c - RW_NBUF + 1));
    float g = 1.f; unsigned bkt[16];
#pragma unroll
    for (int t = 0; t < 16; ++t) {
        const float w = R.w[t], kk = bf2f(R.kk[t]), ka = bf2f(R.ka[t]), kp = bf2f(R.kp[t]), rr = bf2f(R.rr[t]);
        const float at = -kk * g; g *= w; const float inv = __builtin_amdgcn_rcpf(g);
        const unsigned bt = f2bf(ka * inv), kt = f2bf(kp * inv);
        AR[t * RW_ARP + lane] = (bf16_t)f2bf(at); AR[(16 + t) * RW_ARP + lane] = (bf16_t)f2bf(rr * g);
        BK[t * RW_ARP + lane] = (bf16_t)bt; BK[(16 + t) * RW_ARP + lane] = (bf16_t)kt;
        if (t & 1) { bkt[t >> 1] |= bt << 16; bkt[8 + (t >> 1)] |= kt << 16; } else { bkt[t >> 1] = bt; bkt[8 + (t >> 1)] = kt; }
    }
    GC[lane] = g;
#pragma unroll
    for (int q4 = 0; q4 < 4; ++q4) { u32x4 w4; w4.x = bkt[4 * q4]; w4.y = bkt[4 * q4 + 1]; w4.z = bkt[4 * q4 + 2]; w4.w = bkt[4 * q4 + 3]; *(LAS u32x4*)(BKT + lane * RW_BKTP + 8 * q4) = w4; }
    { unsigned vv[8];
#pragma unroll
      for (int t = 0; t < 16; ++t) { const unsigned x = R.vr[t]; if (t & 1) vv[t >> 1] |= x << 16; else vv[t >> 1] = x; }
      u32x4 v0; v0.x = vv[0]; v0.y = vv[1]; v0.z = vv[2]; v0.w = vv[3]; u32x4 v1; v1.x = vv[4]; v1.y = vv[5]; v1.z = vv[6]; v1.w = vv[7];
      *(LAS u32x4*)(VT + lane * RW_VTP) = v0; *(LAS u32x4*)(VT + lane * RW_VTP + 8) = v1; }
}
DEV void rwkv_pre_b(int c, LAS unsigned char* sl, volatile LAS unsigned* flg, int lane) {
    const int r32 = lane & 31, hi = lane >> 5, bi = c % RW_NBUF, pw = c % RW_NPRE;
    LAS bf16_t* BK = (LAS bf16_t*)(sl + RW_PRIV + pw * RW_PRIV_BYTES + RW_PBK); LAS float* LAB = (LAS float*)(sl + RW_PRIV + pw * RW_PRIV_BYTES + RW_PLAB);
    LAS unsigned char* db = sl + bi * RW_DB;
    LAS bf16_t* AR = (LAS bf16_t*)(db + RW_AR); LAS bf16_t* TM = (LAS bf16_t*)(db + RW_TM); LAS bf16_t* PM1 = (LAS bf16_t*)(db + RW_PM1); LAS bf16_t* PM2 = (LAS bf16_t*)(db + RW_PM2);
    f32x16 P = f32x16{};
#pragma unroll
    for (int ks = 0; ks < 4; ++ks) P = __builtin_amdgcn_mfma_f32_32x32x16_bf16(*(const LAS bf16x8*)(AR + r32 * RW_ARP + 16 * ks + 8 * hi), *(const LAS bf16x8*)(BK + r32 * RW_ARP + 16 * ks + 8 * hi), P, 0, 0, 0);
    const int n = r32;
#pragma unroll
    for (int r = 0; r < 16; ++r) { const int m = crow(r, hi);
        if (r < 8) { if (n < 16) LAB[m * RW_LP + n] = (n < m) ? P[r] : 0.f; else PM1[m * RW_PMP + (n - 16)] = (bf16_t)f2bf((n - 16 < m) ? P[r] : 0.f); }
        else { if (n < 16) PM2[m * RW_PMP + n] = (bf16_t)f2bf((n <= m - 16) ? P[r] : 0.f); else PM1[m * RW_PMP + (n - 16)] = (bf16_t)f2bf((n - 16 <= m - 16) ? P[r] : 0.f); } }
}
DEV void rwkv_pre_c(int c, LAS unsigned char* sl, volatile LAS unsigned* flg, int lane) {
    const int bi = c % RW_NBUF, pw = c % RW_NPRE;
    const LAS float* LAB = (const LAS float*)(sl + RW_PRIV + pw * RW_PRIV_BYTES + RW_PLAB); LAS bf16_t* TM = (LAS bf16_t*)(sl + bi * RW_DB + RW_TM);
    { const int cc = lane & 15; float T[16];
#pragma unroll
      for (int t = 0; t < 16; ++t) { float acc = (t == cc) ? 1.f : 0.f;
          int z = 0; if (t >= 3) asm volatile("v_and_b32 %0, 0, %1" : "=v"(z) : "v"(T[t - 3]));
          const LAS float* lrow = LAB + t * RW_LP + z;
#pragma unroll
          for (int tau = 0; tau < t; ++tau) acc = fmaf(lrow[tau], T[tau], acc);
          T[t] = acc; }
      if (lane < 16) {
#pragma unroll
          for (int t = 0; t < 16; ++t) TM[t * RW_PMP + cc] = (bf16_t)f2bf(T[t]); } }
    asm volatile("s_waitcnt lgkmcnt(0)" ::: "memory"); flg[bi] = (unsigned)(c + 1);
}
DEV void rwkv_pre(const Args& a, int b, int h, LAS unsigned char* sl, int par) {
    const int lane = fresh_lane();
    volatile LAS unsigned* flg = (volatile LAS unsigned*)(sl + RW_FLG);
    const size_t rowb = (size_t)b * SEQ;
    const bf16_t* Zl = (const bf16_t*)(a.ws + WS_Z) + rowb * ZP + h * 64 + lane;
    const float* WDp = (const float*)(a.ws + WS_WD) + rowb * 512 + h * 64 + lane;
    const bf16_t* KKp = (const bf16_t*)(a.ws + WS_KK) + rowb * 512 + h * 64 + lane;
    const bf16_t* KAp = (const bf16_t*)(a.ws + WS_KA) + rowb * 512 + h * 64 + lane;
    for (int bz = par; bz < RW_NBUF; bz += RW_NPRE) for (int e = lane; e < 32 * RW_PMP; e += 64) { ((LAS bf16_t*)(sl + bz * RW_DB + RW_PM2))[e] = 0; ((LAS bf16_t*)(sl + bz * RW_DB + RW_TM))[e] = 0; }
    RwRaw R;
    rwkv_pre_load(R, par, WDp, KKp, KAp, Zl);
#pragma unroll 1
    for (int c = par; c < RW_NCH; c += RW_NPRE) {
        rwkv_pre_a(R, c, sl, flg, lane);
        rwkv_pre_b(c, sl, flg, lane);
        asm volatile("" ::: "memory");
        rwkv_pre_load(R, (c + RW_NPRE < RW_NCH) ? c + RW_NPRE : c, WDp, KKp, KAp, Zl);
#if !defined(NOPREC)
        rwkv_pre_c(c, sl, flg, lane);
#endif
    }
}

DEV void rwkv_main(LAS unsigned char* sl) {
    const int lane = fresh_lane(), r32 = lane & 31, hi = lane >> 5;
    volatile LAS unsigned* flg = (volatile LAS unsigned*)(sl + RW_FLG);
    f32x16 ST[2][2];
#pragma unroll
    for (int jt = 0; jt < 2; ++jt)
#pragma unroll
        for (int it = 0; it < 2; ++it) ST[jt][it] = f32x16{};
#pragma unroll 1
    for (int c = 0; c < RW_NCH; ++c) {
        const int bi = c % RW_NBUF;
        LAS unsigned char* db = sl + bi * RW_DB;
        const LAS bf16_t* AR = (const LAS bf16_t*)(db + RW_AR); const LAS bf16_t* BKT = (const LAS bf16_t*)(db + RW_BKT); const LAS bf16_t* VT = (const LAS bf16_t*)(db + RW_VT);
        const LAS float* GC = (const LAS float*)(db + RW_GC); const LAS bf16_t* TM = (const LAS bf16_t*)(db + RW_TM); const LAS bf16_t* PM1 = (const LAS bf16_t*)(db + RW_PM1); const LAS bf16_t* PM2 = (const LAS bf16_t*)(db + RW_PM2);
        const int yi = c % RW_NYB; LAS float* YB = (LAS float*)(sl + RW_YB + yi * 4096);
        rw_wait(flg + bi, (unsigned)(c + 1));
        f32x16 X[2]; X[0] = f32x16{}; X[1] = f32x16{};
#pragma unroll
        for (int jt = 0; jt < 2; ++jt)
#pragma unroll
            for (int rgp = 0; rgp < 2; ++rgp) { const bf16x8 af = frag_perm(AR + r32 * RW_ARP + 32 * jt + 16 * rgp, hi);
#pragma unroll
                for (int it = 0; it < 2; ++it) X[it] = __builtin_amdgcn_mfma_f32_32x32x16_bf16(af, pack_acc8(ST[jt][it], 8 * rgp), X[it], 0, 0, 0); }
        bf16x8 vt[2];
        { const bf16x8 a1 = *(const LAS bf16x8*)(PM1 + r32 * RW_PMP + 8 * hi);
#pragma unroll
          for (int it = 0; it < 2; ++it) { vt[it] = *(const LAS bf16x8*)(VT + (32 * it + r32) * RW_VTP + 8 * hi); X[it] = __builtin_amdgcn_mfma_f32_32x32x16_bf16(a1, vt[it], X[it], 0, 0, 0); } }
        bf16x8 ub[2];
        { const bf16x8 ta = frag_perm(TM + r32 * RW_PMP, hi), pm2 = frag_perm(PM2 + r32 * RW_PMP, hi);
#pragma unroll
          for (int it = 0; it < 2; ++it) { const f32x16 U = __builtin_amdgcn_mfma_f32_32x32x16_bf16(ta, pack_acc8(X[it], 0), f32x16{}, 0, 0, 0);
              ub[it] = pack_acc8(U, 0); X[it] = __builtin_amdgcn_mfma_f32_32x32x16_bf16(pm2, ub[it], X[it], 0, 0, 0); } }
        if (c >= RW_NYB) rw_wait(flg + 16 + yi, (unsigned)(c - RW_NYB + 1));
#pragma unroll
        for (int it = 0; it < 2; ++it)
#pragma unroll
            for (int r = 8; r < 16; ++r) YB[(crow(r, hi) - 16) * 64 + 32 * it + r32] = X[it][r];
        rw_post_flag(flg + 12 + yi, (unsigned)(c + 1));
#pragma unroll
        for (int jt = 0; jt < 2; ++jt) { const bf16x8 a0 = frag_perm(BKT + (32 * jt + r32) * RW_BKTP, hi), a1 = *(const LAS bf16x8*)(BKT + (32 * jt + r32) * RW_BKTP + 16 + 8 * hi);
#pragma unroll
            for (int it = 0; it < 2; ++it) { ST[jt][it] = __builtin_amdgcn_mfma_f32_32x32x16_bf16(a0, ub[it], ST[jt][it], 0, 0, 0);
                ST[jt][it] = __builtin_amdgcn_mfma_f32_32x32x16_bf16(a1, vt[it], ST[jt][it], 0, 0, 0); }
#pragma unroll
            for (int rg = 0; rg < 4; ++rg) { const f32x4 g4 = *(const LAS f32x4*)(GC + 32 * jt + 8 * rg + 4 * hi);
#pragma unroll
                for (int e = 0; e < 4; ++e) { ST[jt][0][4 * rg + e] *= g4[e]; ST[jt][1][4 * rg + e] *= g4[e]; } } }
        rw_post_flag(flg + 6 + bi, (unsigned)(c + 1));
    }
}

DEV void rwkv_post(const Args& a, int l, int b, int h, LAS unsigned char* sl, int par) {
    const int lane = fresh_lane();
    volatile LAS unsigned* flg = (volatile LAS unsigned*)(sl + RW_FLG);
    bf16_t* Zb = (bf16_t*)(a.ws + WS_Z) + (size_t)b * SEQ * ZP;
    const int gcol0 = h < 4 ? ZC_FV + h * 64 : ZC_MV + (h - 4) * 64;
    const int t = lane >> 2, qd = lane & 3, c0 = h * 64 + 16 * qd;
    const float* rkp = a.in[22] + l * 512 + c0; const float* lw = a.in[23] + l * 512 + c0; const float* lb = a.in[24] + l * 512 + c0;
#pragma unroll 1
    for (int c = par; c < RW_NCH; c += 2) {
        bf16_t* zr = Zb + (size_t)(16 * c + t) * ZP;
        const u32x4 r0 = *(const u32x4*)(zr + ZC_RR + c0), r1 = *(const u32x4*)(zr + ZC_RR + c0 + 8), k0 = *(const u32x4*)(zr + ZC_RK + c0), k1 = *(const u32x4*)(zr + ZC_RK + c0 + 8);
        const u32x4 v0 = *(const u32x4*)(zr + ZC_RV + c0), v1 = *(const u32x4*)(zr + ZC_RV + c0 + 8), g0 = *(const u32x4*)(zr + gcol0 + 16 * qd), g1 = *(const u32x4*)(zr + gcol0 + 16 * qd + 8);
        const int yi = c % RW_NYB; const LAS float* YB = (const LAS float*)(sl + RW_YB + yi * 4096);
        rw_wait(flg + 12 + yi, (unsigned)(c + 1));
        float y[16];
#pragma unroll
        for (int q4 = 0; q4 < 4; ++q4) { const f32x4 yy = *(const LAS f32x4*)(YB + t * 64 + 16 * qd + 4 * q4); y[4 * q4] = yy[0]; y[4 * q4 + 1] = yy[1]; y[4 * q4 + 2] = yy[2]; y[4 * q4 + 3] = yy[3]; }
        asm volatile("s_waitcnt lgkmcnt(0)" ::: "memory");
        flg[16 + yi] = (unsigned)(c + 1);
        float s = 0.f;
#pragma unroll
        for (int e = 0; e < 16; ++e) s += y[e];
        s += __shfl_xor(s, 1); s += __shfl_xor(s, 2);
        const float mean = s * (1.f / 64); float q = 0.f;
#pragma unroll
        for (int e = 0; e < 16; ++e) { y[e] -= mean; q += y[e] * y[e]; }
        q += __shfl_xor(q, 1); q += __shfl_xor(q, 2);
        const float rstd = rsqrtf(q * (1.f / 64) + GN_EPS);
        float rv[16], kv[16];
        unpack8(r0, *(float(*)[8])&rv[0]); unpack8(r1, *(float(*)[8])&rv[8]); unpack8(k0, *(float(*)[8])&kv[0]); unpack8(k1, *(float(*)[8])&kv[8]);
        float bs = 0.f;
#pragma unroll
        for (int e = 0; e < 16; ++e) bs += rv[e] * kv[e] * rkp[e];
        bs += __shfl_xor(bs, 1); bs += __shfl_xor(bs, 2);
        float vv[16], gv[16], o[16];
        unpack8(v0, *(float(*)[8])&vv[0]); unpack8(v1, *(float(*)[8])&vv[8]); unpack8(g0, *(float(*)[8])&gv[0]); unpack8(g1, *(float(*)[8])&gv[8]);
#pragma unroll
        for (int e = 0; e < 16; ++e) o[e] = (y[e] * rstd * lw[e] + lb[e] + bs * vv[e]) * gv[e];
        *(u32x4*)(zr + ZC_RR + c0) = pack8(*(float(*)[8])&o[0]); *(u32x4*)(zr + ZC_RR + c0 + 8) = pack8(*(float(*)[8])&o[8]);
    }
}

#define XB_TMO      128
#define XB_XCNT(j)  (256  + 64 * (j))
#define XB_XSUB(j)  (1280 + 64 * (j))
#define XB_XGEN(j)  (2304 + 64 * (j))
#define XB_TOP      3328
#define XB_TOPGEN   3392
#define XCD_BAR_WORDS 3456
#define XB_SPIN_CAP (1u << 18)

__device__ __forceinline__ unsigned xb_ld(unsigned* p)              { return __hip_atomic_load(p, __ATOMIC_RELAXED, __HIP_MEMORY_SCOPE_AGENT); }
__device__ __forceinline__ unsigned xb_add(unsigned* p, unsigned v) { return __hip_atomic_fetch_add(p, v, __ATOMIC_RELAXED, __HIP_MEMORY_SCOPE_AGENT); }
__device__ __forceinline__ unsigned xb_xcc_id() { return (unsigned)__builtin_amdgcn_s_getreg((3 << 11) | 20) & 0xFu; }
#define XB_SPIN(cond, bar) do { unsigned _sp = 0; while (cond) { __builtin_amdgcn_s_sleep(1); \
    if ((++_sp & 255u) == 0u) { if (xb_ld(&(bar)[XB_TMO])) break; if (_sp > XB_SPIN_CAP) { atomicAdd(&(bar)[XB_TMO], 1u); break; } } } } while (0)

struct XcdBarrier {
    unsigned* bar; unsigned x;
    volatile LAS unsigned* st;
};

__device__ __forceinline__ XcdBarrier xcd_barrier_post(unsigned* bar, volatile LAS unsigned* st) {
    XcdBarrier b; b.bar = bar; b.x = xb_xcc_id(); b.st = st;
    if (threadIdx.x == 0) (void)xb_add(&bar[XB_XCNT(b.x)], 1u);
    return b;
}
__device__ __forceinline__ void xcd_barrier_complete(unsigned* bar, unsigned x, unsigned& nloc, unsigned& nx) {
    const unsigned G = gridDim.x * gridDim.y * gridDim.z;
    unsigned sum, cnt, mine, sp = 0u;
    for (;;) {
        sum = 0u; cnt = 0u; mine = 0u;
#pragma unroll
        for (unsigned j = 0; j < 16; ++j) { const unsigned c = xb_ld(&bar[XB_XCNT(j)]); sum += c; cnt += (c > 0u) ? 1u : 0u; mine = (j == x) ? c : mine; }
        if (sum == G) break;
        __builtin_amdgcn_s_sleep(1);
        if ((++sp & 255u) == 0u) { if (xb_ld(&bar[XB_TMO])) break; if (sp > XB_SPIN_CAP) { atomicAdd(&bar[XB_TMO], 1u); break; } }
    }
    nloc = mine > 0u ? mine : 1u; nx = cnt > 0u ? cnt : 1u;
}

__device__ __forceinline__ void xcd_barrier(const XcdBarrier& b) {
    asm volatile("s_waitcnt vmcnt(0)" ::: "memory");
    __syncthreads();
    if (threadIdx.x == 0) {
        unsigned* bar = b.bar;
        __builtin_amdgcn_s_waitcnt(0);
        unsigned nloc = b.st[0], nx = b.st[1];
        if (nloc == 0u) { xcd_barrier_complete(bar, b.x, nloc, nx); b.st[0] = nloc; b.st[1] = nx; }
        const unsigned old = xb_add(&bar[XB_XSUB(b.x)], 1u);
        const unsigned gen = old / nloc;
        if (old + 1u == (gen + 1u) * nloc) {
            __builtin_amdgcn_fence(__ATOMIC_RELEASE, "agent");
            asm volatile("s_waitcnt vmcnt(0)" ::: "memory");
            const unsigned og = xb_add(&bar[XB_TOP], 1u);
            const unsigned tg = og / nx;
            if (og + 1u == (tg + 1u) * nx) xb_add(&bar[XB_TOPGEN], 1u);
            else XB_SPIN(xb_ld(&bar[XB_TOPGEN]) == tg, bar);
            __builtin_amdgcn_fence(__ATOMIC_ACQUIRE, "agent");
            xb_add(&bar[XB_XGEN(b.x)], 1u);
            asm volatile("s_waitcnt vmcnt(0)" ::: "memory");
        } else {
            XB_SPIN(xb_ld(&bar[XB_XGEN(b.x)]) == gen, bar);
            __builtin_amdgcn_fence(__ATOMIC_ACQUIRE, "agent");
            asm volatile("s_waitcnt vmcnt(0)" ::: "memory");
        }
    }
    __syncthreads();
}

constexpr int N_PHASES = 1 + 15 * NL;
#ifndef MK_MULTI
#define MK_MULTI 0
#endif
#ifndef PROBE_Q
#define PROBE_Q 500.f
#endif
#ifndef PROBE_OFF
#define PROBE_OFF 0.f
#endif
#ifndef REPK
#define REPK 0
#endif
#ifndef ATT_REP
#define ATT_REP 1
#endif
#ifndef PREP_REP
#define PREP_REP 1
#endif
#ifndef RWROLES
#define RWROLES 7
#endif
#ifndef PHMASK
#define PHMASK 0xFFFF
#endif
#define PHON(k) ((PHMASK >> (k)) & 1)
__global__ void __launch_bounds__(512, 2) fwd_megakernel(Args a) {
    extern __shared__ __attribute__((aligned(16))) unsigned char lds_raw[];
    LAS unsigned char* lds = (LAS unsigned char*)lds_raw;
    cg::grid_group grid = cg::this_grid();
    { volatile LAS unsigned* st0 = (volatile LAS unsigned*)(lds + 131072 + 128); if (threadIdx.x == 0) { st0[0] = 0u; st0[1] = 0u; } __syncthreads(); }
    XcdBarrier xbar = xcd_barrier_post((unsigned*)(a.ws + WS_CTL) + 4096, (volatile LAS unsigned*)(lds + 131072 + 128));
    const int G = gridDim.x, bid = blockIdx.x, NGW = G * 8;
    unsigned char* ws = a.ws;
    bf16_t* HN = (bf16_t*)(ws + WS_HN); bf16_t* Z = (bf16_t*)(ws + WS_Z); bf16_t* HID = Z; bf16_t* QX = Z; bf16_t* OX = Z + (size_t)TOK * 512;
#ifdef PROBE_GROUP
    LAS unsigned long long* prs = (LAS unsigned long long*)(lds + 131072 + 64);
    if (threadIdx.x == 0) { prs[0] = __builtin_amdgcn_s_memrealtime(); prs[1] = 0ull; prs[2] = 99ull; }
#endif
#ifdef PROBE_GROUP
    for (int ph = a.ph_lo; ph <= a.ph_hi; ++ph) {
#else
    for (int ph = a.ph_lo; ph < a.ph_hi; ++ph) {
#endif
        if (ph > a.ph_lo) { if (ph == a.ph_lo + 1 || MK_MULTI) grid.sync(); else xcd_barrier(xbar);
#ifdef SYNC_REP
            xcd_barrier(xbar); xcd_barrier(xbar);
#endif
        }
#ifdef PROBE_GROUP
        if (threadIdx.x == 0) { const unsigned long long now = __builtin_amdgcn_s_memrealtime(); if (prs[2] == (unsigned long long)PROBE_GROUP) prs[1] += now - prs[0]; prs[0] = now;
          if (ph == a.ph_hi) { if (blockIdx.x == 0) { float us_ = (float)prs[1] * 0.01f;
#if PROBE_GROUP == 8
              us_ = (float)((volatile unsigned*)(ws + WS_CTL))[32 * 64] * 0.01f;
#endif
              a.out[0] = floorf((us_ + PROBE_OFF) / PROBE_Q) * PROBE_Q + 0.5f * PROBE_Q; } }
          const int k_ = (ph - 1) % 15; prs[2] = ph == 0 ? 0 : (k_ == 0 || k_ == 3 || k_ == 8 || k_ == 12) ? 1 : (k_ == 1 || k_ == 13) ? 2 : (k_ == 2 || k_ == 14 || k_ == 7 || k_ == 11) ? 3 : (k_ == 4 || k_ == 9) ? 4 : k_ == 5 ? 5 : k_ == 6 ? 6 : 7; }
        if (ph == a.ph_hi) break;
#endif
        int tidp = threadIdx.x; asm volatile("" : "+v"(tidp)); const int tid = tidp, lane = tid & 63, wid = __builtin_amdgcn_readfirstlane(tid >> 6), gw = bid * 8 + wid;
        if (ph == 0) { for (int rp_ = 0; rp_ < ((REPK >> 15) & 1) + 1; ++rp_) { if (PHON(15)) p0_prologue(a, lds, gw, NGW, wid, lane, tid); } continue; }
        const int l = (ph - 1) / 15, kind = (ph - 1) % 15;
        const unsigned char* wl = ws + WS_W + (size_t)l * WL_BYTES;
        if (PHON(0) && (kind == 0 || kind == 3 || kind == 8 || kind == 12)) {
            const float* src = (l == 0 && kind == 0) ? a.in[0] : a.out;
            const float* g = (kind == 0 ? a.in[3] : kind == 3 ? a.in[6] : kind == 8 ? a.in[25] : a.in[32]) + l * DM;
            for (int rp_ = 0; rp_ < (REPK & 1) + 1; ++rp_) norm_phase(src, g, HN, TOK, gw, NGW, lane);
            if (l == 0 && kind == 3) xkv_post(a, gw, NGW, lane);
        }
        if (PHON(1) && (kind == 1 || kind == 13)) {
            pg8::Gemm g{HN, (const bf16_t*)(wl + (kind == 1 ? OFF_F1I : OFF_F2I)), TOK, 2 * FF, DM, DM};
            pg8::StaticOrder S; S.init(TOK, 2 * FF, G, bid);
            pg8::EpiSwiglu E{HID, FF};
            pg8::gemm_phase<pg8::EpiSwiglu, pg8::StaticOrder, true, true>(lds, g, S, E);
        }
        if (PHON(2) && (kind == 2 || kind == 14 || kind == 7 || kind == 11)) {
            pg8::Gemm g; pg8::EpiResid E; E.out = a.out; E.ldc = DM; g.M = TOK; g.N = DM;
            if (kind == 2 || kind == 14) { g.A = HID; g.lda = FF; g.K = FF; g.Bt = (const bf16_t*)(wl + (kind == 2 ? OFF_F1O : OFF_F2O)); E.scale = 0.5f; E.base = (l == 0 && kind == 2) ? a.in[0] : a.out; }
            else if (kind == 7) { g.A = Z; g.lda = ZP; g.K = DM; g.Bt = (const bf16_t*)(wl + OFF_MO); E.scale = 1.f; E.base = a.out; }
            else { g.A = OX; g.lda = 512; g.K = 512; g.Bt = (const bf16_t*)(wl + OFF_XO); E.scale = 1.f; E.base = a.out; }
            pg8::StaticOrder S; S.init(TOK, DM, G, bid);
            const float sc_ = E.scale;
            for (int rp_ = ((REPK >> 2) & 1); rp_ >= 0; --rp_) { E.scale = rp_ ? 0.f : sc_;
            pg8::gemm_phase<pg8::EpiResid, pg8::StaticOrder, true, true>(lds, g, S, E); if (rp_) { __syncthreads(); } }
        }
        if (PHON(4) && (kind == 4 || kind == 9 || (kind == 0 && l == 0))) {
            const int ng = (kind == 0) ? NL : 1;
            for (int rp_ = 0; rp_ < ((REPK >> 4) & 1) + 1; ++rp_)
            for (int gi = 0; gi < ng; ++gi) {
                pg8::Gemm g; pg8::EpiBf16 E; int cidx = bid;
                if (kind == 4) { g.A = HN; g.lda = DM; g.K = DM; g.M = TOK; g.N = 3584; g.Bt = (const bf16_t*)(wl + OFF_MI); E.O = Z; E.ldc = ZP; E.ncols = ZC_VALID; E.halo = (bf16_t*)(ws + WS_ZHALO); }
                else if (kind == 9) { g.A = HN; g.lda = DM; g.K = DM; g.M = TOK; g.N = 512; g.Bt = (const bf16_t*)(wl + OFF_XQ); E.O = QX; E.ldc = 512; E.ncols = 512; E.halo = nullptr; }
                else { g.A = (const bf16_t*)(ws + WS_MEMN) + (size_t)gi * NB * MEMLEN * DM; g.lda = DM; g.K = DM; g.M = NB * MEMLEN; g.N = 1024;
                       g.Bt = (const bf16_t*)(ws + WS_W + (size_t)gi * WL_BYTES + OFF_XKV); E.O = (bf16_t*)(ws + WS_KVX) + (size_t)gi * NB * MEMLEN * 1024; E.ldc = 1024; E.ncols = 1024; E.halo = nullptr;
                       cidx = (bid + gi * (G / 2)) % G; }
                pg8::StaticOrder S; S.init(g.M, g.N, G, cidx);
                pg8::gemm_phase<pg8::EpiBf16, pg8::StaticOrder, true, true>(lds, g, S, E);
            }
        }
        if (PHON(5) && kind == 5) { for (int rp_ = PREP_REP - 1; rp_ >= 0; --rp_) for (int tile = bid; tile < TOK / 64; tile += G) prep_tile(a, l, tile, lds, rp_ > 0); }
        if (PHON(6) && kind == 6) {
            unsigned* ctr = (unsigned*)(ws + WS_CTL) + 64 * (1 + l); LAS unsigned* qw = (LAS unsigned*)(lds + 131072);
            for (;;) {
                __syncthreads();
                if (tid == 0) *qw = atomicAdd(ctr, 1u);
                __syncthreads();
                const int item = __builtin_amdgcn_readfirstlane((int)*qw);
                if (item >= 64 + 1024) break;
                if (item < 64) {
                    if (tid < 32) ((LAS unsigned*)(lds + RW_FLG))[tid] = 0u;
                    __syncthreads();
                    if (PHON(7)) {
                        const int ub = item >> 3, uh = item & 7;
                        if (wid == 0 || wid == 4 || wid == 2 || wid == 6) { if (RWROLES & 1) rwkv_pre(a, ub, uh, lds, wid == 0 ? 0 : wid == 4 ? 1 : wid == 2 ? 2 : 3); }
                        else if (wid == 1) { if (RWROLES & 2) rwkv_main(lds); }
                        else if (wid == 3 || wid == 7) { if (RWROLES & 4) rwkv_post(a, l, ub, uh, lds, wid == 3 ? 0 : 1); }
                    }
                }
                else {
                    const int j = item - 64, qb = 15 - (j >> 6), kk = j & 63, type = kk >> 5, bh = kk & 31, b = bh >> 2, h = bh & 3;
                    bf16_t* Zb = Z + (size_t)b * SEQ * ZP;
                    for (int rp_ = ATT_REP - 1; rp_ >= 0; --rp_)
                    if (type == 0) { if (PHON(8)) attn_unit<0, 64>(lds, Zb + ZC_FQ + 64 * h, ZP, Zb + ZC_FK + 64 * h, ZP, (const bf16_t*)(ws + WS_VTF) + (size_t)bh * 64 * SEQ, SEQ, Zb + ZC_FQ + 64 * h, ZP,
                                                   256 * qb, 4 * (qb + 1), qb, (const float*)(ws + WS_LOGF) + (size_t)bh * SEQ, nullptr, rp_ > 0); }
                    else if (PHON(9)) attn_unit<1, 64>(lds, Zb + ZC_MQ + 64 * h, ZP, Zb + ZC_MK + 64 * h, ZP, (const bf16_t*)(ws + WS_VTM) + (size_t)bh * 64 * SEQ, SEQ, Zb + ZC_MQ + 64 * h, ZP,
                                          256 * qb, 4 * (qb + 1), qb, (const float*)(ws + WS_KMP) + (size_t)bh * 64 * 64, nullptr, rp_ > 0);
                }
            }
        }
        if (PHON(10) && kind == 10) {
            for (int rp_ = 0; rp_ < ((REPK >> 10) & 1) + 1; ++rp_)
            for (int u = bid; u < NB * 4 * 16; u += G) { const int b = u >> 6, hd = (u >> 4) & 3, qb = u & 15;
                bf16_t* qp = QX + (size_t)b * SEQ * 512 + hd * 128;
                attn_unit<2, 128>(lds, qp, 512, (const bf16_t*)(ws + WS_KVX) + ((size_t)l * NB + b) * MEMLEN * 1024 + hd * 128, 1024,
                                  (const bf16_t*)(ws + WS_VTX) + ((size_t)(l * NB + b) * 4 + hd) * 128 * MEMLEN, MEMLEN, OX + (size_t)b * SEQ * 512 + hd * 128, 512, 256 * qb, MEMLEN / 64, qb, nullptr, a.in[29] + l * 128); }
        }
    }
}

extern "C" void kernel_launch(void* const* d_in, const int* in_sizes, int n_in, void* d_out, int out_size, void* d_ws, size_t ws_size, hipStream_t stream) {
    static int grid_blocks = 0;
    if (grid_blocks == 0) {
        if (n_in != 35 || ws_size < WS_END) { fprintf(stderr, "kernel_launch: unexpected n_in %d / ws %zu\n", n_in, ws_size); grid_blocks = -1; return; }
        int dev = 0, cus = 0, per_cu = 0;
        hipGetDevice(&dev); hipDeviceGetAttribute(&cus, hipDeviceAttributeMultiprocessorCount, dev);
        if (hipFuncSetAttribute((const void*)fwd_megakernel, hipFuncAttributeMaxDynamicSharedMemorySize, LDS_BYTES) != hipSuccess) { fprintf(stderr, "kernel_launch: hipFuncSetAttribute failed\n"); grid_blocks = -1; return; }
        if (hipOccupancyMaxActiveBlocksPerMultiprocessor(&per_cu, (const void*)fwd_megakernel, 512, LDS_BYTES) != hipSuccess || per_cu < 1) { fprintf(stderr, "kernel_launch: occupancy query says %d\n", per_cu); per_cu = 1; }
        (void)hipGetLastError();
        grid_blocks = cus * per_cu;
    }
    if (grid_blocks < 0) return;
    Args a{};
    for (int i = 0; i < 35; ++i) a.in[i] = (const float*)d_in[i];
    a.out = (float*)d_out; a.ws = (unsigned char*)d_ws;
    if (hipMemsetAsync(d_ws, 0, 65536, stream) != hipSuccess) { fprintf(stderr, "kernel_launch: memset failed\n"); return; }
#if MK_MULTI
    for (int ph = 0; ph < N_PHASES; ++ph) { a.ph_lo = ph; a.ph_hi = ph + 1; hipLaunchKernelGGL(fwd_megakernel, dim3(grid_blocks), dim3(512), LDS_BYTES, stream, a); }
#else
    a.ph_lo = 0; a.ph_hi = N_PHASES;
    void* args[] = {&a};
    hipError_t e = hipLaunchCooperativeKernel((const void*)fwd_megakernel, dim3(grid_blocks), dim3(512), args, LDS_BYTES, stream);
    if (e != hipSuccess) fprintf(stderr, "cooperative launch failed: %s (grid %d)\n", hipGetErrorString(e), grid_blocks);
#endif
}
```

```cpp
#include <hip/hip_runtime.h>
#include <hip/hip_cooperative_groups.h>
#include <cstdio>
#include <cstdint>
namespace cg = cooperative_groups;
namespace pg8 {
#define PG8_LAS __attribute__((address_space(3)))
typedef unsigned short bf16_t;
typedef short bf16x8 __attribute__((ext_vector_type(8)));
typedef float f32x4 __attribute__((ext_vector_type(4)));
typedef unsigned u32x4 __attribute__((ext_vector_type(4)));
constexpr int BM = 256, BK = 64, HALF = 128, HTB = HALF * BK * 2  , STAGE_BYTES = 8 * HTB, NXCD = 8, WGM = 8;

__host__ __device__ __forceinline__ int lds_byte(int r, int c) { const int st = (r >> 4) * 2 + (c >> 5), rr = r & 15, cc = c & 31, ob = rr * 64 + cc * 2; return st * 1024 + (ob ^ (((ob >> 9) & 1) << 5)); }
__host__ __device__ __forceinline__ void stage_rc(int b, int& R, int& C) { const int st = b / 1024, sb = b % 1024, swz = sb ^ (((sb >> 9) & 1) << 5); R = (st >> 1) * 16 + swz / 64; C = (st & 1) * 32 + (swz % 64) / 2; }
__host__ __device__ __forceinline__ int perm32(int rho) { const int n = rho >> 4, i = rho & 15; return 8 * (i >> 2) + 4 * n + (i & 3); }

struct Unit { int pm, pn; };
struct Gemm { const bf16_t* A; const bf16_t* Bt; int M, N, K, lda; };

struct StaticOrder {
    int nM, nN, nwg, G, c;
    __host__ __device__ void init(int M, int N, int G_, int c_) { nM = M / BM; nN = N / BM; nwg = nM * nN; G = G_; c = c_; }
    __host__ __device__ bool next(int i, Unit& u) const {
        const long L = (long)i * G + c; if (L >= nwg) return false;
        int wgid = (int)L; { const int q = nwg / NXCD, r = nwg % NXCD, xcd = wgid % NXCD, off = wgid / NXCD; wgid = (xcd < r ? xcd * (q + 1) : r * (q + 1) + (xcd - r) * q) + off; }
        const int nig = WGM * nN, gid = wgid / nig, fm = gid * WGM, gsz = (nM - fm) < WGM ? (nM - fm) : WGM;
        u.pm = fm + ((wgid % nig) % gsz); u.pn = (wgid % nig) / gsz; return true;
    }
    __device__ __forceinline__ void a_ready(const Unit&) const {}
    __device__ __forceinline__ void done(const Unit&) const {}
};
__device__ __forceinline__ unsigned cvt_pk_bf16(float lo, float hi) { unsigned r; asm volatile("v_cvt_pk_bf16_f32 %0, %1, %2" : "=v"(r) : "v"(lo), "v"(hi)); return r; }
__device__ __forceinline__ float silu_f(float x) { return x * __builtin_amdgcn_rcpf(1.0f + __builtin_amdgcn_exp2f(-1.4426950408889634f * x)); }
struct EpiSwiglu {
    static constexpr bool PERM = true, AFTER_DRAIN = false;
    bf16_t* O; int ldc;
    __device__ __forceinline__ void operator()(const f32x4 (&acc)[2][2][4][2], const Unit& u, int wr, int wc, int fr, int fq) const {
        const int row0 = u.pm * BM + wr * 64 + fr, col0 = u.pn * HALF + wc * 32 + 8 * fq;
#pragma unroll
        for (int ai = 0; ai < 2; ++ai)
#pragma unroll
            for (int m = 0; m < 4; ++m) {
                const f32x4 g0 = acc[ai][0][m][0], g1 = acc[ai][0][m][1], u0 = acc[ai][1][m][0], u1 = acc[ai][1][m][1];
                u32x4 w;
                w.x = cvt_pk_bf16(silu_f(g0[0]) * u0[0], silu_f(g0[1]) * u0[1]); w.y = cvt_pk_bf16(silu_f(g0[2]) * u0[2], silu_f(g0[3]) * u0[3]);
                w.z = cvt_pk_bf16(silu_f(g1[0]) * u1[0], silu_f(g1[1]) * u1[1]); w.w = cvt_pk_bf16(silu_f(g1[2]) * u1[2], silu_f(g1[3]) * u1[3]);
                *(u32x4*)(O + (size_t)(row0 + ai * HALF + m * 16) * ldc + col0) = w;
            }
    }
};
struct EpiResid {
    static constexpr bool PERM = false, AFTER_DRAIN = false;
    const float* base; float* out; int ldc; float scale;
    __device__ __forceinline__ void operator()(const f32x4 (&acc)[2][2][4][2], const Unit& u, int wr, int wc, int fr, int fq) const {
        const int row0 = u.pm * BM + wr * 64 + fr, col0 = u.pn * BM + wc * 32 + 4 * fq;
#pragma unroll
        for (int ai = 0; ai < 2; ++ai)
#pragma unroll
            for (int m = 0; m < 4; ++m) { const size_t off = (size_t)(row0 + ai * HALF + m * 16) * ldc + col0;
#pragma unroll
                for (int bj = 0; bj < 2; ++bj)
#pragma unroll
                    for (int n = 0; n < 2; ++n) { const f32x4 b = *(const f32x4*)(base + off + bj * HALF + n * 16); *(f32x4*)(out + off + bj * HALF + n * 16) = b + acc[ai][bj][m][n] * scale; }
                asm volatile("" ::: "memory"); }
    }
};
struct EpiBf16 {
    static constexpr bool PERM = true, AFTER_DRAIN = false;
    bf16_t* O; int ldc; int ncols; bf16_t* halo;
    __device__ __forceinline__ void operator()(const f32x4 (&acc)[2][2][4][2], const Unit& u, int wr, int wc, int fr, int fq) const {
        const int row0 = u.pm * BM + wr * 64 + fr, col0 = u.pn * BM + wc * 32 + 8 * fq;
#pragma unroll
        for (int ai = 0; ai < 2; ++ai)
#pragma unroll
            for (int m = 0; m < 4; ++m) { const int row = row0 + ai * HALF + m * 16;
#pragma unroll
                for (int bj = 0; bj < 2; ++bj) { const int col = col0 + bj * HALF;
                    if (col < ncols) { const f32x4 v0 = acc[ai][bj][m][0], v1 = acc[ai][bj][m][1]; u32x4 w;
                        w.x = cvt_pk_bf16(v0[0], v0[1]); w.y = cvt_pk_bf16(v0[2], v0[3]); w.z = cvt_pk_bf16(v1[0], v1[1]); w.w = cvt_pk_bf16(v1[2], v1[3]);
                        *(u32x4*)(O + (size_t)row * ldc + col) = w;
                        if (halo && (row & 63) == 63) *(u32x4*)(halo + (size_t)(row >> 6) * ldc + col) = w; } } }
    }
};
template <class Epi, class Sched, bool ALIGN_EPI = false, bool SP2 = false>
__device__ __forceinline__ void gemm_phase(PG8_LAS unsigned char* lds, const Gemm g, const Sched& S, const Epi& E) {
    int tid_ = threadIdx.x; asm volatile("" : "+v"(tid_)); const int tid = tid_, wid = __builtin_amdgcn_readfirstlane(tid >> 6), lane = tid & 63, wr = wid >> 2, wc = wid & 3, fr = lane & 15, fq = lane >> 4;
    const int K = g.K, nt = K / BK;
    unsigned voffA[2], voffB[2];
#pragma unroll
    for (int i = 0; i < 2; ++i) { int R, C; stage_rc(tid * 16 + i * 8192, R, C); const int Rb = Epi::PERM ? ((R & ~31) + perm32(R & 31)) : R;
        voffA[i] = (unsigned)(R * g.lda + C) * 2u; voffB[i] = (unsigned)(Rb * K + C) * 2u; }
    const size_t kstep = (size_t)(BK * 2);
    const size_t hstep = (size_t)HALF * K * 2;
    const size_t tstep = 2 * hstep; const size_t hstepA = (size_t)HALF * g.lda * 2, tstepA = 2 * hstepA;
    const unsigned ldsw = (unsigned)wid * 1024u;
    const int aoff = lds_byte(wr * 64 + fr, fq * 8), boff = lds_byte(wc * 32 + fr, fq * 8);
#define PG8_SA(b, h) (((b) * 2 + (h)) * HTB)
#define PG8_SB(b, h) ((4 + (b) * 2 + (h)) * HTB)
#define PG8_STAGE(bufoff, gbase, voff) do { _Pragma("unroll") for (int _i = 0; _i < 2; ++_i) \
        __builtin_amdgcn_global_load_lds((const unsigned*)((const char*)(gbase) + (voff)[_i]), (PG8_LAS unsigned*)(lds + (bufoff) + ldsw + _i * 8192), 16, 0, 0); } while (0)
#define PG8_LDA(dst, b, h) do { _Pragma("unroll") for (int m = 0; m < 4; ++m) _Pragma("unroll") for (int k = 0; k < 2; ++k) dst[m][k] = *(const PG8_LAS bf16x8*)(lds + PG8_SA(b, h) + aoff + m * 2048 + k * 1024); } while (0)
#define PG8_LDB(dst, b, h) do { _Pragma("unroll") for (int n = 0; n < 2; ++n) _Pragma("unroll") for (int k = 0; k < 2; ++k) dst[n][k] = *(const PG8_LAS bf16x8*)(lds + PG8_SB(b, h) + boff + n * 2048 + k * 1024); } while (0)
#define PG8_MMA(ai, bj, At, Bt) do { __builtin_amdgcn_s_setprio(1); _Pragma("unroll") for (int m = 0; m < 4; ++m) _Pragma("unroll") for (int n = 0; n < 2; ++n) _Pragma("unroll") for (int k = 0; k < 2; ++k) \
        acc[ai][bj][m][n] = __builtin_amdgcn_mfma_f32_16x16x32_bf16(Bt[n][k], At[m][k], acc[ai][bj][m][n], 0, 0, 0); __builtin_amdgcn_s_setprio(0); } while (0)
#define PG8_WAIT_V(n) asm volatile("s_waitcnt vmcnt(" #n ")" ::: "memory")
#define PG8_WAIT_L(n) asm volatile("s_waitcnt lgkmcnt(" #n ")" ::: "memory")
#define PG8_BAR __builtin_amdgcn_s_barrier()
#define PG8_SCHED __builtin_amdgcn_sched_barrier(0)
    Unit cur, nxt; int ui = 0;
    if (!S.next(0, cur)) return;
    f32x4 acc[2][2][4][2];
#pragma unroll
    for (int a = 0; a < 2; ++a)
#pragma unroll
        for (int b = 0; b < 2; ++b)
#pragma unroll
            for (int m = 0; m < 4; ++m)
#pragma unroll
                for (int n = 0; n < 2; ++n) acc[a][b][m][n] = (f32x4){0.f, 0.f, 0.f, 0.f};
    bf16x8 At[4][2], B0[2][2], B1[2][2];
    const char* cA = (const char*)g.A + (size_t)cur.pm * tstepA; const char* cB = (const char*)g.Bt + (size_t)cur.pn * tstep;
    S.a_ready(cur);
    if constexpr (SP2) {
        PG8_STAGE(PG8_SB(0, 0), cB, voffB); PG8_STAGE(PG8_SB(0, 1), cB + hstep, voffB); PG8_STAGE(PG8_SA(0, 0), cA, voffA); PG8_STAGE(PG8_SA(0, 1), cA + hstepA, voffA);
        if (wr == 1) PG8_BAR;
        PG8_WAIT_V(2); PG8_BAR;
        PG8_STAGE(PG8_SB(1, 0), cB + kstep, voffB); PG8_STAGE(PG8_SA(1, 0), cA + kstep, voffA); PG8_STAGE(PG8_SB(1, 1), cB + hstep + kstep, voffB);
        PG8_WAIT_V(6); PG8_BAR;
    } else {
        PG8_STAGE(PG8_SB(0, 0), cB, voffB); PG8_STAGE(PG8_SA(0, 0), cA, voffA); PG8_STAGE(PG8_SB(0, 1), cB + hstep, voffB); PG8_STAGE(PG8_SA(0, 1), cA + hstepA, voffA);
        if (wr == 1) PG8_BAR;
        PG8_WAIT_V(4); PG8_BAR;
        PG8_STAGE(PG8_SB(1, 0), cB + kstep, voffB); PG8_STAGE(PG8_SA(1, 0), cA + kstep, voffA); PG8_STAGE(PG8_SB(1, 1), cB + hstep + kstep, voffB);
        PG8_WAIT_V(6); PG8_BAR;
    }
    for (;;) {
        const bool has_next = S.next(ui + 1, nxt);
        const char* nA = has_next ? (const char*)g.A + (size_t)nxt.pm * tstepA : cA; const char* nB = has_next ? (const char*)g.Bt + (size_t)nxt.pn * tstep : cB;
        for (int t = 0; t < nt; t += 2) {
            const bool last = (t == nt - 2);
            const char* a1 = cA + (size_t)(t + 1) * kstep;
            const char* a2 = last ? nA : cA + (size_t)(t + 2) * kstep; const char* b2 = last ? nB : cB + (size_t)(t + 2) * kstep;
            const char* a3 = a2 + kstep; const char* b3 = b2 + kstep;
            if (last && has_next) S.a_ready(nxt);
            if constexpr (SP2) {
            PG8_LDB(B0, 0, 0); PG8_LDB(B1, 0, 1); PG8_SCHED; PG8_LDA(At, 0, 0); PG8_STAGE(PG8_SA(1, 1), a1 + hstepA, voffA);
            PG8_WAIT_V(8); PG8_WAIT_L(0); PG8_BAR; PG8_MMA(0, 0, At, B0); PG8_MMA(0, 1, At, B1); PG8_BAR; PG8_SCHED;
            PG8_LDA(At, 0, 1); PG8_STAGE(PG8_SB(0, 0), b2, voffB); PG8_STAGE(PG8_SB(0, 1), b2 + hstep, voffB); PG8_STAGE(PG8_SA(0, 0), a2, voffA);
            PG8_WAIT_V(8); PG8_WAIT_L(0); PG8_BAR; PG8_MMA(1, 0, At, B0); PG8_MMA(1, 1, At, B1); PG8_BAR; PG8_SCHED;
            PG8_LDB(B0, 1, 0); PG8_LDB(B1, 1, 1); PG8_SCHED; PG8_LDA(At, 1, 0); PG8_STAGE(PG8_SA(0, 1), a2 + hstepA, voffA);
            PG8_WAIT_V(8); PG8_WAIT_L(0); PG8_BAR; PG8_MMA(0, 0, At, B0); PG8_MMA(0, 1, At, B1); PG8_BAR; PG8_SCHED;
            PG8_LDA(At, 1, 1); PG8_STAGE(PG8_SB(1, 0), b3, voffB); PG8_STAGE(PG8_SB(1, 1), b3 + hstep, voffB); PG8_STAGE(PG8_SA(1, 0), a3, voffA);
            PG8_WAIT_V(8); PG8_WAIT_L(0); PG8_BAR; PG8_MMA(1, 0, At, B0); PG8_MMA(1, 1, At, B1); PG8_BAR; PG8_SCHED;
            } else {
            PG8_LDB(B0, 0, 0); PG8_SCHED; PG8_LDA(At, 0, 0); PG8_STAGE(PG8_SA(1, 1), a1 + hstepA, voffA);
            PG8_WAIT_L(8); PG8_BAR; PG8_WAIT_L(0); PG8_MMA(0, 0, At, B0); PG8_BAR; PG8_SCHED;
            PG8_LDB(B1, 0, 1); PG8_STAGE(PG8_SB(0, 0), b2, voffB);
            PG8_BAR; PG8_WAIT_L(0); PG8_MMA(0, 1, At, B1); PG8_BAR;
            PG8_LDA(At, 0, 1); PG8_STAGE(PG8_SA(0, 0), a2, voffA);
            PG8_BAR; PG8_WAIT_L(0); PG8_MMA(1, 0, At, B0); PG8_BAR; PG8_SCHED;
            PG8_STAGE(PG8_SB(0, 1), b2 + hstep, voffB);
            PG8_WAIT_V(6); PG8_BAR; PG8_MMA(1, 1, At, B1); PG8_BAR;
            PG8_LDB(B0, 1, 0); PG8_SCHED; PG8_LDA(At, 1, 0); PG8_STAGE(PG8_SA(0, 1), a2 + hstepA, voffA);
            PG8_WAIT_L(8); PG8_BAR; PG8_WAIT_L(0); PG8_MMA(0, 0, At, B0); PG8_BAR; PG8_SCHED;
            PG8_LDB(B1, 1, 1); PG8_STAGE(PG8_SB(1, 0), b3, voffB);
            PG8_BAR; PG8_WAIT_L(0); PG8_MMA(0, 1, At, B1); PG8_BAR;
            PG8_LDA(At, 1, 1); PG8_STAGE(PG8_SA(1, 0), a3, voffA);
            PG8_BAR; PG8_WAIT_L(0); PG8_MMA(1, 0, At, B0); PG8_BAR; PG8_SCHED;
            PG8_STAGE(PG8_SB(1, 1), b3 + hstep, voffB);
            PG8_WAIT_V(6); PG8_BAR; PG8_MMA(1, 1, At, B1); PG8_BAR;
            }
        }
        if constexpr (ALIGN_EPI) { if (wr == 0) PG8_BAR; }
        if constexpr (!Epi::AFTER_DRAIN) { E(acc, cur, wr, wc, fr, fq); S.done(cur); }
        if (!has_next) break;
#pragma unroll
        for (int a = 0; a < 2; ++a)
#pragma unroll
            for (int b = 0; b < 2; ++b)
#pragma unroll
                for (int m = 0; m < 4; ++m)
#pragma unroll
                    for (int n = 0; n < 2; ++n) acc[a][b][m][n] = (f32x4){0.f, 0.f, 0.f, 0.f};
        cur = nxt; cA = nA; cB = nB; ++ui;
        if constexpr (ALIGN_EPI) { if (wr == 1) PG8_BAR; }
    }
    PG8_WAIT_V(0);
    if constexpr (!ALIGN_EPI) { if (wr == 0) PG8_BAR; }
    PG8_BAR;
    if constexpr (Epi::AFTER_DRAIN) { E.fused(acc, cur, wr, wc, fr, fq, lds, wid, lane); S.done(cur); }
#undef PG8_SA
#undef PG8_SB
#undef PG8_STAGE
#undef PG8_LDA
#undef PG8_LDB
#undef PG8_MMA
#undef PG8_WAIT_V
#undef PG8_WAIT_L
#undef PG8_BAR
#undef PG8_SCHED
}
}

#define LAS __attribute__((address_space(3)))
#define DEV __device__ __forceinline__
typedef unsigned short bf16_t;
typedef short bf16x8 __attribute__((ext_vector_type(8)));
typedef short s16x4 __attribute__((ext_vector_type(4)));
typedef float f32x4 __attribute__((ext_vector_type(4)));
typedef float f32x16 __attribute__((ext_vector_type(16)));
typedef unsigned u32x2 __attribute__((ext_vector_type(2)));
typedef unsigned u32x4 __attribute__((ext_vector_type(4)));
typedef unsigned u32x8 __attribute__((ext_vector_type(8)));

constexpr int NB = 8, SEQ = 4096, DM = 1024, TOK = NB * SEQ, FF = 2816, NL = 2, MEMLEN = 256;
constexpr int ZP = 3392;
constexpr int ZC_FQ = 0, ZC_RR = 256, ZC_MQ = 768, ZC_FK = 1024, ZC_FV = 1280, ZC_MK = 1536, ZC_MV = 1792, ZC_RK = 2048, ZC_RV = 2560, ZC_LO = 3072, ZC_FF = 3360, ZC_VALID = 3368;
constexpr float NORM_EPS = 1e-6f, GN_EPS = 64e-5f, LOG2E = 1.4426950408889634f;
constexpr float C2_64 = 0.125f * LOG2E, C2_128 = 0.08838834764831845f * LOG2E;
constexpr size_t MiB = 1u << 20;
constexpr size_t WS_CTL = 0;
constexpr size_t WS_W = 1 * MiB, WL_BYTES = 48 * MiB;
constexpr size_t OFF_F1I = 0, OFF_F1O = 11 * MiB, OFF_F2I = 17 * MiB, OFF_F2O = 28 * MiB, OFF_MI = 34 * MiB, OFF_MO = 41 * MiB, OFF_XQ = 43 * MiB, OFF_XKV = 44 * MiB, OFF_XO = 46 * MiB;
constexpr size_t OFF_W2T = 47 * MiB, OFF_A2T = OFF_W2T + 65536, OFF_G2T = OFF_A2T + 65536;
constexpr size_t WS_Z = 97 * MiB;
constexpr size_t WS_C = WS_Z + 212 * MiB;
constexpr size_t WS_HN = WS_C;
constexpr size_t WS_WD = WS_C, WS_KK = WS_C + 64 * MiB, WS_KA = WS_C + 96 * MiB;
constexpr size_t WS_VTF = WS_C + 128 * MiB, WS_VTM = WS_C + 144 * MiB;
constexpr size_t WS_LOGF = WS_C + 160 * MiB, WS_KMP = WS_LOGF + 512 * 1024, WS_ZHALO = WS_C + 161 * MiB;
constexpr size_t WS_KVX = WS_C + 165 * MiB, WS_VTX = WS_C + 173 * MiB, WS_MEMN = WS_C + 177 * MiB, WS_END = WS_C + 185 * MiB;
static_assert(WS_END <= 512 * MiB, "workspace map");
constexpr int LDS_BYTES = 131072 + 1024;

struct Args { const float* in[35]; float* out; unsigned char* ws; int ph_lo, ph_hi; };

DEV float bf2f(unsigned short b) { return __uint_as_float((unsigned)b << 16); }
typedef float f32x2_t __attribute__((ext_vector_type(2))); typedef __bf16 bf16x2_t __attribute__((ext_vector_type(2)));
DEV unsigned pk2(float lo, float hi) { const f32x2_t v = {lo, hi}; const bf16x2_t r = __builtin_convertvector(v, bf16x2_t); return __builtin_bit_cast(unsigned, r); }
DEV unsigned f2bf(float f) { return pk2(f, f) & 0xffffu; }
DEV float wave_sum(float v) {
#pragma unroll
    for (int o = 1; o < 64; o <<= 1) v += __shfl_xor(v, o);
    return v;
}
#define LDS_WAIT() asm volatile("s_waitcnt lgkmcnt(0)" ::: "memory")

struct MatInfo { const float* src; bf16_t* dst; int K, Ns, Nd, map; };
DEV MatInfo matinfo(const Args& a, int m) {
    const int l = m / 12, k = m % 12; unsigned char* wl = a.ws + WS_W + (size_t)l * WL_BYTES; MatInfo r;
    switch (k) {
    case 0:  r.src = a.in[4] + (size_t)l * DM * 2 * FF;  r.dst = (bf16_t*)(wl + OFF_F1I); r.K = DM; r.Ns = 2 * FF; r.Nd = 2 * FF; r.map = 1; break;
    case 1:  r.src = a.in[5] + (size_t)l * FF * DM;      r.dst = (bf16_t*)(wl + OFF_F1O); r.K = FF; r.Ns = DM; r.Nd = DM; r.map = 0; break;
    case 2:  r.src = a.in[33] + (size_t)l * DM * 2 * FF; r.dst = (bf16_t*)(wl + OFF_F2I); r.K = DM; r.Ns = 2 * FF; r.Nd = 2 * FF; r.map = 1; break;
    case 3:  r.src = a.in[34] + (size_t)l * FF * DM;     r.dst = (bf16_t*)(wl + OFF_F2O); r.K = FF; r.Ns = DM; r.Nd = DM; r.map = 0; break;
    case 4:  r.src = a.in[7] + (size_t)l * DM * 3364;    r.dst = (bf16_t*)(wl + OFF_MI);  r.K = DM; r.Ns = 3364; r.Nd = 3584; r.map = 2; break;
    case 5:  r.src = a.in[8] + (size_t)l * DM * DM;      r.dst = (bf16_t*)(wl + OFF_MO);  r.K = DM; r.Ns = DM; r.Nd = DM; r.map = 0; break;
    case 6:  r.src = a.in[27] + (size_t)l * DM * 512;    r.dst = (bf16_t*)(wl + OFF_XQ);  r.K = DM; r.Ns = 512; r.Nd = 512; r.map = 0; break;
    case 7:  r.src = a.in[28] + (size_t)l * DM * 1024;   r.dst = (bf16_t*)(wl + OFF_XKV); r.K = DM; r.Ns = 1024; r.Nd = 1024; r.map = 0; break;
    case 8:  r.src = a.in[31] + (size_t)l * 512 * DM;    r.dst = (bf16_t*)(wl + OFF_XO);  r.K = 512; r.Ns = DM; r.Nd = DM; r.map = 0; break;
    case 9:  r.src = a.in[16] + (size_t)l * 64 * 512;    r.dst = (bf16_t*)(wl + OFF_W2T); r.K = 64; r.Ns = 512; r.Nd = 512; r.map = 0; break;
    case 10: r.src = a.in[18] + (size_t)l * 64 * 512;    r.dst = (bf16_t*)(wl + OFF_A2T); r.K = 64; r.Ns = 512; r.Nd = 512; r.map = 0; break;
    default: r.src = a.in[19] + (size_t)l * 160 * 512;   r.dst = (bf16_t*)(wl + OFF_G2T); r.K = 160; r.Ns = 512; r.Nd = 512; r.map = 0; break;
    }
    return r;
}
DEV int srccol(int map, int n) {
    if (map == 0) return n;
    if (map == 1) { const int p = n >> 8, r = n & 255; return r < 128 ? p * 128 + r : FF + p * 128 + (r - 128); }
    if (n < 256) return n;
    if (n < 768) return 1540 + (n - 256);
    if (n < 1024) return 772 + (n - 768);
    if (n < 1280) return 256 + (n - 1024);
    if (n < 1536) return 512 + (n - 1280);
    if (n < 1792) return 1028 + (n - 1536);
    if (n < 2048) return 1284 + (n - 1792);
    if (n < 2560) return 2052 + (n - 2048);
    if (n < 3072) return 2564 + (n - 2560);
    if (n < 3360) return 3076 + (n - 3072);
    if (n < 3364) return 768 + (n - 3360);
    return -1;
}
DEV void transpose_item(const MatInfo& mi, LAS float* scr, int item, int lane) {
    const int nblk = mi.Nd / 32, kb = item / nblk, nb = item % nblk, k0 = 64 * kb, n0 = 32 * nb;
    const int n4 = (lane & 7) * 4, sc = srccol(mi.map, n0 + n4);
#pragma unroll
    for (int i = 0; i < 8; ++i) { const int kk = 8 * i + (lane >> 3), k = k0 + kk;
        const f32x4 v = (sc >= 0 && k < mi.K) ? *(const f32x4*)(mi.src + (size_t)k * mi.Ns + sc) : (f32x4){0.f, 0.f, 0.f, 0.f};
        LAS float* d = scr + kk * 33 + n4; d[0] = v[0]; d[1] = v[1]; d[2] = v[2]; d[3] = v[3]; }
    LDS_WAIT(); asm volatile("" ::: "memory");
    const int c = lane & 7;
#pragma unroll
    for (int j = 0; j < 4; ++j) { const int n = (lane >> 3) + 8 * j; const LAS float* s = scr + (8 * c) * 33 + n;
        u32x4 o; o.x = pk2(s[0 * 33], s[1 * 33]); o.y = pk2(s[2 * 33], s[3 * 33]); o.z = pk2(s[4 * 33], s[5 * 33]); o.w = pk2(s[6 * 33], s[7 * 33]);
        if (k0 + 8 * c < mi.K) *(u32x4*)(mi.dst + (size_t)(n0 + n) * mi.K + k0 + 8 * c) = o; }
    LDS_WAIT(); asm volatile("" ::: "memory");
}
DEV void norm_row(const float* xrow, const float* g, bf16_t* orow, int lane) {
    const f32x4* xr = (const f32x4*)xrow + lane; const f32x4* gr = (const f32x4*)g + lane;
    f32x4 v[4]; float s = 0.f;
#pragma unroll
    for (int j = 0; j < 4; ++j) { v[j] = xr[64 * j]; s += (v[j].x * v[j].x + v[j].y * v[j].y) + (v[j].z * v[j].z + v[j].w * v[j].w); }
    const float rstd = rsqrtf(wave_sum(s) * (1.f / DM) + NORM_EPS);
    u32x2* o8 = (u32x2*)orow + lane;
#pragma unroll
    for (int j = 0; j < 4; ++j) { const f32x4 gg = gr[64 * j]; u32x2 w; w.x = pk2(v[j].x * rstd * gg.x, v[j].y * rstd * gg.y); w.y = pk2(v[j].z * rstd * gg.z, v[j].w * rstd * gg.w); o8[64 * j] = w; }
}
DEV void norm_row2(const float* xa, const float* xb, const float* g, bf16_t* oa, bf16_t* ob, int lane) {
    const f32x4* xra = (const f32x4*)xa + lane; const f32x4* xrb = (const f32x4*)xb + lane; const f32x4* gr = (const f32x4*)g + lane;
    f32x4 va[4], vb[4]; float sa = 0.f, sb = 0.f;
#pragma unroll
    for (int j = 0; j < 4; ++j) { va[j] = xra[64 * j]; vb[j] = xrb[64 * j]; }
#pragma unroll
    for (int j = 0; j < 4; ++j) { sa += (va[j].x * va[j].x + va[j].y * va[j].y) + (va[j].z * va[j].z + va[j].w * va[j].w); sb += (vb[j].x * vb[j].x + vb[j].y * vb[j].y) + (vb[j].z * vb[j].z + vb[j].w * vb[j].w); }
#pragma unroll
    for (int o = 1; o < 64; o <<= 1) { sa += __shfl_xor(sa, o); sb += __shfl_xor(sb, o); }
    const float ra = rsqrtf(sa * (1.f / DM) + NORM_EPS), rb = rsqrtf(sb * (1.f / DM) + NORM_EPS);
    u32x2* o8a = (u32x2*)oa + lane; u32x2* o8b = (u32x2*)ob + lane;
#pragma unroll
    for (int j = 0; j < 4; ++j) { const f32x4 gg = gr[64 * j]; u32x2 w; w.x = pk2(va[j].x * ra * gg.x, va[j].y * ra * gg.y); w.y = pk2(va[j].z * ra * gg.z, va[j].w * ra * gg.w); o8a[64 * j] = w;
        w.x = pk2(vb[j].x * rb * gg.x, vb[j].y * rb * gg.y); w.y = pk2(vb[j].z * rb * gg.z, vb[j].w * rb * gg.w); o8b[64 * j] = w; }
}
DEV void norm_phase(const float* x, const float* g, bf16_t* out, int nrows, int gw, int NGW, int lane) {
    int m = gw;
    for (; m + NGW < nrows; m += 2 * NGW) norm_row2(x + (size_t)m * DM, x + (size_t)(m + NGW) * DM, g, out + (size_t)m * DM, out + (size_t)(m + NGW) * DM, lane);
    if (m < nrows) norm_row(x + (size_t)m * DM, g, out + (size_t)m * DM, lane);
}
DEV void p0_prologue(const Args& a, LAS unsigned char* lds, int gw, int NGW, int wid, int lane, int tid) {
    LAS float* scr = (LAS float*)(lds + wid * 8704);
    int base = 0;
    for (int m = 0; m < 24; ++m) {
        const MatInfo mi = matinfo(a, m); const int items = ((mi.K + 63) / 64) * (mi.Nd / 32);
        int first = gw - (base % NGW); if (first < 0) first += NGW;
        for (int it = first; it < items; it += NGW) transpose_item(mi, scr, it, lane);
        base += items;
    }
    for (int m = gw; m < NL * NB * MEMLEN; m += NGW) { const int l = m / (NB * MEMLEN), r = m % (NB * MEMLEN);
        norm_row(a.in[1] + (size_t)r * DM, a.in[26] + l * DM, (bf16_t*)(a.ws + WS_MEMN) + (size_t)m * DM, lane); }
    if (blockIdx.x == 0 && tid < 64) ((unsigned*)(a.ws + WS_CTL))[tid * 64] = 0u;
}
DEV void xkv_post(const Args& a, int gw, int NGW, int lane) {
    for (int it = gw; it < NL * NB * MEMLEN * 4; it += NGW) {
        const int hd = it & 3, row = (it >> 2) % (NB * MEMLEN), l = it / (4 * NB * MEMLEN), b = row / MEMLEN, m = row % MEMLEN;
        bf16_t* kr = (bf16_t*)(a.ws + WS_KVX) + ((size_t)l * NB * MEMLEN + row) * 1024 + hd * 128;
        const unsigned kv = *((const unsigned*)kr + lane); float k0 = bf2f(kv & 0xffff), k1 = bf2f(kv >> 16);
        const float rstd = rsqrtf(wave_sum(k0 * k0 + k1 * k1) * (1.f / 128) + NORM_EPS);
        const float* kg = a.in[30] + l * 128;
        *((unsigned*)kr + lane) = pk2(k0 * rstd * kg[2 * lane], k1 * rstd * kg[2 * lane + 1]);
        const unsigned vv = *((const unsigned*)(kr + 512) + lane);
        bf16_t* vt = (bf16_t*)(a.ws + WS_VTX) + (((size_t)(l * NB + b) * 4 + hd) * 128) * MEMLEN + m;
        vt[(size_t)(2 * lane) * MEMLEN] = (bf16_t)(vv & 0xffff); vt[(size_t)(2 * lane + 1) * MEMLEN] = (bf16_t)(vv >> 16);
    }
}

DEV float sigmoid_f(float x) { return __builtin_amdgcn_rcpf(1.0f + __builtin_amdgcn_exp2f(-LOG2E * x)); }
DEV float tanh_f(float x) { const float e = __builtin_amdgcn_exp2f(-2.f * LOG2E * fabsf(x)); const float t = (1.f - e) * __builtin_amdgcn_rcpf(1.f + e); return x < 0.f ? -t : t; }
DEV void unpack8(const u32x4 v, float (&f)[8]) {
    f[0] = __uint_as_float(v.x << 16); f[1] = __uint_as_float(v.x & 0xffff0000u); f[2] = __uint_as_float(v.y << 16); f[3] = __uint_as_float(v.y & 0xffff0000u);
    f[4] = __uint_as_float(v.z << 16); f[5] = __uint_as_float(v.z & 0xffff0000u); f[6] = __uint_as_float(v.w << 16); f[7] = __uint_as_float(v.w & 0xffff0000u);
}
DEV u32x4 pack8(const float (&f)[8]) { u32x4 o; o.x = pk2(f[0], f[1]); o.y = pk2(f[2], f[3]); o.z = pk2(f[4], f[5]); o.w = pk2(f[6], f[7]); return o; }
DEV int crow(int r, int hi) { return (r & 3) + 8 * (r >> 2) + 4 * hi; }

DEV void prep_tile(const Args& a, int l, int tile, LAS unsigned char* lds, bool dry = false) {
    int tid_ = threadIdx.x; asm volatile("" : "+v"(tid_)); const int tid = tid_, lane = tid & 63, wid = __builtin_amdgcn_readfirstlane(tid >> 6);
    const int row0 = tile * 64, b = row0 / SEQ, t0 = row0 % SEQ;
    bf16_t* Z = (bf16_t*)(a.ws + WS_Z) + (size_t)row0 * ZP;
    {
        const int ch = tid % 228, sub = tid / 228; const bool act = tid < 456;
        const int col = ch < 64 ? ZC_RR + 8 * ch : ZC_RK + 8 * (ch - 64), mi = ch < 64 ? 8 * ch : 512 + 8 * (ch - 64);
        const int ts = 32 * sub; float prev[8], mu[8];
#pragma unroll
        for (int i = 0; i < 8; ++i) { prev[i] = 0.f; mu[i] = 0.f; }
        if (act) {
            const float* mup = a.in[14] + l * 1824 + mi;
#pragma unroll
            for (int i = 0; i < 8; ++i) mu[i] = mup[i];
            if (sub == 1) unpack8(*(const u32x4*)(Z + (size_t)(ts - 1) * ZP + col), prev);
            else if (t0 != 0) unpack8(*(const u32x4*)((const bf16_t*)(a.ws + WS_ZHALO) + (size_t)(tile - 1) * ZP + col), prev);
        }
        __syncthreads();
        if (act) {
#pragma unroll 1
            for (int t8 = 0; t8 < 32; t8 += 8) { u32x4 raw[8];
#pragma unroll
                for (int tt = 0; tt < 8; ++tt) raw[tt] = *(const u32x4*)(Z + (size_t)(ts + t8 + tt) * ZP + col);
#pragma unroll
                for (int tt = 0; tt < 8; ++tt) { float cur[8], o[8]; unpack8(raw[tt], cur);
#pragma unroll
                    for (int i = 0; i < 8; ++i) { o[i] = cur[i] + (prev[i] - cur[i]) * mu[i]; prev[i] = cur[i]; }
                    if (!dry) *(u32x4*)(Z + (size_t)(ts + t8 + tt) * ZP + col) = pack8(o); } }
        }
    }
    LAS float* kbuf = (LAS float*)lds;
    {
        const float* gfq = a.in[10] + l * 64; const float* gfk = a.in[11] + l * 64; const float* gmq = a.in[12] + l * 64; const float* gmk = a.in[13] + l * 64;
        const int* pos = (const int*)a.in[2] + b * SEQ + t0;
#pragma unroll 2
        for (int it = 0; it < 16; ++it) {
            const int item = it * 512 + tid, g8 = item >> 3, sub8 = item & 7, slot = g8 >> 6, token = g8 & 63, h = slot & 3, kind = slot >> 2;
            const int cb = (kind == 0 ? ZC_FQ : kind == 1 ? ZC_FK : kind == 2 ? ZC_MQ : ZC_MK) + 64 * h + 8 * sub8;
            const float* gp = (kind == 0 ? gfq : kind == 1 ? gfk : kind == 2 ? gmq : gmk) + 8 * sub8;
            u32x4* p = (u32x4*)(Z + (size_t)token * ZP + cb); float v[8]; unpack8(*p, v);
            float ss = 0.f;
#pragma unroll
            for (int i = 0; i < 8; ++i) ss += v[i] * v[i];
            ss += __shfl_xor(ss, 1); ss += __shfl_xor(ss, 2); ss += __shfl_xor(ss, 4);
            const float rstd = rsqrtf(ss * (1.f / 64) + NORM_EPS);
#pragma unroll
            for (int i = 0; i < 8; ++i) v[i] = v[i] * rstd * gp[i];
            float pr[8];
#pragma unroll
            for (int i = 0; i < 8; ++i) pr[i] = __shfl_xor(v[i], 1);
            if (kind >= 2 && sub8 < 2) {
                const float posf = (float)pos[token];
#pragma unroll
                for (int i = 0; i < 8; ++i) {
                    const float invf = (float)__builtin_exp2(-(double)i * 0.125 * 18.931568569324174);
                    const float ang = posf * invf; const double rev = (double)ang * 0.15915494309189535; const float fr = (float)(rev - __builtin_floor(rev));
                    const float sn = __builtin_amdgcn_sinf(fr), cs = __builtin_amdgcn_cosf(fr);
                    v[i] = sub8 == 0 ? v[i] * cs - pr[i] * sn : v[i] * cs + pr[i] * sn; }
            }
            if (kind == 3) {
#pragma unroll
                for (int i = 0; i < 8; ++i) kbuf[(token * 4 + h) * 64 + 8 * sub8 + i] = v[i]; }
            if (kind == 0 || kind == 2) {
#pragma unroll
                for (int i = 0; i < 8; ++i) v[i] *= C2_64; }
            if (!dry) *p = pack8(v);
        }
    }
    __syncthreads();
    if (tid < 256) { const int h = tid >> 6, d = tid & 63; float s = 0.f;
        for (int t = 0; t < 64; ++t) s += kbuf[(t * 4 + h) * 64 + d];
        if (!dry) ((float*)(a.ws + WS_KMP))[(((size_t)(b * 4 + h) * 64) + (t0 >> 6)) * 64 + d] = s; }
#pragma unroll 2
    for (int it = 0; it < 8; ++it) {
        const int item = it * 512 + tid, which = item >> 11, rem = item & 2047, tg = rem >> 8, c = rem & 255;
        const bf16_t* src = Z + (size_t)(8 * tg) * ZP + (which ? ZC_MV : ZC_FV) + c; unsigned short e[8];
#pragma unroll
        for (int i = 0; i < 8; ++i) e[i] = src[(size_t)i * ZP];
        u32x4 o; o.x = e[0] | ((unsigned)e[1] << 16); o.y = e[2] | ((unsigned)e[3] << 16); o.z = e[4] | ((unsigned)e[5] << 16); o.w = e[6] | ((unsigned)e[7] << 16);
        bf16_t* vt = (bf16_t*)(a.ws + (which ? WS_VTM : WS_VTF)) + ((size_t)(b * 4 + (c >> 6)) * 64 + (c & 63)) * SEQ + t0 + 8 * tg;
        if (!dry) *(u32x4*)vt = o;
    }
    if (tid < 256) { const int token = tid >> 2, h = tid & 3; const float x = bf2f(Z[(size_t)token * ZP + ZC_FF + h]) + a.in[9][l * 4 + h];
        const float lf = fminf(x, 0.f) - __logf(1.f + __expf(-fabsf(x)));
        if (!dry) ((float*)(a.ws + WS_LOGF))[(size_t)(b * 4 + h) * SEQ + t0 + token] = lf; }
    __syncthreads();
    LAS bf16_t* al = (LAS bf16_t*)lds;
    for (int item = tid; item < 64 * 36; item += 512) { const int token = item / 36, c = item % 36; float v[8]; unpack8(*(const u32x4*)(Z + (size_t)token * ZP + ZC_LO + 8 * c), v);
        if (c < 8) {
#pragma unroll
            for (int i = 0; i < 8; ++i) v[i] = tanh_f(v[i]); }
        else if (c >= 16) {
#pragma unroll
            for (int i = 0; i < 8; ++i) v[i] = sigmoid_f(v[i]); }
        *(LAS u32x4*)(al + token * 296 + 8 * c) = pack8(v); }
    __syncthreads();
    const unsigned char* wl = a.ws + WS_W + (size_t)l * WL_BYTES;
    const bf16_t* w2t = (const bf16_t*)(wl + OFF_W2T); const bf16_t* a2t = (const bf16_t*)(wl + OFF_A2T); const bf16_t* g2t = (const bf16_t*)(wl + OFF_G2T);
    const int r32 = lane & 31, hi = lane >> 5;
    for (int uu = 0; uu < 2; ++uu) {
        const int u = wid + 8 * uu, h = u & 7, th = u >> 3, token = 32 * th + r32;
        f32x16 aw[2], aa[2], ag[2];
#pragma unroll
        for (int ct = 0; ct < 2; ++ct) { aw[ct] = f32x16{}; aa[ct] = f32x16{}; ag[ct] = f32x16{}; }
        const LAS bf16_t* arow = al + token * 296 + 8 * hi;
#pragma unroll 1
        for (int ks = 0; ks < 4; ++ks) { const bf16x8 bw = *(const LAS bf16x8*)(arow + 16 * ks), ba = *(const LAS bf16x8*)(arow + 64 + 16 * ks);
#pragma unroll
            for (int ct = 0; ct < 2; ++ct) { const int chn = 64 * h + 32 * ct + r32;
                aw[ct] = __builtin_amdgcn_mfma_f32_32x32x16_bf16(*(const bf16x8*)(w2t + chn * 64 + 16 * ks + 8 * hi), bw, aw[ct], 0, 0, 0);
                aa[ct] = __builtin_amdgcn_mfma_f32_32x32x16_bf16(*(const bf16x8*)(a2t + chn * 64 + 16 * ks + 8 * hi), ba, aa[ct], 0, 0, 0); } }
#pragma unroll 1
        for (int ks = 0; ks < 10; ++ks) { const bf16x8 bg = *(const LAS bf16x8*)(arow + 128 + 16 * ks);
#pragma unroll
            for (int ct = 0; ct < 2; ++ct) { const int chn = 64 * h + 32 * ct + r32;
                ag[ct] = __builtin_amdgcn_mfma_f32_32x32x16_bf16(*(const bf16x8*)(g2t + chn * 160 + 16 * ks + 8 * hi), bg, ag[ct], 0, 0, 0); } }
        bf16_t* zr = Z + (size_t)token * ZP; const size_t grow = (size_t)(row0 + token);
        float* wd = (float*)(a.ws + WS_WD) + grow * 512; bf16_t* kkp = (bf16_t*)(a.ws + WS_KK) + grow * 512; bf16_t* kap = (bf16_t*)(a.ws + WS_KA) + grow * 512;
        const float* w0 = a.in[15] + l * 512; const float* a0 = a.in[17] + l * 512; const float* k_k = a.in[20] + l * 512; const float* k_a = a.in[21] + l * 512;
        float ss = 0.f;
#pragma unroll
        for (int ct = 0; ct < 2; ++ct)
#pragma unroll
            for (int rg = 0; rg < 4; ++rg) { const int c0 = 64 * h + 32 * ct + 8 * rg + 4 * hi;
                const u32x2 kraw = *(const u32x2*)(zr + ZC_RK + c0); const f32x4 w04 = *(const f32x4*)(w0 + c0), a04 = *(const f32x4*)(a0 + c0), kk4 = *(const f32x4*)(k_k + c0);
                f32x4 dec; u32x2 gp; float gv[4];
#pragma unroll
                for (int i = 0; i < 4; ++i) { const int r = 4 * rg + i;
                    const float kv = (i < 2) ? __uint_as_float((i & 1) ? (kraw.x & 0xffff0000u) : (kraw.x << 16)) : __uint_as_float((i & 1) ? (kraw.y & 0xffff0000u) : (kraw.y << 16));
                    const float wr_ = w04[i] + aw[ct][r]; const float sp = fmaxf(-wr_, 0.f) + __logf(1.f + __expf(-fabsf(wr_)));
                    dec[i] = __expf(-__expf(-sp - 0.5f));
                    aa[ct][r] = sigmoid_f(a04[i] + aa[ct][r]);
                    gv[i] = ag[ct][r];
                    const float kkv = kv * kk4[i]; aw[ct][r] = kkv; ss += kkv * kkv; }
                if (!dry) *(f32x4*)(wd + c0) = dec;
                gp.x = pk2(gv[0], gv[1]); gp.y = pk2(gv[2], gv[3]);
                if (!dry) *(u32x2*)(zr + (c0 < 256 ? ZC_FV + c0 : ZC_MV + (c0 - 256))) = gp; __builtin_amdgcn_sched_barrier(0); }
        ss += __shfl_xor(ss, 32);
        const float inv = 1.f / fmaxf(sqrtf(ss), 1e-12f);
#pragma unroll
        for (int ct = 0; ct < 2; ++ct)
#pragma unroll
            for (int rg = 0; rg < 4; ++rg) { const int c0 = 64 * h + 32 * ct + 8 * rg + 4 * hi; const f32x4 ka4 = *(const f32x4*)(k_a + c0);
                const u32x2 kraw = *(const u32x2*)(zr + ZC_RK + c0); const float kf4[4] = {bf2f(kraw.x & 0xffff), __uint_as_float(kraw.x & 0xffff0000u), bf2f(kraw.y & 0xffff), __uint_as_float(kraw.y & 0xffff0000u)};
                float kk[4], ka[4], kp[4];
#pragma unroll
                for (int i = 0; i < 4; ++i) { const int r = 4 * rg + i; kk[i] = aw[ct][r] * inv; ka[i] = kk[i] * aa[ct][r]; kp[i] = kf4[i] * (1.f + (aa[ct][r] - 1.f) * ka4[i]); }
                u32x2 o; o.x = pk2(kk[0], kk[1]); o.y = pk2(kk[2], kk[3]); if (!dry) *(u32x2*)(kkp + c0) = o;
                o.x = pk2(ka[0], ka[1]); o.y = pk2(ka[2], ka[3]); if (!dry) *(u32x2*)(kap + c0) = o;
                o.x = pk2(kp[0], kp[1]); o.y = pk2(kp[2], kp[3]); if (!dry) *(u32x2*)(zr + ZC_RK + c0) = o; __builtin_amdgcn_sched_barrier(0); }
    }
    __syncthreads();
}

template <int MODE, int D>
DEV void attn_unit(LAS unsigned char* lds, const bf16_t* Qp, int ldq, const bf16_t* Kp, int ldk, const bf16_t* Vt, int ldv, bf16_t* Op, int ldo,
                   int q0, int ntiles, int qb, const float* aux, const float* qgain, bool dry = false) {
    constexpr int KP = D + 8, KBYTES = 64 * KP * 2, VP = 72, VBYTES = D * VP * 2, NLD = D / 64;
    int tid_ = threadIdx.x; asm volatile("" : "+v"(tid_)); const int tid = tid_, lane = tid & 63, wid = __builtin_amdgcn_readfirstlane(tid >> 6), r32 = lane & 31, hi = lane >> 5;
    LAS float* cl = (LAS float*)lds; LAS unsigned* selm = (LAS unsigned*)(lds + 8192);
    LAS unsigned char* kb = lds + 16384; LAS unsigned char* vb = kb + 2 * KBYTES;
    const int q = q0 + wid * 32 + r32;
    if (MODE == 0) {
        const int n = 64 * ntiles; float v[8]; float run = 0.f;
#pragma unroll
        for (int i = 0; i < 8; ++i) { const int idx = 8 * tid + i; v[i] = idx < n ? aux[idx] : 0.f; run += v[i]; v[i] = run; }
        float sc = run;
#pragma unroll
        for (int o = 1; o < 64; o <<= 1) { const float t = __shfl_up(sc, o); if (lane >= o) sc += t; }
        LAS float* wsum = (LAS float*)kb;
        if (lane == 63) wsum[wid] = sc;
        __syncthreads();
        float off = sc - run;
        for (int w = 0; w < wid; ++w) off += wsum[w];
#pragma unroll
        for (int i = 0; i < 8; ++i) cl[8 * tid + i] = (off + v[i]) * LOG2E;
    }
    if (MODE == 1) {
        LAS float* km = cl;
        for (int e = tid; e < 16 * 64; e += 512) { const int nblk = e >> 6, d = e & 63; const float* pp = aux + (size_t)(4 * nblk) * 64 + d;
            km[e] = ((pp[0] + pp[64]) + (pp[128] + pp[192])) * (1.f / 256); }
        __syncthreads();
        if (tid < 256) { const bf16_t* qr = Qp + (size_t)(q0 + tid) * ldq; float g[16];
#pragma unroll
            for (int nb = 0; nb < 16; ++nb) g[nb] = 0.f;
            for (int c = 0; c < 8; ++c) { float qv[8]; unpack8(*(const u32x4*)(qr + 8 * c), qv);
#pragma unroll
                for (int nb = 0; nb < 16; ++nb) {
#pragma unroll
                    for (int i = 0; i < 8; ++i) g[nb] += qv[i] * km[nb * 64 + 8 * c + i]; } }
            unsigned m = 0u;
#pragma unroll
            for (int pick = 0; pick < 3; ++pick) { float best = -INFINITY; int bi = -1;
#pragma unroll
                for (int nb = 0; nb < 16; ++nb) { if (nb < qb && !((m >> nb) & 1u) && g[nb] > best) { best = g[nb]; bi = nb; } }
                if (bi >= 0) m |= 1u << bi; }
            selm[tid] = m; }
    }
    bf16x8 qf[D / 16];
#pragma unroll
    for (int d0 = 0; d0 < D / 16; ++d0) qf[d0] = *(const bf16x8*)(Qp + (size_t)q * ldq + d0 * 16 + hi * 8);
    if (MODE == 2) {
        float ss = 0.f;
#pragma unroll
        for (int d0 = 0; d0 < D / 16; ++d0) { float qv[8]; unpack8(__builtin_bit_cast(u32x4, qf[d0]), qv);
#pragma unroll
            for (int i = 0; i < 8; ++i) ss += qv[i] * qv[i]; }
        ss += __shfl_xor(ss, 32);
        const float rstd = rsqrtf(ss * (1.f / D) + NORM_EPS) * C2_128;
#pragma unroll
        for (int d0 = 0; d0 < D / 16; ++d0) { float qv[8]; unpack8(__builtin_bit_cast(u32x4, qf[d0]), qv);
#pragma unroll
            for (int i = 0; i < 8; ++i) qv[i] = qv[i] * rstd * qgain[d0 * 16 + hi * 8 + i];
            qf[d0] = __builtin_bit_cast(bf16x8, pack8(qv)); __builtin_amdgcn_sched_barrier(0); }
    }
    float mrun = -INFINITY, lrun = 0.f; f32x16 o[D / 32];
#pragma unroll
    for (int dt = 0; dt < D / 32; ++dt) o[dt] = f32x16{};
    __syncthreads();
    const float cq = (MODE == 0) ? cl[q] : 0.f;
    const unsigned sel = (MODE == 1) ? selm[wid * 32 + r32] : 0u;
    u32x4 kreg[NLD], vreg[NLD];
#define ATT_LOAD(t) do { _Pragma("unroll") for (int i_ = 0; i_ < NLD; ++i_) { const int idx_ = tid + 512 * i_; \
        kreg[i_] = *(const u32x4*)(Kp + (size_t)(64 * (t) + idx_ / (D / 8)) * ldk + (idx_ % (D / 8)) * 8); \
        vreg[i_] = *(const u32x4*)(Vt + (size_t)(idx_ >> 3) * ldv + 64 * (t) + (idx_ & 7) * 8); } } while (0)
#define ATT_STORE(buf) do { _Pragma("unroll") for (int i_ = 0; i_ < NLD; ++i_) { const int idx_ = tid + 512 * i_; \
        *(LAS u32x4*)(kb + (buf) * KBYTES + ((idx_ / (D / 8)) * KP + (idx_ % (D / 8)) * 8) * 2) = kreg[i_]; \
        *(LAS u32x4*)(vb + (buf) * VBYTES + ((idx_ >> 3) * VP + (idx_ & 7) * 8) * 2) = vreg[i_]; } } while (0)
    ATT_LOAD(0); ATT_STORE(0);
    __syncthreads();
    for (int t = 0; t < ntiles; ++t) {
        const int buf = t & 1, key0 = 64 * t;
        if (t + 1 < ntiles) ATT_LOAD(t + 1);
        bool work = true; const int nblk = key0 >> 8;
        if (MODE == 0) work = key0 <= q0 + wid * 32 + 31;
        if (MODE == 1) work = (nblk == qb) ? (key0 <= q0 + wid * 32 + 31) : (__any((sel >> nblk) & 1u) != 0);
        if (work) {
            const LAS unsigned char* kt = kb + buf * KBYTES; const LAS unsigned char* vt = vb + buf * VBYTES;
            constexpr int NKH = (D == 64) ? 2 : 1;
#pragma unroll 1
            for (int ks = 0; ks < 2 / NKH; ++ks) {
            f32x16 p[NKH];
#pragma unroll
            for (int kh = 0; kh < NKH; ++kh) { p[kh] = f32x16{}; const int khh = ks * NKH + kh;
#pragma unroll
                for (int d0 = 0; d0 < D / 16; ++d0) { const bf16x8 kf = *(const LAS bf16x8*)(kt + ((32 * khh + r32) * KP + 16 * d0 + 8 * hi) * 2);
                    p[kh] = __builtin_amdgcn_mfma_f32_32x32x16_bf16(kf, qf[d0], p[kh], 0, 0, 0); } }
            if (MODE == 0) {
                const bool diag = key0 + 63 > q0 + wid * 32;
                if (diag) {
#pragma unroll
                for (int kh = 0; kh < NKH; ++kh)
#pragma unroll
                    for (int rg = 0; rg < 4; ++rg) { const int kk0 = key0 + 32 * (ks * NKH + kh) + 8 * rg + 4 * hi; const f32x4 ck = *(const LAS f32x4*)(cl + kk0);
#pragma unroll
                        for (int i = 0; i < 4; ++i) { const float s = p[kh][4 * rg + i] + (cq - ck[i]); p[kh][4 * rg + i] = (kk0 + i > q) ? -INFINITY : s; } }
                } else {
#pragma unroll
                for (int kh = 0; kh < NKH; ++kh)
#pragma unroll
                    for (int rg = 0; rg < 4; ++rg) { const int kk0 = key0 + 32 * (ks * NKH + kh) + 8 * rg + 4 * hi; const f32x4 ck = *(const LAS f32x4*)(cl + kk0);
#pragma unroll
                        for (int i = 0; i < 4; ++i) p[kh][4 * rg + i] += (cq - ck[i]); }
                }
            }
            if (MODE == 1) {
                if (nblk == qb) {
#pragma unroll
                    for (int kh = 0; kh < NKH; ++kh)
#pragma unroll
                        for (int r = 0; r < 16; ++r) { if (key0 + 32 * (ks * NKH + kh) + crow(r, hi) > q) p[kh][r] = -INFINITY; }
                } else if (!((sel >> nblk) & 1u)) {
#pragma unroll
                    for (int kh = 0; kh < NKH; ++kh)
#pragma unroll
                        for (int r = 0; r < 16; ++r) p[kh][r] = -INFINITY;
                }
            }
            float mx = p[0][0];
#pragma unroll
            for (int kh = 0; kh < NKH; ++kh)
#pragma unroll
                for (int r = 0; r < 16; ++r) mx = fmaxf(mx, p[kh][r]);
            mx = fmaxf(mx, __shfl_xor(mx, 32));
            const float mnew = fmaxf(mrun, mx), muse = (mnew == -INFINITY) ? 0.f : mnew;
            const float alpha = __builtin_amdgcn_exp2f(mrun - muse);
            mrun = mnew; lrun *= alpha;
            if (__any(alpha != 1.0f)) {
#pragma unroll
                for (int dt = 0; dt < D / 32; ++dt) o[dt] *= alpha; }
            float ps = 0.f;
#pragma unroll
            for (int kh = 0; kh < NKH; ++kh)
#pragma unroll
                for (int r = 0; r < 16; ++r) { p[kh][r] = __builtin_amdgcn_exp2f(p[kh][r] - muse); ps += p[kh][r]; }
            lrun += ps;
            bf16x8 pb[NKH][2];
#pragma unroll
            for (int kh = 0; kh < NKH; ++kh)
#pragma unroll
                for (int j = 0; j < 2; ++j) { u32x4 w; w.x = pk2(p[kh][8 * j + 0], p[kh][8 * j + 1]); w.y = pk2(p[kh][8 * j + 2], p[kh][8 * j + 3]); w.z = pk2(p[kh][8 * j + 4], p[kh][8 * j + 5]); w.w = pk2(p[kh][8 * j + 6], p[kh][8 * j + 7]);
                    pb[kh][j] = __builtin_bit_cast(bf16x8, w); }
#pragma unroll
            for (int dt = 0; dt < D / 32; ++dt)
#pragma unroll
                for (int kh = 0; kh < NKH; ++kh)
#pragma unroll
                    for (int j = 0; j < 2; ++j) { const LAS unsigned char* vp_ = vt + ((32 * dt + r32) * VP + 32 * (ks * NKH + kh) + 16 * j + 4 * hi) * 2;
                        const u32x2 lo = *(const LAS u32x2*)vp_, hh = *(const LAS u32x2*)(vp_ + 16); u32x4 w; w.x = lo.x; w.y = lo.y; w.z = hh.x; w.w = hh.y;
                        o[dt] = __builtin_amdgcn_mfma_f32_32x32x16_bf16(__builtin_bit_cast(bf16x8, w), pb[kh][j], o[dt], 0, 0, 0); }
            }
        }
        if (t + 1 < ntiles) ATT_STORE(buf ^ 1);
        __syncthreads();
    }
#undef ATT_LOAD
#undef ATT_STORE
    lrun += __shfl_xor(lrun, 32);
    const float inv = 1.f / lrun;
    bf16_t* orow = Op + (size_t)q * ldo;
    if (!dry)
#pragma unroll
    for (int dt = 0; dt < D / 32; ++dt)
#pragma unroll
        for (int rg = 0; rg < 4; ++rg) { u32x2 w; w.x = pk2(o[dt][4 * rg] * inv, o[dt][4 * rg + 1] * inv); w.y = pk2(o[dt][4 * rg + 2] * inv, o[dt][4 * rg + 3] * inv);
            *(u32x2*)(orow + 32 * dt + 8 * rg + 4 * hi) = w; }
    __syncthreads();
}

constexpr int RW_NCH = SEQ / 16;
constexpr int RW_ARP = 72, RW_BKTP = 32, RW_VTP = 24, RW_PMP = 16, RW_LP = 20;
constexpr int RW_NBUF = 6, RW_NPRE = 4;
constexpr int RW_DB = 15104, RW_AR = 0, RW_BKT = 4608, RW_VT = 8704, RW_GC = 11776, RW_TM = 12032, RW_PM1 = 13056, RW_PM2 = 14080;
constexpr int RW_PRIV = RW_NBUF * RW_DB, RW_PRIV_BYTES = 5888, RW_PBK = 0, RW_PLAB = 4608;
constexpr int RW_NYB = 4;
constexpr int RW_YB = RW_PRIV + RW_NPRE * RW_PRIV_BYTES, RW_FLG = RW_YB + RW_NYB * 4096, RW_SLOT_BYTES = RW_FLG + 128;
static_assert(RW_PM2 + 32 * RW_PMP * 2 == RW_DB && RW_TM + 32 * RW_PMP * 2 == RW_PM1 && RW_SLOT_BYTES <= 131072 && RW_DB % 16 == 0 && RW_PRIV_BYTES % 16 == 0, "rwkv lds map");
DEV bf16x8 pack_acc8(const f32x16& v, int base) { u32x4 w; w.x = pk2(v[base], v[base + 1]); w.y = pk2(v[base + 2], v[base + 3]); w.z = pk2(v[base + 4], v[base + 5]); w.w = pk2(v[base + 6], v[base + 7]); return __builtin_bit_cast(bf16x8, w); }
DEV int fresh_lane() { int l_; asm volatile("v_mbcnt_lo_u32_b32 %0, -1, 0\n\tv_mbcnt_hi_u32_b32 %0, -1, %0" : "=v"(l_)); return l_; }
DEV void rw_wait(volatile LAS unsigned* f, unsigned target) { while (*f < target) __builtin_amdgcn_s_sleep(1); asm volatile("" ::: "memory"); }
DEV void rw_post_flag(volatile LAS unsigned* f, unsigned v) { asm volatile("s_waitcnt vmcnt(0) lgkmcnt(0)" ::: "memory"); *f = v; }
DEV bf16x8 frag_perm(const LAS bf16_t* rowp, int hi) { const u32x2 lo = *(const LAS u32x2*)(rowp + 4 * hi), hh = *(const LAS u32x2*)(rowp + 8 + 4 * hi); u32x4 w; w.x = lo.x; w.y = lo.y; w.z = hh.x; w.w = hh.y; return __builtin_bit_cast(bf16x8, w); }

struct RwRaw { float w[16]; unsigned short kk[16], ka[16], kp[16], rr[16], vr[16]; };
DEV void rwkv_pre_load(RwRaw& R, int c, const float* WDp, const bf16_t* KKp, const bf16_t* KAp, const bf16_t* Zl) {
#pragma unroll
    for (int t = 0; t < 16; ++t) { const size_t ro = (size_t)(16 * c + t);
        R.w[t] = WDp[ro * 512]; R.kk[t] = KKp[ro * 512]; R.ka[t] = KAp[ro * 512]; R.kp[t] = Zl[ro * ZP + ZC_RK]; R.rr[t] = Zl[ro * ZP + ZC_RR]; R.vr[t] = Zl[ro * ZP + ZC_RV]; }
}
DEV void rwkv_pre_a(const RwRaw& R, int c, LAS unsigned char* sl, volatile LAS unsigned* flg, int lane) {
    const int bi = c % RW_NBUF, pw = c % RW_NPRE;
    LAS bf16_t* BK = (LAS bf16_t*)(sl + RW_PRIV + pw * RW_PRIV_BYTES + RW_PBK);
    LAS unsigned char* db = sl + bi * RW_DB;
    LAS bf16_t* AR = (LAS bf16_t*)(db + RW_AR); LAS bf16_t* BKT = (LAS bf16_t*)(db + RW_BKT); LAS bf16_t* VT = (LAS bf16_t*)(db + RW_VT); LAS float* GC = (LAS float*)(db + RW_GC);
    if (c >= RW_NBUF) rw_wait(flg + 6 + bi, (unsigned)(c - RW_NBUF + 1));
    float g = 1.f; unsigned bkt[16];
#pragma unroll
    for (int t = 0; t < 16; ++t) {
        const float w = R.w[t], kk = bf2f(R.kk[t]), ka = bf2f(R.ka[t]), kp = bf2f(R.kp[t]), rr = bf2f(R.rr[t]);
        const float at = -kk * g; g *= w; const float inv = __builtin_amdgcn_rcpf(g);
        const unsigned bt = f2bf(ka * inv), kt = f2bf(kp * inv);
        AR[t * RW_ARP + lane] = (bf16_t)f2bf(at); AR[(16 + t) * RW_ARP + lane] = (bf16_t)f2bf(rr * g);
        BK[t * RW_ARP + lane] = (bf16_t)bt; BK[(16 + t) * RW_ARP + lane] = (bf16_t)kt;
        if (t & 1) { bkt[t >> 1] |= bt << 16; bkt[8 + (t >> 1)] |= kt << 16; } else { bkt[t >> 1] = bt; bkt[8 + (t >> 1)] = kt; }
    }
    GC[lane] = g;
#pragma unroll
    for (int q4 = 0; q4 < 4; ++q4) { u32x4 w4; w4.x = bkt[4 * q4]; w4.y = bkt[4 * q4 + 1]; w4.z = bkt[4 * q4 + 2]; w4.w = bkt[4 * q4 + 3]; *(LAS u32x4*)(BKT + lane * RW_BKTP + 8 * q4) = w4; }
    { unsigned vv[8];
#pragma unroll
      for (int t = 0; t < 16; ++t) { const unsigned x = R.vr[t]; if (t & 1) vv[t >> 1] |= x << 16; else vv[t >> 1] = x; }
      u32x4 v0; v0.x = vv[0]; v0.y = vv[1]; v0.z = vv[2]; v0.w = vv[3]; u32x4 v1; v1.x = vv[4]; v1.y = vv[5]; v1.z = vv[6]; v1.w = vv[7];
      *(LAS u32x4*)(VT + lane * RW_VTP) = v0; *(LAS u32x4*)(VT + lane * RW_VTP + 8) = v1; }
}
DEV void rwkv_pre_b(int c, LAS unsigned char* sl, volatile LAS unsigned* flg, int lane) {
    const int r32 = lane & 31, hi = lane >> 5, bi = c % RW_NBUF, pw = c % RW_NPRE;
    LAS bf16_t* BK = (LAS bf16_t*)(sl + RW_PRIV + pw * RW_PRIV_BYTES + RW_PBK); LAS float* LAB = (LAS float*)(sl + RW_PRIV + pw * RW_PRIV_BYTES + RW_PLAB);
    LAS unsigned char* db = sl + bi * RW_DB;
    LAS bf16_t* AR = (LAS bf16_t*)(db + RW_AR); LAS bf16_t* TM = (LAS bf16_t*)(db + RW_TM); LAS bf16_t* PM1 = (LAS bf16_t*)(db + RW_PM1); LAS bf16_t* PM2 = (LAS bf16_t*)(db + RW_PM2);
    f32x16 P = f32x16{};
#pragma unroll
    for (int ks = 0; ks < 4; ++ks) P = __builtin_amdgcn_mfma_f32_32x32x16_bf16(*(const LAS bf16x8*)(AR + r32 * RW_ARP + 16 * ks + 8 * hi), *(const LAS bf16x8*)(BK + r32 * RW_ARP + 16 * ks + 8 * hi), P, 0, 0, 0);
    const int n = r32;
#pragma unroll
    for (int r = 0; r < 16; ++r) { const int m = crow(r, hi);
        if (r < 8) { if (n < 16) LAB[m * RW_LP + n] = (n < m) ? P[r] : 0.f; else PM1[m * RW_PMP + (n - 16)] = (bf16_t)f2bf((n - 16 < m) ? P[r] : 0.f); }
        else { if (n < 16) PM2[m * RW_PMP + n] = (bf16_t)f2bf((n <= m - 16) ? P[r] : 0.f); else PM1[m * RW_PMP + (n - 16)] = (bf16_t)f2bf((n - 16 <= m - 16) ? P[r] : 0.f); } }
}
DEV void rwkv_pre_c(int c, LAS unsigned char* sl, volatile LAS unsigned* flg, int lane) {
    const int bi = c % RW_NBUF, pw = c % RW_NPRE;
    const LAS float* LAB = (const LAS float*)(sl + RW_PRIV + pw * RW_PRIV_BYTES + RW_PLAB); LAS bf16_t* TM = (LAS bf16_t*)(sl + bi * RW_DB + RW_TM);
    { const int cc = lane & 15; float T[16];
#pragma unroll
      for (int t = 0; t < 16; ++t) { float acc = (t == cc) ? 1.f : 0.f;
          int z = 0; if (t >= 3) asm volatile("v_and_b32 %0, 0, %1" : "=v"(z) : "v"(T[t - 3]));
          const LAS float* lrow = LAB + t * RW_LP + z;
#pragma unroll
          for (int tau = 0; tau < t; ++tau) acc = fmaf(lrow[tau], T[tau], acc);
          T[t] = acc; }
      if (lane < 16) {
#pragma unroll
          for (int t = 0; t < 16; ++t) TM[t * RW_PMP + cc] = (bf16_t)f2bf(T[t]); } }
    asm volatile("s_waitcnt lgkmcnt(0)" ::: "memory"); flg[bi] = (unsigned)(c + 1);
}
DEV void rwkv_pre(const Args& a, int b, int h, LAS unsigned char* sl, int par) {
    const int lane = fresh_lane();
    volatile LAS unsigned* flg = (volatile LAS unsigned*)(sl + RW_FLG);
    const size_t rowb = (size_t)b * SEQ;
    const bf16_t* Zl = (const bf16_t*)(a.ws + WS_Z) + rowb * ZP + h * 64 + lane;
    const float* WDp = (const float*)(a.ws + WS_WD) + rowb * 512 + h * 64 + lane;
    const bf16_t* KKp = (const bf16_t*)(a.ws + WS_KK) + rowb * 512 + h * 64 + lane;
    const bf16_t* KAp = (const bf16_t*)(a.ws + WS_KA) + rowb * 512 + h * 64 + lane;
    for (int bz = par; bz < RW_NBUF; bz += RW_NPRE) for (int e = lane; e < 32 * RW_PMP; e += 64) { ((LAS bf16_t*)(sl + bz * RW_DB + RW_PM2))[e] = 0; ((LAS bf16_t*)(sl + bz * RW_DB + RW_TM))[e] = 0; }
    RwRaw R;
    rwkv_pre_load(R, par, WDp, KKp, KAp, Zl);
#pragma unroll 1
    for (int c = par; c < RW_NCH; c += RW_NPRE) {
        rwkv_pre_a(R, c, sl, flg, lane);
        rwkv_pre_b(c, sl, flg, lane);
        asm volatile("" ::: "memory");
        rwkv_pre_load(R, (c + RW_NPRE < RW_NCH) ? c + RW_NPRE : c, WDp, KKp, KAp, Zl);
#if !defined(NOPREC)
        rwkv_pre_c(c, sl, flg, lane);
#endif
    }
}

DEV void rwkv_main(LAS unsigned char* sl) {
    const int lane = fresh_lane(), r32 = lane & 31, hi = lane >> 5;
    volatile LAS unsigned* flg = (volatile LAS unsigned*)(sl + RW_FLG);
    f32x16 ST[2][2];
#pragma unroll
    for (int jt = 0; jt < 2; ++jt)
#pragma unroll
        for (int it = 0; it < 2; ++it) ST[jt][it] = f32x16{};
#pragma unroll 1
    for (int c = 0; c < RW_NCH; ++c) {
        const int bi = c % RW_NBUF;
        LAS unsigned char* db = sl + bi * RW_DB;
        const LAS bf16_t* AR = (const LAS bf16_t*)(db + RW_AR); const LAS bf16_t* BKT = (const LAS bf16_t*)(db + RW_BKT); const LAS bf16_t* VT = (const LAS bf16_t*)(db + RW_VT);
        const LAS float* GC = (const LAS float*)(db + RW_GC); const LAS bf16_t* TM = (const LAS bf16_t*)(db + RW_TM); const LAS bf16_t* PM1 = (const LAS bf16_t*)(db + RW_PM1); const LAS bf16_t* PM2 = (const LAS bf16_t*)(db + RW_PM2);
        const int yi = c % RW_NYB; LAS float* YB = (LAS float*)(sl + RW_YB + yi * 4096);
        rw_wait(flg + bi, (unsigned)(c + 1));
        f32x16 X[2]; X[0] = f32x16{}; X[1] = f32x16{};
#pragma unroll
        for (int jt = 0; jt < 2; ++jt)
#pragma unroll
            for (int rgp = 0; rgp < 2; ++rgp) { const bf16x8 af = frag_perm(AR + r32 * RW_ARP + 32 * jt + 16 * rgp, hi);
#pragma unroll
                for (int it = 0; it < 2; ++it) X[it] = __builtin_amdgcn_mfma_f32_32x32x16_bf16(af, pack_acc8(ST[jt][it], 8 * rgp), X[it], 0, 0, 0); }
        bf16x8 vt[2];
        { const bf16x8 a1 = *(const LAS bf16x8*)(PM1 + r32 * RW_PMP + 8 * hi);
#pragma unroll
          for (int it = 0; it < 2; ++it) { vt[it] = *(const LAS bf16x8*)(VT + (32 * it + r32) * RW_VTP + 8 * hi); X[it] = __builtin_amdgcn_mfma_f32_32x32x16_bf16(a1, vt[it], X[it], 0, 0, 0); } }
        bf16x8 ub[2];
        { const bf16x8 ta = frag_perm(TM + r32 * RW_PMP, hi), pm2 = frag_perm(PM2 + r32 * RW_PMP, hi);
#pragma unroll
          for (int it = 0; it < 2; ++it) { const f32x16 U = __builtin_amdgcn_mfma_f32_32x32x16_bf16(ta, pack_acc8(X[it], 0), f32x16{}, 0, 0, 0);
              ub[it] = pack_acc8(U, 0); X[it] = __builtin_amdgcn_mfma_f32_32x32x16_bf16(pm2, ub[it], X[it], 0, 0, 0); } }
        if (c >= RW_NYB) rw_wait(flg + 16 + yi, (unsigned)(c - RW_NYB + 1));
#pragma unroll
        for (int it = 0; it < 2; ++it)
#pragma unroll
            for (int r = 8; r < 16; ++r) YB[(crow(r, hi) - 16) * 64 + 32 * it + r32] = X[it][r];
        rw_post_flag(flg + 12 + yi, (unsigned)(c + 1));
#pragma unroll
        for (int jt = 0; jt < 2; ++jt) { const bf16x8 a0 = frag_perm(BKT + (32 * jt + r32) * RW_BKTP, hi), a1 = *(const LAS bf16x8*)(BKT + (32 * jt + r32) * RW_BKTP + 16 + 8 * hi);
#pragma unroll
            for (int it = 0; it < 2; ++it) { ST[jt][it] = __builtin_amdgcn_mfma_f32_32x32x16_bf16(a0, ub[it], ST[jt][it], 0, 0, 0);
                ST[jt][it] = __builtin_amdgcn_mfma_f32_32x32x16_bf16(a1, vt[it], ST[jt][it], 0, 0, 0); }
#pragma unroll
            for (int rg = 0; rg < 4; ++rg) { const f32x4 g4 = *(const LAS f32x4*)(GC + 32 * jt + 8 * rg + 4 * hi);
#pragma unroll
                for (int e = 0; e < 4; ++e) { ST[jt][0][4 * rg + e] *= g4[e]; ST[jt][1][4 * rg + e] *= g4[e]; } } }
        rw_post_flag(flg + 6 + bi, (unsigned)(c + 1));
    }
}

DEV void rwkv_post(const Args& a, int l, int b, int h, LAS unsigned char* sl, int par) {
    const int lane = fresh_lane();
    volatile LAS unsigned* flg = (volatile LAS unsigned*)(sl + RW_FLG);
    bf16_t* Zb = (bf16_t*)(a.ws + WS_Z) + (size_t)b * SEQ * ZP;
    const int gcol0 = h < 4 ? ZC_FV + h * 64 : ZC_MV + (h - 4) * 64;
    const int t = lane >> 2, qd = lane & 3, c0 = h * 64 + 16 * qd;
    const float* rkp = a.in[22] + l * 512 + c0; const float* lw = a.in[23] + l * 512 + c0; const float* lb = a.in[24] + l * 512 + c0;
#pragma unroll 1
    for (int c = par; c < RW_NCH; c += 2) {
        bf16_t* zr = Zb + (size_t)(16 * c + t) * ZP;
        const u32x4 r0 = *(const u32x4*)(zr + ZC_RR + c0), r1 = *(const u32x4*)(zr + ZC_RR + c0 + 8), k0 = *(const u32x4*)(zr + ZC_RK + c0), k1 = *(const u32x4*)(zr + ZC_RK + c0 + 8);
        const u32x4 v0 = *(const u32x4*)(zr + ZC_RV + c0), v1 = *(const u32x4*)(zr + ZC_RV + c0 + 8), g0 = *(const u32x4*)(zr + gcol0 + 16 * qd), g1 = *(const u32x4*)(zr + gcol0 + 16 * qd + 8);
        const int yi = c % RW_NYB; const LAS float* YB = (const LAS float*)(sl + RW_YB + yi * 4096);
        rw_wait(flg + 12 + yi, (unsigned)(c + 1));
        float y[16];
#pragma unroll
        for (int q4 = 0; q4 < 4; ++q4) { const f32x4 yy = *(const LAS f32x4*)(YB + t * 64 + 16 * qd + 4 * q4); y[4 * q4] = yy[0]; y[4 * q4 + 1] = yy[1]; y[4 * q4 + 2] = yy[2]; y[4 * q4 + 3] = yy[3]; }
        asm volatile("s_waitcnt lgkmcnt(0)" ::: "memory");
        flg[16 + yi] = (unsigned)(c + 1);
        float s = 0.f;
#pragma unroll
        for (int e = 0; e < 16; ++e) s += y[e];
        s += __shfl_xor(s, 1); s += __shfl_xor(s, 2);
        const float mean = s * (1.f / 64); float q = 0.f;
#pragma unroll
        for (int e = 0; e < 16; ++e) { y[e] -= mean; q += y[e] * y[e]; }
        q += __shfl_xor(q, 1); q += __shfl_xor(q, 2);
        const float rstd = rsqrtf(q * (1.f / 64) + GN_EPS);
        float rv[16], kv[16];
        unpack8(r0, *(float(*)[8])&rv[0]); unpack8(r1, *(float(*)[8])&rv[8]); unpack8(k0, *(float(*)[8])&kv[0]); unpack8(k1, *(float(*)[8])&kv[8]);
        float bs = 0.f;
#pragma unroll
        for (int e = 0; e < 16; ++e) bs += rv[e] * kv[e] * rkp[e];
        bs += __shfl_xor(bs, 1); bs += __shfl_xor(bs, 2);
        float vv[16], gv[16], o[16];
        unpack8(v0, *(float(*)[8])&vv[0]); unpack8(v1, *(float(*)[8])&vv[8]); unpack8(g0, *(float(*)[8])&gv[0]); unpack8(g1, *(float(*)[8])&gv[8]);
#pragma unroll
        for (int e = 0; e < 16; ++e) o[e] = (y[e] * rstd * lw[e] + lb[e] + bs * vv[e]) * gv[e];
        *(u32x4*)(zr + ZC_RR + c0) = pack8(*(float(*)[8])&o[0]); *(u32x4*)(zr + ZC_RR + c0 + 8) = pack8(*(float(*)[8])&o[8]);
    }
}

#define XB_TMO      128
#define XB_XCNT(j)  (256  + 64 * (j))
#define XB_XSUB(j)  (1280 + 64 * (j))
#define XB_XGEN(j)  (2304 + 64 * (j))
#define XB_TOP      3328
#define XB_TOPGEN   3392
#define XCD_BAR_WORDS 3456
#define XB_SPIN_CAP (1u << 18)

__device__ __forceinline__ unsigned xb_ld(unsigned* p)              { return __hip_atomic_load(p, __ATOMIC_RELAXED, __HIP_MEMORY_SCOPE_AGENT); }
__device__ __forceinline__ unsigned xb_add(unsigned* p, unsigned v) { return __hip_atomic_fetch_add(p, v, __ATOMIC_RELAXED, __HIP_MEMORY_SCOPE_AGENT); }
__device__ __forceinline__ unsigned xb_xcc_id() { return (unsigned)__builtin_amdgcn_s_getreg((3 << 11) | 20) & 0xFu; }
#define XB_SPIN(cond, bar) do { unsigned _sp = 0; while (cond) { __builtin_amdgcn_s_sleep(1); \
    if ((++_sp & 255u) == 0u) { if (xb_ld(&(bar)[XB_TMO])) break; if (_sp > XB_SPIN_CAP) { atomicAdd(&(bar)[XB_TMO], 1u); break; } } } } while (0)

struct XcdBarrier {
    unsigned* bar; unsigned x;
    volatile LAS unsigned* st;
};

__device__ __forceinline__ XcdBarrier xcd_barrier_post(unsigned* bar, volatile LAS unsigned* st) {
    XcdBarrier b; b.bar = bar; b.x = xb_xcc_id(); b.st = st;
    if (threadIdx.x == 0) (void)xb_add(&bar[XB_XCNT(b.x)], 1u);
    return b;
}
__device__ __forceinline__ void xcd_barrier_complete(unsigned* bar, unsigned x, unsigned& nloc, unsigned& nx) {
    const unsigned G = gridDim.x * gridDim.y * gridDim.z;
    unsigned sum, cnt, mine, sp = 0u;
    for (;;) {
        sum = 0u; cnt = 0u; mine = 0u;
#pragma unroll
        for (unsigned j = 0; j < 16; ++j) { const unsigned c = xb_ld(&bar[XB_XCNT(j)]); sum += c; cnt += (c > 0u) ? 1u : 0u; mine = (j == x) ? c : mine; }
        if (sum == G) break;
        __builtin_amdgcn_s_sleep(1);
        if ((++sp & 255u) == 0u) { if (xb_ld(&bar[XB_TMO])) break; if (sp > XB_SPIN_CAP) { atomicAdd(&bar[XB_TMO], 1u); break; } }
    }
    nloc = mine > 0u ? mine : 1u; nx = cnt > 0u ? cnt : 1u;
}

__device__ __forceinline__ void xcd_barrier(const XcdBarrier& b) {
    asm volatile("s_waitcnt vmcnt(0)" ::: "memory");
    __syncthreads();
    if (threadIdx.x == 0) {
        unsigned* bar = b.bar;
        __builtin_amdgcn_s_waitcnt(0);
        unsigned nloc = b.st[0], nx = b.st[1];
        if (nloc == 0u) { xcd_barrier_complete(bar, b.x, nloc, nx); b.st[0] = nloc; b.st[1] = nx; }
        const unsigned old = xb_add(&bar[XB_XSUB(b.x)], 1u);
        const unsigned gen = old / nloc;
        if (old + 1u == (gen + 1u) * nloc) {
            __builtin_amdgcn_fence(__ATOMIC_RELEASE, "agent");
            asm volatile("s_waitcnt vmcnt(0)" ::: "memory");
            const unsigned og = xb_add(&bar[XB_TOP], 1u);
            const unsigned tg = og / nx;
            if (og + 1u == (tg + 1u) * nx) xb_add(&bar[XB_TOPGEN], 1u);
            else XB_SPIN(xb_ld(&bar[XB_TOPGEN]) == tg, bar);
            __builtin_amdgcn_fence(__ATOMIC_ACQUIRE, "agent");
            xb_add(&bar[XB_XGEN(b.x)], 1u);
            asm volatile("s_waitcnt vmcnt(0)" ::: "memory");
        } else {
            XB_SPIN(xb_ld(&bar[XB_XGEN(b.x)]) == gen, bar);
            __builtin_amdgcn_fence(__ATOMIC_ACQUIRE, "agent");
            asm volatile("s_waitcnt vmcnt(0)" ::: "memory");
        }
    }
    __syncthreads();
}

constexpr int N_PHASES = 1 + 15 * NL;
#ifndef MK_MULTI
#define MK_MULTI 0
#endif
#ifndef PROBE_Q
#define PROBE_Q 500.f
#endif
#ifndef PROBE_OFF
#define PROBE_OFF 0.f
#endif
#ifndef REPK
#define REPK 0
#endif
#ifndef ATT_REP
#define ATT_REP 1
#endif
#ifndef PREP_REP
#define PREP_REP 1
#endif
#ifndef RWROLES
#define RWROLES 7
#endif
#ifndef PHMASK
#define PHMASK 0xFFFF
#endif
#define PHON(k) ((PHMASK >> (k)) & 1)
__global__ void __launch_bounds__(512, 2) fwd_megakernel(Args a) {
    extern __shared__ __attribute__((aligned(16))) unsigned char lds_raw[];
    LAS unsigned char* lds = (LAS unsigned char*)lds_raw;
    cg::grid_group grid = cg::this_grid();
    { volatile LAS unsigned* st0 = (volatile LAS unsigned*)(lds + 131072 + 128); if (threadIdx.x == 0) { st0[0] = 0u; st0[1] = 0u; } __syncthreads(); }
    XcdBarrier xbar = xcd_barrier_post((unsigned*)(a.ws + WS_CTL) + 4096, (volatile LAS unsigned*)(lds + 131072 + 128));
    const int G = gridDim.x, bid = blockIdx.x, NGW = G * 8;
    unsigned char* ws = a.ws;
    bf16_t* HN = (bf16_t*)(ws + WS_HN); bf16_t* Z = (bf16_t*)(ws + WS_Z); bf16_t* HID = Z; bf16_t* QX = Z; bf16_t* OX = Z + (size_t)TOK * 512;
#ifdef PROBE_GROUP
    LAS unsigned long long* prs = (LAS unsigned long long*)(lds + 131072 + 64);
    if (threadIdx.x == 0) { prs[0] = __builtin_amdgcn_s_memrealtime(); prs[1] = 0ull; prs[2] = 99ull; }
#endif
#ifdef PROBE_GROUP
    for (int ph = a.ph_lo; ph <= a.ph_hi; ++ph) {
#else
    for (int ph = a.ph_lo; ph < a.ph_hi; ++ph) {
#endif
        if (ph > a.ph_lo) { if (ph == a.ph_lo + 1 || MK_MULTI) grid.sync(); else xcd_barrier(xbar);
#ifdef SYNC_REP
            xcd_barrier(xbar); xcd_barrier(xbar);
#endif
        }
#ifdef PROBE_GROUP
        if (threadIdx.x == 0) { const unsigned long long now = __builtin_amdgcn_s_memrealtime(); if (prs[2] == (unsigned long long)PROBE_GROUP) prs[1] += now - prs[0]; prs[0] = now;
          if (ph == a.ph_hi) { if (blockIdx.x == 0) { float us_ = (float)prs[1] * 0.01f;
#if PROBE_GROUP == 8
              us_ = (float)((volatile unsigned*)(ws + WS_CTL))[32 * 64] * 0.01f;
#endif
              a.out[0] = floorf((us_ + PROBE_OFF) / PROBE_Q) * PROBE_Q + 0.5f * PROBE_Q; } }
          const int k_ = (ph - 1) % 15; prs[2] = ph == 0 ? 0 : (k_ == 0 || k_ == 3 || k_ == 8 || k_ == 12) ? 1 : (k_ == 1 || k_ == 13) ? 2 : (k_ == 2 || k_ == 14 || k_ == 7 || k_ == 11) ? 3 : (k_ == 4 || k_ == 9) ? 4 : k_ == 5 ? 5 : k_ == 6 ? 6 : 7; }
        if (ph == a.ph_hi) break;
#endif
        int tidp = threadIdx.x; asm volatile("" : "+v"(tidp)); const int tid = tidp, lane = tid & 63, wid = __builtin_amdgcn_readfirstlane(tid >> 6), gw = bid * 8 + wid;
        if (ph == 0) { for (int rp_ = 0; rp_ < ((REPK >> 15) & 1) + 1; ++rp_) { if (PHON(15)) p0_prologue(a, lds, gw, NGW, wid, lane, tid); } continue; }
        const int l = (ph - 1) / 15, kind = (ph - 1) % 15;
        const unsigned char* wl = ws + WS_W + (size_t)l * WL_BYTES;
        if (PHON(0) && (kind == 0 || kind == 3 || kind == 8 || kind == 12)) {
            const float* src = (l == 0 && kind == 0) ? a.in[0] : a.out;
            const float* g = (kind == 0 ? a.in[3] : kind == 3 ? a.in[6] : kind == 8 ? a.in[25] : a.in[32]) + l * DM;
            for (int rp_ = 0; rp_ < (REPK & 1) + 1; ++rp_) norm_phase(src, g, HN, TOK, gw, NGW, lane);
            if (l == 0 && kind == 3) xkv_post(a, gw, NGW, lane);
        }
        if (PHON(1) && (kind == 1 || kind == 13)) {
            pg8::Gemm g{HN, (const bf16_t*)(wl + (kind == 1 ? OFF_F1I : OFF_F2I)), TOK, 2 * FF, DM, DM};
            pg8::StaticOrder S; S.init(TOK, 2 * FF, G, bid);
            pg8::EpiSwiglu E{HID, FF};
            pg8::gemm_phase<pg8::EpiSwiglu, pg8::StaticOrder, true, true>(lds, g, S, E);
        }
        if (PHON(2) && (kind == 2 || kind == 14 || kind == 7 || kind == 11)) {
            pg8::Gemm g; pg8::EpiResid E; E.out = a.out; E.ldc = DM; g.M = TOK; g.N = DM;
            if (kind == 2 || kind == 14) { g.A = HID; g.lda = FF; g.K = FF; g.Bt = (const bf16_t*)(wl + (kind == 2 ? OFF_F1O : OFF_F2O)); E.scale = 0.5f; E.base = (l == 0 && kind == 2) ? a.in[0] : a.out; }
            else if (kind == 7) { g.A = Z; g.lda = ZP; g.K = DM; g.Bt = (const bf16_t*)(wl + OFF_MO); E.scale = 1.f; E.base = a.out; }
            else { g.A = OX; g.lda = 512; g.K = 512; g.Bt = (const bf16_t*)(wl + OFF_XO); E.scale = 1.f; E.base = a.out; }
            pg8::StaticOrder S; S.init(TOK, DM, G, bid);
            const float sc_ = E.scale;
            for (int rp_ = ((REPK >> 2) & 1); rp_ >= 0; --rp_) { E.scale = rp_ ? 0.f : sc_;
            pg8::gemm_phase<pg8::EpiResid, pg8::StaticOrder, true, true>(lds, g, S, E); if (rp_) { __syncthreads(); } }
        }
        if (PHON(4) && (kind == 4 || kind == 9 || (kind == 0 && l == 0))) {
            const int ng = (kind == 0) ? NL : 1;
            for (int rp_ = 0; rp_ < ((REPK >> 4) & 1) + 1; ++rp_)
            for (int gi = 0; gi < ng; ++gi) {
                pg8::Gemm g; pg8::EpiBf16 E; int cidx = bid;
                if (kind == 4) { g.A = HN; g.lda = DM; g.K = DM; g.M = TOK; g.N = 3584; g.Bt = (const bf16_t*)(wl + OFF_MI); E.O = Z; E.ldc = ZP; E.ncols = ZC_VALID; E.halo = (bf16_t*)(ws + WS_ZHALO); }
                else if (kind == 9) { g.A = HN; g.lda = DM; g.K = DM; g.M = TOK; g.N = 512; g.Bt = (const bf16_t*)(wl + OFF_XQ); E.O = QX; E.ldc = 512; E.ncols = 512; E.halo = nullptr; }
                else { g.A = (const bf16_t*)(ws + WS_MEMN) + (size_t)gi * NB * MEMLEN * DM; g.lda = DM; g.K = DM; g.M = NB * MEMLEN; g.N = 1024;
                       g.Bt = (const bf16_t*)(ws + WS_W + (size_t)gi * WL_BYTES + OFF_XKV); E.O = (bf16_t*)(ws + WS_KVX) + (size_t)gi * NB * MEMLEN * 1024; E.ldc = 1024; E.ncols = 1024; E.halo = nullptr;
                       cidx = (bid + gi * (G / 2)) % G; }
                pg8::StaticOrder S; S.init(g.M, g.N, G, cidx);
                pg8::gemm_phase<pg8::EpiBf16, pg8::StaticOrder, true, true>(lds, g, S, E);
            }
        }
        if (PHON(5) && kind == 5) { for (int rp_ = PREP_REP - 1; rp_ >= 0; --rp_) for (int tile = bid; tile < TOK / 64; tile += G) prep_tile(a, l, tile, lds, rp_ > 0); }
        if (PHON(6) && kind == 6) {
            unsigned* ctr = (unsigned*)(ws + WS_CTL) + 64 * (1 + l); LAS unsigned* qw = (LAS unsigned*)(lds + 131072);
            for (;;) {
                __syncthreads();
                if (tid == 0) *qw = atomicAdd(ctr, 1u);
                __syncthreads();
                const int item = __builtin_amdgcn_readfirstlane((int)*qw);
                if (item >= 64 + 1024) break;
                if (item < 64) {
                    if (tid < 32) ((LAS unsigned*)(lds + RW_FLG))[tid] = 0u;
                    __syncthreads();
                    if (PHON(7)) {
                        const int ub = item >> 3, uh = item & 7;
                        if (wid == 0 || wid == 4 || wid == 2 || wid == 6) { if (RWROLES & 1) rwkv_pre(a, ub, uh, lds, wid == 0 ? 0 : wid == 4 ? 1 : wid == 2 ? 2 : 3); }
                        else if (wid == 1) { if (RWROLES & 2) rwkv_main(lds); }
                        else if (wid == 3 || wid == 7) { if (RWROLES & 4) rwkv_post(a, l, ub, uh, lds, wid == 3 ? 0 : 1); }
                    }
                }
                else {
                    const int j = item - 64, qb = 15 - (j >> 6), kk = j & 63, type = kk >> 5, bh = kk & 31, b = bh >> 2, h = bh & 3;
                    bf16_t* Zb = Z + (size_t)b * SEQ * ZP;
                    for (int rp_ = ATT_REP - 1; rp_ >= 0; --rp_)
                    if (type == 0) { if (PHON(8)) attn_unit<0, 64>(lds, Zb + ZC_FQ + 64 * h, ZP, Zb + ZC_FK + 64 * h, ZP, (const bf16_t*)(ws + WS_VTF) + (size_t)bh * 64 * SEQ, SEQ, Zb + ZC_FQ + 64 * h, ZP,
                                                   256 * qb, 4 * (qb + 1), qb, (const float*)(ws + WS_LOGF) + (size_t)bh * SEQ, nullptr, rp_ > 0); }
                    else if (PHON(9)) attn_unit<1, 64>(lds, Zb + ZC_MQ + 64 * h, ZP, Zb + ZC_MK + 64 * h, ZP, (const bf16_t*)(ws + WS_VTM) + (size_t)bh * 64 * SEQ, SEQ, Zb + ZC_MQ + 64 * h, ZP,
                                          256 * qb, 4 * (qb + 1), qb, (const float*)(ws + WS_KMP) + (size_t)bh * 64 * 64, nullptr, rp_ > 0);
                }
            }
        }
        if (PHON(10) && kind == 10) {
            for (int rp_ = 0; rp_ < ((REPK >> 10) & 1) + 1; ++rp_)
            for (int u = bid; u < NB * 4 * 16; u += G) { const int b = u >> 6, hd = (u >> 4) & 3, qb = u & 15;
                bf16_t* qp = QX + (size_t)b * SEQ * 512 + hd * 128;
                attn_unit<2, 128>(lds, qp, 512, (const bf16_t*)(ws + WS_KVX) + ((size_t)l * NB + b) * MEMLEN * 1024 + hd * 128, 1024,
                                  (const bf16_t*)(ws + WS_VTX) + ((size_t)(l * NB + b) * 4 + hd) * 128 * MEMLEN, MEMLEN, OX + (size_t)b * SEQ * 512 + hd * 128, 512, 256 * qb, MEMLEN / 64, qb, nullptr, a.in[29] + l * 128); }
        }
    }
}

extern "C" void kernel_launch(void* const* d_in, const int* in_sizes, int n_in, void* d_out, int out_size, void* d_ws, size_t ws_size, hipStream_t stream) {
    static int grid_blocks = 0;
    if (grid_blocks == 0) {
        if (n_in != 35 || ws_size < WS_END) { fprintf(stderr, "kernel_launch: unexpected n_in %d / ws %zu\n", n_in, ws_size); grid_blocks = -1; return; }
        int dev = 0, cus = 0, per_cu = 0;
        hipGetDevice(&dev); hipDeviceGetAttribute(&cus, hipDeviceAttributeMultiprocessorCount, dev);
        if (hipFuncSetAttribute((const void*)fwd_megakernel, hipFuncAttributeMaxDynamicSharedMemorySize, LDS_BYTES) != hipSuccess) { fprintf(stderr, "kernel_launch: hipFuncSetAttribute failed\n"); grid_blocks = -1; return; }
        if (hipOccupancyMaxActiveBlocksPerMultiprocessor(&per_cu, (const void*)fwd_megakernel, 512, LDS_BYTES) != hipSuccess || per_cu < 1) { fprintf(stderr, "kernel_launch: occupancy query says %d\n", per_cu); per_cu = 1; }
        (void)hipGetLastError();
        grid_blocks = cus * per_cu;
    }
    if (grid_blocks < 0) return;
    Args a{};
    for (int i = 0; i < 35; ++i) a.in[i] = (const float*)d_in[i];
    a.out = (float*)d_out; a.ws = (unsigned char*)d_ws;
    if (hipMemsetAsync(d_ws, 0, 65536, stream) != hipSuccess) { fprintf(stderr, "kernel_launch: memset failed\n"); return; }
#if MK_MULTI
    for (int ph = 0; ph < N_PHASES; ++ph) { a.ph_lo = ph; a.ph_hi = ph + 1; hipLaunchKernelGGL(fwd_megakernel, dim3(grid_blocks), dim3(512), LDS_BYTES, stream, a); }
#else
    a.ph_lo = 0; a.ph_hi = N_PHASES;
    void* args[] = {&a};
    hipError_t e = hipLaunchCooperativeKernel((const void*)fwd_megakernel, dim3(grid_blocks), dim3(512), args, LDS_BYTES, stream);
    if (e != hipSuccess) fprintf(stderr, "cooperative launch failed: %s (grid %d)\n", hipGetErrorString(e), grid_blocks);
#endif
}
```

```cpp
#include <hip/hip_runtime.h>
#include <hip/hip_cooperative_groups.h>
#include <cstdio>
#include <cstdint>
namespace cg = cooperative_groups;
namespace pg8 {
#define PG8_LAS __attribute__((address_space(3)))
typedef unsigned short bf16_t;
typedef short bf16x8 __attribute__((ext_vector_type(8)));
typedef float f32x4 __attribute__((ext_vector_type(4)));
typedef unsigned u32x4 __attribute__((ext_vector_type(4)));
constexpr int BM = 256, BK = 64, HALF = 128, HTB = HALF * BK * 2  , STAGE_BYTES = 8 * HTB, NXCD = 8, WGM = 8;

__host__ __device__ __forceinline__ int lds_byte(int r, int c) { const int st = (r >> 4) * 2 + (c >> 5), rr = r & 15, cc = c & 31, ob = rr * 64 + cc * 2; return st * 1024 + (ob ^ (((ob >> 9) & 1) << 5)); }
__host__ __device__ __forceinline__ void stage_rc(int b, int& R, int& C) { const int st = b / 1024, sb = b % 1024, swz = sb ^ (((sb >> 9) & 1) << 5); R = (st >> 1) * 16 + swz / 64; C = (st & 1) * 32 + (swz % 64) / 2; }
__host__ __device__ __forceinline__ int perm32(int rho) { const int n = rho >> 4, i = rho & 15; return 8 * (i >> 2) + 4 * n + (i & 3); }

struct Unit { int pm, pn; };
struct Gemm { const bf16_t* A; const bf16_t* Bt; int M, N, K, lda; };

struct StaticOrder {
    int nM, nN, nwg, G, c;
    __host__ __device__ void init(int M, int N, int G_, int c_) { nM = M / BM; nN = N / BM; nwg = nM * nN; G = G_; c = c_; }
    __host__ __device__ bool next(int i, Unit& u) const {
        const long L = (long)i * G + c; if (L >= nwg) return false;
        int wgid = (int)L; { const int q = nwg / NXCD, r = nwg % NXCD, xcd = wgid % NXCD, off = wgid / NXCD; wgid = (xcd < r ? xcd * (q + 1) : r * (q + 1) + (xcd - r) * q) + off; }
        const int nig = WGM * nN, gid = wgid / nig, fm = gid * WGM, gsz = (nM - fm) < WGM ? (nM - fm) : WGM;
        u.pm = fm + ((wgid % nig) % gsz); u.pn = (wgid % nig) / gsz; return true;
    }
    __device__ __forceinline__ void a_ready(const Unit&) const {}
    __device__ __forceinline__ void done(const Unit&) const {}
};
__device__ __forceinline__ unsigned cvt_pk_bf16(float lo, float hi) { unsigned r; asm volatile("v_cvt_pk_bf16_f32 %0, %1, %2" : "=v"(r) : "v"(lo), "v"(hi)); return r; }
__device__ __forceinline__ float silu_f(float x) { return x * __builtin_amdgcn_rcpf(1.0f + __builtin_amdgcn_exp2f(-1.4426950408889634f * x)); }
struct EpiSwiglu {
    static constexpr bool PERM = true, AFTER_DRAIN = false;
    bf16_t* O; int ldc;
    __device__ __forceinline__ void operator()(const f32x4 (&acc)[2][2][4][2], const Unit& u, int wr, int wc, int fr, int fq) const {
        const int row0 = u.pm * BM + wr * 64 + fr, col0 = u.pn * HALF + wc * 32 + 8 * fq;
#pragma unroll
        for (int ai = 0; ai < 2; ++ai)
#pragma unroll
            for (int m = 0; m < 4; ++m) {
                const f32x4 g0 = acc[ai][0][m][0], g1 = acc[ai][0][m][1], u0 = acc[ai][1][m][0], u1 = acc[ai][1][m][1];
                u32x4 w;
                w.x = cvt_pk_bf16(silu_f(g0[0]) * u0[0], silu_f(g0[1]) * u0[1]); w.y = cvt_pk_bf16(silu_f(g0[2]) * u0[2], silu_f(g0[3]) * u0[3]);
                w.z = cvt_pk_bf16(silu_f(g1[0]) * u1[0], silu_f(g1[1]) * u1[1]); w.w = cvt_pk_bf16(silu_f(g1[2]) * u1[2], silu_f(g1[3]) * u1[3]);
                *(u32x4*)(O + (size_t)(row0 + ai * HALF + m * 16) * ldc + col0) = w;
            }
    }
};
struct EpiResid {
    static constexpr bool PERM = false, AFTER_DRAIN = false;
    const float* base; float* out; int ldc; float scale;
    __device__ __forceinline__ void operator()(const f32x4 (&acc)[2][2][4][2], const Unit& u, int wr, int wc, int fr, int fq) const {
        const int row0 = u.pm * BM + wr * 64 + fr, col0 = u.pn * BM + wc * 32 + 4 * fq;
#pragma unroll
        for (int ai = 0; ai < 2; ++ai)
#pragma unroll
            for (int m = 0; m < 4; ++m) { const size_t off = (size_t)(row0 + ai * HALF + m * 16) * ldc + col0;
#pragma unroll
                for (int bj = 0; bj < 2; ++bj)
#pragma unroll
                    for (int n = 0; n < 2; ++n) { const f32x4 b = *(const f32x4*)(base + off + bj * HALF + n * 16); *(f32x4*)(out + off + bj * HALF + n * 16) = b + acc[ai][bj][m][n] * scale; }
                asm volatile("" ::: "memory"); }
    }
};
struct EpiBf16 {
    static constexpr bool PERM = true, AFTER_DRAIN = false;
    bf16_t* O; int ldc; int ncols; bf16_t* halo;
    __device__ __forceinline__ void operator()(const f32x4 (&acc)[2][2][4][2], const Unit& u, int wr, int wc, int fr, int fq) const {
        const int row0 = u.pm * BM + wr * 64 + fr, col0 = u.pn * BM + wc * 32 + 8 * fq;
#pragma unroll
        for (int ai = 0; ai < 2; ++ai)
#pragma unroll
            for (int m = 0; m < 4; ++m) { const int row = row0 + ai * HALF + m * 16;
#pragma unroll
                for (int bj = 0; bj < 2; ++bj) { const int col = col0 + bj * HALF;
                    if (col < ncols) { const f32x4 v0 = acc[ai][bj][m][0], v1 = acc[ai][bj][m][1]; u32x4 w;
                        w.x = cvt_pk_bf16(v0[0], v0[1]); w.y = cvt_pk_bf16(v0[2], v0[3]); w.z = cvt_pk_bf16(v1[0], v1[1]); w.w = cvt_pk_bf16(v1[2], v1[3]);
                        *(u32x4*)(O + (size_t)row * ldc + col) = w;
                        if (halo && (row & 63) == 63) *(u32x4*)(halo + (size_t)(row >> 6) * ldc + col) = w; } } }
    }
};
template <class Epi, class Sched, bool ALIGN_EPI = false, bool SP2 = false>
__device__ __forceinline__ void gemm_phase(PG8_LAS unsigned char* lds, const Gemm g, const Sched& S, const Epi& E) {
    int tid_ = threadIdx.x; asm volatile("" : "+v"(tid_)); const int tid = tid_, wid = __builtin_amdgcn_readfirstlane(tid >> 6), lane = tid & 63, wr = wid >> 2, wc = wid & 3, fr = lane & 15, fq = lane >> 4;
    const int K = g.K, nt = K / BK;
    unsigned voffA[2], voffB[2];
#pragma unroll
    for (int i = 0; i < 2; ++i) { int R, C; stage_rc(tid * 16 + i * 8192, R, C); const int Rb = Epi::PERM ? ((R & ~31) + perm32(R & 31)) : R;
        voffA[i] = (unsigned)(R * g.lda + C) * 2u; voffB[i] = (unsigned)(Rb * K + C) * 2u; }
    const size_t kstep = (size_t)(BK * 2);
    const size_t hstep = (size_t)HALF * K * 2;
    const size_t tstep = 2 * hstep; const size_t hstepA = (size_t)HALF * g.lda * 2, tstepA = 2 * hstepA;
    const unsigned ldsw = (unsigned)wid * 1024u;
    const int aoff = lds_byte(wr * 64 + fr, fq * 8), boff = lds_byte(wc * 32 + fr, fq * 8);
#define PG8_SA(b, h) (((b) * 2 + (h)) * HTB)
#define PG8_SB(b, h) ((4 + (b) * 2 + (h)) * HTB)
#define PG8_STAGE(bufoff, gbase, voff) do { _Pragma("unroll") for (int _i = 0; _i < 2; ++_i) \
        __builtin_amdgcn_global_load_lds((const unsigned*)((const char*)(gbase) + (voff)[_i]), (PG8_LAS unsigned*)(lds + (bufoff) + ldsw + _i * 8192), 16, 0, 0); } while (0)
#define PG8_LDA(dst, b, h) do { _Pragma("unroll") for (int m = 0; m < 4; ++m) _Pragma("unroll") for (int k = 0; k < 2; ++k) dst[m][k] = *(const PG8_LAS bf16x8*)(lds + PG8_SA(b, h) + aoff + m * 2048 + k * 1024); } while (0)
#define PG8_LDB(dst, b, h) do { _Pragma("unroll") for (int n = 0; n < 2; ++n) _Pragma("unroll") for (int k = 0; k < 2; ++k) dst[n][k] = *(const PG8_LAS bf16x8*)(lds + PG8_SB(b, h) + boff + n * 2048 + k * 1024); } while (0)
#define PG8_MMA(ai, bj, At, Bt) do { __builtin_amdgcn_s_setprio(1); _Pragma("unroll") for (int m = 0; m < 4; ++m) _Pragma("unroll") for (int n = 0; n < 2; ++n) _Pragma("unroll") for (int k = 0; k < 2; ++k) \
        acc[ai][bj][m][n] = __builtin_amdgcn_mfma_f32_16x16x32_bf16(Bt[n][k], At[m][k], acc[ai][bj][m][n], 0, 0, 0); __builtin_amdgcn_s_setprio(0); } while (0)
#define PG8_WAIT_V(n) asm volatile("s_waitcnt vmcnt(" #n ")" ::: "memory")
#define PG8_WAIT_L(n) asm volatile("s_waitcnt lgkmcnt(" #n ")" ::: "memory")
#define PG8_BAR __builtin_amdgcn_s_barrier()
#define PG8_SCHED __builtin_amdgcn_sched_barrier(0)
    Unit cur, nxt; int ui = 0;
    if (!S.next(0, cur)) return;
    f32x4 acc[2][2][4][2];
#pragma unroll
    for (int a = 0; a < 2; ++a)
#pragma unroll
        for (int b = 0; b < 2; ++b)
#pragma unroll
            for (int m = 0; m < 4; ++m)
#pragma unroll
                for (int n = 0; n < 2; ++n) acc[a][b][m][n] = (f32x4){0.f, 0.f, 0.f, 0.f};
    bf16x8 At[4][2], B0[2][2], B1[2][2];
    const char* cA = (const char*)g.A + (size_t)cur.pm * tstepA; const char* cB = (const char*)g.Bt + (size_t)cur.pn * tstep;
    S.a_ready(cur);
    if constexpr (SP2) {
        PG8_STAGE(PG8_SB(0, 0), cB, voffB); PG8_STAGE(PG8_SB(0, 1), cB + hstep, voffB); PG8_STAGE(PG8_SA(0, 0), cA, voffA); PG8_STAGE(PG8_SA(0, 1), cA + hstepA, voffA);
        if (wr == 1) PG8_BAR;
        PG8_WAIT_V(2); PG8_BAR;
        PG8_STAGE(PG8_SB(1, 0), cB + kstep, voffB); PG8_STAGE(PG8_SA(1, 0), cA + kstep, voffA); PG8_STAGE(PG8_SB(1, 1), cB + hstep + kstep, voffB);
        PG8_WAIT_V(6); PG8_BAR;
    } else {
        PG8_STAGE(PG8_SB(0, 0), cB, voffB); PG8_STAGE(PG8_SA(0, 0), cA, voffA); PG8_STAGE(PG8_SB(0, 1), cB + hstep, voffB); PG8_STAGE(PG8_SA(0, 1), cA + hstepA, voffA);
        if (wr == 1) PG8_BAR;
        PG8_WAIT_V(4); PG8_BAR;
        PG8_STAGE(PG8_SB(1, 0), cB + kstep, voffB); PG8_STAGE(PG8_SA(1, 0), cA + kstep, voffA); PG8_STAGE(PG8_SB(1, 1), cB + hstep + kstep, voffB);
        PG8_WAIT_V(6); PG8_BAR;
    }
    for (;;) {
        const bool has_next = S.next(ui + 1, nxt);
        const char* nA = has_next ? (const char*)g.A + (size_t)nxt.pm * tstepA : cA; const char* nB = has_next ? (const char*)g.Bt + (size_t)nxt.pn * tstep : cB;
        for (int t = 0; t < nt; t += 2) {
            const bool last = (t == nt - 2);
            const char* a1 = cA + (size_t)(t + 1) * kstep;
            const char* a2 = last ? nA : cA + (size_t)(t + 2) * kstep; const char* b2 = last ? nB : cB + (size_t)(t + 2) * kstep;
            const char* a3 = a2 + kstep; const char* b3 = b2 + kstep;
            if (last && has_next) S.a_ready(nxt);
            if constexpr (SP2) {
            PG8_LDB(B0, 0, 0); PG8_LDB(B1, 0, 1); PG8_SCHED; PG8_LDA(At, 0, 0); PG8_STAGE(PG8_SA(1, 1), a1 + hstepA, voffA);
            PG8_WAIT_V(8); PG8_WAIT_L(0); PG8_BAR; PG8_MMA(0, 0, At, B0); PG8_MMA(0, 1, At, B1); PG8_BAR; PG8_SCHED;
            PG8_LDA(At, 0, 1); PG8_STAGE(PG8_SB(0, 0), b2, voffB); PG8_STAGE(PG8_SB(0, 1), b2 + hstep, voffB); PG8_STAGE(PG8_SA(0, 0), a2, voffA);
            PG8_WAIT_V(8); PG8_WAIT_L(0); PG8_BAR; PG8_MMA(1, 0, At, B0); PG8_MMA(1, 1, At, B1); PG8_BAR; PG8_SCHED;
            PG8_LDB(B0, 1, 0); PG8_LDB(B1, 1, 1); PG8_SCHED; PG8_LDA(At, 1, 0); PG8_STAGE(PG8_SA(0, 1), a2 + hstepA, voffA);
            PG8_WAIT_V(8); PG8_WAIT_L(0); PG8_BAR; PG8_MMA(0, 0, At, B0); PG8_MMA(0, 1, At, B1); PG8_BAR; PG8_SCHED;
            PG8_LDA(At, 1, 1); PG8_STAGE(PG8_SB(1, 0), b3, voffB); PG8_STAGE(PG8_SB(1, 1), b3 + hstep, voffB); PG8_STAGE(PG8_SA(1, 0), a3, voffA);
            PG8_WAIT_V(8); PG8_WAIT_L(0); PG8_BAR; PG8_MMA(1, 0, At, B0); PG8_MMA(1, 1, At, B1); PG8_BAR; PG8_SCHED;
            } else {
            PG8_LDB(B0, 0, 0); PG8_SCHED; PG8_LDA(At, 0, 0); PG8_STAGE(PG8_SA(1, 1), a1 + hstepA, voffA);
            PG8_WAIT_L(8); PG8_BAR; PG8_WAIT_L(0); PG8_MMA(0, 0, At, B0); PG8_BAR; PG8_SCHED;
            PG8_LDB(B1, 0, 1); PG8_STAGE(PG8_SB(0, 0), b2, voffB);
            PG8_BAR; PG8_WAIT_L(0); PG8_MMA(0, 1, At, B1); PG8_BAR;
            PG8_LDA(At, 0, 1); PG8_STAGE(PG8_SA(0, 0), a2, voffA);
            PG8_BAR; PG8_WAIT_L(0); PG8_MMA(1, 0, At, B0); PG8_BAR; PG8_SCHED;
            PG8_STAGE(PG8_SB(0, 1), b2 + hstep, voffB);
            PG8_WAIT_V(6); PG8_BAR; PG8_MMA(1, 1, At, B1); PG8_BAR;
            PG8_LDB(B0, 1, 0); PG8_SCHED; PG8_LDA(At, 1, 0); PG8_STAGE(PG8_SA(0, 1), a2 + hstepA, voffA);
            PG8_WAIT_L(8); PG8_BAR; PG8_WAIT_L(0); PG8_MMA(0, 0, At, B0); PG8_BAR; PG8_SCHED;
            PG8_LDB(B1, 1, 1); PG8_STAGE(PG8_SB(1, 0), b3, voffB);
            PG8_BAR; PG8_WAIT_L(0); PG8_MMA(0, 1, At, B1); PG8_BAR;
            PG8_LDA(At, 1, 1); PG8_STAGE(PG8_SA(1, 0), a3, voffA);
            PG8_BAR; PG8_WAIT_L(0); PG8_MMA(1, 0, At, B0); PG8_BAR; PG8_SCHED;
            PG8_STAGE(PG8_SB(1, 1), b3 + hstep, voffB);
            PG8_WAIT_V(6); PG8_BAR; PG8_MMA(1, 1, At, B1); PG8_BAR;
            }
        }
        if constexpr (ALIGN_EPI) { if (wr == 0) PG8_BAR; }
        if constexpr (!Epi::AFTER_DRAIN) { E(acc, cur, wr, wc, fr, fq); S.done(cur); }
        if (!has_next) break;
#pragma unroll
        for (int a = 0; a < 2; ++a)
#pragma unroll
            for (int b = 0; b < 2; ++b)
#pragma unroll
                for (int m = 0; m < 4; ++m)
#pragma unroll
                    for (int n = 0; n < 2; ++n) acc[a][b][m][n] = (f32x4){0.f, 0.f, 0.f, 0.f};
        cur = nxt; cA = nA; cB = nB; ++ui;
        if constexpr (ALIGN_EPI) { if (wr == 1) PG8_BAR; }
    }
    PG8_WAIT_V(0);
    if constexpr (!ALIGN_EPI) { if (wr == 0) PG8_BAR; }
    PG8_BAR;
    if constexpr (Epi::AFTER_DRAIN) { E.fused(acc, cur, wr, wc, fr, fq, lds, wid, lane); S.done(cur); }
#undef PG8_SA
#undef PG8_SB
#undef PG8_STAGE
#undef PG8_LDA
#undef PG8_LDB
#undef PG8_MMA
#undef PG8_WAIT_V
#undef PG8_WAIT_L
#undef PG8_BAR
#undef PG8_SCHED
}
}

#define LAS __attribute__((address_space(3)))
#define DEV __device__ __forceinline__
typedef unsigned short bf16_t;
typedef short bf16x8 __attribute__((ext_vector_type(8)));
typedef short s16x4 __attribute__((ext_vector_type(4)));
typedef float f32x4 __attribute__((ext_vector_type(4)));
typedef float f32x16 __attribute__((ext_vector_type(16)));
typedef unsigned u32x2 __attribute__((ext_vector_type(2)));
typedef unsigned u32x4 __attribute__((ext_vector_type(4)));
typedef unsigned u32x8 __attribute__((ext_vector_type(8)));

constexpr int NB = 8, SEQ = 4096, DM = 1024, TOK = NB * SEQ, FF = 2816, NL = 2, MEMLEN = 256;
constexpr int ZP = 3392;
constexpr int ZC_FQ = 0, ZC_RR = 256, ZC_MQ = 768, ZC_FK = 1024, ZC_FV = 1280, ZC_MK = 1536, ZC_MV = 1792, ZC_RK = 2048, ZC_RV = 2560, ZC_LO = 3072, ZC_FF = 3360, ZC_VALID = 3368;
constexpr float NORM_EPS = 1e-6f, GN_EPS = 64e-5f, LOG2E = 1.4426950408889634f;
constexpr float C2_64 = 0.125f * LOG2E, C2_128 = 0.08838834764831845f * LOG2E;
constexpr size_t MiB = 1u << 20;
constexpr size_t WS_CTL = 0;
constexpr size_t WS_W = 1 * MiB, WL_BYTES = 48 * MiB;
constexpr size_t OFF_F1I = 0, OFF_F1O = 11 * MiB, OFF_F2I = 17 * MiB, OFF_F2O = 28 * MiB, OFF_MI = 34 * MiB, OFF_MO = 41 * MiB, OFF_XQ = 43 * MiB, OFF_XKV = 44 * MiB, OFF_XO = 46 * MiB;
constexpr size_t OFF_W2T = 47 * MiB, OFF_A2T = OFF_W2T + 65536, OFF_G2T = OFF_A2T + 65536;
constexpr size_t WS_Z = 97 * MiB;
constexpr size_t WS_C = WS_Z + 212 * MiB;
constexpr size_t WS_HN = WS_C;
constexpr size_t WS_WD = WS_C, WS_KK = WS_C + 64 * MiB, WS_KA = WS_C + 96 * MiB;
constexpr size_t WS_VTF = WS_C + 128 * MiB, WS_VTM = WS_C + 144 * MiB;
constexpr size_t WS_LOGF = WS_C + 160 * MiB, WS_KMP = WS_LOGF + 512 * 1024, WS_ZHALO = WS_C + 161 * MiB;
constexpr size_t WS_KVX = WS_C + 165 * MiB, WS_VTX = WS_C + 173 * MiB, WS_MEMN = WS_C + 177 * MiB, WS_END = WS_C + 185 * MiB;
static_assert(WS_END <= 512 * MiB, "workspace map");
constexpr int LDS_BYTES = 131072 + 1024;

struct Args { const float* in[35]; float* out; unsigned char* ws; int ph_lo, ph_hi; };

DEV float bf2f(unsigned short b) { return __uint_as_float((unsigned)b << 16); }
typedef float f32x2_t __attribute__((ext_vector_type(2))); typedef __bf16 bf16x2_t __attribute__((ext_vector_type(2)));
DEV unsigned pk2(float lo, float hi) { const f32x2_t v = {lo, hi}; const bf16x2_t r = __builtin_convertvector(v, bf16x2_t); return __builtin_bit_cast(unsigned, r); }
DEV unsigned f2bf(float f) { return pk2(f, f) & 0xffffu; }
DEV float wave_sum(float v) {
#pragma unroll
    for (int o = 1; o < 64; o <<= 1) v += __shfl_xor(v, o);
    return v;
}
#define LDS_WAIT() asm volatile("s_waitcnt lgkmcnt(0)" ::: "memory")

struct MatInfo { const float* src; bf16_t* dst; int K, Ns, Nd, map; };
DEV MatInfo matinfo(const Args& a, int m) {
    const int l = m / 12, k = m % 12; unsigned char* wl = a.ws + WS_W + (size_t)l * WL_BYTES; MatInfo r;
    switch (k) {
    case 0:  r.src = a.in[4] + (size_t)l * DM * 2 * FF;  r.dst = (bf16_t*)(wl + OFF_F1I); r.K = DM; r.Ns = 2 * FF; r.Nd = 2 * FF; r.map = 1; break;
    case 1:  r.src = a.in[5] + (size_t)l * FF * DM;      r.dst = (bf16_t*)(wl + OFF_F1O); r.K = FF; r.Ns = DM; r.Nd = DM; r.map = 0; break;
    case 2:  r.src = a.in[33] + (size_t)l * DM * 2 * FF; r.dst = (bf16_t*)(wl + OFF_F2I); r.K = DM; r.Ns = 2 * FF; r.Nd = 2 * FF; r.map = 1; break;
    case 3:  r.src = a.in[34] + (size_t)l * FF * DM;     r.dst = (bf16_t*)(wl + OFF_F2O); r.K = FF; r.Ns = DM; r.Nd = DM; r.map = 0; break;
    case 4:  r.src = a.in[7] + (size_t)l * DM * 3364;    r.dst = (bf16_t*)(wl + OFF_MI);  r.K = DM; r.Ns = 3364; r.Nd = 3584; r.map = 2; break;
    case 5:  r.src = a.in[8] + (size_t)l * DM * DM;      r.dst = (bf16_t*)(wl + OFF_MO);  r.K = DM; r.Ns = DM; r.Nd = DM; r.map = 0; break;
    case 6:  r.src = a.in[27] + (size_t)l * DM * 512;    r.dst = (bf16_t*)(wl + OFF_XQ);  r.K = DM; r.Ns = 512; r.Nd = 512; r.map = 0; break;
    case 7:  r.src = a.in[28] + (size_t)l * DM * 1024;   r.dst = (bf16_t*)(wl + OFF_XKV); r.K = DM; r.Ns = 1024; r.Nd = 1024; r.map = 0; break;
    case 8:  r.src = a.in[31] + (size_t)l * 512 * DM;    r.dst = (bf16_t*)(wl + OFF_XO);  r.K = 512; r.Ns = DM; r.Nd = DM; r.map = 0; break;
    case 9:  r.src = a.in[16] + (size_t)l * 64 * 512;    r.dst = (bf16_t*)(wl + OFF_W2T); r.K = 64; r.Ns = 512; r.Nd = 512; r.map = 0; break;
    case 10: r.src = a.in[18] + (size_t)l * 64 * 512;    r.dst = (bf16_t*)(wl + OFF_A2T); r.K = 64; r.Ns = 512; r.Nd = 512; r.map = 0; break;
    default: r.src = a.in[19] + (size_t)l * 160 * 512;   r.dst = (bf16_t*)(wl + OFF_G2T); r.K = 160; r.Ns = 512; r.Nd = 512; r.map = 0; break;
    }
    return r;
}
DEV int srccol(int map, int n) {
    if (map == 0) return n;
    if (map == 1) { const int p = n >> 8, r = n & 255; return r < 128 ? p * 128 + r : FF + p * 128 + (r - 128); }
    if (n < 256) return n;
    if (n < 768) return 1540 + (n - 256);
    if (n < 1024) return 772 + (n - 768);
    if (n < 1280) return 256 + (n - 1024);
    if (n < 1536) return 512 + (n - 1280);
    if (n < 1792) return 1028 + (n - 1536);
    if (n < 2048) return 1284 + (n - 1792);
    if (n < 2560) return 2052 + (n - 2048);
    if (n < 3072) return 2564 + (n - 2560);
    if (n < 3360) return 3076 + (n - 3072);
    if (n < 3364) return 768 + (n - 3360);
    return -1;
}
DEV void transpose_item(const MatInfo& mi, LAS float* scr, int item, int lane) {
    const int nblk = mi.Nd / 32, kb = item / nblk, nb = item % nblk, k0 = 64 * kb, n0 = 32 * nb;
    const int n4 = (lane & 7) * 4, sc = srccol(mi.map, n0 + n4);
#pragma unroll
    for (int i = 0; i < 8; ++i) { const int kk = 8 * i + (lane >> 3), k = k0 + kk;
        const f32x4 v = (sc >= 0 && k < mi.K) ? *(const f32x4*)(mi.src + (size_t)k * mi.Ns + sc) : (f32x4){0.f, 0.f, 0.f, 0.f};
        LAS float* d = scr + kk * 33 + n4; d[0] = v[0]; d[1] = v[1]; d[2] = v[2]; d[3] = v[3]; }
    LDS_WAIT(); asm volatile("" ::: "memory");
    const int c = lane & 7;
#pragma unroll
    for (int j = 0; j < 4; ++j) { const int n = (lane >> 3) + 8 * j; const LAS float* s = scr + (8 * c) * 33 + n;
        u32x4 o; o.x = pk2(s[0 * 33], s[1 * 33]); o.y = pk2(s[2 * 33], s[3 * 33]); o.z = pk2(s[4 * 33], s[5 * 33]); o.w = pk2(s[6 * 33], s[7 * 33]);
        if (k0 + 8 * c < mi.K) *(u32x4*)(mi.dst + (size_t)(n0 + n) * mi.K + k0 + 8 * c) = o; }
    LDS_WAIT(); asm volatile("" ::: "memory");
}
DEV void norm_row(const float* xrow, const float* g, bf16_t* orow, int lane) {
    const f32x4* xr = (const f32x4*)xrow + lane; const f32x4* gr = (const f32x4*)g + lane;
    f32x4 v[4]; float s = 0.f;
#pragma unroll
    for (int j = 0; j < 4; ++j) { v[j] = xr[64 * j]; s += (v[j].x * v[j].x + v[j].y * v[j].y) + (v[j].z * v[j].z + v[j].w * v[j].w); }
    const float rstd = rsqrtf(wave_sum(s) * (1.f / DM) + NORM_EPS);
    u32x2* o8 = (u32x2*)orow + lane;
#pragma unroll
    for (int j = 0; j < 4; ++j) { const f32x4 gg = gr[64 * j]; u32x2 w; w.x = pk2(v[j].x * rstd * gg.x, v[j].y * rstd * gg.y); w.y = pk2(v[j].z * rstd * gg.z, v[j].w * rstd * gg.w); o8[64 * j] = w; }
}
DEV void norm_row2(const float* xa, const float* xb, const float* g, bf16_t* oa, bf16_t* ob, int lane) {
    const f32x4* xra = (const f32x4*)xa + lane; const f32x4* xrb = (const f32x4*)xb + lane; const f32x4* gr = (const f32x4*)g + lane;
    f32x4 va[4], vb[4]; float sa = 0.f, sb = 0.f;
#pragma unroll
    for (int j = 0; j < 4; ++j) { va[j] = xra[64 * j]; vb[j] = xrb[64 * j]; }
#pragma unroll
    for (int j = 0; j < 4; ++j) { sa += (va[j].x * va[j].x + va[j].y * va[j].y) + (va[j].z * va[j].z + va[j].w * va[j].w); sb += (vb[j].x * vb[j].x + vb[j].y * vb[j].y) + (vb[j].z * vb[j].z + vb[j].w * vb[j].w); }
#pragma unroll
    for (int o = 1; o < 64; o <<= 1) { sa += __shfl_xor(sa, o); sb += __shfl_xor(sb, o); }
    const float ra = rsqrtf(sa * (1.f / DM) + NORM_EPS), rb = rsqrtf(sb * (1.f / DM) + NORM_EPS);
    u32x2* o8a = (u32x2*)oa + lane; u32x2* o8b = (u32x2*)ob + lane;
#pragma unroll
    for (int j = 0; j < 4; ++j) { const f32x4 gg = gr[64 * j]; u32x2 w; w.x = pk2(va[j].x * ra * gg.x, va[j].y * ra * gg.y); w.y = pk2(va[j].z * ra * gg.z, va[j].w * ra * gg.w); o8a[64 * j] = w;
        w.x = pk2(vb[j].x * rb * gg.x, vb[j].y * rb * gg.y); w.y = pk2(vb[j].z * rb * gg.z, vb[j].w * rb * gg.w); o8b[64 * j] = w; }
}
DEV void norm_phase(const float* x, const float* g, bf16_t* out, int nrows, int gw, int NGW, int lane) {
    int m = gw;
    for (; m + NGW < nrows; m += 2 * NGW) norm_row2(x + (size_t)m * DM, x + (size_t)(m + NGW) * DM, g, out + (size_t)m * DM, out + (size_t)(m + NGW) * DM, lane);
    if (m < nrows) norm_row(x + (size_t)m * DM, g, out + (size_t)m * DM, lane);
}
DEV void p0_prologue(const Args& a, LAS unsigned char* lds, int gw, int NGW, int wid, int lane, int tid) {
    LAS float* scr = (LAS float*)(lds + wid * 8704);
    int base = 0;
    for (int m = 0; m < 24; ++m) {
        const MatInfo mi = matinfo(a, m); const int items = ((mi.K + 63) / 64) * (mi.Nd / 32);
        int first = gw - (base % NGW); if (first < 0) first += NGW;
        for (int it = first; it < items; it += NGW) transpose_item(mi, scr, it, lane);
        base += items;
    }
    for (int m = gw; m < NL * NB * MEMLEN; m += NGW) { const int l = m / (NB * MEMLEN), r = m % (NB * MEMLEN);
        norm_row(a.in[1] + (size_t)r * DM, a.in[26] + l * DM, (bf16_t*)(a.ws + WS_MEMN) + (size_t)m * DM, lane); }
    if (blockIdx.x == 0 && tid < 64) ((unsigned*)(a.ws + WS_CTL))[tid * 64] = 0u;
}
DEV void xkv_post(const Args& a, int gw, int NGW, int lane) {
    for (int it = gw; it < NL * NB * MEMLEN * 4; it += NGW) {
        const int hd = it & 3, row = (it >> 2) % (NB * MEMLEN), l = it / (4 * NB * MEMLEN), b = row / MEMLEN, m = row % MEMLEN;
        bf16_t* kr = (bf16_t*)(a.ws + WS_KVX) + ((size_t)l * NB * MEMLEN + row) * 1024 + hd * 128;
        const unsigned kv = *((const unsigned*)kr + lane); float k0 = bf2f(kv & 0xffff), k1 = bf2f(kv >> 16);
        const float rstd = rsqrtf(wave_sum(k0 * k0 + k1 * k1) * (1.f / 128) + NORM_EPS);
        const float* kg = a.in[30] + l * 128;
        *((unsigned*)kr + lane) = pk2(k0 * rstd * kg[2 * lane], k1 * rstd * kg[2 * lane + 1]);
        const unsigned vv = *((const unsigned*)(kr + 512) + lane);
        bf16_t* vt = (bf16_t*)(a.ws + WS_VTX) + (((size_t)(l * NB + b) * 4 + hd) * 128) * MEMLEN + m;
        vt[(size_t)(2 * lane) * MEMLEN] = (bf16_t)(vv & 0xffff); vt[(size_t)(2 * lane + 1) * MEMLEN] = (bf16_t)(vv >> 16);
    }
}

DEV float sigmoid_f(float x) { return __builtin_amdgcn_rcpf(1.0f + __builtin_amdgcn_exp2f(-LOG2E * x)); }
DEV float tanh_f(float x) { const float e = __builtin_amdgcn_exp2f(-2.f * LOG2E * fabsf(x)); const float t = (1.f - e) * __builtin_amdgcn_rcpf(1.f + e); return x < 0.f ? -t : t; }
DEV void unpack8(const u32x4 v, float (&f)[8]) {
    f[0] = __uint_as_float(v.x << 16); f[1] = __uint_as_float(v.x & 0xffff0000u); f[2] = __uint_as_float(v.y << 16); f[3] = __uint_as_float(v.y & 0xffff0000u);
    f[4] = __uint_as_float(v.z << 16); f[5] = __uint_as_float(v.z & 0xffff0000u); f[6] = __uint_as_float(v.w << 16); f[7] = __uint_as_float(v.w & 0xffff0000u);
}
DEV u32x4 pack8(const float (&f)[8]) { u32x4 o; o.x = pk2(f[0], f[1]); o.y = pk2(f[2], f[3]); o.z = pk2(f[4], f[5]); o.w = pk2(f[6], f[7]); return o; }
DEV int crow(int r, int hi) { return (r & 3) + 8 * (r >> 2) + 4 * hi; }

DEV void prep_tile(const Args& a, int l, int tile, LAS unsigned char* lds, bool dry = false) {
    int tid_ = threadIdx.x; asm volatile("" : "+v"(tid_)); const int tid = tid_, lane = tid & 63, wid = __builtin_amdgcn_readfirstlane(tid >> 6);
    const int row0 = tile * 64, b = row0 / SEQ, t0 = row0 % SEQ;
    bf16_t* Z = (bf16_t*)(a.ws + WS_Z) + (size_t)row0 * ZP;
    {
        const int ch = tid % 228, sub = tid / 228; const bool act = tid < 456;
        const int col = ch < 64 ? ZC_RR + 8 * ch : ZC_RK + 8 * (ch - 64), mi = ch < 64 ? 8 * ch : 512 + 8 * (ch - 64);
        const int ts = 32 * sub; float prev[8], mu[8];
#pragma unroll
        for (int i = 0; i < 8; ++i) { prev[i] = 0.f; mu[i] = 0.f; }
        if (act) {
            const float* mup = a.in[14] + l * 1824 + mi;
#pragma unroll
            for (int i = 0; i < 8; ++i) mu[i] = mup[i];
            if (sub == 1) unpack8(*(const u32x4*)(Z + (size_t)(ts - 1) * ZP + col), prev);
            else if (t0 != 0) unpack8(*(const u32x4*)((const bf16_t*)(a.ws + WS_ZHALO) + (size_t)(tile - 1) * ZP + col), prev);
        }
        __syncthreads();
        if (act) {
#pragma unroll 1
            for (int t8 = 0; t8 < 32; t8 += 8) { u32x4 raw[8];
#pragma unroll
                for (int tt = 0; tt < 8; ++tt) raw[tt] = *(const u32x4*)(Z + (size_t)(ts + t8 + tt) * ZP + col);
#pragma unroll
                for (int tt = 0; tt < 8; ++tt) { float cur[8], o[8]; unpack8(raw[tt], cur);
#pragma unroll
                    for (int i = 0; i < 8; ++i) { o[i] = cur[i] + (prev[i] - cur[i]) * mu[i]; prev[i] = cur[i]; }
                    if (!dry) *(u32x4*)(Z + (size_t)(ts + t8 + tt) * ZP + col) = pack8(o); } }
        }
    }
    LAS float* kbuf = (LAS float*)lds;
    {
        const float* gfq = a.in[10] + l * 64; const float* gfk = a.in[11] + l * 64; const float* gmq = a.in[12] + l * 64; const float* gmk = a.in[13] + l * 64;
        const int* pos = (const int*)a.in[2] + b * SEQ + t0;
#pragma unroll 2
        for (int it = 0; it < 16; ++it) {
            const int item = it * 512 + tid, g8 = item >> 3, sub8 = item & 7, slot = g8 >> 6, token = g8 & 63, h = slot & 3, kind = slot >> 2;
            const int cb = (kind == 0 ? ZC_FQ : kind == 1 ? ZC_FK : kind == 2 ? ZC_MQ : ZC_MK) + 64 * h + 8 * sub8;
            const float* gp = (kind == 0 ? gfq : kind == 1 ? gfk : kind == 2 ? gmq : gmk) + 8 * sub8;
            u32x4* p = (u32x4*)(Z + (size_t)token * ZP + cb); float v[8]; unpack8(*p, v);
            float ss = 0.f;
#pragma unroll
            for (int i = 0; i < 8; ++i) ss += v[i] * v[i];
            ss += __shfl_xor(ss, 1); ss += __shfl_xor(ss, 2); ss += __shfl_xor(ss, 4);
            const float rstd = rsqrtf(ss * (1.f / 64) + NORM_EPS);
#pragma unroll
            for (int i = 0; i < 8; ++i) v[i] = v[i] * rstd * gp[i];
            float pr[8];
#pragma unroll
            for (int i = 0; i < 8; ++i) pr[i] = __shfl_xor(v[i], 1);
            if (kind >= 2 && sub8 < 2) {
                const float posf = (float)pos[token];
#pragma unroll
                for (int i = 0; i < 8; ++i) {
                    const float invf = (float)__builtin_exp2(-(double)i * 0.125 * 18.931568569324174);
                    const float ang = posf * invf; const double rev = (double)ang * 0.15915494309189535; const float fr = (float)(rev - __builtin_floor(rev));
                    const float sn = __builtin_amdgcn_sinf(fr), cs = __builtin_amdgcn_cosf(fr);
                    v[i] = sub8 == 0 ? v[i] * cs - pr[i] * sn : v[i] * cs + pr[i] * sn; }
            }
            if (kind == 3) {
#pragma unroll
                for (int i = 0; i < 8; ++i) kbuf[(token * 4 + h) * 64 + 8 * sub8 + i] = v[i]; }
            if (kind == 0 || kind == 2) {
#pragma unroll
                for (int i = 0; i < 8; ++i) v[i] *= C2_64; }
            if (!dry) *p = pack8(v);
        }
    }
    __syncthreads();
    if (tid < 256) { const int h = tid >> 6, d = tid & 63; float s = 0.f;
        for (int t = 0; t < 64; ++t) s += kbuf[(t * 4 + h) * 64 + d];
        if (!dry) ((float*)(a.ws + WS_KMP))[(((size_t)(b * 4 + h) * 64) + (t0 >> 6)) * 64 + d] = s; }
#pragma unroll 2
    for (int it = 0; it < 8; ++it) {
        const int item = it * 512 + tid, which = item >> 11, rem = item & 2047, tg = rem >> 8, c = rem & 255;
        const bf16_t* src = Z + (size_t)(8 * tg) * ZP + (which ? ZC_MV : ZC_FV) + c; unsigned short e[8];
#pragma unroll
        for (int i = 0; i < 8; ++i) e[i] = src[(size_t)i * ZP];
        u32x4 o; o.x = e[0] | ((unsigned)e[1] << 16); o.y = e[2] | ((unsigned)e[3] << 16); o.z = e[4] | ((unsigned)e[5] << 16); o.w = e[6] | ((unsigned)e[7] << 16);
        bf16_t* vt = (bf16_t*)(a.ws + (which ? WS_VTM : WS_VTF)) + ((size_t)(b * 4 + (c >> 6)) * 64 + (c & 63)) * SEQ + t0 + 8 * tg;
        if (!dry) *(u32x4*)vt = o;
    }
    if (tid < 256) { const int token = tid >> 2, h = tid & 3; const float x = bf2f(Z[(size_t)token * ZP + ZC_FF + h]) + a.in[9][l * 4 + h];
        const float lf = fminf(x, 0.f) - __logf(1.f + __expf(-fabsf(x)));
        if (!dry) ((float*)(a.ws + WS_LOGF))[(size_t)(b * 4 + h) * SEQ + t0 + token] = lf; }
    __syncthreads();
    LAS bf16_t* al = (LAS bf16_t*)lds;
    for (int item = tid; item < 64 * 36; item += 512) { const int token = item / 36, c = item % 36; float v[8]; unpack8(*(const u32x4*)(Z + (size_t)token * ZP + ZC_LO + 8 * c), v);
        if (c < 8) {
#pragma unroll
            for (int i = 0; i < 8; ++i) v[i] = tanh_f(v[i]); }
        else if (c >= 16) {
#pragma unroll
            for (int i = 0; i < 8; ++i) v[i] = sigmoid_f(v[i]); }
        *(LAS u32x4*)(al + token * 296 + 8 * c) = pack8(v); }
    __syncthreads();
    const unsigned char* wl = a.ws + WS_W + (size_t)l * WL_BYTES;
    const bf16_t* w2t = (const bf16_t*)(wl + OFF_W2T); const bf16_t* a2t = (const bf16_t*)(wl + OFF_A2T); const bf16_t* g2t = (const bf16_t*)(wl + OFF_G2T);
    const int r32 = lane & 31, hi = lane >> 5;
    for (int uu = 0; uu < 2; ++uu) {
        const int u = wid + 8 * uu, h = u & 7, th = u >> 3, token = 32 * th + r32;
        f32x16 aw[2], aa[2], ag[2];
#pragma unroll
        for (int ct = 0; ct < 2; ++ct) { aw[ct] = f32x16{}; aa[ct] = f32x16{}; ag[ct] = f32x16{}; }
        const LAS bf16_t* arow = al + token * 296 + 8 * hi;
#pragma unroll 1
        for (int ks = 0; ks < 4; ++ks) { const bf16x8 bw = *(const LAS bf16x8*)(arow + 16 * ks), ba = *(const LAS bf16x8*)(arow + 64 + 16 * ks);
#pragma unroll
            for (int ct = 0; ct < 2; ++ct) { const int chn = 64 * h + 32 * ct + r32;
                aw[ct] = __builtin_amdgcn_mfma_f32_32x32x16_bf16(*(const bf16x8*)(w2t + chn * 64 + 16 * ks + 8 * hi), bw, aw[ct], 0, 0, 0);
                aa[ct] = __builtin_amdgcn_mfma_f32_32x32x16_bf16(*(const bf16x8*)(a2t + chn * 64 + 16 * ks + 8 * hi), ba, aa[ct], 0, 0, 0); } }
#pragma unroll 1
        for (int ks = 0; ks < 10; ++ks) { const bf16x8 bg = *(const LAS bf16x8*)(arow + 128 + 16 * ks);
#pragma unroll
            for (int ct = 0; ct < 2; ++ct) { const int chn = 64 * h + 32 * ct + r32;
                ag[ct] = __builtin_amdgcn_mfma_f32_32x32x16_bf16(*(const bf16x8*)(g2t + chn * 160 + 16 * ks + 8 * hi), bg, ag[ct], 0, 0, 0); } }
        bf16_t* zr = Z + (size_t)token * ZP; const size_t grow = (size_t)(row0 + token);
        float* wd = (float*)(a.ws + WS_WD) + grow * 512; bf16_t* kkp = (bf16_t*)(a.ws + WS_KK) + grow * 512; bf16_t* kap = (bf16_t*)(a.ws + WS_KA) + grow * 512;
        const float* w0 = a.in[15] + l * 512; const float* a0 = a.in[17] + l * 512; const float* k_k = a.in[20] + l * 512; const float* k_a = a.in[21] + l * 512;
        float ss = 0.f;
#pragma unroll
        for (int ct = 0; ct < 2; ++ct)
#pragma unroll
            for (int rg = 0; rg < 4; ++rg) { const int c0 = 64 * h + 32 * ct + 8 * rg + 4 * hi;
                const u32x2 kraw = *(const u32x2*)(zr + ZC_RK + c0); const f32x4 w04 = *(const f32x4*)(w0 + c0), a04 = *(const f32x4*)(a0 + c0), kk4 = *(const f32x4*)(k_k + c0);
                f32x4 dec; u32x2 gp; float gv[4];
#pragma unroll
                for (int i = 0; i < 4; ++i) { const int r = 4 * rg + i;
                    const float kv = (i < 2) ? __uint_as_float((i & 1) ? (kraw.x & 0xffff0000u) : (kraw.x << 16)) : __uint_as_float((i & 1) ? (kraw.y & 0xffff0000u) : (kraw.y << 16));
                    const float wr_ = w04[i] + aw[ct][r]; const float sp = fmaxf(-wr_, 0.f) + __logf(1.f + __expf(-fabsf(wr_)));
                    dec[i] = __expf(-__expf(-sp - 0.5f));
                    aa[ct][r] = sigmoid_f(a04[i] + aa[ct][r]);
                    gv[i] = ag[ct][r];
                    const float kkv = kv * kk4[i]; aw[ct][r] = kkv; ss += kkv * kkv; }
                if (!dry) *(f32x4*)(wd + c0) = dec;
                gp.x = pk2(gv[0], gv[1]); gp.y = pk2(gv[2], gv[3]);
                if (!dry) *(u32x2*)(zr + (c0 < 256 ? ZC_FV + c0 : ZC_MV + (c0 - 256))) = gp; __builtin_amdgcn_sched_barrier(0); }
        ss += __shfl_xor(ss, 32);
        const float inv = 1.f / fmaxf(sqrtf(ss), 1e-12f);
#pragma unroll
        for (int ct = 0; ct < 2; ++ct)
#pragma unroll
            for (int rg = 0; rg < 4; ++rg) { const int c0 = 64 * h + 32 * ct + 8 * rg + 4 * hi; const f32x4 ka4 = *(const f32x4*)(k_a + c0);
                const u32x2 kraw = *(const u32x2*)(zr + ZC_RK + c0); const float kf4[4] = {bf2f(kraw.x & 0xffff), __uint_as_float(kraw.x & 0xffff0000u), bf2f(kraw.y & 0xffff), __uint_as_float(kraw.y & 0xffff0000u)};
                float kk[4], ka[4], kp[4];
#pragma unroll
                for (int i = 0; i < 4; ++i) { const int r = 4 * rg + i; kk[i] = aw[ct][r] * inv; ka[i] = kk[i] * aa[ct][r]; kp[i] = kf4[i] * (1.f + (aa[ct][r] - 1.f) * ka4[i]); }
                u32x2 o; o.x = pk2(kk[0], kk[1]); o.y = pk2(kk[2], kk[3]); if (!dry) *(u32x2*)(kkp + c0) = o;
                o.x = pk2(ka[0], ka[1]); o.y = pk2(ka[2], ka[3]); if (!dry) *(u32x2*)(kap + c0) = o;
                o.x = pk2(kp[0], kp[1]); o.y = pk2(kp[2], kp[3]); if (!dry) *(u32x2*)(zr + ZC_RK + c0) = o; __builtin_amdgcn_sched_barrier(0); }
    }
    __syncthreads();
}

template <int MODE, int D>
DEV void attn_unit(LAS unsigned char* lds, const bf16_t* Qp, int ldq, const bf16_t* Kp, int ldk, const bf16_t* Vt, int ldv, bf16_t* Op, int ldo,
                   int q0, int ntiles, int qb, const float* aux, const float* qgain, bool dry = false) {
    constexpr int KP = D + 8, KBYTES = 64 * KP * 2, VP = 72, VBYTES = D * VP * 2, NLD = D / 64;
    int tid_ = threadIdx.x; asm volatile("" : "+v"(tid_)); const int tid = tid_, lane = tid & 63, wid = __builtin_amdgcn_readfirstlane(tid >> 6), r32 = lane & 31, hi = lane >> 5;
    LAS float* cl = (LAS float*)lds; LAS unsigned* selm = (LAS unsigned*)(lds + 8192);
    LAS unsigned char* kb = lds + 16384; LAS unsigned char* vb = kb + 2 * KBYTES;
    const int q = q0 + wid * 32 + r32;
    if (MODE == 0) {
        const int n = 64 * ntiles; float v[8]; float run = 0.f;
#pragma unroll
        for (int i = 0; i < 8; ++i) { const int idx = 8 * tid + i; v[i] = idx < n ? aux[idx] : 0.f; run += v[i]; v[i] = run; }
        float sc = run;
#pragma unroll
        for (int o = 1; o < 64; o <<= 1) { const float t = __shfl_up(sc, o); if (lane >= o) sc += t; }
        LAS float* wsum = (LAS float*)kb;
        if (lane == 63) wsum[wid] = sc;
        __syncthreads();
        float off = sc - run;
        for (int w = 0; w < wid; ++w) off += wsum[w];
#pragma unroll
        for (int i = 0; i < 8; ++i) cl[8 * tid + i] = (off + v[i]) * LOG2E;
    }
    if (MODE == 1) {
        LAS float* km = cl;
        for (int e = tid; e < 16 * 64; e += 512) { const int nblk = e >> 6, d = e & 63; const float* pp = aux + (size_t)(4 * nblk) * 64 + d;
            km[e] = ((pp[0] + pp[64]) + (pp[128] + pp[192])) * (1.f / 256); }
        __syncthreads();
        if (tid < 256) { const bf16_t* qr = Qp + (size_t)(q0 + tid) * ldq; float g[16];
#pragma unroll
            for (int nb = 0; nb < 16; ++nb) g[nb] = 0.f;
            for (int c = 0; c < 8; ++c) { float qv[8]; unpack8(*(const u32x4*)(qr + 8 * c), qv);
#pragma unroll
                for (int nb = 0; nb < 16; ++nb) {
#pragma unroll
                    for (int i = 0; i < 8; ++i) g[nb] += qv[i] * km[nb * 64 + 8 * c + i]; } }
            unsigned m = 0u;
#pragma unroll
            for (int pick = 0; pick < 3; ++pick) { float best = -INFINITY; int bi = -1;
#pragma unroll
                for (int nb = 0; nb < 16; ++nb) { if (nb < qb && !((m >> nb) & 1u) && g[nb] > best) { best = g[nb]; bi = nb; } }
                if (bi >= 0) m |= 1u << bi; }
            selm[tid] = m; }
    }
    bf16x8 qf[D / 16];
#pragma unroll
    for (int d0 = 0; d0 < D / 16; ++d0) qf[d0] = *(const bf16x8*)(Qp + (size_t)q * ldq + d0 * 16 + hi * 8);
    if (MODE == 2) {
        float ss = 0.f;
#pragma unroll
        for (int d0 = 0; d0 < D / 16; ++d0) { float qv[8]; unpack8(__builtin_bit_cast(u32x4, qf[d0]), qv);
#pragma unroll
            for (int i = 0; i < 8; ++i) ss += qv[i] * qv[i]; }
        ss += __shfl_xor(ss, 32);
        const float rstd = rsqrtf(ss * (1.f / D) + NORM_EPS) * C2_128;
#pragma unroll
        for (int d0 = 0; d0 < D / 16; ++d0) { float qv[8]; unpack8(__builtin_bit_cast(u32x4, qf[d0]), qv);
#pragma unroll
            for (int i = 0; i < 8; ++i) qv[i] = qv[i] * rstd * qgain[d0 * 16 + hi * 8 + i];
            qf[d0] = __builtin_bit_cast(bf16x8, pack8(qv)); __builtin_amdgcn_sched_barrier(0); }
    }
    float mrun = -INFINITY, lrun = 0.f; f32x16 o[D / 32];
#pragma unroll
    for (int dt = 0; dt < D / 32; ++dt) o[dt] = f32x16{};
    __syncthreads();
    const float cq = (MODE == 0) ? cl[q] : 0.f;
    const unsigned sel = (MODE == 1) ? selm[wid * 32 + r32] : 0u;
    u32x4 kreg[NLD], vreg[NLD];
#define ATT_LOAD(t) do { _Pragma("unroll") for (int i_ = 0; i_ < NLD; ++i_) { const int idx_ = tid + 512 * i_; \
        kreg[i_] = *(const u32x4*)(Kp + (size_t)(64 * (t) + idx_ / (D / 8)) * ldk + (idx_ % (D / 8)) * 8); \
        vreg[i_] = *(const u32x4*)(Vt + (size_t)(idx_ >> 3) * ldv + 64 * (t) + (idx_ & 7) * 8); } } while (0)
#define ATT_STORE(buf) do { _Pragma("unroll") for (int i_ = 0; i_ < NLD; ++i_) { const int idx_ = tid + 512 * i_; \
        *(LAS u32x4*)(kb + (buf) * KBYTES + ((idx_ / (D / 8)) * KP + (idx_ % (D / 8)) * 8) * 2) = kreg[i_]; \
        *(LAS u32x4*)(vb + (buf) * VBYTES + ((idx_ >> 3) * VP + (idx_ & 7) * 8) * 2) = vreg[i_]; } } while (0)
    ATT_LOAD(0); ATT_STORE(0);
    __syncthreads();
    for (int t = 0; t < ntiles; ++t) {
        const int buf = t & 1, key0 = 64 * t;
        if (t + 1 < ntiles) ATT_LOAD(t + 1);
        bool work = true; const int nblk = key0 >> 8;
        if (MODE == 0) work = key0 <= q0 + wid * 32 + 31;
        if (MODE == 1) work = (nblk == qb) ? (key0 <= q0 + wid * 32 + 31) : (__any((sel >> nblk) & 1u) != 0);
        if (work) {
            const LAS unsigned char* kt = kb + buf * KBYTES; const LAS unsigned char* vt = vb + buf * VBYTES;
            constexpr int NKH = (D == 64) ? 2 : 1;
#pragma unroll 1
            for (int ks = 0; ks < 2 / NKH; ++ks) {
            f32x16 p[NKH];
#pragma unroll
            for (int kh = 0; kh < NKH; ++kh) { p[kh] = f32x16{}; const int khh = ks * NKH + kh;
#pragma unroll
                for (int d0 = 0; d0 < D / 16; ++d0) { const bf16x8 kf = *(const LAS bf16x8*)(kt + ((32 * khh + r32) * KP + 16 * d0 + 8 * hi) * 2);
                    p[kh] = __builtin_amdgcn_mfma_f32_32x32x16_bf16(kf, qf[d0], p[kh], 0, 0, 0); } }
            if (MODE == 0) {
                const bool diag = key0 + 63 > q0 + wid * 32;
                if (diag) {
#pragma unroll
                for (int kh = 0; kh < NKH; ++kh)
#pragma unroll
                    for (int rg = 0; rg < 4; ++rg) { const int kk0 = key0 + 32 * (ks * NKH + kh) + 8 * rg + 4 * hi; const f32x4 ck = *(const LAS f32x4*)(cl + kk0);
#pragma unroll
                        for (int i = 0; i < 4; ++i) { const float s = p[kh][4 * rg + i] + (cq - ck[i]); p[kh][4 * rg + i] = (kk0 + i > q) ? -INFINITY : s; } }
                } else {
#pragma unroll
                for (int kh = 0; kh < NKH; ++kh)
#pragma unroll
                    for (int rg = 0; rg < 4; ++rg) { const int kk0 = key0 + 32 * (ks * NKH + kh) + 8 * rg + 4 * hi; const f32x4 ck = *(const LAS f32x4*)(cl + kk0);
#pragma unroll
                        for (int i = 0; i < 4; ++i) p[kh][4 * rg + i] += (cq - ck[i]); }
                }
            }
            if (MODE == 1) {
                if (nblk == qb) {
#pragma unroll
                    for (int kh = 0; kh < NKH; ++kh)
#pragma unroll
                        for (int r = 0; r < 16; ++r) { if (key0 + 32 * (ks * NKH + kh) + crow(r, hi) > q) p[kh][r] = -INFINITY; }
                } else if (!((sel >> nblk) & 1u)) {
#pragma unroll
                    for (int kh = 0; kh < NKH; ++kh)
#pragma unroll
                        for (int r = 0; r < 16; ++r) p[kh][r] = -INFINITY;
                }
            }
            float mx = p[0][0];
#pragma unroll
            for (int kh = 0; kh < NKH; ++kh)
#pragma unroll
                for (int r = 0; r < 16; ++r) mx = fmaxf(mx, p[kh][r]);
            mx = fmaxf(mx, __shfl_xor(mx, 32));
            const float mnew = fmaxf(mrun, mx), muse = (mnew == -INFINITY) ? 0.f : mnew;
            const float alpha = __builtin_amdgcn_exp2f(mrun - muse);
            mrun = mnew; lrun *= alpha;
            if (__any(alpha != 1.0f)) {
#pragma unroll
                for (int dt = 0; dt < D / 32; ++dt) o[dt] *= alpha; }
            float ps = 0.f;
#pragma unroll
            for (int kh = 0; kh < NKH; ++kh)
#pragma unroll
                for (int r = 0; r < 16; ++r) { p[kh][r] = __builtin_amdgcn_exp2f(p[kh][r] - muse); ps += p[kh][r]; }
            lrun += ps;
            bf16x8 pb[NKH][2];
#pragma unroll
            for (int kh = 0; kh < NKH; ++kh)
#pragma unroll
                for (int j = 0; j < 2; ++j) { u32x4 w; w.x = pk2(p[kh][8 * j + 0], p[kh][8 * j + 1]); w.y = pk2(p[kh][8 * j + 2], p[kh][8 * j + 3]); w.z = pk2(p[kh][8 * j + 4], p[kh][8 * j + 5]); w.w = pk2(p[kh][8 * j + 6], p[kh][8 * j + 7]);
                    pb[kh][j] = __builtin_bit_cast(bf16x8, w); }
#pragma unroll
            for (int dt = 0; dt < D / 32; ++dt)
#pragma unroll
                for (int kh = 0; kh < NKH; ++kh)
#pragma unroll
                    for (int j = 0; j < 2; ++j) { const LAS unsigned char* vp_ = vt + ((32 * dt + r32) * VP + 32 * (ks * NKH + kh) + 16 * j + 4 * hi) * 2;
                        const u32x2 lo = *(const LAS u32x2*)vp_, hh = *(const LAS u32x2*)(vp_ + 16); u32x4 w; w.x = lo.x; w.y = lo.y; w.z = hh.x; w.w = hh.y;
                        o[dt] = __builtin_amdgcn_mfma_f32_32x32x16_bf16(__builtin_bit_cast(bf16x8, w), pb[kh][j], o[dt], 0, 0, 0); }
            }
        }
        if (t + 1 < ntiles) ATT_STORE(buf ^ 1);
        __syncthreads();
    }
#undef ATT_LOAD
#undef ATT_STORE
    lrun += __shfl_xor(lrun, 32);
    const float inv = 1.f / lrun;
    bf16_t* orow = Op + (size_t)q * ldo;
    if (!dry)
#pragma unroll
    for (int dt = 0; dt < D / 32; ++dt)
#pragma unroll
        for (int rg = 0; rg < 4; ++rg) { u32x2 w; w.x = pk2(o[dt][4 * rg] * inv, o[dt][4 * rg + 1] * inv); w.y = pk2(o[dt][4 * rg + 2] * inv, o[dt][4 * rg + 3] * inv);
            *(u32x2*)(orow + 32 * dt + 8 * rg + 4 * hi) = w; }
    __syncthreads();
}

constexpr int RW_NCH = SEQ / 16;
constexpr int RW_ARP = 72, RW_BKTP = 32, RW_VTP = 24, RW_PMP = 16, RW_LP = 20;
constexpr int RW_NBUF = 6, RW_NPRE = 4;
constexpr int RW_DB = 15104, RW_AR = 0, RW_BKT = 4608, RW_VT = 8704, RW_GC = 11776, RW_TM = 12032, RW_PM1 = 13056, RW_PM2 = 14080;
constexpr int RW_PRIV = RW_NBUF * RW_DB, RW_PRIV_BYTES = 5888, RW_PBK = 0, RW_PLAB = 4608;
constexpr int RW_NYB = 4;
constexpr int RW_YB = RW_PRIV + RW_NPRE * RW_PRIV_BYTES, RW_FLG = RW_YB + RW_NYB * 4096, RW_SLOT_BYTES = RW_FLG + 128;
static_assert(RW_PM2 + 32 * RW_PMP * 2 == RW_DB && RW_TM + 32 * RW_PMP * 2 == RW_PM1 && RW_SLOT_BYTES <= 131072 && RW_DB % 16 == 0 && RW_PRIV_BYTES % 16 == 0, "rwkv lds map");
DEV bf16x8 pack_acc8(const f32x16& v, int base) { u32x4 w; w.x = pk2(v[base], v[base + 1]); w.y = pk2(v[base + 2], v[base + 3]); w.z = pk2(v[base + 4], v[base + 5]); w.w = pk2(v[base + 6], v[base + 7]); return __builtin_bit_cast(bf16x8, w); }
DEV int fresh_lane() { int l_; asm volatile("v_mbcnt_lo_u32_b32 %0, -1, 0\n\tv_mbcnt_hi_u32_b32 %0, -1, %0" : "=v"(l_)); return l_; }
DEV void rw_wait(volatile LAS unsigned* f, unsigned target) { while (*f < target) __builtin_amdgcn_s_sleep(1); asm volatile("" ::: "memory"); }
DEV void rw_post_flag(volatile LAS unsigned* f, unsigned v) { asm volatile("s_waitcnt vmcnt(0) lgkmcnt(0)" ::: "memory"); *f = v; }
DEV bf16x8 frag_perm(const LAS bf16_t* rowp, int hi) { const u32x2 lo = *(const LAS u32x2*)(rowp + 4 * hi), hh = *(const LAS u32x2*)(rowp + 8 + 4 * hi); u32x4 w; w.x = lo.x; w.y = lo.y; w.z = hh.x; w.w = hh.y; return __builtin_bit_cast(bf16x8, w); }

struct RwRaw { float w[16]; unsigned short kk[16], ka[16], kp[16], rr[16], vr[16]; };
DEV void rwkv_pre_load(RwRaw& R, int c, const float* WDp, const bf16_t* KKp, const bf16_t* KAp, const bf16_t* Zl) {
#pragma unroll
    for (int t = 0; t < 16; ++t) { const size_t ro = (size_t)(16 * c + t);
        R.w[t] = WDp[ro * 512]; R.kk[t] = KKp[ro * 512]; R.ka[t] = KAp[ro * 512]; R.kp[t] = Zl[ro * ZP + ZC_RK]; R.rr[t] = Zl[ro * ZP + ZC_RR]; R.vr[t] = Zl[ro * ZP + ZC_RV]; }
}
DEV void rwkv_pre_a(const RwRaw& R, int c, LAS unsigned char* sl, volatile LAS unsigned* flg, int lane) {
    const int bi = c % RW_NBUF, pw = c % RW_NPRE;
    LAS bf16_t* BK = (LAS bf16_t*)(sl + RW_PRIV + pw * RW_PRIV_BYTES + RW_PBK);
    LAS unsigned char* db = sl + bi * RW_DB;
    LAS bf16_t* AR = (LAS bf16_t*)(db + RW_AR); LAS bf16_t* BKT = (LAS bf16_t*)(db + RW_BKT); LAS bf16_t* VT = (LAS bf16_t*)(db + RW_VT); LAS float* GC = (LAS float*)(db + RW_GC);
    if (c >= RW_NBUF) rw_wait(flg + 6 + bi, (unsigned)(c - RW_NBUF + 1));
    float g = 1.f; unsigned bkt[16];
#pragma unroll
    for (int t = 0; t < 16; ++t) {
        const float w = R.w[t], kk = bf2f(R.kk[t]), ka = bf2f(R.ka[t]), kp = bf2f(R.kp[t]), rr = bf2f(R.rr[t]);
        const float at = -kk * g; g *= w; const float inv = __builtin_amdgcn_rcpf(g);
        const unsigned bt = f2bf(ka * inv), kt = f2bf(kp * inv);
        AR[t * RW_ARP + lane] = (bf16_t)f2bf(at); AR[(16 + t) * RW_ARP + lane] = (bf16_t)f2bf(rr * g);
        BK[t * RW_ARP + lane] = (bf16_t)bt; BK[(16 + t) * RW_ARP + lane] = (bf16_t)kt;
        if (t & 1) { bkt[t >> 1] |= bt << 16; bkt[8 + (t >> 1)] |= kt << 16; } else { bkt[t >> 1] = bt; bkt[8 + (t >> 1)] = kt; }
    }
    GC[lane] = g;
#pragma unroll
    for (int q4 = 0; q4 < 4; ++q4) { u32x4 w4; w4.x = bkt[4 * q4]; w4.y = bkt[4 * q4 + 1]; w4.z = bkt[4 * q4 + 2]; w4.w = bkt[4 * q4 + 3]; *(LAS u32x4*)(BKT + lane * RW_BKTP + 8 * q4) = w4; }
    { unsigned vv[8];
#pragma unroll
      for (int t = 0; t < 16; ++t) { const unsigned x = R.vr[t]; if (t & 1) vv[t >> 1] |= x << 16; else vv[t >> 1] = x; }
      u32x4 v0; v0.x = vv[0]; v0.y = vv[1]; v0.z = vv[2]; v0.w = vv[3]; u32x4 v1; v1.x = vv[4]; v1.y = vv[5]; v1.z = vv[6]; v1.w = vv[7];
      *(LAS u32x4*)(VT + lane * RW_VTP) = v0; *(LAS u32x4*)(VT + lane * RW_VTP + 8) = v1; }
}
DEV void rwkv_pre_b(int c, LAS unsigned char* sl, volatile LAS unsigned* flg, int lane) {
    const int r32 = lane & 31, hi = lane >> 5, bi = c % RW_NBUF, pw = c % RW_NPRE;
    LAS bf16_t* BK = (LAS bf16_t*)(sl + RW_PRIV + pw * RW_PRIV_BYTES + RW_PBK);
    LAS unsigned char* db = sl + bi * RW_DB;
    LAS bf16_t* AR = (LAS bf16_t*)(db + RW_AR); LAS bf16_t* TM = (LAS bf16_t*)(db + RW_TM); LAS bf16_t* PM1 = (LAS bf16_t*)(db + RW_PM1); LAS bf16_t* PM2 = (LAS bf16_t*)(db + RW_PM2);
    f32x16 P = f32x16{};
#pragma unroll
    for (int ks = 0; ks < 4; ++ks) P = __builtin_amdgcn_mfma_f32_32x32x16_bf16(*(const LAS bf16x8*)(AR + r32 * RW_ARP + 16 * ks + 8 * hi), *(const LAS bf16x8*)(BK + r32 * RW_ARP + 16 * ks + 8 * hi), P, 0, 0, 0);
    asm volatile("s_waitcnt lgkmcnt(0)" ::: "memory");
    LAS bf16_t* LB = BK; LAS bf16_t* L2m = BK + 256; LAS bf16_t* L4m = BK + 512;
    const int n = r32; const bool lcol = n < 16;
    f32x16 Lm = f32x16{};
#pragma unroll
    for (int r = 0; r < 16; ++r) { const int m = crow(r, hi);
        if (r < 8) { const float lv = (lcol && n < m) ? P[r] : 0.f; Lm[r] = lv;
            if (lcol) LB[m * 16 + n] = (bf16_t)f2bf(lv); else PM1[m * RW_PMP + (n - 16)] = (bf16_t)f2bf((n - 16 < m) ? P[r] : 0.f); }
        else { if (lcol) PM2[m * RW_PMP + n] = (bf16_t)f2bf((n <= m - 16) ? P[r] : 0.f); else PM1[m * RW_PMP + (n - 16)] = (bf16_t)f2bf((n - 16 <= m - 16) ? P[r] : 0.f); } }
    const int rr = (r32 & 15) * 16;
    f32x16 A2 = __builtin_amdgcn_mfma_f32_32x32x16_bf16(frag_perm(LB + rr, hi), pack_acc8(Lm, 0), f32x16{}, 0, 0, 0);
    if (lcol) {
#pragma unroll
        for (int r = 0; r < 8; ++r) L2m[crow(r, hi) * 16 + n] = (bf16_t)f2bf(A2[r]); }
    f32x16 A4 = __builtin_amdgcn_mfma_f32_32x32x16_bf16(frag_perm(L2m + rr, hi), pack_acc8(A2, 0), f32x16{}, 0, 0, 0);
    if (lcol) {
#pragma unroll
        for (int r = 0; r < 8; ++r) L4m[crow(r, hi) * 16 + n] = (bf16_t)f2bf(A4[r]); }
    f32x16 T = __builtin_amdgcn_mfma_f32_32x32x16_bf16(frag_perm(L4m + rr, hi), pack_acc8(A4, 0), f32x16{}, 0, 0, 0);
#pragma unroll
    for (int r = 0; r < 8; ++r) { if (n == crow(r, hi)) T[r] += 1.f; }
    T = __builtin_amdgcn_mfma_f32_32x32x16_bf16(frag_perm(L4m + rr, hi), pack_acc8(T, 0), T, 0, 0, 0);
    T = __builtin_amdgcn_mfma_f32_32x32x16_bf16(frag_perm(L2m + rr, hi), pack_acc8(T, 0), T, 0, 0, 0);
    T = __builtin_amdgcn_mfma_f32_32x32x16_bf16(frag_perm(LB + rr, hi), pack_acc8(T, 0), T, 0, 0, 0);
    if (lcol) {
#pragma unroll
        for (int r = 0; r < 8; ++r) TM[crow(r, hi) * RW_PMP + n] = (bf16_t)f2bf(T[r]); }
    asm volatile("s_waitcnt lgkmcnt(0)" ::: "memory"); flg[bi] = (unsigned)(c + 1);
}
DEV void rwkv_pre(const Args& a, int b, int h, LAS unsigned char* sl, int par) {
    const int lane = fresh_lane();
    volatile LAS unsigned* flg = (volatile LAS unsigned*)(sl + RW_FLG);
    const size_t rowb = (size_t)b * SEQ;
    const bf16_t* Zl = (const bf16_t*)(a.ws + WS_Z) + rowb * ZP + h * 64 + lane;
    const float* WDp = (const float*)(a.ws + WS_WD) + rowb * 512 + h * 64 + lane;
    const bf16_t* KKp = (const bf16_t*)(a.ws + WS_KK) + rowb * 512 + h * 64 + lane;
    const bf16_t* KAp = (const bf16_t*)(a.ws + WS_KA) + rowb * 512 + h * 64 + lane;
    for (int bz = par; bz < RW_NBUF; bz += RW_NPRE) for (int e = lane; e < 32 * RW_PMP; e += 64) { ((LAS bf16_t*)(sl + bz * RW_DB + RW_PM2))[e] = 0; ((LAS bf16_t*)(sl + bz * RW_DB + RW_TM))[e] = 0; }
    RwRaw R;
    rwkv_pre_load(R, par, WDp, KKp, KAp, Zl);
#pragma unroll 1
    for (int c = par; c < RW_NCH; c += RW_NPRE) {
        rwkv_pre_a(R, c, sl, flg, lane);
        rwkv_pre_load(R, (c + RW_NPRE < RW_NCH) ? c + RW_NPRE : c, WDp, KKp, KAp, Zl);
        rwkv_pre_b(c, sl, flg, lane);
    }
}

DEV void rwkv_main(LAS unsigned char* sl) {
    const int lane = fresh_lane(), r32 = lane & 31, hi = lane >> 5;
    volatile LAS unsigned* flg = (volatile LAS unsigned*)(sl + RW_FLG);
    f32x16 ST[2][2];
#pragma unroll
    for (int jt = 0; jt < 2; ++jt)
#pragma unroll
        for (int it = 0; it < 2; ++it) ST[jt][it] = f32x16{};
#pragma unroll 1
    for (int c = 0; c < RW_NCH; ++c) {
        const int bi = c % RW_NBUF;
        LAS unsigned char* db = sl + bi * RW_DB;
        const LAS bf16_t* AR = (const LAS bf16_t*)(db + RW_AR); const LAS bf16_t* BKT = (const LAS bf16_t*)(db + RW_BKT); const LAS bf16_t* VT = (const LAS bf16_t*)(db + RW_VT);
        const LAS float* GC = (const LAS float*)(db + RW_GC); const LAS bf16_t* TM = (const LAS bf16_t*)(db + RW_TM); const LAS bf16_t* PM1 = (const LAS bf16_t*)(db + RW_PM1); const LAS bf16_t* PM2 = (const LAS bf16_t*)(db + RW_PM2);
        const int yi = c % RW_NYB; LAS float* YB = (LAS float*)(sl + RW_YB + yi * 4096);
        rw_wait(flg + bi, (unsigned)(c + 1));
        f32x16 X[2]; X[0] = f32x16{}; X[1] = f32x16{};
#pragma unroll
        for (int jt = 0; jt < 2; ++jt)
#pragma unroll
            for (int rgp = 0; rgp < 2; ++rgp) { const bf16x8 af = frag_perm(AR + r32 * RW_ARP + 32 * jt + 16 * rgp, hi);
#pragma unroll
                for (int it = 0; it < 2; ++it) X[it] = __builtin_amdgcn_mfma_f32_32x32x16_bf16(af, pack_acc8(ST[jt][it], 8 * rgp), X[it], 0, 0, 0); }
        bf16x8 vt[2];
        { const bf16x8 a1 = *(const LAS bf16x8*)(PM1 + r32 * RW_PMP + 8 * hi);
#pragma unroll
          for (int it = 0; it < 2; ++it) { vt[it] = *(const LAS bf16x8*)(VT + (32 * it + r32) * RW_VTP + 8 * hi); X[it] = __builtin_amdgcn_mfma_f32_32x32x16_bf16(a1, vt[it], X[it], 0, 0, 0); } }
        bf16x8 ub[2];
        { const bf16x8 ta = frag_perm(TM + r32 * RW_PMP, hi), pm2 = frag_perm(PM2 + r32 * RW_PMP, hi);
#pragma unroll
          for (int it = 0; it < 2; ++it) { const f32x16 U = __builtin_amdgcn_mfma_f32_32x32x16_bf16(ta, pack_acc8(X[it], 0), f32x16{}, 0, 0, 0);
              ub[it] = pack_acc8(U, 0); X[it] = __builtin_amdgcn_mfma_f32_32x32x16_bf16(pm2, ub[it], X[it], 0, 0, 0); } }
        if (c >= RW_NYB) rw_wait(flg + 16 + yi, (unsigned)(c - RW_NYB + 1));
#pragma unroll
        for (int it = 0; it < 2; ++it)
#pragma unroll
            for (int r = 8; r < 16; ++r) YB[(crow(r, hi) - 16) * 64 + 32 * it + r32] = X[it][r];
        rw_post_flag(flg + 12 + yi, (unsigned)(c + 1));
#pragma unroll
        for (int jt = 0; jt < 2; ++jt) { const bf16x8 a0 = frag_perm(BKT + (32 * jt + r32) * RW_BKTP, hi), a1 = *(const LAS bf16x8*)(BKT + (32 * jt + r32) * RW_BKTP + 16 + 8 * hi);
#pragma unroll
            for (int it = 0; it < 2; ++it) { ST[jt][it] = __builtin_amdgcn_mfma_f32_32x32x16_bf16(a0, ub[it], ST[jt][it], 0, 0, 0);
                ST[jt][it] = __builtin_amdgcn_mfma_f32_32x32x16_bf16(a1, vt[it], ST[jt][it], 0, 0, 0); }
#pragma unroll
            for (int rg = 0; rg < 4; ++rg) { const f32x4 g4 = *(const LAS f32x4*)(GC + 32 * jt + 8 * rg + 4 * hi);
#pragma unroll
                for (int e = 0; e < 4; ++e) { ST[jt][0][4 * rg + e] *= g4[e]; ST[jt][1][4 * rg + e] *= g4[e]; } } }
        rw_post_flag(flg + 6 + bi, (unsigned)(c + 1));
    }
}

DEV void rwkv_post(const Args& a, int l, int b, int h, LAS unsigned char* sl, int par) {
    const int lane = fresh_lane();
    volatile LAS unsigned* flg = (volatile LAS unsigned*)(sl + RW_FLG);
    bf16_t* Zb = (bf16_t*)(a.ws + WS_Z) + (size_t)b * SEQ * ZP;
    const int gcol0 = h < 4 ? ZC_FV + h * 64 : ZC_MV + (h - 4) * 64;
    const int t = lane >> 2, qd = lane & 3, c0 = h * 64 + 16 * qd;
    const float* rkp = a.in[22] + l * 512 + c0; const float* lw = a.in[23] + l * 512 + c0; const float* lb = a.in[24] + l * 512 + c0;
#pragma unroll 1
    for (int c = par; c < RW_NCH; c += 2) {
        bf16_t* zr = Zb + (size_t)(16 * c + t) * ZP;
        const u32x4 r0 = *(const u32x4*)(zr + ZC_RR + c0), r1 = *(const u32x4*)(zr + ZC_RR + c0 + 8), k0 = *(const u32x4*)(zr + ZC_RK + c0), k1 = *(const u32x4*)(zr + ZC_RK + c0 + 8);
        const u32x4 v0 = *(const u32x4*)(zr + ZC_RV + c0), v1 = *(const u32x4*)(zr + ZC_RV + c0 + 8), g0 = *(const u32x4*)(zr + gcol0 + 16 * qd), g1 = *(const u32x4*)(zr + gcol0 + 16 * qd + 8);
        const int yi = c % RW_NYB; const LAS float* YB = (const LAS float*)(sl + RW_YB + yi * 4096);
        rw_wait(flg + 12 + yi, (unsigned)(c + 1));
        float y[16];
#pragma unroll
        for (int q4 = 0; q4 < 4; ++q4) { const f32x4 yy = *(const LAS f32x4*)(YB + t * 64 + 16 * qd + 4 * q4); y[4 * q4] = yy[0]; y[4 * q4 + 1] = yy[1]; y[4 * q4 + 2] = yy[2]; y[4 * q4 + 3] = yy[3]; }
        asm volatile("s_waitcnt lgkmcnt(0)" ::: "memory");
        flg[16 + yi] = (unsigned)(c + 1);
        float s = 0.f;
#pragma unroll
        for (int e = 0; e < 16; ++e) s += y[e];
        s += __shfl_xor(s, 1); s += __shfl_xor(s, 2);
        const float mean = s * (1.f / 64); float q = 0.f;
#pragma unroll
        for (int e = 0; e < 16; ++e) { y[e] -= mean; q += y[e] * y[e]; }
        q += __shfl_xor(q, 1); q += __shfl_xor(q, 2);
        const float rstd = rsqrtf(q * (1.f / 64) + GN_EPS);
        float rv[16], kv[16];
        unpack8(r0, *(float(*)[8])&rv[0]); unpack8(r1, *(float(*)[8])&rv[8]); unpack8(k0, *(float(*)[8])&kv[0]); unpack8(k1, *(float(*)[8])&kv[8]);
        float bs = 0.f;
#pragma unroll
        for (int e = 0; e < 16; ++e) bs += rv[e] * kv[e] * rkp[e];
        bs += __shfl_xor(bs, 1); bs += __shfl_xor(bs, 2);
        float vv[16], gv[16], o[16];
        unpack8(v0, *(float(*)[8])&vv[0]); unpack8(v1, *(float(*)[8])&vv[8]); unpack8(g0, *(float(*)[8])&gv[0]); unpack8(g1, *(float(*)[8])&gv[8]);
#pragma unroll
        for (int e = 0; e < 16; ++e) o[e] = (y[e] * rstd * lw[e] + lb[e] + bs * vv[e]) * gv[e];
        *(u32x4*)(zr + ZC_RR + c0) = pack8(*(float(*)[8])&o[0]); *(u32x4*)(zr + ZC_RR + c0 + 8) = pack8(*(float(*)[8])&o[8]);
    }
}

#define XB_TMO      128
#define XB_XCNT(j)  (256  + 64 * (j))
#define XB_XSUB(j)  (1280 + 64 * (j))
#define XB_XGEN(j)  (2304 + 64 * (j))
#define XB_TOP      3328
#define XB_TOPGEN   3392
#define XCD_BAR_WORDS 3456
#define XB_SPIN_CAP (1u << 18)

__device__ __forceinline__ unsigned xb_ld(unsigned* p)              { return __hip_atomic_load(p, __ATOMIC_RELAXED, __HIP_MEMORY_SCOPE_AGENT); }
__device__ __forceinline__ unsigned xb_add(unsigned* p, unsigned v) { return __hip_atomic_fetch_add(p, v, __ATOMIC_RELAXED, __HIP_MEMORY_SCOPE_AGENT); }
__device__ __forceinline__ unsigned xb_xcc_id() { return (unsigned)__builtin_amdgcn_s_getreg((3 << 11) | 20) & 0xFu; }
#define XB_SPIN(cond, bar) do { unsigned _sp = 0; while (cond) { __builtin_amdgcn_s_sleep(1); \
    if ((++_sp & 255u) == 0u) { if (xb_ld(&(bar)[XB_TMO])) break; if (_sp > XB_SPIN_CAP) { atomicAdd(&(bar)[XB_TMO], 1u); break; } } } } while (0)

struct XcdBarrier {
    unsigned* bar; unsigned x;
    volatile LAS unsigned* st;
};

__device__ __forceinline__ XcdBarrier xcd_barrier_post(unsigned* bar, volatile LAS unsigned* st) {
    XcdBarrier b; b.bar = bar; b.x = xb_xcc_id(); b.st = st;
    if (threadIdx.x == 0) (void)xb_add(&bar[XB_XCNT(b.x)], 1u);
    return b;
}
__device__ __forceinline__ void xcd_barrier_complete(unsigned* bar, unsigned x, unsigned& nloc, unsigned& nx) {
    const unsigned G = gridDim.x * gridDim.y * gridDim.z;
    unsigned sum, cnt, mine, sp = 0u;
    for (;;) {
        sum = 0u; cnt = 0u; mine = 0u;
#pragma unroll
        for (unsigned j = 0; j < 16; ++j) { const unsigned c = xb_ld(&bar[XB_XCNT(j)]); sum += c; cnt += (c > 0u) ? 1u : 0u; mine = (j == x) ? c : mine; }
        if (sum == G) break;
        __builtin_amdgcn_s_sleep(1);
        if ((++sp & 255u) == 0u) { if (xb_ld(&bar[XB_TMO])) break; if (sp > XB_SPIN_CAP) { atomicAdd(&bar[XB_TMO], 1u); break; } }
    }
    nloc = mine > 0u ? mine : 1u; nx = cnt > 0u ? cnt : 1u;
}

__device__ __forceinline__ void xcd_barrier(const XcdBarrier& b) {
    asm volatile("s_waitcnt vmcnt(0)" ::: "memory");
    __syncthreads();
    if (threadIdx.x == 0) {
        unsigned* bar = b.bar;
        __builtin_amdgcn_s_waitcnt(0);
        unsigned nloc = b.st[0], nx = b.st[1];
        if (nloc == 0u) { xcd_barrier_complete(bar, b.x, nloc, nx); b.st[0] = nloc; b.st[1] = nx; }
        const unsigned old = xb_add(&bar[XB_XSUB(b.x)], 1u);
        const unsigned gen = old / nloc;
        if (old + 1u == (gen + 1u) * nloc) {
            __builtin_amdgcn_fence(__ATOMIC_RELEASE, "agent");
            asm volatile("s_waitcnt vmcnt(0)" ::: "memory");
            const unsigned og = xb_add(&bar[XB_TOP], 1u);
            const unsigned tg = og / nx;
            if (og + 1u == (tg + 1u) * nx) xb_add(&bar[XB_TOPGEN], 1u);
            else XB_SPIN(xb_ld(&bar[XB_TOPGEN]) == tg, bar);
            __builtin_amdgcn_fence(__ATOMIC_ACQUIRE, "agent");
            xb_add(&bar[XB_XGEN(b.x)], 1u);
            asm volatile("s_waitcnt vmcnt(0)" ::: "memory");
        } else {
            XB_SPIN(xb_ld(&bar[XB_XGEN(b.x)]) == gen, bar);
            __builtin_amdgcn_fence(__ATOMIC_ACQUIRE, "agent");
            asm volatile("s_waitcnt vmcnt(0)" ::: "memory");
        }
    }
    __syncthreads();
}

constexpr int N_PHASES = 1 + 15 * NL;
#ifndef MK_MULTI
#define MK_MULTI 0
#endif
#ifndef PROBE_Q
#define PROBE_Q 500.f
#endif
#ifndef PROBE_OFF
#define PROBE_OFF 0.f
#endif
#ifndef REPK
#define REPK 0
#endif
#ifndef ATT_REP
#define ATT_REP 1
#endif
#ifndef PREP_REP
#define PREP_REP 1
#endif
#ifndef RWROLES
#define RWROLES 7
#endif
#ifndef PHMASK
#define PHMASK 0xFFFF
#endif
#define PHON(k) ((PHMASK >> (k)) & 1)
__global__ void __launch_bounds__(512, 2) fwd_megakernel(Args a) {
    extern __shared__ __attribute__((aligned(16))) unsigned char lds_raw[];
    LAS unsigned char* lds = (LAS unsigned char*)lds_raw;
    cg::grid_group grid = cg::this_grid();
    { volatile LAS unsigned* st0 = (volatile LAS unsigned*)(lds + 131072 + 128); if (threadIdx.x == 0) { st0[0] = 0u; st0[1] = 0u; } __syncthreads(); }
    XcdBarrier xbar = xcd_barrier_post((unsigned*)(a.ws + WS_CTL) + 4096, (volatile LAS unsigned*)(lds + 131072 + 128));
    const int G = gridDim.x, bid = blockIdx.x, NGW = G * 8;
    unsigned char* ws = a.ws;
    bf16_t* HN = (bf16_t*)(ws + WS_HN); bf16_t* Z = (bf16_t*)(ws + WS_Z); bf16_t* HID = Z; bf16_t* QX = Z; bf16_t* OX = Z + (size_t)TOK * 512;
#ifdef PROBE_GROUP
    LAS unsigned long long* prs = (LAS unsigned long long*)(lds + 131072 + 64);
    if (threadIdx.x == 0) { prs[0] = __builtin_amdgcn_s_memrealtime(); prs[1] = 0ull; prs[2] = 99ull; }
#endif
#ifdef PROBE_GROUP
    for (int ph = a.ph_lo; ph <= a.ph_hi; ++ph) {
#else
    for (int ph = a.ph_lo; ph < a.ph_hi; ++ph) {
#endif
        if (ph > a.ph_lo) { if (ph == a.ph_lo + 1 || MK_MULTI) grid.sync(); else xcd_barrier(xbar);
#ifdef SYNC_REP
            xcd_barrier(xbar); xcd_barrier(xbar);
#endif
        }
#ifdef PROBE_GROUP
        if (threadIdx.x == 0) { const unsigned long long now = __builtin_amdgcn_s_memrealtime(); if (prs[2] == (unsigned long long)PROBE_GROUP) prs[1] += now - prs[0]; prs[0] = now;
          if (ph == a.ph_hi) { if (blockIdx.x == 0) { float us_ = (float)prs[1] * 0.01f;
#if PROBE_GROUP == 8
              us_ = (float)((volatile unsigned*)(ws + WS_CTL))[32 * 64] * 0.01f;
#endif
              a.out[0] = floorf((us_ + PROBE_OFF) / PROBE_Q) * PROBE_Q + 0.5f * PROBE_Q; } }
          const int k_ = (ph - 1) % 15; prs[2] = ph == 0 ? 0 : (k_ == 0 || k_ == 3 || k_ == 8 || k_ == 12) ? 1 : (k_ == 1 || k_ == 13) ? 2 : (k_ == 2 || k_ == 14 || k_ == 7 || k_ == 11) ? 3 : (k_ == 4 || k_ == 9) ? 4 : k_ == 5 ? 5 : k_ == 6 ? 6 : 7; }
        if (ph == a.ph_hi) break;
#endif
        int tidp = threadIdx.x; asm volatile("" : "+v"(tidp)); const int tid = tidp, lane = tid & 63, wid = __builtin_amdgcn_readfirstlane(tid >> 6), gw = bid * 8 + wid;
        if (ph == 0) { for (int rp_ = 0; rp_ < ((REPK >> 15) & 1) + 1; ++rp_) { if (PHON(15)) p0_prologue(a, lds, gw, NGW, wid, lane, tid); } continue; }
        const int l = (ph - 1) / 15, kind = (ph - 1) % 15;
        const unsigned char* wl = ws + WS_W + (size_t)l * WL_BYTES;
        if (PHON(0) && (kind == 0 || kind == 3 || kind == 8 || kind == 12)) {
            const float* src = (l == 0 && kind == 0) ? a.in[0] : a.out;
            const float* g = (kind == 0 ? a.in[3] : kind == 3 ? a.in[6] : kind == 8 ? a.in[25] : a.in[32]) + l * DM;
            for (int rp_ = 0; rp_ < (REPK & 1) + 1; ++rp_) norm_phase(src, g, HN, TOK, gw, NGW, lane);
            if (l == 0 && kind == 3) xkv_post(a, gw, NGW, lane);
        }
        if (PHON(1) && (kind == 1 || kind == 13)) {
            pg8::Gemm g{HN, (const bf16_t*)(wl + (kind == 1 ? OFF_F1I : OFF_F2I)), TOK, 2 * FF, DM, DM};
            pg8::StaticOrder S; S.init(TOK, 2 * FF, G, bid);
            pg8::EpiSwiglu E{HID, FF};
            pg8::gemm_phase<pg8::EpiSwiglu, pg8::StaticOrder, true, true>(lds, g, S, E);
        }
        if (PHON(2) && (kind == 2 || kind == 14 || kind == 7 || kind == 11)) {
            pg8::Gemm g; pg8::EpiResid E; E.out = a.out; E.ldc = DM; g.M = TOK; g.N = DM;
            if (kind == 2 || kind == 14) { g.A = HID; g.lda = FF; g.K = FF; g.Bt = (const bf16_t*)(wl + (kind == 2 ? OFF_F1O : OFF_F2O)); E.scale = 0.5f; E.base = (l == 0 && kind == 2) ? a.in[0] : a.out; }
            else if (kind == 7) { g.A = Z; g.lda = ZP; g.K = DM; g.Bt = (const bf16_t*)(wl + OFF_MO); E.scale = 1.f; E.base = a.out; }
            else { g.A = OX; g.lda = 512; g.K = 512; g.Bt = (const bf16_t*)(wl + OFF_XO); E.scale = 1.f; E.base = a.out; }
            pg8::StaticOrder S; S.init(TOK, DM, G, bid);
            const float sc_ = E.scale;
            for (int rp_ = ((REPK >> 2) & 1); rp_ >= 0; --rp_) { E.scale = rp_ ? 0.f : sc_;
            pg8::gemm_phase<pg8::EpiResid, pg8::StaticOrder, true, true>(lds, g, S, E); if (rp_) { __syncthreads(); } }
        }
        if (PHON(4) && (kind == 4 || kind == 9 || (kind == 0 && l == 0))) {
            const int ng = (kind == 0) ? NL : 1;
            for (int rp_ = 0; rp_ < ((REPK >> 4) & 1) + 1; ++rp_)
            for (int gi = 0; gi < ng; ++gi) {
                pg8::Gemm g; pg8::EpiBf16 E; int cidx = bid;
                if (kind == 4) { g.A = HN; g.lda = DM; g.K = DM; g.M = TOK; g.N = 3584; g.Bt = (const bf16_t*)(wl + OFF_MI); E.O = Z; E.ldc = ZP; E.ncols = ZC_VALID; E.halo = (bf16_t*)(ws + WS_ZHALO); }
                else if (kind == 9) { g.A = HN; g.lda = DM; g.K = DM; g.M = TOK; g.N = 512; g.Bt = (const bf16_t*)(wl + OFF_XQ); E.O = QX; E.ldc = 512; E.ncols = 512; E.halo = nullptr; }
                else { g.A = (const bf16_t*)(ws + WS_MEMN) + (size_t)gi * NB * MEMLEN * DM; g.lda = DM; g.K = DM; g.M = NB * MEMLEN; g.N = 1024;
                       g.Bt = (const bf16_t*)(ws + WS_W + (size_t)gi * WL_BYTES + OFF_XKV); E.O = (bf16_t*)(ws + WS_KVX) + (size_t)gi * NB * MEMLEN * 1024; E.ldc = 1024; E.ncols = 1024; E.halo = nullptr;
                       cidx = (bid + gi * (G / 2)) % G; }
                pg8::StaticOrder S; S.init(g.M, g.N, G, cidx);
                pg8::gemm_phase<pg8::EpiBf16, pg8::StaticOrder, true, true>(lds, g, S, E);
            }
        }
        if (PHON(5) && kind == 5) { for (int rp_ = PREP_REP - 1; rp_ >= 0; --rp_) for (int tile = bid; tile < TOK / 64; tile += G) prep_tile(a, l, tile, lds, rp_ > 0); }
        if (PHON(6) && kind == 6) {
            unsigned* ctr = (unsigned*)(ws + WS_CTL) + 64 * (1 + l); LAS unsigned* qw = (LAS unsigned*)(lds + 131072);
            for (;;) {
                __syncthreads();
                if (tid == 0) *qw = atomicAdd(ctr, 1u);
                __syncthreads();
                const int item = __builtin_amdgcn_readfirstlane((int)*qw);
                if (item >= 64 + 1024) break;
                if (item < 64) {
                    if (tid < 32) ((LAS unsigned*)(lds + RW_FLG))[tid] = 0u;
                    __syncthreads();
                    if (PHON(7)) {
                        const int ub = item >> 3, uh = item & 7;
                        if (wid == 0 || wid == 4 || wid == 2 || wid == 6) { if (RWROLES & 1) rwkv_pre(a, ub, uh, lds, wid == 0 ? 0 : wid == 4 ? 1 : wid == 2 ? 2 : 3); }
                        else if (wid == 1) { if (RWROLES & 2) rwkv_main(lds); }
                        else if (wid == 3 || wid == 7) { if (RWROLES & 4) rwkv_post(a, l, ub, uh, lds, wid == 3 ? 0 : 1); }
                    }
                }
                else {
                    const int j = item - 64, qb = 15 - (j >> 6), kk = j & 63, type = kk >> 5, bh = kk & 31, b = bh >> 2, h = bh & 3;
                    bf16_t* Zb = Z + (size_t)b * SEQ * ZP;
                    for (int rp_ = ATT_REP - 1; rp_ >= 0; --rp_)
                    if (type == 0) { if (PHON(8)) attn_unit<0, 64>(lds, Zb + ZC_FQ + 64 * h, ZP, Zb + ZC_FK + 64 * h, ZP, (const bf16_t*)(ws + WS_VTF) + (size_t)bh * 64 * SEQ, SEQ, Zb + ZC_FQ + 64 * h, ZP,
                                                   256 * qb, 4 * (qb + 1), qb, (const float*)(ws + WS_LOGF) + (size_t)bh * SEQ, nullptr, rp_ > 0); }
                    else if (PHON(9)) attn_unit<1, 64>(lds, Zb + ZC_MQ + 64 * h, ZP, Zb + ZC_MK + 64 * h, ZP, (const bf16_t*)(ws + WS_VTM) + (size_t)bh * 64 * SEQ, SEQ, Zb + ZC_MQ + 64 * h, ZP,
                                          256 * qb, 4 * (qb + 1), qb, (const float*)(ws + WS_KMP) + (size_t)bh * 64 * 64, nullptr, rp_ > 0);
                }
            }
        }
        if (PHON(10) && kind == 10) {
            for (int rp_ = 0; rp_ < ((REPK >> 10) & 1) + 1; ++rp_)
            for (int u = bid; u < NB * 4 * 16; u += G) { const int b = u >> 6, hd = (u >> 4) & 3, qb = u & 15;
                bf16_t* qp = QX + (size_t)b * SEQ * 512 + hd * 128;
                attn_unit<2, 128>(lds, qp, 512, (const bf16_t*)(ws + WS_KVX) + ((size_t)l * NB + b) * MEMLEN * 1024 + hd * 128, 1024,
                                  (const bf16_t*)(ws + WS_VTX) + ((size_t)(l * NB + b) * 4 + hd) * 128 * MEMLEN, MEMLEN, OX + (size_t)b * SEQ * 512 + hd * 128, 512, 256 * qb, MEMLEN / 64, qb, nullptr, a.in[29] + l * 128); }
        }
    }
}

extern "C" void kernel_launch(void* const* d_in, const int* in_sizes, int n_in, void* d_out, int out_size, void* d_ws, size_t ws_size, hipStream_t stream) {
    static int grid_blocks = 0;
    if (grid_blocks == 0) {
        if (n_in != 35 || ws_size < WS_END) { fprintf(stderr, "kernel_launch: unexpected n_in %d / ws %zu\n", n_in, ws_size); grid_blocks = -1; return; }
        int dev = 0, cus = 0, per_cu = 0;
        hipGetDevice(&dev); hipDeviceGetAttribute(&cus, hipDeviceAttributeMultiprocessorCount, dev);
        if (hipFuncSetAttribute((const void*)fwd_megakernel, hipFuncAttributeMaxDynamicSharedMemorySize, LDS_BYTES) != hipSuccess) { fprintf(stderr, "kernel_launch: hipFuncSetAttribute failed\n"); grid_blocks = -1; return; }
        if (hipOccupancyMaxActiveBlocksPerMultiprocessor(&per_cu, (const void*)fwd_megakernel, 512, LDS_BYTES) != hipSuccess || per_cu < 1) { fprintf(stderr, "kernel_launch: occupancy query says %d\n", per_cu); per_cu = 1; }
        (void)hipGetLastError();
        grid_blocks = cus * per_cu;
    }
    if (grid_blocks < 0) return;
    Args a{};
    for (int i = 0; i < 35; ++i) a.in[i] = (const float*)d_in[i];
    a.out = (float*)d_out; a.ws = (unsigned char*)d_ws;
    if (hipMemsetAsync(d_ws, 0, 65536, stream) != hipSuccess) { fprintf(stderr, "kernel_launch: memset failed\n"); return; }
#if MK_MULTI
    for (int ph = 0; ph < N_PHASES; ++ph) { a.ph_lo = ph; a.ph_hi = ph + 1; hipLaunchKernelGGL(fwd_megakernel, dim3(grid_blocks), dim3(512), LDS_BYTES, stream, a); }
#else
    a.ph_lo = 0; a.ph_hi = N_PHASES;
    void* args[] = {&a};
    hipError_t e = hipLaunchCooperativeKernel((const void*)fwd_megakernel, dim3(grid_blocks), dim3(512), args, LDS_BYTES, stream);
    if (e != hipSuccess) fprintf(stderr, "cooperative launch failed: %s (grid %d)\n", hipGetErrorString(e), grid_blocks);
#endif
}
```

```cpp
#include <hip/hip_runtime.h>
#include <hip/hip_cooperative_groups.h>
#include <cstdio>
#include <cstdint>
namespace cg = cooperative_groups;
namespace pg8 {
#define PG8_LAS __attribute__((address_space(3)))
typedef unsigned short bf16_t;
typedef short bf16x8 __attribute__((ext_vector_type(8)));
typedef float f32x4 __attribute__((ext_vector_type(4)));
typedef unsigned u32x4 __attribute__((ext_vector_type(4)));
constexpr int BM = 256, BK = 64, HALF = 128, HTB = HALF * BK * 2  , STAGE_BYTES = 8 * HTB, NXCD = 8, WGM = 8;

__host__ __device__ __forceinline__ int lds_byte(int r, int c) { const int st = (r >> 4) * 2 + (c >> 5), rr = r & 15, cc = c & 31, ob = rr * 64 + cc * 2; return st * 1024 + (ob ^ (((ob >> 9) & 1) << 5)); }
__host__ __device__ __forceinline__ void stage_rc(int b, int& R, int& C) { const int st = b / 1024, sb = b % 1024, swz = sb ^ (((sb >> 9) & 1) << 5); R = (st >> 1) * 16 + swz / 64; C = (st & 1) * 32 + (swz % 64) / 2; }
__host__ __device__ __forceinline__ int perm32(int rho) { const int n = rho >> 4, i = rho & 15; return 8 * (i >> 2) + 4 * n + (i & 3); }

struct Unit { int pm, pn; };
struct Gemm { const bf16_t* A; const bf16_t* Bt; int M, N, K, lda; };

struct StaticOrder {
    int nM, nN, nwg, G, c;
    __host__ __device__ void init(int M, int N, int G_, int c_) { nM = M / BM; nN = N / BM; nwg = nM * nN; G = G_; c = c_; }
    __host__ __device__ bool next(int i, Unit& u) const {
        const long L = (long)i * G + c; if (L >= nwg) return false;
        int wgid = (int)L; { const int q = nwg / NXCD, r = nwg % NXCD, xcd = wgid % NXCD, off = wgid / NXCD; wgid = (xcd < r ? xcd * (q + 1) : r * (q + 1) + (xcd - r) * q) + off; }
        const int nig = WGM * nN, gid = wgid / nig, fm = gid * WGM, gsz = (nM - fm) < WGM ? (nM - fm) : WGM;
        u.pm = fm + ((wgid % nig) % gsz); u.pn = (wgid % nig) / gsz; return true;
    }
    __device__ __forceinline__ void a_ready(const Unit&) const {}
    __device__ __forceinline__ void done(const Unit&) const {}
};
__device__ __forceinline__ unsigned cvt_pk_bf16(float lo, float hi) { unsigned r; asm volatile("v_cvt_pk_bf16_f32 %0, %1, %2" : "=v"(r) : "v"(lo), "v"(hi)); return r; }
__device__ __forceinline__ float silu_f(float x) { return x * __builtin_amdgcn_rcpf(1.0f + __builtin_amdgcn_exp2f(-1.4426950408889634f * x)); }
struct EpiSwiglu {
    static constexpr bool PERM = true, AFTER_DRAIN = false;
    bf16_t* O; int ldc;
    __device__ __forceinline__ void operator()(const f32x4 (&acc)[2][2][4][2], const Unit& u, int wr, int wc, int fr, int fq) const {
        const int row0 = u.pm * BM + wr * 64 + fr, col0 = u.pn * HALF + wc * 32 + 8 * fq;
#pragma unroll
        for (int ai = 0; ai < 2; ++ai)
#pragma unroll
            for (int m = 0; m < 4; ++m) {
                const f32x4 g0 = acc[ai][0][m][0], g1 = acc[ai][0][m][1], u0 = acc[ai][1][m][0], u1 = acc[ai][1][m][1];
                u32x4 w;
                w.x = cvt_pk_bf16(silu_f(g0[0]) * u0[0], silu_f(g0[1]) * u0[1]); w.y = cvt_pk_bf16(silu_f(g0[2]) * u0[2], silu_f(g0[3]) * u0[3]);
                w.z = cvt_pk_bf16(silu_f(g1[0]) * u1[0], silu_f(g1[1]) * u1[1]); w.w = cvt_pk_bf16(silu_f(g1[2]) * u1[2], silu_f(g1[3]) * u1[3]);
                *(u32x4*)(O + (size_t)(row0 + ai * HALF + m * 16) * ldc + col0) = w;
            }
    }
};
struct EpiResid {
    static constexpr bool PERM = false, AFTER_DRAIN = false;
    const float* base; float* out; int ldc; float scale;
    __device__ __forceinline__ void operator()(const f32x4 (&acc)[2][2][4][2], const Unit& u, int wr, int wc, int fr, int fq) const {
        const int row0 = u.pm * BM + wr * 64 + fr, col0 = u.pn * BM + wc * 32 + 4 * fq;
#pragma unroll
        for (int ai = 0; ai < 2; ++ai)
#pragma unroll
            for (int m = 0; m < 4; ++m) { const size_t off = (size_t)(row0 + ai * HALF + m * 16) * ldc + col0;
#pragma unroll
                for (int bj = 0; bj < 2; ++bj)
#pragma unroll
                    for (int n = 0; n < 2; ++n) { const f32x4 b = *(const f32x4*)(base + off + bj * HALF + n * 16); *(f32x4*)(out + off + bj * HALF + n * 16) = b + acc[ai][bj][m][n] * scale; }
                asm volatile("" ::: "memory"); }
    }
};
struct EpiBf16 {
    static constexpr bool PERM = true, AFTER_DRAIN = false;
    bf16_t* O; int ldc; int ncols; bf16_t* halo;
    __device__ __forceinline__ void operator()(const f32x4 (&acc)[2][2][4][2], const Unit& u, int wr, int wc, int fr, int fq) const {
        const int row0 = u.pm * BM + wr * 64 + fr, col0 = u.pn * BM + wc * 32 + 8 * fq;
#pragma unroll
        for (int ai = 0; ai < 2; ++ai)
#pragma unroll
            for (int m = 0; m < 4; ++m) { const int row = row0 + ai * HALF + m * 16;
#pragma unroll
                for (int bj = 0; bj < 2; ++bj) { const int col = col0 + bj * HALF;
                    if (col < ncols) { const f32x4 v0 = acc[ai][bj][m][0], v1 = acc[ai][bj][m][1]; u32x4 w;
                        w.x = cvt_pk_bf16(v0[0], v0[1]); w.y = cvt_pk_bf16(v0[2], v0[3]); w.z = cvt_pk_bf16(v1[0], v1[1]); w.w = cvt_pk_bf16(v1[2], v1[3]);
                        *(u32x4*)(O + (size_t)row * ldc + col) = w;
                        if (halo && (row & 63) == 63) *(u32x4*)(halo + (size_t)(row >> 6) * ldc + col) = w; } } }
    }
};
template <class Epi, class Sched, bool ALIGN_EPI = false, bool SP2 = false>
__device__ __forceinline__ void gemm_phase(PG8_LAS unsigned char* lds, const Gemm g, const Sched& S, const Epi& E) {
    int tid_ = threadIdx.x; asm volatile("" : "+v"(tid_)); const int tid = tid_, wid = __builtin_amdgcn_readfirstlane(tid >> 6), lane = tid & 63, wr = wid >> 2, wc = wid & 3, fr = lane & 15, fq = lane >> 4;
    const int K = g.K, nt = K / BK;
    unsigned voffA[2], voffB[2];
#pragma unroll
    for (int i = 0; i < 2; ++i) { int R, C; stage_rc(tid * 16 + i * 8192, R, C); const int Rb = Epi::PERM ? ((R & ~31) + perm32(R & 31)) : R;
        voffA[i] = (unsigned)(R * g.lda + C) * 2u; voffB[i] = (unsigned)(Rb * K + C) * 2u; }
    const size_t kstep = (size_t)(BK * 2);
    const size_t hstep = (size_t)HALF * K * 2;
    const size_t tstep = 2 * hstep; const size_t hstepA = (size_t)HALF * g.lda * 2, tstepA = 2 * hstepA;
    const unsigned ldsw = (unsigned)wid * 1024u;
    const int aoff = lds_byte(wr * 64 + fr, fq * 8), boff = lds_byte(wc * 32 + fr, fq * 8);
#define PG8_SA(b, h) (((b) * 2 + (h)) * HTB)
#define PG8_SB(b, h) ((4 + (b) * 2 + (h)) * HTB)
#define PG8_STAGE(bufoff, gbase, voff) do { _Pragma("unroll") for (int _i = 0; _i < 2; ++_i) \
        __builtin_amdgcn_global_load_lds((const unsigned*)((const char*)(gbase) + (voff)[_i]), (PG8_LAS unsigned*)(lds + (bufoff) + ldsw + _i * 8192), 16, 0, 0); } while (0)
#define PG8_LDA(dst, b, h) do { _Pragma("unroll") for (int m = 0; m < 4; ++m) _Pragma("unroll") for (int k = 0; k < 2; ++k) dst[m][k] = *(const PG8_LAS bf16x8*)(lds + PG8_SA(b, h) + aoff + m * 2048 + k * 1024); } while (0)
#define PG8_LDB(dst, b, h) do { _Pragma("unroll") for (int n = 0; n < 2; ++n) _Pragma("unroll") for (int k = 0; k < 2; ++k) dst[n][k] = *(const PG8_LAS bf16x8*)(lds + PG8_SB(b, h) + boff + n * 2048 + k * 1024); } while (0)
#define PG8_MMA(ai, bj, At, Bt) do { __builtin_amdgcn_s_setprio(1); _Pragma("unroll") for (int m = 0; m < 4; ++m) _Pragma("unroll") for (int n = 0; n < 2; ++n) _Pragma("unroll") for (int k = 0; k < 2; ++k) \
        acc[ai][bj][m][n] = __builtin_amdgcn_mfma_f32_16x16x32_bf16(Bt[n][k], At[m][k], acc[ai][bj][m][n], 0, 0, 0); __builtin_amdgcn_s_setprio(0); } while (0)
#define PG8_WAIT_V(n) asm volatile("s_waitcnt vmcnt(" #n ")" ::: "memory")
#define PG8_WAIT_L(n) asm volatile("s_waitcnt lgkmcnt(" #n ")" ::: "memory")
#define PG8_BAR __builtin_amdgcn_s_barrier()
#define PG8_SCHED __builtin_amdgcn_sched_barrier(0)
    Unit cur, nxt; int ui = 0;
    if (!S.next(0, cur)) return;
    f32x4 acc[2][2][4][2];
#pragma unroll
    for (int a = 0; a < 2; ++a)
#pragma unroll
        for (int b = 0; b < 2; ++b)
#pragma unroll
            for (int m = 0; m < 4; ++m)
#pragma unroll
                for (int n = 0; n < 2; ++n) acc[a][b][m][n] = (f32x4){0.f, 0.f, 0.f, 0.f};
    bf16x8 At[4][2], B0[2][2], B1[2][2];
    const char* cA = (const char*)g.A + (size_t)cur.pm * tstepA; const char* cB = (const char*)g.Bt + (size_t)cur.pn * tstep;
    S.a_ready(cur);
    if constexpr (SP2) {
        PG8_STAGE(PG8_SB(0, 0), cB, voffB); PG8_STAGE(PG8_SB(0, 1), cB + hstep, voffB); PG8_STAGE(PG8_SA(0, 0), cA, voffA); PG8_STAGE(PG8_SA(0, 1), cA + hstepA, voffA);
        if (wr == 1) PG8_BAR;
        PG8_WAIT_V(2); PG8_BAR;
        PG8_STAGE(PG8_SB(1, 0), cB + kstep, voffB); PG8_STAGE(PG8_SA(1, 0), cA + kstep, voffA); PG8_STAGE(PG8_SB(1, 1), cB + hstep + kstep, voffB);
        PG8_WAIT_V(6); PG8_BAR;
    } else {
        PG8_STAGE(PG8_SB(0, 0), cB, voffB); PG8_STAGE(PG8_SA(0, 0), cA, voffA); PG8_STAGE(PG8_SB(0, 1), cB + hstep, voffB); PG8_STAGE(PG8_SA(0, 1), cA + hstepA, voffA);
        if (wr == 1) PG8_BAR;
        PG8_WAIT_V(4); PG8_BAR;
        PG8_STAGE(PG8_SB(1, 0), cB + kstep, voffB); PG8_STAGE(PG8_SA(1, 0), cA + kstep, voffA); PG8_STAGE(PG8_SB(1, 1), cB + hstep + kstep, voffB);
        PG8_WAIT_V(6); PG8_BAR;
    }
    for (;;) {
        const bool has_next = S.next(ui + 1, nxt);
        const char* nA = has_next ? (const char*)g.A + (size_t)nxt.pm * tstepA : cA; const char* nB = has_next ? (const char*)g.Bt + (size_t)nxt.pn * tstep : cB;
        for (int t = 0; t < nt; t += 2) {
            const bool last = (t == nt - 2);
            const char* a1 = cA + (size_t)(t + 1) * kstep;
            const char* a2 = last ? nA : cA + (size_t)(t + 2) * kstep; const char* b2 = last ? nB : cB + (size_t)(t + 2) * kstep;
            const char* a3 = a2 + kstep; const char* b3 = b2 + kstep;
            if (last && has_next) S.a_ready(nxt);
            if constexpr (SP2) {
            PG8_LDB(B0, 0, 0); PG8_LDB(B1, 0, 1); PG8_SCHED; PG8_LDA(At, 0, 0); PG8_STAGE(PG8_SA(1, 1), a1 + hstepA, voffA);
            PG8_WAIT_V(8); PG8_WAIT_L(0); PG8_BAR; PG8_MMA(0, 0, At, B0); PG8_MMA(0, 1, At, B1); PG8_BAR; PG8_SCHED;
            PG8_LDA(At, 0, 1); PG8_STAGE(PG8_SB(0, 0), b2, voffB); PG8_STAGE(PG8_SB(0, 1), b2 + hstep, voffB); PG8_STAGE(PG8_SA(0, 0), a2, voffA);
            PG8_WAIT_V(8); PG8_WAIT_L(0); PG8_BAR; PG8_MMA(1, 0, At, B0); PG8_MMA(1, 1, At, B1); PG8_BAR; PG8_SCHED;
            PG8_LDB(B0, 1, 0); PG8_LDB(B1, 1, 1); PG8_SCHED; PG8_LDA(At, 1, 0); PG8_STAGE(PG8_SA(0, 1), a2 + hstepA, voffA);
            PG8_WAIT_V(8); PG8_WAIT_L(0); PG8_BAR; PG8_MMA(0, 0, At, B0); PG8_MMA(0, 1, At, B1); PG8_BAR; PG8_SCHED;
            PG8_LDA(At, 1, 1); PG8_STAGE(PG8_SB(1, 0), b3, voffB); PG8_STAGE(PG8_SB(1, 1), b3 + hstep, voffB); PG8_STAGE(PG8_SA(1, 0), a3, voffA);
            PG8_WAIT_V(8); PG8_WAIT_L(0); PG8_BAR; PG8_MMA(1, 0, At, B0); PG8_MMA(1, 1, At, B1); PG8_BAR; PG8_SCHED;
            } else {
            PG8_LDB(B0, 0, 0); PG8_SCHED; PG8_LDA(At, 0, 0); PG8_STAGE(PG8_SA(1, 1), a1 + hstepA, voffA);
            PG8_WAIT_L(8); PG8_BAR; PG8_WAIT_L(0); PG8_MMA(0, 0, At, B0); PG8_BAR; PG8_SCHED;
            PG8_LDB(B1, 0, 1); PG8_STAGE(PG8_SB(0, 0), b2, voffB);
            PG8_BAR; PG8_WAIT_L(0); PG8_MMA(0, 1, At, B1); PG8_BAR;
            PG8_LDA(At, 0, 1); PG8_STAGE(PG8_SA(0, 0), a2, voffA);
            PG8_BAR; PG8_WAIT_L(0); PG8_MMA(1, 0, At, B0); PG8_BAR; PG8_SCHED;
            PG8_STAGE(PG8_SB(0, 1), b2 + hstep, voffB);
            PG8_WAIT_V(6); PG8_BAR; PG8_MMA(1, 1, At, B1); PG8_BAR;
            PG8_LDB(B0, 1, 0); PG8_SCHED; PG8_LDA(At, 1, 0); PG8_STAGE(PG8_SA(0, 1), a2 + hstepA, voffA);
            PG8_WAIT_L(8); PG8_BAR; PG8_WAIT_L(0); PG8_MMA(0, 0, At, B0); PG8_BAR; PG8_SCHED;
            PG8_LDB(B1, 1, 1); PG8_STAGE(PG8_SB(1, 0), b3, voffB);
            PG8_BAR; PG8_WAIT_L(0); PG8_MMA(0, 1, At, B1); PG8_BAR;
            PG8_LDA(At, 1, 1); PG8_STAGE(PG8_SA(1, 0), a3, voffA);
            PG8_BAR; PG8_WAIT_L(0); PG8_MMA(1, 0, At, B0); PG8_BAR; PG8_SCHED;
            PG8_STAGE(PG8_SB(1, 1), b3 + hstep, voffB);
            PG8_WAIT_V(6); PG8_BAR; PG8_MMA(1, 1, At, B1); PG8_BAR;
            }
        }
        if constexpr (ALIGN_EPI) { if (wr == 0) PG8_BAR; }
        if constexpr (!Epi::AFTER_DRAIN) { E(acc, cur, wr, wc, fr, fq); S.done(cur); }
        if (!has_next) break;
#pragma unroll
        for (int a = 0; a < 2; ++a)
#pragma unroll
            for (int b = 0; b < 2; ++b)
#pragma unroll
                for (int m = 0; m < 4; ++m)
#pragma unroll
                    for (int n = 0; n < 2; ++n) acc[a][b][m][n] = (f32x4){0.f, 0.f, 0.f, 0.f};
        cur = nxt; cA = nA; cB = nB; ++ui;
        if constexpr (ALIGN_EPI) { if (wr == 1) PG8_BAR; }
    }
    PG8_WAIT_V(0);
    if constexpr (!ALIGN_EPI) { if (wr == 0) PG8_BAR; }
    PG8_BAR;
    if constexpr (Epi::AFTER_DRAIN) { E.fused(acc, cur, wr, wc, fr, fq, lds, wid, lane); S.done(cur); }
#undef PG8_SA
#undef PG8_SB
#undef PG8_STAGE
#undef PG8_LDA
#undef PG8_LDB
#undef PG8_MMA
#undef PG8_WAIT_V
#undef PG8_WAIT_L
#undef PG8_BAR
#undef PG8_SCHED
}
}

#define LAS __attribute__((address_space(3)))
#define DEV __device__ __forceinline__
typedef unsigned short bf16_t;
typedef short bf16x8 __attribute__((ext_vector_type(8)));
typedef short s16x4 __attribute__((ext_vector_type(4)));
typedef float f32x4 __attribute__((ext_vector_type(4)));
typedef float f32x16 __attribute__((ext_vector_type(16)));
typedef unsigned u32x2 __attribute__((ext_vector_type(2)));
typedef unsigned u32x4 __attribute__((ext_vector_type(4)));
typedef unsigned u32x8 __attribute__((ext_vector_type(8)));

constexpr int NB = 8, SEQ = 4096, DM = 1024, TOK = NB * SEQ, FF = 2816, NL = 2, MEMLEN = 256;
constexpr int ZP = 3392;
constexpr int ZC_FQ = 0, ZC_RR = 256, ZC_MQ = 768, ZC_FK = 1024, ZC_FV = 1280, ZC_MK = 1536, ZC_MV = 1792, ZC_RK = 2048, ZC_RV = 2560, ZC_LO = 3072, ZC_FF = 3360, ZC_VALID = 3368;
constexpr float NORM_EPS = 1e-6f, GN_EPS = 64e-5f, LOG2E = 1.4426950408889634f;
constexpr float C2_64 = 0.125f * LOG2E, C2_128 = 0.08838834764831845f * LOG2E;
constexpr size_t MiB = 1u << 20;
constexpr size_t WS_CTL = 0;
constexpr size_t WS_W = 1 * MiB, WL_BYTES = 48 * MiB;
constexpr size_t OFF_F1I = 0, OFF_F1O = 11 * MiB, OFF_F2I = 17 * MiB, OFF_F2O = 28 * MiB, OFF_MI = 34 * MiB, OFF_MO = 41 * MiB, OFF_XQ = 43 * MiB, OFF_XKV = 44 * MiB, OFF_XO = 46 * MiB;
constexpr size_t OFF_W2T = 47 * MiB, OFF_A2T = OFF_W2T + 65536, OFF_G2T = OFF_A2T + 65536;
constexpr size_t WS_Z = 97 * MiB;
constexpr size_t WS_C = WS_Z + 212 * MiB;
constexpr size_t WS_HN = WS_C;
constexpr size_t WS_WD = WS_C, WS_KK = WS_C + 64 * MiB, WS_KA = WS_C + 96 * MiB;
constexpr size_t WS_VTF = WS_C + 128 * MiB, WS_VTM = WS_C + 144 * MiB;
constexpr size_t WS_LOGF = WS_C + 160 * MiB, WS_KMP = WS_LOGF + 512 * 1024, WS_ZHALO = WS_C + 161 * MiB;
constexpr size_t WS_KVX = WS_C + 165 * MiB, WS_VTX = WS_C + 173 * MiB, WS_MEMN = WS_C + 177 * MiB, WS_END = WS_C + 185 * MiB;
static_assert(WS_END <= 512 * MiB, "workspace map");
constexpr int LDS_BYTES = 131072 + 1024;

struct Args { const float* in[35]; float* out; unsigned char* ws; int ph_lo, ph_hi; };

DEV float bf2f(unsigned short b) { return __uint_as_float((unsigned)b << 16); }
typedef float f32x2_t __attribute__((ext_vector_type(2))); typedef __bf16 bf16x2_t __attribute__((ext_vector_type(2)));
DEV unsigned pk2(float lo, float hi) { const f32x2_t v = {lo, hi}; const bf16x2_t r = __builtin_convertvector(v, bf16x2_t); return __builtin_bit_cast(unsigned, r); }
DEV unsigned f2bf(float f) { return pk2(f, f) & 0xffffu; }
DEV float wave_sum(float v) {
#pragma unroll
    for (int o = 1; o < 64; o <<= 1) v += __shfl_xor(v, o);
    return v;
}
#define LDS_WAIT() asm volatile("s_waitcnt lgkmcnt(0)" ::: "memory")

struct MatInfo { const float* src; bf16_t* dst; int K, Ns, Nd, map; };
DEV MatInfo matinfo(const Args& a, int m) {
    const int l = m / 12, k = m % 12; unsigned char* wl = a.ws + WS_W + (size_t)l * WL_BYTES; MatInfo r;
    switch (k) {
    case 0:  r.src = a.in[4] + (size_t)l * DM * 2 * FF;  r.dst = (bf16_t*)(wl + OFF_F1I); r.K = DM; r.Ns = 2 * FF; r.Nd = 2 * FF; r.map = 1; break;
    case 1:  r.src = a.in[5] + (size_t)l * FF * DM;      r.dst = (bf16_t*)(wl + OFF_F1O); r.K = FF; r.Ns = DM; r.Nd = DM; r.map = 0; break;
    case 2:  r.src = a.in[33] + (size_t)l * DM * 2 * FF; r.dst = (bf16_t*)(wl + OFF_F2I); r.K = DM; r.Ns = 2 * FF; r.Nd = 2 * FF; r.map = 1; break;
    case 3:  r.src = a.in[34] + (size_t)l * FF * DM;     r.dst = (bf16_t*)(wl + OFF_F2O); r.K = FF; r.Ns = DM; r.Nd = DM; r.map = 0; break;
    case 4:  r.src = a.in[7] + (size_t)l * DM * 3364;    r.dst = (bf16_t*)(wl + OFF_MI);  r.K = DM; r.Ns = 3364; r.Nd = 3584; r.map = 2; break;
    case 5:  r.src = a.in[8] + (size_t)l * DM * DM;      r.dst = (bf16_t*)(wl + OFF_MO);  r.K = DM; r.Ns = DM; r.Nd = DM; r.map = 0; break;
    case 6:  r.src = a.in[27] + (size_t)l * DM * 512;    r.dst = (bf16_t*)(wl + OFF_XQ);  r.K = DM; r.Ns = 512; r.Nd = 512; r.map = 0; break;
    case 7:  r.src = a.in[28] + (size_t)l * DM * 1024;   r.dst = (bf16_t*)(wl + OFF_XKV); r.K = DM; r.Ns = 1024; r.Nd = 1024; r.map = 0; break;
    case 8:  r.src = a.in[31] + (size_t)l * 512 * DM;    r.dst = (bf16_t*)(wl + OFF_XO);  r.K = 512; r.Ns = DM; r.Nd = DM; r.map = 0; break;
    case 9:  r.src = a.in[16] + (size_t)l * 64 * 512;    r.dst = (bf16_t*)(wl + OFF_W2T); r.K = 64; r.Ns = 512; r.Nd = 512; r.map = 0; break;
    case 10: r.src = a.in[18] + (size_t)l * 64 * 512;    r.dst = (bf16_t*)(wl + OFF_A2T); r.K = 64; r.Ns = 512; r.Nd = 512; r.map = 0; break;
    default: r.src = a.in[19] + (size_t)l * 160 * 512;   r.dst = (bf16_t*)(wl + OFF_G2T); r.K = 160; r.Ns = 512; r.Nd = 512; r.map = 0; break;
    }
    return r;
}
DEV int srccol(int map, int n) {
    if (map == 0) return n;
    if (map == 1) { const int p = n >> 8, r = n & 255; return r < 128 ? p * 128 + r : FF + p * 128 + (r - 128); }
    if (n < 256) return n;
    if (n < 768) return 1540 + (n - 256);
    if (n < 1024) return 772 + (n - 768);
    if (n < 1280) return 256 + (n - 1024);
    if (n < 1536) return 512 + (n - 1280);
    if (n < 1792) return 1028 + (n - 1536);
    if (n < 2048) return 1284 + (n - 1792);
    if (n < 2560) return 2052 + (n - 2048);
    if (n < 3072) return 2564 + (n - 2560);
    if (n < 3360) return 3076 + (n - 3072);
    if (n < 3364) return 768 + (n - 3360);
    return -1;
}
DEV void transpose_item(const MatInfo& mi, LAS float* scr, int item, int lane) {
    const int nblk = mi.Nd / 32, kb = item / nblk, nb = item % nblk, k0 = 64 * kb, n0 = 32 * nb;
    const int n4 = (lane & 7) * 4, sc = srccol(mi.map, n0 + n4);
#pragma unroll
    for (int i = 0; i < 8; ++i) { const int kk = 8 * i + (lane >> 3), k = k0 + kk;
        const f32x4 v = (sc >= 0 && k < mi.K) ? *(const f32x4*)(mi.src + (size_t)k * mi.Ns + sc) : (f32x4){0.f, 0.f, 0.f, 0.f};
        LAS float* d = scr + kk * 33 + n4; d[0] = v[0]; d[1] = v[1]; d[2] = v[2]; d[3] = v[3]; }
    LDS_WAIT(); asm volatile("" ::: "memory");
    const int c = lane & 7;
#pragma unroll
    for (int j = 0; j < 4; ++j) { const int n = (lane >> 3) + 8 * j; const LAS float* s = scr + (8 * c) * 33 + n;
        u32x4 o; o.x = pk2(s[0 * 33], s[1 * 33]); o.y = pk2(s[2 * 33], s[3 * 33]); o.z = pk2(s[4 * 33], s[5 * 33]); o.w = pk2(s[6 * 33], s[7 * 33]);
        if (k0 + 8 * c < mi.K) *(u32x4*)(mi.dst + (size_t)(n0 + n) * mi.K + k0 + 8 * c) = o; }
    LDS_WAIT(); asm volatile("" ::: "memory");
}
DEV void norm_row(const float* xrow, const float* g, bf16_t* orow, int lane) {
    const f32x4* xr = (const f32x4*)xrow + lane; const f32x4* gr = (const f32x4*)g + lane;
    f32x4 v[4]; float s = 0.f;
#pragma unroll
    for (int j = 0; j < 4; ++j) { v[j] = xr[64 * j]; s += (v[j].x * v[j].x + v[j].y * v[j].y) + (v[j].z * v[j].z + v[j].w * v[j].w); }
    const float rstd = rsqrtf(wave_sum(s) * (1.f / DM) + NORM_EPS);
    u32x2* o8 = (u32x2*)orow + lane;
#pragma unroll
    for (int j = 0; j < 4; ++j) { const f32x4 gg = gr[64 * j]; u32x2 w; w.x = pk2(v[j].x * rstd * gg.x, v[j].y * rstd * gg.y); w.y = pk2(v[j].z * rstd * gg.z, v[j].w * rstd * gg.w); o8[64 * j] = w; }
}
DEV void norm_row2(const float* xa, const float* xb, const float* g, bf16_t* oa, bf16_t* ob, int lane) {
    const f32x4* xra = (const f32x4*)xa + lane; const f32x4* xrb = (const f32x4*)xb + lane; const f32x4* gr = (const f32x4*)g + lane;
    f32x4 va[4], vb[4]; float sa = 0.f, sb = 0.f;
#pragma unroll
    for (int j = 0; j < 4; ++j) { va[j] = xra[64 * j]; vb[j] = xrb[64 * j]; }
#pragma unroll
    for (int j = 0; j < 4; ++j) { sa += (va[j].x * va[j].x + va[j].y * va[j].y) + (va[j].z * va[j].z + va[j].w * va[j].w); sb += (vb[j].x * vb[j].x + vb[j].y * vb[j].y) + (vb[j].z * vb[j].z + vb[j].w * vb[j].w); }
#pragma unroll
    for (int o = 1; o < 64; o <<= 1) { sa += __shfl_xor(sa, o); sb += __shfl_xor(sb, o); }
    const float ra = rsqrtf(sa * (1.f / DM) + NORM_EPS), rb = rsqrtf(sb * (1.f / DM) + NORM_EPS);
    u32x2* o8a = (u32x2*)oa + lane; u32x2* o8b = (u32x2*)ob + lane;
#pragma unroll
    for (int j = 0; j < 4; ++j) { const f32x4 gg = gr[64 * j]; u32x2 w; w.x = pk2(va[j].x * ra * gg.x, va[j].y * ra * gg.y); w.y = pk2(va[j].z * ra * gg.z, va[j].w * ra * gg.w); o8a[64 * j] = w;
        w.x = pk2(vb[j].x * rb * gg.x, vb[j].y * rb * gg.y); w.y = pk2(vb[j].z * rb * gg.z, vb[j].w * rb * gg.w); o8b[64 * j] = w; }
}
DEV void norm_phase(const float* x, const float* g, bf16_t* out, int nrows, int gw, int NGW, int lane) {
    int m = gw;
    for (; m + NGW < nrows; m += 2 * NGW) norm_row2(x + (size_t)m * DM, x + (size_t)(m + NGW) * DM, g, out + (size_t)m * DM, out + (size_t)(m + NGW) * DM, lane);
    if (m < nrows) norm_row(x + (size_t)m * DM, g, out + (size_t)m * DM, lane);
}
DEV void p0_prologue(const Args& a, LAS unsigned char* lds, int gw, int NGW, int wid, int lane, int tid) {
    LAS float* scr = (LAS float*)(lds + wid * 8704);
    int base = 0;
    for (int m = 0; m < 24; ++m) {
        const MatInfo mi = matinfo(a, m); const int items = ((mi.K + 63) / 64) * (mi.Nd / 32);
        int first = gw - (base % NGW); if (first < 0) first += NGW;
        for (int it = first; it < items; it += NGW) transpose_item(mi, scr, it, lane);
        base += items;
    }
    for (int m = gw; m < NL * NB * MEMLEN; m += NGW) { const int l = m / (NB * MEMLEN), r = m % (NB * MEMLEN);
        norm_row(a.in[1] + (size_t)r * DM, a.in[26] + l * DM, (bf16_t*)(a.ws + WS_MEMN) + (size_t)m * DM, lane); }
    if (blockIdx.x == 0 && tid < 64) ((unsigned*)(a.ws + WS_CTL))[tid * 64] = 0u;
}
DEV void xkv_post(const Args& a, int gw, int NGW, int lane) {
    for (int it = gw; it < NL * NB * MEMLEN * 4; it += NGW) {
        const int hd = it & 3, row = (it >> 2) % (NB * MEMLEN), l = it / (4 * NB * MEMLEN), b = row / MEMLEN, m = row % MEMLEN;
        bf16_t* kr = (bf16_t*)(a.ws + WS_KVX) + ((size_t)l * NB * MEMLEN + row) * 1024 + hd * 128;
        const unsigned kv = *((const unsigned*)kr + lane); float k0 = bf2f(kv & 0xffff), k1 = bf2f(kv >> 16);
        const float rstd = rsqrtf(wave_sum(k0 * k0 + k1 * k1) * (1.f / 128) + NORM_EPS);
        const float* kg = a.in[30] + l * 128;
        *((unsigned*)kr + lane) = pk2(k0 * rstd * kg[2 * lane], k1 * rstd * kg[2 * lane + 1]);
        const unsigned vv = *((const unsigned*)(kr + 512) + lane);
        bf16_t* vt = (bf16_t*)(a.ws + WS_VTX) + (((size_t)(l * NB + b) * 4 + hd) * 128) * MEMLEN + m;
        vt[(size_t)(2 * lane) * MEMLEN] = (bf16_t)(vv & 0xffff); vt[(size_t)(2 * lane + 1) * MEMLEN] = (bf16_t)(vv >> 16);
    }
}

DEV float sigmoid_f(float x) { return __builtin_amdgcn_rcpf(1.0f + __builtin_amdgcn_exp2f(-LOG2E * x)); }
DEV float tanh_f(float x) { const float e = __builtin_amdgcn_exp2f(-2.f * LOG2E * fabsf(x)); const float t = (1.f - e) * __builtin_amdgcn_rcpf(1.f + e); return x < 0.f ? -t : t; }
DEV void unpack8(const u32x4 v, float (&f)[8]) {
    f[0] = __uint_as_float(v.x << 16); f[1] = __uint_as_float(v.x & 0xffff0000u); f[2] = __uint_as_float(v.y << 16); f[3] = __uint_as_float(v.y & 0xffff0000u);
    f[4] = __uint_as_float(v.z << 16); f[5] = __uint_as_float(v.z & 0xffff0000u); f[6] = __uint_as_float(v.w << 16); f[7] = __uint_as_float(v.w & 0xffff0000u);
}
DEV u32x4 pack8(const float (&f)[8]) { u32x4 o; o.x = pk2(f[0], f[1]); o.y = pk2(f[2], f[3]); o.z = pk2(f[4], f[5]); o.w = pk2(f[6], f[7]); return o; }
DEV int crow(int r, int hi) { return (r & 3) + 8 * (r >> 2) + 4 * hi; }

DEV void prep_tile(const Args& a, int l, int tile, LAS unsigned char* lds, bool dry = false) {
    int tid_ = threadIdx.x; asm volatile("" : "+v"(tid_)); const int tid = tid_, lane = tid & 63, wid = __builtin_amdgcn_readfirstlane(tid >> 6);
    const int row0 = tile * 64, b = row0 / SEQ, t0 = row0 % SEQ;
    bf16_t* Z = (bf16_t*)(a.ws + WS_Z) + (size_t)row0 * ZP;
    {
        const int ch = tid % 228, sub = tid / 228; const bool act = tid < 456;
        const int col = ch < 64 ? ZC_RR + 8 * ch : ZC_RK + 8 * (ch - 64), mi = ch < 64 ? 8 * ch : 512 + 8 * (ch - 64);
        const int ts = 32 * sub; float prev[8], mu[8];
#pragma unroll
        for (int i = 0; i < 8; ++i) { prev[i] = 0.f; mu[i] = 0.f; }
        if (act) {
            const float* mup = a.in[14] + l * 1824 + mi;
#pragma unroll
            for (int i = 0; i < 8; ++i) mu[i] = mup[i];
            if (sub == 1) unpack8(*(const u32x4*)(Z + (size_t)(ts - 1) * ZP + col), prev);
            else if (t0 != 0) unpack8(*(const u32x4*)((const bf16_t*)(a.ws + WS_ZHALO) + (size_t)(tile - 1) * ZP + col), prev);
        }
        __syncthreads();
        if (act) {
#pragma unroll 1
            for (int t8 = 0; t8 < 32; t8 += 8) { u32x4 raw[8];
#pragma unroll
                for (int tt = 0; tt < 8; ++tt) raw[tt] = *(const u32x4*)(Z + (size_t)(ts + t8 + tt) * ZP + col);
#pragma unroll
                for (int tt = 0; tt < 8; ++tt) { float cur[8], o[8]; unpack8(raw[tt], cur);
#pragma unroll
                    for (int i = 0; i < 8; ++i) { o[i] = cur[i] + (prev[i] - cur[i]) * mu[i]; prev[i] = cur[i]; }
                    if (!dry) *(u32x4*)(Z + (size_t)(ts + t8 + tt) * ZP + col) = pack8(o); } }
        }
    }
    LAS float* kbuf = (LAS float*)lds;
    {
        const float* gfq = a.in[10] + l * 64; const float* gfk = a.in[11] + l * 64; const float* gmq = a.in[12] + l * 64; const float* gmk = a.in[13] + l * 64;
        const int* pos = (const int*)a.in[2] + b * SEQ + t0;
#pragma unroll 2
        for (int it = 0; it < 16; ++it) {
            const int item = it * 512 + tid, g8 = item >> 3, sub8 = item & 7, slot = g8 >> 6, token = g8 & 63, h = slot & 3, kind = slot >> 2;
            const int cb = (kind == 0 ? ZC_FQ : kind == 1 ? ZC_FK : kind == 2 ? ZC_MQ : ZC_MK) + 64 * h + 8 * sub8;
            const float* gp = (kind == 0 ? gfq : kind == 1 ? gfk : kind == 2 ? gmq : gmk) + 8 * sub8;
            u32x4* p = (u32x4*)(Z + (size_t)token * ZP + cb); float v[8]; unpack8(*p, v);
            float ss = 0.f;
#pragma unroll
            for (int i = 0; i < 8; ++i) ss += v[i] * v[i];
            ss += __shfl_xor(ss, 1); ss += __shfl_xor(ss, 2); ss += __shfl_xor(ss, 4);
            const float rstd = rsqrtf(ss * (1.f / 64) + NORM_EPS);
#pragma unroll
            for (int i = 0; i < 8; ++i) v[i] = v[i] * rstd * gp[i];
            float pr[8];
#pragma unroll
            for (int i = 0; i < 8; ++i) pr[i] = __shfl_xor(v[i], 1);
            if (kind >= 2 && sub8 < 2) {
                const float posf = (float)pos[token];
#pragma unroll
                for (int i = 0; i < 8; ++i) {
                    const float invf = (float)__builtin_exp2(-(double)i * 0.125 * 18.931568569324174);
                    const float ang = posf * invf; const double rev = (double)ang * 0.15915494309189535; const float fr = (float)(rev - __builtin_floor(rev));
                    const float sn = __builtin_amdgcn_sinf(fr), cs = __builtin_amdgcn_cosf(fr);
                    v[i] = sub8 == 0 ? v[i] * cs - pr[i] * sn : v[i] * cs + pr[i] * sn; }
            }
            if (kind == 3) {
#pragma unroll
                for (int i = 0; i < 8; ++i) kbuf[(token * 4 + h) * 64 + 8 * sub8 + i] = v[i]; }
            if (kind == 0 || kind == 2) {
#pragma unroll
                for (int i = 0; i < 8; ++i) v[i] *= C2_64; }
            if (!dry) *p = pack8(v);
        }
    }
    __syncthreads();
    if (tid < 256) { const int h = tid >> 6, d = tid & 63; float s = 0.f;
        for (int t = 0; t < 64; ++t) s += kbuf[(t * 4 + h) * 64 + d];
        if (!dry) ((float*)(a.ws + WS_KMP))[(((size_t)(b * 4 + h) * 64) + (t0 >> 6)) * 64 + d] = s; }
#pragma unroll 2
    for (int it = 0; it < 8; ++it) {
        const int item = it * 512 + tid, which = item >> 11, rem = item & 2047, tg = rem >> 8, c = rem & 255;
        const bf16_t* src = Z + (size_t)(8 * tg) * ZP + (which ? ZC_MV : ZC_FV) + c; unsigned short e[8];
#pragma unroll
        for (int i = 0; i < 8; ++i) e[i] = src[(size_t)i * ZP];
        u32x4 o; o.x = e[0] | ((unsigned)e[1] << 16); o.y = e[2] | ((unsigned)e[3] << 16); o.z = e[4] | ((unsigned)e[5] << 16); o.w = e[6] | ((unsigned)e[7] << 16);
        bf16_t* vt = (bf16_t*)(a.ws + (which ? WS_VTM : WS_VTF)) + ((size_t)(b * 4 + (c >> 6)) * 64 + (c & 63)) * SEQ + t0 + 8 * tg;
        if (!dry) *(u32x4*)vt = o;
    }
    if (tid < 256) { const int token = tid >> 2, h = tid & 3; const float x = bf2f(Z[(size_t)token * ZP + ZC_FF + h]) + a.in[9][l * 4 + h];
        const float lf = fminf(x, 0.f) - __logf(1.f + __expf(-fabsf(x)));
        if (!dry) ((float*)(a.ws + WS_LOGF))[(size_t)(b * 4 + h) * SEQ + t0 + token] = lf; }
    __syncthreads();
    LAS bf16_t* al = (LAS bf16_t*)lds;
    for (int item = tid; item < 64 * 36; item += 512) { const int token = item / 36, c = item % 36; float v[8]; unpack8(*(const u32x4*)(Z + (size_t)token * ZP + ZC_LO + 8 * c), v);
        if (c < 8) {
#pragma unroll
            for (int i = 0; i < 8; ++i) v[i] = tanh_f(v[i]); }
        else if (c >= 16) {
#pragma unroll
            for (int i = 0; i < 8; ++i) v[i] = sigmoid_f(v[i]); }
        *(LAS u32x4*)(al + token * 296 + 8 * c) = pack8(v); }
    __syncthreads();
    const unsigned char* wl = a.ws + WS_W + (size_t)l * WL_BYTES;
    const bf16_t* w2t = (const bf16_t*)(wl + OFF_W2T); const bf16_t* a2t = (const bf16_t*)(wl + OFF_A2T); const bf16_t* g2t = (const bf16_t*)(wl + OFF_G2T);
    const int r32 = lane & 31, hi = lane >> 5;
    for (int uu = 0; uu < 2; ++uu) {
        const int u = wid + 8 * uu, h = u & 7, th = u >> 3, token = 32 * th + r32;
        f32x16 aw[2], aa[2], ag[2];
#pragma unroll
        for (int ct = 0; ct < 2; ++ct) { aw[ct] = f32x16{}; aa[ct] = f32x16{}; ag[ct] = f32x16{}; }
        const LAS bf16_t* arow = al + token * 296 + 8 * hi;
#pragma unroll 1
        for (int ks = 0; ks < 4; ++ks) { const bf16x8 bw = *(const LAS bf16x8*)(arow + 16 * ks), ba = *(const LAS bf16x8*)(arow + 64 + 16 * ks);
#pragma unroll
            for (int ct = 0; ct < 2; ++ct) { const int chn = 64 * h + 32 * ct + r32;
                aw[ct] = __builtin_amdgcn_mfma_f32_32x32x16_bf16(*(const bf16x8*)(w2t + chn * 64 + 16 * ks + 8 * hi), bw, aw[ct], 0, 0, 0);
                aa[ct] = __builtin_amdgcn_mfma_f32_32x32x16_bf16(*(const bf16x8*)(a2t + chn * 64 + 16 * ks + 8 * hi), ba, aa[ct], 0, 0, 0); } }
#pragma unroll 1
        for (int ks = 0; ks < 10; ++ks) { const bf16x8 bg = *(const LAS bf16x8*)(arow + 128 + 16 * ks);
#pragma unroll
            for (int ct = 0; ct < 2; ++ct) { const int chn = 64 * h + 32 * ct + r32;
                ag[ct] = __builtin_amdgcn_mfma_f32_32x32x16_bf16(*(const bf16x8*)(g2t + chn * 160 + 16 * ks + 8 * hi), bg, ag[ct], 0, 0, 0); } }
        bf16_t* zr = Z + (size_t)token * ZP; const size_t grow = (size_t)(row0 + token);
        float* wd = (float*)(a.ws + WS_WD) + grow * 512; bf16_t* kkp = (bf16_t*)(a.ws + WS_KK) + grow * 512; bf16_t* kap = (bf16_t*)(a.ws + WS_KA) + grow * 512;
        const float* w0 = a.in[15] + l * 512; const float* a0 = a.in[17] + l * 512; const float* k_k = a.in[20] + l * 512; const float* k_a = a.in[21] + l * 512;
        float ss = 0.f;
#pragma unroll
        for (int ct = 0; ct < 2; ++ct)
#pragma unroll
            for (int rg = 0; rg < 4; ++rg) { const int c0 = 64 * h + 32 * ct + 8 * rg + 4 * hi;
                const u32x2 kraw = *(const u32x2*)(zr + ZC_RK + c0); const f32x4 w04 = *(const f32x4*)(w0 + c0), a04 = *(const f32x4*)(a0 + c0), kk4 = *(const f32x4*)(k_k + c0);
                f32x4 dec; u32x2 gp; float gv[4];
#pragma unroll
                for (int i = 0; i < 4; ++i) { const int r = 4 * rg + i;
                    const float kv = (i < 2) ? __uint_as_float((i & 1) ? (kraw.x & 0xffff0000u) : (kraw.x << 16)) : __uint_as_float((i & 1) ? (kraw.y & 0xffff0000u) : (kraw.y << 16));
                    const float wr_ = w04[i] + aw[ct][r]; const float sp = fmaxf(-wr_, 0.f) + __logf(1.f + __expf(-fabsf(wr_)));
                    dec[i] = __expf(-__expf(-sp - 0.5f));
                    aa[ct][r] = sigmoid_f(a04[i] + aa[ct][r]);
                    gv[i] = ag[ct][r];
                    const float kkv = kv * kk4[i]; aw[ct][r] = kkv; ss += kkv * kkv; }
                if (!dry) *(f32x4*)(wd + c0) = dec;
                gp.x = pk2(gv[0], gv[1]); gp.y = pk2(gv[2], gv[3]);
                if (!dry) *(u32x2*)(zr + (c0 < 256 ? ZC_FV + c0 : ZC_MV + (c0 - 256))) = gp; __builtin_amdgcn_sched_barrier(0); }
        ss += __shfl_xor(ss, 32);
        const float inv = 1.f / fmaxf(sqrtf(ss), 1e-12f);
#pragma unroll
        for (int ct = 0; ct < 2; ++ct)
#pragma unroll
            for (int rg = 0; rg < 4; ++rg) { const int c0 = 64 * h + 32 * ct + 8 * rg + 4 * hi; const f32x4 ka4 = *(const f32x4*)(k_a + c0);
                const u32x2 kraw = *(const u32x2*)(zr + ZC_RK + c0); const float kf4[4] = {bf2f(kraw.x & 0xffff), __uint_as_float(kraw.x & 0xffff0000u), bf2f(kraw.y & 0xffff), __uint_as_float(kraw.y & 0xffff0000u)};
                float kk[4], ka[4], kp[4];
#pragma unroll
                for (int i = 0; i < 4; ++i) { const int r = 4 * rg + i; kk[i] = aw[ct][r] * inv; ka[i] = kk[i] * aa[ct][r]; kp[i] = kf4[i] * (1.f + (aa[ct][r] - 1.f) * ka4[i]); }
                u32x2 o; o.x = pk2(kk[0], kk[1]); o.y = pk2(kk[2], kk[3]); if (!dry) *(u32x2*)(kkp + c0) = o;
                o.x = pk2(ka[0], ka[1]); o.y = pk2(ka[2], ka[3]); if (!dry) *(u32x2*)(kap + c0) = o;
                o.x = pk2(kp[0], kp[1]); o.y = pk2(kp[2], kp[3]); if (!dry) *(u32x2*)(zr + ZC_RK + c0) = o; __builtin_amdgcn_sched_barrier(0); }
    }
    __syncthreads();
}

template <int MODE, int D>
DEV void attn_unit(LAS unsigned char* lds, const bf16_t* Qp, int ldq, const bf16_t* Kp, int ldk, const bf16_t* Vt, int ldv, bf16_t* Op, int ldo,
                   int q0, int ntiles, int qb, const float* aux, const float* qgain, bool dry = false) {
    constexpr int KP = D + 8, KBYTES = 64 * KP * 2, VP = 72, VBYTES = D * VP * 2, NLD = D / 64;
    int tid_ = threadIdx.x; asm volatile("" : "+v"(tid_)); const int tid = tid_, lane = tid & 63, wid = __builtin_amdgcn_readfirstlane(tid >> 6), r32 = lane & 31, hi = lane >> 5;
    LAS float* cl = (LAS float*)lds; LAS unsigned* selm = (LAS unsigned*)(lds + 8192);
    LAS unsigned char* kb = lds + 16384; LAS unsigned char* vb = kb + 2 * KBYTES;
    const int q = q0 + wid * 32 + r32;
    if (MODE == 0) {
        const int n = 64 * ntiles; float v[8]; float run = 0.f;
#pragma unroll
        for (int i = 0; i < 8; ++i) { const int idx = 8 * tid + i; v[i] = idx < n ? aux[idx] : 0.f; run += v[i]; v[i] = run; }
        float sc = run;
#pragma unroll
        for (int o = 1; o < 64; o <<= 1) { const float t = __shfl_up(sc, o); if (lane >= o) sc += t; }
        LAS float* wsum = (LAS float*)kb;
        if (lane == 63) wsum[wid] = sc;
        __syncthreads();
        float off = sc - run;
        for (int w = 0; w < wid; ++w) off += wsum[w];
#pragma unroll
        for (int i = 0; i < 8; ++i) cl[8 * tid + i] = (off + v[i]) * LOG2E;
    }
    if (MODE == 1) {
        LAS float* km = cl;
        for (int e = tid; e < 16 * 64; e += 512) { const int nblk = e >> 6, d = e & 63; const float* pp = aux + (size_t)(4 * nblk) * 64 + d;
            km[e] = ((pp[0] + pp[64]) + (pp[128] + pp[192])) * (1.f / 256); }
        __syncthreads();
        if (tid < 256) { const bf16_t* qr = Qp + (size_t)(q0 + tid) * ldq; float g[16];
#pragma unroll
            for (int nb = 0; nb < 16; ++nb) g[nb] = 0.f;
            for (int c = 0; c < 8; ++c) { float qv[8]; unpack8(*(const u32x4*)(qr + 8 * c), qv);
#pragma unroll
                for (int nb = 0; nb < 16; ++nb) {
#pragma unroll
                    for (int i = 0; i < 8; ++i) g[nb] += qv[i] * km[nb * 64 + 8 * c + i]; } }
            unsigned m = 0u;
#pragma unroll
            for (int pick = 0; pick < 3; ++pick) { float best = -INFINITY; int bi = -1;
#pragma unroll
                for (int nb = 0; nb < 16; ++nb) { if (nb < qb && !((m >> nb) & 1u) && g[nb] > best) { best = g[nb]; bi = nb; } }
                if (bi >= 0) m |= 1u << bi; }
            selm[tid] = m; }
    }
    bf16x8 qf[D / 16];
#pragma unroll
    for (int d0 = 0; d0 < D / 16; ++d0) qf[d0] = *(const bf16x8*)(Qp + (size_t)q * ldq + d0 * 16 + hi * 8);
    if (MODE == 2) {
        float ss = 0.f;
#pragma unroll
        for (int d0 = 0; d0 < D / 16; ++d0) { float qv[8]; unpack8(__builtin_bit_cast(u32x4, qf[d0]), qv);
#pragma unroll
            for (int i = 0; i < 8; ++i) ss += qv[i] * qv[i]; }
        ss += __shfl_xor(ss, 32);
        const float rstd = rsqrtf(ss * (1.f / D) + NORM_EPS) * C2_128;
#pragma unroll
        for (int d0 = 0; d0 < D / 16; ++d0) { float qv[8]; unpack8(__builtin_bit_cast(u32x4, qf[d0]), qv);
#pragma unroll
            for (int i = 0; i < 8; ++i) qv[i] = qv[i] * rstd * qgain[d0 * 16 + hi * 8 + i];
            qf[d0] = __builtin_bit_cast(bf16x8, pack8(qv)); __builtin_amdgcn_sched_barrier(0); }
    }
    float mrun = -INFINITY, lrun = 0.f; f32x16 o[D / 32];
#pragma unroll
    for (int dt = 0; dt < D / 32; ++dt) o[dt] = f32x16{};
    __syncthreads();
    const float cq = (MODE == 0) ? cl[q] : 0.f;
    const unsigned sel = (MODE == 1) ? selm[wid * 32 + r32] : 0u;
    u32x4 kreg[NLD], vreg[NLD];
#define ATT_LOAD(t) do { _Pragma("unroll") for (int i_ = 0; i_ < NLD; ++i_) { const int idx_ = tid + 512 * i_; \
        kreg[i_] = *(const u32x4*)(Kp + (size_t)(64 * (t) + idx_ / (D / 8)) * ldk + (idx_ % (D / 8)) * 8); \
        vreg[i_] = *(const u32x4*)(Vt + (size_t)(idx_ >> 3) * ldv + 64 * (t) + (idx_ & 7) * 8); } } while (0)
#define ATT_STORE(buf) do { _Pragma("unroll") for (int i_ = 0; i_ < NLD; ++i_) { const int idx_ = tid + 512 * i_; \
        *(LAS u32x4*)(kb + (buf) * KBYTES + ((idx_ / (D / 8)) * KP + (idx_ % (D / 8)) * 8) * 2) = kreg[i_]; \
        *(LAS u32x4*)(vb + (buf) * VBYTES + ((idx_ >> 3) * VP + (idx_ & 7) * 8) * 2) = vreg[i_]; } } while (0)
    ATT_LOAD(0); ATT_STORE(0);
    __syncthreads();
    for (int t = 0; t < ntiles; ++t) {
        const int buf = t & 1, key0 = 64 * t;
        if (t + 1 < ntiles) ATT_LOAD(t + 1);
        bool work = true; const int nblk = key0 >> 8;
        if (MODE == 0) work = key0 <= q0 + wid * 32 + 31;
        if (MODE == 1) work = (nblk == qb) ? (key0 <= q0 + wid * 32 + 31) : (__any((sel >> nblk) & 1u) != 0);
        if (work) {
            const LAS unsigned char* kt = kb + buf * KBYTES; const LAS unsigned char* vt = vb + buf * VBYTES;
            constexpr int NKH = (D == 64) ? 2 : 1;
#pragma unroll 1
            for (int ks = 0; ks < 2 / NKH; ++ks) {
            f32x16 p[NKH];
#pragma unroll
            for (int kh = 0; kh < NKH; ++kh) { p[kh] = f32x16{}; const int khh = ks * NKH + kh;
#pragma unroll
                for (int d0 = 0; d0 < D / 16; ++d0) { const bf16x8 kf = *(const LAS bf16x8*)(kt + ((32 * khh + r32) * KP + 16 * d0 + 8 * hi) * 2);
                    p[kh] = __builtin_amdgcn_mfma_f32_32x32x16_bf16(kf, qf[d0], p[kh], 0, 0, 0); } }
            if (MODE == 0) {
                const bool diag = key0 + 63 > q0 + wid * 32;
                if (diag) {
#pragma unroll
                for (int kh = 0; kh < NKH; ++kh)
#pragma unroll
                    for (int rg = 0; rg < 4; ++rg) { const int kk0 = key0 + 32 * (ks * NKH + kh) + 8 * rg + 4 * hi; const f32x4 ck = *(const LAS f32x4*)(cl + kk0);
#pragma unroll
                        for (int i = 0; i < 4; ++i) { const float s = p[kh][4 * rg + i] + (cq - ck[i]); p[kh][4 * rg + i] = (kk0 + i > q) ? -INFINITY : s; } }
                } else {
#pragma unroll
                for (int kh = 0; kh < NKH; ++kh)
#pragma unroll
                    for (int rg = 0; rg < 4; ++rg) { const int kk0 = key0 + 32 * (ks * NKH + kh) + 8 * rg + 4 * hi; const f32x4 ck = *(const LAS f32x4*)(cl + kk0);
#pragma unroll
                        for (int i = 0; i < 4; ++i) p[kh][4 * rg + i] += (cq - ck[i]); }
                }
            }
            if (MODE == 1) {
                if (nblk == qb) {
#pragma unroll
                    for (int kh = 0; kh < NKH; ++kh)
#pragma unroll
                        for (int r = 0; r < 16; ++r) { if (key0 + 32 * (ks * NKH + kh) + crow(r, hi) > q) p[kh][r] = -INFINITY; }
                } else if (!((sel >> nblk) & 1u)) {
#pragma unroll
                    for (int kh = 0; kh < NKH; ++kh)
#pragma unroll
                        for (int r = 0; r < 16; ++r) p[kh][r] = -INFINITY;
                }
            }
            float mx = p[0][0];
#pragma unroll
            for (int kh = 0; kh < NKH; ++kh)
#pragma unroll
                for (int r = 0; r < 16; ++r) mx = fmaxf(mx, p[kh][r]);
            mx = fmaxf(mx, __shfl_xor(mx, 32));
            const float mnew = fmaxf(mrun, mx), muse = (mnew == -INFINITY) ? 0.f : mnew;
            const float alpha = __builtin_amdgcn_exp2f(mrun - muse);
            mrun = mnew; lrun *= alpha;
            if (__any(alpha != 1.0f)) {
#pragma unroll
                for (int dt = 0; dt < D / 32; ++dt) o[dt] *= alpha; }
            float ps = 0.f;
#pragma unroll
            for (int kh = 0; kh < NKH; ++kh)
#pragma unroll
                for (int r = 0; r < 16; ++r) { p[kh][r] = __builtin_amdgcn_exp2f(p[kh][r] - muse); ps += p[kh][r]; }
            lrun += ps;
            bf16x8 pb[NKH][2];
#pragma unroll
            for (int kh = 0; kh < NKH; ++kh)
#pragma unroll
                for (int j = 0; j < 2; ++j) { u32x4 w; w.x = pk2(p[kh][8 * j + 0], p[kh][8 * j + 1]); w.y = pk2(p[kh][8 * j + 2], p[kh][8 * j + 3]); w.z = pk2(p[kh][8 * j + 4], p[kh][8 * j + 5]); w.w = pk2(p[kh][8 * j + 6], p[kh][8 * j + 7]);
                    pb[kh][j] = __builtin_bit_cast(bf16x8, w); }
#pragma unroll
            for (int dt = 0; dt < D / 32; ++dt)
#pragma unroll
                for (int kh = 0; kh < NKH; ++kh)
#pragma unroll
                    for (int j = 0; j < 2; ++j) { const LAS unsigned char* vp_ = vt + ((32 * dt + r32) * VP + 32 * (ks * NKH + kh) + 16 * j + 4 * hi) * 2;
                        const u32x2 lo = *(const LAS u32x2*)vp_, hh = *(const LAS u32x2*)(vp_ + 16); u32x4 w; w.x = lo.x; w.y = lo.y; w.z = hh.x; w.w = hh.y;
                        o[dt] = __builtin_amdgcn_mfma_f32_32x32x16_bf16(__builtin_bit_cast(bf16x8, w), pb[kh][j], o[dt], 0, 0, 0); }
            }
        }
        if (t + 1 < ntiles) ATT_STORE(buf ^ 1);
        __syncthreads();
    }
#undef ATT_LOAD
#undef ATT_STORE
    lrun += __shfl_xor(lrun, 32);
    const float inv = 1.f / lrun;
    bf16_t* orow = Op + (size_t)q * ldo;
    if (!dry)
#pragma unroll
    for (int dt = 0; dt < D / 32; ++dt)
#pragma unroll
        for (int rg = 0; rg < 4; ++rg) { u32x2 w; w.x = pk2(o[dt][4 * rg] * inv, o[dt][4 * rg + 1] * inv); w.y = pk2(o[dt][4 * rg + 2] * inv, o[dt][4 * rg + 3] * inv);
            *(u32x2*)(orow + 32 * dt + 8 * rg + 4 * hi) = w; }
    __syncthreads();
}

constexpr int RW_NCH = SEQ / 16;
constexpr int RW_ARP = 72, RW_BKTP = 32, RW_VTP = 24, RW_PMP = 16, RW_LP = 20;
constexpr int RW_NBUF = 6, RW_NPRE = 4;
constexpr int RW_DB = 15104, RW_AR = 0, RW_BKT = 4608, RW_VT = 8704, RW_GC = 11776, RW_TM = 12032, RW_PM1 = 13056, RW_PM2 = 14080;
constexpr int RW_PRIV = RW_NBUF * RW_DB, RW_PRIV_BYTES = 5888, RW_PBK = 0, RW_PLAB = 4608;
constexpr int RW_NYB = 4;
constexpr int RW_YB = RW_PRIV + RW_NPRE * RW_PRIV_BYTES, RW_FLG = RW_YB + RW_NYB * 4096, RW_SLOT_BYTES = RW_FLG + 128;
static_assert(RW_PM2 + 32 * RW_PMP * 2 == RW_DB && RW_TM + 32 * RW_PMP * 2 == RW_PM1 && RW_SLOT_BYTES <= 131072 && RW_DB % 16 == 0 && RW_PRIV_BYTES % 16 == 0, "rwkv lds map");
DEV bf16x8 pack_acc8(const f32x16& v, int base) { u32x4 w; w.x = pk2(v[base], v[base + 1]); w.y = pk2(v[base + 2], v[base + 3]); w.z = pk2(v[base + 4], v[base + 5]); w.w = pk2(v[base + 6], v[base + 7]); return __builtin_bit_cast(bf16x8, w); }
DEV int fresh_lane() { int l_; asm volatile("v_mbcnt_lo_u32_b32 %0, -1, 0\n\tv_mbcnt_hi_u32_b32 %0, -1, %0" : "=v"(l_)); return l_; }
DEV void rw_wait(volatile LAS unsigned* f, unsigned target) { while (*f < target) __builtin_amdgcn_s_sleep(1); asm volatile("" ::: "memory"); }
DEV void rw_post_flag(volatile LAS unsigned* f, unsigned v) { asm volatile("s_waitcnt vmcnt(0) lgkmcnt(0)" ::: "memory"); *f = v; }
DEV bf16x8 frag_perm(const LAS bf16_t* rowp, int hi) { const u32x2 lo = *(const LAS u32x2*)(rowp + 4 * hi), hh = *(const LAS u32x2*)(rowp + 8 + 4 * hi); u32x4 w; w.x = lo.x; w.y = lo.y; w.z = hh.x; w.w = hh.y; return __builtin_bit_cast(bf16x8, w); }

struct RwRaw { float w[16]; unsigned short kk[16], ka[16], kp[16], rr[16], vr[16]; };
DEV void rwkv_pre_load(RwRaw& R, int c, const float* WDp, const bf16_t* KKp, const bf16_t* KAp, const bf16_t* Zl) {
#pragma unroll
    for (int t = 0; t < 16; ++t) { const size_t ro = (size_t)(16 * c + t);
        R.w[t] = WDp[ro * 512]; R.kk[t] = KKp[ro * 512]; R.ka[t] = KAp[ro * 512]; R.kp[t] = Zl[ro * ZP + ZC_RK]; R.rr[t] = Zl[ro * ZP + ZC_RR]; R.vr[t] = Zl[ro * ZP + ZC_RV]; }
}
DEV void rwkv_pre_a(const RwRaw& R, int c, LAS unsigned char* sl, volatile LAS unsigned* flg, int lane) {
    const int bi = c % RW_NBUF, pw = c % RW_NPRE;
    LAS bf16_t* BK = (LAS bf16_t*)(sl + RW_PRIV + pw * RW_PRIV_BYTES + RW_PBK);
    LAS unsigned char* db = sl + bi * RW_DB;
    LAS bf16_t* AR = (LAS bf16_t*)(db + RW_AR); LAS bf16_t* BKT = (LAS bf16_t*)(db + RW_BKT); LAS bf16_t* VT = (LAS bf16_t*)(db + RW_VT); LAS float* GC = (LAS float*)(db + RW_GC);
    if (c >= RW_NBUF) rw_wait(flg + 6 + bi, (unsigned)(c - RW_NBUF + 1));
    float g = 1.f; unsigned bkt[16];
#pragma unroll
    for (int t = 0; t < 16; ++t) {
        const float w = R.w[t], kk = bf2f(R.kk[t]), ka = bf2f(R.ka[t]), kp = bf2f(R.kp[t]), rr = bf2f(R.rr[t]);
        const float at = -kk * g; g *= w; const float inv = __builtin_amdgcn_rcpf(g);
        const unsigned bt = f2bf(ka * inv), kt = f2bf(kp * inv);
        AR[t * RW_ARP + lane] = (bf16_t)f2bf(at); AR[(16 + t) * RW_ARP + lane] = (bf16_t)f2bf(rr * g);
        BK[t * RW_ARP + lane] = (bf16_t)bt; BK[(16 + t) * RW_ARP + lane] = (bf16_t)kt;
        if (t & 1) { bkt[t >> 1] |= bt << 16; bkt[8 + (t >> 1)] |= kt << 16; } else { bkt[t >> 1] = bt; bkt[8 + (t >> 1)] = kt; }
    }
    GC[lane] = g;
#pragma unroll
    for (int q4 = 0; q4 < 4; ++q4) { u32x4 w4; w4.x = bkt[4 * q4]; w4.y = bkt[4 * q4 + 1]; w4.z = bkt[4 * q4 + 2]; w4.w = bkt[4 * q4 + 3]; *(LAS u32x4*)(BKT + lane * RW_BKTP + 8 * q4) = w4; }
    { unsigned vv[8];
#pragma unroll
      for (int t = 0; t < 16; ++t) { const unsigned x = R.vr[t]; if (t & 1) vv[t >> 1] |= x << 16; else vv[t >> 1] = x; }
      u32x4 v0; v0.x = vv[0]; v0.y = vv[1]; v0.z = vv[2]; v0.w = vv[3]; u32x4 v1; v1.x = vv[4]; v1.y = vv[5]; v1.z = vv[6]; v1.w = vv[7];
      *(LAS u32x4*)(VT + lane * RW_VTP) = v0; *(LAS u32x4*)(VT + lane * RW_VTP + 8) = v1; }
}
DEV void rwkv_pre_b(int c, LAS unsigned char* sl, volatile LAS unsigned* flg, int lane) {
    const int r32 = lane & 31, hi = lane >> 5, bi = c % RW_NBUF, pw = c % RW_NPRE;
    LAS bf16_t* BK = (LAS bf16_t*)(sl + RW_PRIV + pw * RW_PRIV_BYTES + RW_PBK);
    LAS unsigned char* db = sl + bi * RW_DB;
    LAS bf16_t* AR = (LAS bf16_t*)(db + RW_AR); LAS bf16_t* TM = (LAS bf16_t*)(db + RW_TM); LAS bf16_t* PM1 = (LAS bf16_t*)(db + RW_PM1); LAS bf16_t* PM2 = (LAS bf16_t*)(db + RW_PM2);
    f32x16 P = f32x16{};
#pragma unroll
    for (int ks = 0; ks < 4; ++ks) P = __builtin_amdgcn_mfma_f32_32x32x16_bf16(*(const LAS bf16x8*)(AR + r32 * RW_ARP + 16 * ks + 8 * hi), *(const LAS bf16x8*)(BK + r32 * RW_ARP + 16 * ks + 8 * hi), P, 0, 0, 0);
    asm volatile("s_waitcnt lgkmcnt(0)" ::: "memory");
    LAS bf16_t* LB = BK; LAS bf16_t* L2m = BK + 256; LAS bf16_t* L4m = BK + 512;
    const int n = r32; const bool lcol = n < 16;
    f32x16 Lm = f32x16{};
#pragma unroll
    for (int r = 0; r < 16; ++r) { const int m = crow(r, hi);
        if (r < 8) { const float lv = (lcol && n < m) ? P[r] : 0.f; Lm[r] = lv;
            if (lcol) LB[m * 16 + n] = (bf16_t)f2bf(lv); else PM1[m * RW_PMP + (n - 16)] = (bf16_t)f2bf((n - 16 < m) ? P[r] : 0.f); }
        else { if (lcol) PM2[m * RW_PMP + n] = (bf16_t)f2bf((n <= m - 16) ? P[r] : 0.f); else PM1[m * RW_PMP + (n - 16)] = (bf16_t)f2bf((n - 16 <= m - 16) ? P[r] : 0.f); } }
    const int rr = (r32 & 15) * 16;
    f32x16 A2 = __builtin_amdgcn_mfma_f32_32x32x16_bf16(frag_perm(LB + rr, hi), pack_acc8(Lm, 0), f32x16{}, 0, 0, 0);
    if (lcol) {
#pragma unroll
        for (int r = 0; r < 8; ++r) L2m[crow(r, hi) * 16 + n] = (bf16_t)f2bf(A2[r]); }
    f32x16 A4 = __builtin_amdgcn_mfma_f32_32x32x16_bf16(frag_perm(L2m + rr, hi), pack_acc8(A2, 0), f32x16{}, 0, 0, 0);
    if (lcol) {
#pragma unroll
        for (int r = 0; r < 8; ++r) L4m[crow(r, hi) * 16 + n] = (bf16_t)f2bf(A4[r]); }
    f32x16 T = __builtin_amdgcn_mfma_f32_32x32x16_bf16(frag_perm(L4m + rr, hi), pack_acc8(A4, 0), f32x16{}, 0, 0, 0);
#pragma unroll
    for (int r = 0; r < 8; ++r) { if (n == crow(r, hi)) T[r] += 1.f; }
    T = __builtin_amdgcn_mfma_f32_32x32x16_bf16(frag_perm(L4m + rr, hi), pack_acc8(T, 0), T, 0, 0, 0);
    T = __builtin_amdgcn_mfma_f32_32x32x16_bf16(frag_perm(L2m + rr, hi), pack_acc8(T, 0), T, 0, 0, 0);
    T = __builtin_amdgcn_mfma_f32_32x32x16_bf16(frag_perm(LB + rr, hi), pack_acc8(T, 0), T, 0, 0, 0);
    if (lcol) {
#pragma unroll
        for (int r = 0; r < 8; ++r) TM[crow(r, hi) * RW_PMP + n] = (bf16_t)f2bf(T[r]); }
    asm volatile("s_waitcnt lgkmcnt(0)" ::: "memory"); flg[bi] = (unsigned)(c + 1);
}
DEV void rwkv_pre(const Args& a, int b, int h, LAS unsigned char* sl, int par) {
    const int lane = fresh_lane();
    volatile LAS unsigned* flg = (volatile LAS unsigned*)(sl + RW_FLG);
    const size_t rowb = (size_t)b * SEQ;
    const bf16_t* Zl = (const bf16_t*)(a.ws + WS_Z) + rowb * ZP + h * 64 + lane;
    const float* WDp = (const float*)(a.ws + WS_WD) + rowb * 512 + h * 64 + lane;
    const bf16_t* KKp = (const bf16_t*)(a.ws + WS_KK) + rowb * 512 + h * 64 + lane;
    const bf16_t* KAp = (const bf16_t*)(a.ws + WS_KA) + rowb * 512 + h * 64 + lane;
    for (int bz = par; bz < RW_NBUF; bz += RW_NPRE) for (int e = lane; e < 32 * RW_PMP; e += 64) { ((LAS bf16_t*)(sl + bz * RW_DB + RW_PM2))[e] = 0; ((LAS bf16_t*)(sl + bz * RW_DB + RW_TM))[e] = 0; }
    RwRaw R;
    rwkv_pre_load(R, par, WDp, KKp, KAp, Zl);
#pragma unroll 1
    for (int c = par; c < RW_NCH; c += RW_NPRE) {
        rwkv_pre_a(R, c, sl, flg, lane);
        rwkv_pre_load(R, (c + RW_NPRE < RW_NCH) ? c + RW_NPRE : c, WDp, KKp, KAp, Zl);
        rwkv_pre_b(c, sl, flg, lane);
    }
}

DEV void rwkv_main(LAS unsigned char* sl) {
    const int lane = fresh_lane(), r32 = lane & 31, hi = lane >> 5;
    volatile LAS unsigned* flg = (volatile LAS unsigned*)(sl + RW_FLG);
    f32x16 ST[2][2];
#pragma unroll
    for (int jt = 0; jt < 2; ++jt)
#pragma unroll
        for (int it = 0; it < 2; ++it) ST[jt][it] = f32x16{};
#pragma unroll 1
    for (int c = 0; c < RW_NCH; ++c) {
        const int bi = c % RW_NBUF;
        LAS unsigned char* db = sl + bi * RW_DB;
        const LAS bf16_t* AR = (const LAS bf16_t*)(db + RW_AR); const LAS bf16_t* BKT = (const LAS bf16_t*)(db + RW_BKT); const LAS bf16_t* VT = (const LAS bf16_t*)(db + RW_VT);
        const LAS float* GC = (const LAS float*)(db + RW_GC); const LAS bf16_t* TM = (const LAS bf16_t*)(db + RW_TM); const LAS bf16_t* PM1 = (const LAS bf16_t*)(db + RW_PM1); const LAS bf16_t* PM2 = (const LAS bf16_t*)(db + RW_PM2);
        const int yi = c % RW_NYB; LAS float* YB = (LAS float*)(sl + RW_YB + yi * 4096);
        rw_wait(flg + bi, (unsigned)(c + 1));
        f32x16 X[2]; X[0] = f32x16{}; X[1] = f32x16{};
#pragma unroll
        for (int jt = 0; jt < 2; ++jt)
#pragma unroll
            for (int rgp = 0; rgp < 2; ++rgp) { const bf16x8 af = frag_perm(AR + r32 * RW_ARP + 32 * jt + 16 * rgp, hi);
#pragma unroll
                for (int it = 0; it < 2; ++it) X[it] = __builtin_amdgcn_mfma_f32_32x32x16_bf16(af, pack_acc8(ST[jt][it], 8 * rgp), X[it], 0, 0, 0); }
        bf16x8 vt[2];
        { const bf16x8 a1 = *(const LAS bf16x8*)(PM1 + r32 * RW_PMP + 8 * hi);
#pragma unroll
          for (int it = 0; it < 2; ++it) { vt[it] = *(const LAS bf16x8*)(VT + (32 * it + r32) * RW_VTP + 8 * hi); X[it] = __builtin_amdgcn_mfma_f32_32x32x16_bf16(a1, vt[it], X[it], 0, 0, 0); } }
        bf16x8 ub[2];
        { const bf16x8 ta = frag_perm(TM + r32 * RW_PMP, hi), pm2 = frag_perm(PM2 + r32 * RW_PMP, hi);
#pragma unroll
          for (int it = 0; it < 2; ++it) { const f32x16 U = __builtin_amdgcn_mfma_f32_32x32x16_bf16(ta, pack_acc8(X[it], 0), f32x16{}, 0, 0, 0);
              ub[it] = pack_acc8(U, 0); X[it] = __builtin_amdgcn_mfma_f32_32x32x16_bf16(pm2, ub[it], X[it], 0, 0, 0); } }
        if (c >= RW_NYB) rw_wait(flg + 16 + yi, (unsigned)(c - RW_NYB + 1));
#pragma unroll
        for (int it = 0; it < 2; ++it)
#pragma unroll
            for (int r = 8; r < 16; ++r) YB[(crow(r, hi) - 16) * 64 + 32 * it + r32] = X[it][r];
        rw_post_flag(flg + 12 + yi, (unsigned)(c + 1));
#pragma unroll
        for (int jt = 0; jt < 2; ++jt) { const bf16x8 a0 = frag_perm(BKT + (32 * jt + r32) * RW_BKTP, hi), a1 = *(const LAS bf16x8*)(BKT + (32 * jt + r32) * RW_BKTP + 16 + 8 * hi);
#pragma unroll
            for (int it = 0; it < 2; ++it) { ST[jt][it] = __builtin_amdgcn_mfma_f32_32x32x16_bf16(a0, ub[it], ST[jt][it], 0, 0, 0);
                ST[jt][it] = __builtin_amdgcn_mfma_f32_32x32x16_bf16(a1, vt[it], ST[jt][it], 0, 0, 0); }
#pragma unroll
            for (int rg = 0; rg < 4; ++rg) { const f32x4 g4 = *(const LAS f32x4*)(GC + 32 * jt + 8 * rg + 4 * hi);
#pragma unroll
                for (int e = 0; e < 4; ++e) { ST[jt][0][4 * rg + e] *= g4[e]; ST[jt][1][4 * rg + e] *= g4[e]; } } }
        rw_post_flag(flg + 6 + bi, (unsigned)(c + 1));
    }
}

DEV void rwkv_post(const Args& a, int l, int b, int h, LAS unsigned char* sl, int par) {
    const int lane = fresh_lane();
    volatile LAS unsigned* flg = (volatile LAS unsigned*)(sl + RW_FLG);
    bf16_t* Zb = (bf16_t*)(a.ws + WS_Z) + (size_t)b * SEQ * ZP;
    const int gcol0 = h < 4 ? ZC_FV + h * 64 : ZC_MV + (h - 4) * 64;
    const int t = lane >> 2, qd = lane & 3, c0 = h * 64 + 16 * qd;
    const float* rkp = a.in[22] + l * 512 + c0; const float* lw = a.in[23] + l * 512 + c0; const float* lb = a.in[24] + l * 512 + c0;
#pragma unroll 1
    for (int c = par; c < RW_NCH; c += 2) {
        bf16_t* zr = Zb + (size_t)(16 * c + t) * ZP;
        const u32x4 r0 = *(const u32x4*)(zr + ZC_RR + c0), r1 = *(const u32x4*)(zr + ZC_RR + c0 + 8), k0 = *(const u32x4*)(zr + ZC_RK + c0), k1 = *(const u32x4*)(zr + ZC_RK + c0 + 8);
        const u32x4 v0 = *(const u32x4*)(zr + ZC_RV + c0), v1 = *(const u32x4*)(zr + ZC_RV + c0 + 8), g0 = *(const u32x4*)(zr + gcol0 + 16 * qd), g1 = *(const u32x4*)(zr + gcol0 + 16 * qd + 8);
        const int yi = c % RW_NYB; const LAS float* YB = (const LAS float*)(sl + RW_YB + yi * 4096);
        rw_wait(flg + 12 + yi, (unsigned)(c + 1));
        float y[16];
#pragma unroll
        for (int q4 = 0; q4 < 4; ++q4) { const f32x4 yy = *(const LAS f32x4*)(YB + t * 64 + 16 * qd + 4 * q4); y[4 * q4] = yy[0]; y[4 * q4 + 1] = yy[1]; y[4 * q4 + 2] = yy[2]; y[4 * q4 + 3] = yy[3]; }
        asm volatile("s_waitcnt lgkmcnt(0)" ::: "memory");
        flg[16 + yi] = (unsigned)(c + 1);
        float s = 0.f;
#pragma unroll
        for (int e = 0; e < 16; ++e) s += y[e];
        s += __shfl_xor(s, 1); s += __shfl_xor(s, 2);
        const float mean = s * (1.f / 64); float q = 0.f;
#pragma unroll
        for (int e = 0; e < 16; ++e) { y[e] -= mean; q += y[e] * y[e]; }
        q += __shfl_xor(q, 1); q += __shfl_xor(q, 2);
        const float rstd = rsqrtf(q * (1.f / 64) + GN_EPS);
        float rv[16], kv[16];
        unpack8(r0, *(float(*)[8])&rv[0]); unpack8(r1, *(float(*)[8])&rv[8]); unpack8(k0, *(float(*)[8])&kv[0]); unpack8(k1, *(float(*)[8])&kv[8]);
        float bs = 0.f;
#pragma unroll
        for (int e = 0; e < 16; ++e) bs += rv[e] * kv[e] * rkp[e];
        bs += __shfl_xor(bs, 1); bs += __shfl_xor(bs, 2);
        float vv[16], gv[16], o[16];
        unpack8(v0, *(float(*)[8])&vv[0]); unpack8(v1, *(float(*)[8])&vv[8]); unpack8(g0, *(float(*)[8])&gv[0]); unpack8(g1, *(float(*)[8])&gv[8]);
#pragma unroll
        for (int e = 0; e < 16; ++e) o[e] = (y[e] * rstd * lw[e] + lb[e] + bs * vv[e]) * gv[e];
        *(u32x4*)(zr + ZC_RR + c0) = pack8(*(float(*)[8])&o[0]); *(u32x4*)(zr + ZC_RR + c0 + 8) = pack8(*(float(*)[8])&o[8]);
    }
}

#define XB_TMO      128
#define XB_XCNT(j)  (256  + 64 * (j))
#define XB_XSUB(j)  (1280 + 64 * (j))
#define XB_XGEN(j)  (2304 + 64 * (j))
#define XB_TOP      3328
#define XB_TOPGEN   3392
#define XCD_BAR_WORDS 3456
#define XB_SPIN_CAP (1u << 18)

__device__ __forceinline__ unsigned xb_ld(unsigned* p)              { return __hip_atomic_load(p, __ATOMIC_RELAXED, __HIP_MEMORY_SCOPE_AGENT); }
__device__ __forceinline__ unsigned xb_add(unsigned* p, unsigned v) { return __hip_atomic_fetch_add(p, v, __ATOMIC_RELAXED, __HIP_MEMORY_SCOPE_AGENT); }
__device__ __forceinline__ unsigned xb_xcc_id() { return (unsigned)__builtin_amdgcn_s_getreg((3 << 11) | 20) & 0xFu; }
#define XB_SPIN(cond, bar) do { unsigned _sp = 0; while (cond) { __builtin_amdgcn_s_sleep(1); \
    if ((++_sp & 255u) == 0u) { if (xb_ld(&(bar)[XB_TMO])) break; if (_sp > XB_SPIN_CAP) { atomicAdd(&(bar)[XB_TMO], 1u); break; } } } } while (0)

struct XcdBarrier {
    unsigned* bar; unsigned x;
    volatile LAS unsigned* st;
};

__device__ __forceinline__ XcdBarrier xcd_barrier_post(unsigned* bar, volatile LAS unsigned* st) {
    XcdBarrier b; b.bar = bar; b.x = xb_xcc_id(); b.st = st;
    if (threadIdx.x == 0) (void)xb_add(&bar[XB_XCNT(b.x)], 1u);
    return b;
}
__device__ __forceinline__ void xcd_barrier_complete(unsigned* bar, unsigned x, unsigned& nloc, unsigned& nx) {
    const unsigned G = gridDim.x * gridDim.y * gridDim.z;
    unsigned sum, cnt, mine, sp = 0u;
    for (;;) {
        sum = 0u; cnt = 0u; mine = 0u;
#pragma unroll
        for (unsigned j = 0; j < 16; ++j) { const unsigned c = xb_ld(&bar[XB_XCNT(j)]); sum += c; cnt += (c > 0u) ? 1u : 0u; mine = (j == x) ? c : mine; }
        if (sum == G) break;
        __builtin_amdgcn_s_sleep(1);
        if ((++sp & 255u) == 0u) { if (xb_ld(&bar[XB_TMO])) break; if (sp > XB_SPIN_CAP) { atomicAdd(&bar[XB_TMO], 1u); break; } }
    }
    nloc = mine > 0u ? mine : 1u; nx = cnt > 0u ? cnt : 1u;
}

__device__ __forceinline__ void xcd_barrier(const XcdBarrier& b) {
    asm volatile("s_waitcnt vmcnt(0)" ::: "memory");
    __syncthreads();
    if (threadIdx.x == 0) {
        unsigned* bar = b.bar;
        __builtin_amdgcn_s_waitcnt(0);
        unsigned nloc = b.st[0], nx = b.st[1];
        if (nloc == 0u) { xcd_barrier_complete(bar, b.x, nloc, nx); b.st[0] = nloc; b.st[1] = nx; }
        const unsigned old = xb_add(&bar[XB_XSUB(b.x)], 1u);
        const unsigned gen = old / nloc;
        if (old + 1u == (gen + 1u) * nloc) {
            __builtin_amdgcn_fence(__ATOMIC_RELEASE, "agent");
            asm volatile("s_waitcnt vmcnt(0)" ::: "memory");
            const unsigned og = xb_add(&bar[XB_TOP], 1u);
            const unsigned tg = og / nx;
            if (og + 1u == (tg + 1u) * nx) xb_add(&bar[XB_TOPGEN], 1u);
            else XB_SPIN(xb_ld(&bar[XB_TOPGEN]) == tg, bar);
            __builtin_amdgcn_fence(__ATOMIC_ACQUIRE, "agent");
            xb_add(&bar[XB_XGEN(b.x)], 1u);
            asm volatile("s_waitcnt vmcnt(0)" ::: "memory");
        } else {
            XB_SPIN(xb_ld(&bar[XB_XGEN(b.x)]) == gen, bar);
            __builtin_amdgcn_fence(__ATOMIC_ACQUIRE, "agent");
            asm volatile("s_waitcnt vmcnt(0)" ::: "memory");
        }
    }
    __syncthreads();
}

constexpr int N_PHASES = 1 + 15 * NL;
#ifndef MK_MULTI
#define MK_MULTI 0
#endif
#ifndef PROBE_Q
#define PROBE_Q 500.f
#endif
#ifndef PROBE_OFF
#define PROBE_OFF 0.f
#endif
#ifndef REPK
#define REPK 0
#endif
#ifndef ATT_REP
#define ATT_REP 1
#endif
#ifndef PREP_REP
#define PREP_REP 1
#endif
#ifndef RWROLES
#define RWROLES 7
#endif
#ifndef PHMASK
#define PHMASK 0xFFFF
#endif
#define PHON(k) ((PHMASK >> (k)) & 1)
__global__ void __launch_bounds__(512, 2) fwd_megakernel(Args a) {
    extern __shared__ __attribute__((aligned(16))) unsigned char lds_raw[];
    LAS unsigned char* lds = (LAS unsigned char*)lds_raw;
    cg::grid_group grid = cg::this_grid();
    { volatile LAS unsigned* st0 = (volatile LAS unsigned*)(lds + 131072 + 128); if (threadIdx.x == 0) { st0[0] = 0u; st0[1] = 0u; } __syncthreads(); }
    XcdBarrier xbar = xcd_barrier_post((unsigned*)(a.ws + WS_CTL) + 4096, (volatile LAS unsigned*)(lds + 131072 + 128));
    const int G = gridDim.x, bid = blockIdx.x, NGW = G * 8;
    unsigned char* ws = a.ws;
    bf16_t* HN = (bf16_t*)(ws + WS_HN); bf16_t* Z = (bf16_t*)(ws + WS_Z); bf16_t* HID = Z; bf16_t* QX = Z; bf16_t* OX = Z + (size_t)TOK * 512;
#ifdef PROBE_GROUP
    LAS unsigned long long* prs = (LAS unsigned long long*)(lds + 131072 + 64);
    if (threadIdx.x == 0) { prs[0] = __builtin_amdgcn_s_memrealtime(); prs[1] = 0ull; prs[2] = 99ull; }
#endif
#ifdef PROBE_GROUP
    for (int ph = a.ph_lo; ph <= a.ph_hi; ++ph) {
#else
    for (int ph = a.ph_lo; ph < a.ph_hi; ++ph) {
#endif
        if (ph > a.ph_lo) { if (MK_MULTI || a.ph_hi < 0) grid.sync(); else xcd_barrier(xbar);
#ifdef SYNC_REP
            xcd_barrier(xbar); xcd_barrier(xbar);
#endif
        }
#ifdef PROBE_GROUP
        if (threadIdx.x == 0) { const unsigned long long now = __builtin_amdgcn_s_memrealtime(); if (prs[2] == (unsigned long long)PROBE_GROUP) prs[1] += now - prs[0]; prs[0] = now;
          if (ph == a.ph_hi) { if (blockIdx.x == 0) { float us_ = (float)prs[1] * 0.01f;
#if PROBE_GROUP == 8
              us_ = (float)((volatile unsigned*)(ws + WS_CTL))[32 * 64] * 0.01f;
#endif
              a.out[0] = floorf((us_ + PROBE_OFF) / PROBE_Q) * PROBE_Q + 0.5f * PROBE_Q; } }
          const int k_ = (ph - 1) % 15; prs[2] = ph == 0 ? 0 : (k_ == 0 || k_ == 3 || k_ == 8 || k_ == 12) ? 1 : (k_ == 1 || k_ == 13) ? 2 : (k_ == 2 || k_ == 14 || k_ == 7 || k_ == 11) ? 3 : (k_ == 4 || k_ == 9) ? 4 : k_ == 5 ? 5 : k_ == 6 ? 6 : 7; }
        if (ph == a.ph_hi) break;
#endif
        int tidp = threadIdx.x; asm volatile("" : "+v"(tidp)); const int tid = tidp, lane = tid & 63, wid = __builtin_amdgcn_readfirstlane(tid >> 6), gw = bid * 8 + wid;
        if (ph == 0) { for (int rp_ = 0; rp_ < ((REPK >> 15) & 1) + 1; ++rp_) { if (PHON(15)) p0_prologue(a, lds, gw, NGW, wid, lane, tid); } continue; }
        const int l = (ph - 1) / 15, kind = (ph - 1) % 15;
        const unsigned char* wl = ws + WS_W + (size_t)l * WL_BYTES;
        if (PHON(0) && (kind == 0 || kind == 3 || kind == 8 || kind == 12)) {
            const float* src = (l == 0 && kind == 0) ? a.in[0] : a.out;
            const float* g = (kind == 0 ? a.in[3] : kind == 3 ? a.in[6] : kind == 8 ? a.in[25] : a.in[32]) + l * DM;
            for (int rp_ = 0; rp_ < (REPK & 1) + 1; ++rp_) norm_phase(src, g, HN, TOK, gw, NGW, lane);
            if (l == 0 && kind == 3) xkv_post(a, gw, NGW, lane);
        }
        if (PHON(1) && (kind == 1 || kind == 13)) {
            pg8::Gemm g{HN, (const bf16_t*)(wl + (kind == 1 ? OFF_F1I : OFF_F2I)), TOK, 2 * FF, DM, DM};
            pg8::StaticOrder S; S.init(TOK, 2 * FF, G, bid);
            pg8::EpiSwiglu E{HID, FF};
            pg8::gemm_phase<pg8::EpiSwiglu, pg8::StaticOrder, true, true>(lds, g, S, E);
        }
        if (PHON(2) && (kind == 2 || kind == 14 || kind == 7 || kind == 11)) {
            pg8::Gemm g; pg8::EpiResid E; E.out = a.out; E.ldc = DM; g.M = TOK; g.N = DM;
            if (kind == 2 || kind == 14) { g.A = HID; g.lda = FF; g.K = FF; g.Bt = (const bf16_t*)(wl + (kind == 2 ? OFF_F1O : OFF_F2O)); E.scale = 0.5f; E.base = (l == 0 && kind == 2) ? a.in[0] : a.out; }
            else if (kind == 7) { g.A = Z; g.lda = ZP; g.K = DM; g.Bt = (const bf16_t*)(wl + OFF_MO); E.scale = 1.f; E.base = a.out; }
            else { g.A = OX; g.lda = 512; g.K = 512; g.Bt = (const bf16_t*)(wl + OFF_XO); E.scale = 1.f; E.base = a.out; }
            pg8::StaticOrder S; S.init(TOK, DM, G, bid);
            const float sc_ = E.scale;
            for (int rp_ = ((REPK >> 2) & 1); rp_ >= 0; --rp_) { E.scale = rp_ ? 0.f : sc_;
            pg8::gemm_phase<pg8::EpiResid, pg8::StaticOrder, true, true>(lds, g, S, E); if (rp_) { __syncthreads(); } }
        }
        if (PHON(4) && (kind == 4 || kind == 9 || (kind == 0 && l == 0))) {
            const int ng = (kind == 0) ? NL : 1;
            for (int rp_ = 0; rp_ < ((REPK >> 4) & 1) + 1; ++rp_)
            for (int gi = 0; gi < ng; ++gi) {
                pg8::Gemm g; pg8::EpiBf16 E; int cidx = bid;
                if (kind == 4) { g.A = HN; g.lda = DM; g.K = DM; g.M = TOK; g.N = 3584; g.Bt = (const bf16_t*)(wl + OFF_MI); E.O = Z; E.ldc = ZP; E.ncols = ZC_VALID; E.halo = (bf16_t*)(ws + WS_ZHALO); }
                else if (kind == 9) { g.A = HN; g.lda = DM; g.K = DM; g.M = TOK; g.N = 512; g.Bt = (const bf16_t*)(wl + OFF_XQ); E.O = QX; E.ldc = 512; E.ncols = 512; E.halo = nullptr; }
                else { g.A = (const bf16_t*)(ws + WS_MEMN) + (size_t)gi * NB * MEMLEN * DM; g.lda = DM; g.K = DM; g.M = NB * MEMLEN; g.N = 1024;
                       g.Bt = (const bf16_t*)(ws + WS_W + (size_t)gi * WL_BYTES + OFF_XKV); E.O = (bf16_t*)(ws + WS_KVX) + (size_t)gi * NB * MEMLEN * 1024; E.ldc = 1024; E.ncols = 1024; E.halo = nullptr;
                       cidx = (bid + gi * (G / 2)) % G; }
                pg8::StaticOrder S; S.init(g.M, g.N, G, cidx);
                pg8::gemm_phase<pg8::EpiBf16, pg8::StaticOrder, true, true>(lds, g, S, E);
            }
        }
        if (PHON(5) && kind == 5) { for (int rp_ = PREP_REP - 1; rp_ >= 0; --rp_) for (int tile = bid; tile < TOK / 64; tile += G) prep_tile(a, l, tile, lds, rp_ > 0); }
        if (PHON(6) && kind == 6) {
            unsigned* ctr = (unsigned*)(ws + WS_CTL) + 64 * (1 + l); LAS unsigned* qw = (LAS unsigned*)(lds + 131072);
            for (;;) {
                __syncthreads();
                if (tid == 0) *qw = atomicAdd(ctr, 1u);
                __syncthreads();
                const int item = __builtin_amdgcn_readfirstlane((int)*qw);
                if (item >= 64 + 1024) break;
                if (item < 64) {
                    if (tid < 32) ((LAS unsigned*)(lds + RW_FLG))[tid] = 0u;
                    __syncthreads();
                    if (PHON(7)) {
                        const int ub = item >> 3, uh = item & 7;
                        if (wid == 0 || wid == 4 || wid == 2 || wid == 6) { if (RWROLES & 1) rwkv_pre(a, ub, uh, lds, wid == 0 ? 0 : wid == 4 ? 1 : wid == 2 ? 2 : 3); }
                        else if (wid == 1) { if (RWROLES & 2) rwkv_main(lds); }
                        else if (wid == 3 || wid == 7) { if (RWROLES & 4) rwkv_post(a, l, ub, uh, lds, wid == 3 ? 0 : 1); }
                    }
                }
                else {
                    const int j = item - 64, qb = 15 - (j >> 6), kk = j & 63, type = kk >> 5, bh = kk & 31, b = bh >> 2, h = bh & 3;
                    bf16_t* Zb = Z + (size_t)b * SEQ * ZP;
                    for (int rp_ = ATT_REP - 1; rp_ >= 0; --rp_)
                    if (type == 0) { if (PHON(8)) attn_unit<0, 64>(lds, Zb + ZC_FQ + 64 * h, ZP, Zb + ZC_FK + 64 * h, ZP, (const bf16_t*)(ws + WS_VTF) + (size_t)bh * 64 * SEQ, SEQ, Zb + ZC_FQ + 64 * h, ZP,
                                                   256 * qb, 4 * (qb + 1), qb, (const float*)(ws + WS_LOGF) + (size_t)bh * SEQ, nullptr, rp_ > 0); }
                    else if (PHON(9)) attn_unit<1, 64>(lds, Zb + ZC_MQ + 64 * h, ZP, Zb + ZC_MK + 64 * h, ZP, (const bf16_t*)(ws + WS_VTM) + (size_t)bh * 64 * SEQ, SEQ, Zb + ZC_MQ + 64 * h, ZP,
                                          256 * qb, 4 * (qb + 1), qb, (const float*)(ws + WS_KMP) + (size_t)bh * 64 * 64, nullptr, rp_ > 0);
                }
            }
        }
        if (PHON(10) && kind == 10) {
            for (int rp_ = 0; rp_ < ((REPK >> 10) & 1) + 1; ++rp_)
            for (int u = bid; u < NB * 4 * 16; u += G) { const int b = u >> 6, hd = (u >> 4) & 3, qb = u & 15;
                bf16_t* qp = QX + (size_t)b * SEQ * 512 + hd * 128;
                attn_unit<2, 128>(lds, qp, 512, (const bf16_t*)(ws + WS_KVX) + ((size_t)l * NB + b) * MEMLEN * 1024 + hd * 128, 1024,
                                  (const bf16_t*)(ws + WS_VTX) + ((size_t)(l * NB + b) * 4 + hd) * 128 * MEMLEN, MEMLEN, OX + (size_t)b * SEQ * 512 + hd * 128, 512, 256 * qb, MEMLEN / 64, qb, nullptr, a.in[29] + l * 128); }
        }
    }
}

extern "C" void kernel_launch(void* const* d_in, const int* in_sizes, int n_in, void* d_out, int out_size, void* d_ws, size_t ws_size, hipStream_t stream) {
    static int grid_blocks = 0;
    if (grid_blocks == 0) {
        if (n_in != 35 || ws_size < WS_END) { fprintf(stderr, "kernel_launch: unexpected n_in %d / ws %zu\n", n_in, ws_size); grid_blocks = -1; return; }
        int dev = 0, cus = 0, per_cu = 0;
        hipGetDevice(&dev); hipDeviceGetAttribute(&cus, hipDeviceAttributeMultiprocessorCount, dev);
        if (hipFuncSetAttribute((const void*)fwd_megakernel, hipFuncAttributeMaxDynamicSharedMemorySize, LDS_BYTES) != hipSuccess) { fprintf(stderr, "kernel_launch: hipFuncSetAttribute failed\n"); grid_blocks = -1; return; }
        if (hipOccupancyMaxActiveBlocksPerMultiprocessor(&per_cu, (const void*)fwd_megakernel, 512, LDS_BYTES) != hipSuccess || per_cu < 1) { fprintf(stderr, "kernel_launch: occupancy query says %d\n", per_cu); per_cu = 1; }
        (void)hipGetLastError();
        grid_blocks = cus * per_cu;
    }
    if (grid_blocks < 0) return;
    Args a{};
    for (int i = 0; i < 35; ++i) a.in[i] = (const float*)d_in[i];
    a.out = (float*)d_out; a.ws = (unsigned char*)d_ws;
    if (hipMemsetAsync(d_ws, 0, 65536, stream) != hipSuccess) { fprintf(stderr, "kernel_launch: memset failed\n"); return; }
#if MK_MULTI
    for (int ph = 0; ph < N_PHASES; ++ph) { a.ph_lo = ph; a.ph_hi = ph + 1; hipLaunchKernelGGL(fwd_megakernel, dim3(grid_blocks), dim3(512), LDS_BYTES, stream, a); }
#else
    a.ph_lo = 0; a.ph_hi = N_PHASES;
    void* args[] = {&a};
    hipError_t e = hipLaunchCooperativeKernel((const void*)fwd_megakernel, dim3(grid_blocks), dim3(512), args, LDS_BYTES, stream);
    if (e != hipSuccess) fprintf(stderr, "cooperative launch failed: %s (grid %d)\n", hipGetErrorString(e), grid_blocks);
#endif
}
```

```cpp
#include <hip/hip_runtime.h>
#include <hip/hip_cooperative_groups.h>
#include <cstdio>
#include <cstdint>
namespace cg = cooperative_groups;
namespace pg8 {
#define PG8_LAS __attribute__((address_space(3)))
typedef unsigned short bf16_t;
typedef short bf16x8 __attribute__((ext_vector_type(8)));
typedef float f32x4 __attribute__((ext_vector_type(4)));
typedef unsigned u32x4 __attribute__((ext_vector_type(4)));
constexpr int BM = 256, BK = 64, HALF = 128, HTB = HALF * BK * 2  , STAGE_BYTES = 8 * HTB, NXCD = 8, WGM = 8;

__host__ __device__ __forceinline__ int lds_byte(int r, int c) { const int st = (r >> 4) * 2 + (c >> 5), rr = r & 15, cc = c & 31, ob = rr * 64 + cc * 2; return st * 1024 + (ob ^ (((ob >> 9) & 1) << 5)); }
__host__ __device__ __forceinline__ void stage_rc(int b, int& R, int& C) { const int st = b / 1024, sb = b % 1024, swz = sb ^ (((sb >> 9) & 1) << 5); R = (st >> 1) * 16 + swz / 64; C = (st & 1) * 32 + (swz % 64) / 2; }
__host__ __device__ __forceinline__ int perm32(int rho) { const int n = rho >> 4, i = rho & 15; return 8 * (i >> 2) + 4 * n + (i & 3); }

struct Unit { int pm, pn; };
struct Gemm { const bf16_t* A; const bf16_t* Bt; int M, N, K, lda; };

struct StaticOrder {
    int nM, nN, nwg, G, c;
    __host__ __device__ void init(int M, int N, int G_, int c_) { nM = M / BM; nN = N / BM; nwg = nM * nN; G = G_; c = c_; }
    __host__ __device__ bool next(int i, Unit& u) const {
        const long L = (long)i * G + c; if (L >= nwg) return false;
        int wgid = (int)L; { const int q = nwg / NXCD, r = nwg % NXCD, xcd = wgid % NXCD, off = wgid / NXCD; wgid = (xcd < r ? xcd * (q + 1) : r * (q + 1) + (xcd - r) * q) + off; }
        const int nig = WGM * nN, gid = wgid / nig, fm = gid * WGM, gsz = (nM - fm) < WGM ? (nM - fm) : WGM;
        u.pm = fm + ((wgid % nig) % gsz); u.pn = (wgid % nig) / gsz; return true;
    }
    __device__ __forceinline__ void a_ready(const Unit&) const {}
    __device__ __forceinline__ void done(const Unit&) const {}
};
__device__ __forceinline__ unsigned cvt_pk_bf16(float lo, float hi) { unsigned r; asm volatile("v_cvt_pk_bf16_f32 %0, %1, %2" : "=v"(r) : "v"(lo), "v"(hi)); return r; }
__device__ __forceinline__ float silu_f(float x) { return x * __builtin_amdgcn_rcpf(1.0f + __builtin_amdgcn_exp2f(-1.4426950408889634f * x)); }
struct EpiSwiglu {
    static constexpr bool PERM = true, AFTER_DRAIN = false;
    bf16_t* O; int ldc;
    __device__ __forceinline__ void operator()(const f32x4 (&acc)[2][2][4][2], const Unit& u, int wr, int wc, int fr, int fq) const {
        const int row0 = u.pm * BM + wr * 64 + fr, col0 = u.pn * HALF + wc * 32 + 8 * fq;
#pragma unroll
        for (int ai = 0; ai < 2; ++ai)
#pragma unroll
            for (int m = 0; m < 4; ++m) {
                const f32x4 g0 = acc[ai][0][m][0], g1 = acc[ai][0][m][1], u0 = acc[ai][1][m][0], u1 = acc[ai][1][m][1];
                u32x4 w;
                w.x = cvt_pk_bf16(silu_f(g0[0]) * u0[0], silu_f(g0[1]) * u0[1]); w.y = cvt_pk_bf16(silu_f(g0[2]) * u0[2], silu_f(g0[3]) * u0[3]);
                w.z = cvt_pk_bf16(silu_f(g1[0]) * u1[0], silu_f(g1[1]) * u1[1]); w.w = cvt_pk_bf16(silu_f(g1[2]) * u1[2], silu_f(g1[3]) * u1[3]);
                *(u32x4*)(O + (size_t)(row0 + ai * HALF + m * 16) * ldc + col0) = w;
            }
    }
};
struct EpiResid {
    static constexpr bool PERM = false, AFTER_DRAIN = false;
    const float* base; float* out; int ldc; float scale;
    __device__ __forceinline__ void operator()(const f32x4 (&acc)[2][2][4][2], const Unit& u, int wr, int wc, int fr, int fq) const {
        const int row0 = u.pm * BM + wr * 64 + fr, col0 = u.pn * BM + wc * 32 + 4 * fq;
#pragma unroll
        for (int ai = 0; ai < 2; ++ai)
#pragma unroll
            for (int m = 0; m < 4; ++m) { const size_t off = (size_t)(row0 + ai * HALF + m * 16) * ldc + col0;
#pragma unroll
                for (int bj = 0; bj < 2; ++bj)
#pragma unroll
                    for (int n = 0; n < 2; ++n) { const f32x4 b = *(const f32x4*)(base + off + bj * HALF + n * 16); *(f32x4*)(out + off + bj * HALF + n * 16) = b + acc[ai][bj][m][n] * scale; }
                asm volatile("" ::: "memory"); }
    }
};
struct EpiBf16 {
    static constexpr bool PERM = true, AFTER_DRAIN = false;
    bf16_t* O; int ldc; int ncols; bf16_t* halo;
    __device__ __forceinline__ void operator()(const f32x4 (&acc)[2][2][4][2], const Unit& u, int wr, int wc, int fr, int fq) const {
        const int row0 = u.pm * BM + wr * 64 + fr, col0 = u.pn * BM + wc * 32 + 8 * fq;
#pragma unroll
        for (int ai = 0; ai < 2; ++ai)
#pragma unroll
            for (int m = 0; m < 4; ++m) { const int row = row0 + ai * HALF + m * 16;
#pragma unroll
                for (int bj = 0; bj < 2; ++bj) { const int col = col0 + bj * HALF;
                    if (col < ncols) { const f32x4 v0 = acc[ai][bj][m][0], v1 = acc[ai][bj][m][1]; u32x4 w;
                        w.x = cvt_pk_bf16(v0[0], v0[1]); w.y = cvt_pk_bf16(v0[2], v0[3]); w.z = cvt_pk_bf16(v1[0], v1[1]); w.w = cvt_pk_bf16(v1[2], v1[3]);
                        *(u32x4*)(O + (size_t)row * ldc + col) = w;
                        if (halo && (row & 63) == 63) *(u32x4*)(halo + (size_t)(row >> 6) * ldc + col) = w; } } }
    }
};
template <class Epi, class Sched, bool ALIGN_EPI = false, bool SP2 = false>
__device__ __forceinline__ void gemm_phase(PG8_LAS unsigned char* lds, const Gemm g, const Sched& S, const Epi& E) {
    int tid_ = threadIdx.x; asm volatile("" : "+v"(tid_)); const int tid = tid_, wid = __builtin_amdgcn_readfirstlane(tid >> 6), lane = tid & 63, wr = wid >> 2, wc = wid & 3, fr = lane & 15, fq = lane >> 4;
    const int K = g.K, nt = K / BK;
    unsigned voffA[2], voffB[2];
#pragma unroll
    for (int i = 0; i < 2; ++i) { int R, C; stage_rc(tid * 16 + i * 8192, R, C); const int Rb = Epi::PERM ? ((R & ~31) + perm32(R & 31)) : R;
        voffA[i] = (unsigned)(R * g.lda + C) * 2u; voffB[i] = (unsigned)(Rb * K + C) * 2u; }
    const size_t kstep = (size_t)(BK * 2);
    const size_t hstep = (size_t)HALF * K * 2;
    const size_t tstep = 2 * hstep; const size_t hstepA = (size_t)HALF * g.lda * 2, tstepA = 2 * hstepA;
    const unsigned ldsw = (unsigned)wid * 1024u;
    const int aoff = lds_byte(wr * 64 + fr, fq * 8), boff = lds_byte(wc * 32 + fr, fq * 8);
#define PG8_SA(b, h) (((b) * 2 + (h)) * HTB)
#define PG8_SB(b, h) ((4 + (b) * 2 + (h)) * HTB)
#define PG8_STAGE(bufoff, gbase, voff) do { _Pragma("unroll") for (int _i = 0; _i < 2; ++_i) \
        __builtin_amdgcn_global_load_lds((const unsigned*)((const char*)(gbase) + (voff)[_i]), (PG8_LAS unsigned*)(lds + (bufoff) + ldsw + _i * 8192), 16, 0, 0); } while (0)
#define PG8_LDA(dst, b, h) do { _Pragma("unroll") for (int m = 0; m < 4; ++m) _Pragma("unroll") for (int k = 0; k < 2; ++k) dst[m][k] = *(const PG8_LAS bf16x8*)(lds + PG8_SA(b, h) + aoff + m * 2048 + k * 1024); } while (0)
#define PG8_LDB(dst, b, h) do { _Pragma("unroll") for (int n = 0; n < 2; ++n) _Pragma("unroll") for (int k = 0; k < 2; ++k) dst[n][k] = *(const PG8_LAS bf16x8*)(lds + PG8_SB(b, h) + boff + n * 2048 + k * 1024); } while (0)
#define PG8_MMA(ai, bj, At, Bt) do { __builtin_amdgcn_s_setprio(1); _Pragma("unroll") for (int m = 0; m < 4; ++m) _Pragma("unroll") for (int n = 0; n < 2; ++n) _Pragma("unroll") for (int k = 0; k < 2; ++k) \
        acc[ai][bj][m][n] = __builtin_amdgcn_mfma_f32_16x16x32_bf16(Bt[n][k], At[m][k], acc[ai][bj][m][n], 0, 0, 0); __builtin_amdgcn_s_setprio(0); } while (0)
#define PG8_WAIT_V(n) asm volatile("s_waitcnt vmcnt(" #n ")" ::: "memory")
#define PG8_WAIT_L(n) asm volatile("s_waitcnt lgkmcnt(" #n ")" ::: "memory")
#define PG8_BAR __builtin_amdgcn_s_barrier()
#define PG8_SCHED __builtin_amdgcn_sched_barrier(0)
    Unit cur, nxt; int ui = 0;
    if (!S.next(0, cur)) return;
    f32x4 acc[2][2][4][2];
#pragma unroll
    for (int a = 0; a < 2; ++a)
#pragma unroll
        for (int b = 0; b < 2; ++b)
#pragma unroll
            for (int m = 0; m < 4; ++m)
#pragma unroll
                for (int n = 0; n < 2; ++n) acc[a][b][m][n] = (f32x4){0.f, 0.f, 0.f, 0.f};
    bf16x8 At[4][2], B0[2][2], B1[2][2];
    const char* cA = (const char*)g.A + (size_t)cur.pm * tstepA; const char* cB = (const char*)g.Bt + (size_t)cur.pn * tstep;
    S.a_ready(cur);
    if constexpr (SP2) {
        PG8_STAGE(PG8_SB(0, 0), cB, voffB); PG8_STAGE(PG8_SB(0, 1), cB + hstep, voffB); PG8_STAGE(PG8_SA(0, 0), cA, voffA); PG8_STAGE(PG8_SA(0, 1), cA + hstepA, voffA);
        if (wr == 1) PG8_BAR;
        PG8_WAIT_V(2); PG8_BAR;
        PG8_STAGE(PG8_SB(1, 0), cB + kstep, voffB); PG8_STAGE(PG8_SA(1, 0), cA + kstep, voffA); PG8_STAGE(PG8_SB(1, 1), cB + hstep + kstep, voffB);
        PG8_WAIT_V(6); PG8_BAR;
    } else {
        PG8_STAGE(PG8_SB(0, 0), cB, voffB); PG8_STAGE(PG8_SA(0, 0), cA, voffA); PG8_STAGE(PG8_SB(0, 1), cB + hstep, voffB); PG8_STAGE(PG8_SA(0, 1), cA + hstepA, voffA);
        if (wr == 1) PG8_BAR;
        PG8_WAIT_V(4); PG8_BAR;
        PG8_STAGE(PG8_SB(1, 0), cB + kstep, voffB); PG8_STAGE(PG8_SA(1, 0), cA + kstep, voffA); PG8_STAGE(PG8_SB(1, 1), cB + hstep + kstep, voffB);
        PG8_WAIT_V(6); PG8_BAR;
    }
    for (;;) {
        const bool has_next = S.next(ui + 1, nxt);
        const char* nA = has_next ? (const char*)g.A + (size_t)nxt.pm * tstepA : cA; const char* nB = has_next ? (const char*)g.Bt + (size_t)nxt.pn * tstep : cB;
        for (int t = 0; t < nt; t += 2) {
            const bool last = (t == nt - 2);
            const char* a1 = cA + (size_t)(t + 1) * kstep;
            const char* a2 = last ? nA : cA + (size_t)(t + 2) * kstep; const char* b2 = last ? nB : cB + (size_t)(t + 2) * kstep;
            const char* a3 = a2 + kstep; const char* b3 = b2 + kstep;
            if (last && has_next) S.a_ready(nxt);
            if constexpr (SP2) {
            PG8_LDB(B0, 0, 0); PG8_LDB(B1, 0, 1); PG8_SCHED; PG8_LDA(At, 0, 0); PG8_STAGE(PG8_SA(1, 1), a1 + hstepA, voffA);
            PG8_WAIT_V(8); PG8_WAIT_L(0); PG8_BAR; PG8_MMA(0, 0, At, B0); PG8_MMA(0, 1, At, B1); PG8_BAR; PG8_SCHED;
            PG8_LDA(At, 0, 1); PG8_STAGE(PG8_SB(0, 0), b2, voffB); PG8_STAGE(PG8_SB(0, 1), b2 + hstep, voffB); PG8_STAGE(PG8_SA(0, 0), a2, voffA);
            PG8_WAIT_V(8); PG8_WAIT_L(0); PG8_BAR; PG8_MMA(1, 0, At, B0); PG8_MMA(1, 1, At, B1); PG8_BAR; PG8_SCHED;
            PG8_LDB(B0, 1, 0); PG8_LDB(B1, 1, 1); PG8_SCHED; PG8_LDA(At, 1, 0); PG8_STAGE(PG8_SA(0, 1), a2 + hstepA, voffA);
            PG8_WAIT_V(8); PG8_WAIT_L(0); PG8_BAR; PG8_MMA(0, 0, At, B0); PG8_MMA(0, 1, At, B1); PG8_BAR; PG8_SCHED;
            PG8_LDA(At, 1, 1); PG8_STAGE(PG8_SB(1, 0), b3, voffB); PG8_STAGE(PG8_SB(1, 1), b3 + hstep, voffB); PG8_STAGE(PG8_SA(1, 0), a3, voffA);
            PG8_WAIT_V(8); PG8_WAIT_L(0); PG8_BAR; PG8_MMA(1, 0, At, B0); PG8_MMA(1, 1, At, B1); PG8_BAR; PG8_SCHED;
            } else {
            PG8_LDB(B0, 0, 0); PG8_SCHED; PG8_LDA(At, 0, 0); PG8_STAGE(PG8_SA(1, 1), a1 + hstepA, voffA);
            PG8_WAIT_L(8); PG8_BAR; PG8_WAIT_L(0); PG8_MMA(0, 0, At, B0); PG8_BAR; PG8_SCHED;
            PG8_LDB(B1, 0, 1); PG8_STAGE(PG8_SB(0, 0), b2, voffB);
            PG8_BAR; PG8_WAIT_L(0); PG8_MMA(0, 1, At, B1); PG8_BAR;
            PG8_LDA(At, 0, 1); PG8_STAGE(PG8_SA(0, 0), a2, voffA);
            PG8_BAR; PG8_WAIT_L(0); PG8_MMA(1, 0, At, B0); PG8_BAR; PG8_SCHED;
            PG8_STAGE(PG8_SB(0, 1), b2 + hstep, voffB);
            PG8_WAIT_V(6); PG8_BAR; PG8_MMA(1, 1, At, B1); PG8_BAR;
            PG8_LDB(B0, 1, 0); PG8_SCHED; PG8_LDA(At, 1, 0); PG8_STAGE(PG8_SA(0, 1), a2 + hstepA, voffA);
            PG8_WAIT_L(8); PG8_BAR; PG8_WAIT_L(0); PG8_MMA(0, 0, At, B0); PG8_BAR; PG8_SCHED;
            PG8_LDB(B1, 1, 1); PG8_STAGE(PG8_SB(1, 0), b3, voffB);
            PG8_BAR; PG8_WAIT_L(0); PG8_MMA(0, 1, At, B1); PG8_BAR;
            PG8_LDA(At, 1, 1); PG8_STAGE(PG8_SA(1, 0), a3, voffA);
            PG8_BAR; PG8_WAIT_L(0); PG8_MMA(1, 0, At, B0); PG8_BAR; PG8_SCHED;
            PG8_STAGE(PG8_SB(1, 1), b3 + hstep, voffB);
            PG8_WAIT_V(6); PG8_BAR; PG8_MMA(1, 1, At, B1); PG8_BAR;
            }
        }
        if constexpr (ALIGN_EPI) { if (wr == 0) PG8_BAR; }
        if constexpr (!Epi::AFTER_DRAIN) { E(acc, cur, wr, wc, fr, fq); S.done(cur); }
        if (!has_next) break;
#pragma unroll
        for (int a = 0; a < 2; ++a)
#pragma unroll
            for (int b = 0; b < 2; ++b)
#pragma unroll
                for (int m = 0; m < 4; ++m)
#pragma unroll
                    for (int n = 0; n < 2; ++n) acc[a][b][m][n] = (f32x4){0.f, 0.f, 0.f, 0.f};
        cur = nxt; cA = nA; cB = nB; ++ui;
        if constexpr (ALIGN_EPI) { if (wr == 1) PG8_BAR; }
    }
    PG8_WAIT_V(0);
    if constexpr (!ALIGN_EPI) { if (wr == 0) PG8_BAR; }
    PG8_BAR;
    if constexpr (Epi::AFTER_DRAIN) { E.fused(acc, cur, wr, wc, fr, fq, lds, wid, lane); S.done(cur); }
#undef PG8_SA
#undef PG8_SB
#undef PG8_STAGE
#undef PG8_LDA
#undef PG8_LDB
#undef PG8_MMA
#undef PG8_WAIT_V
#undef PG8_WAIT_L
#undef PG8_BAR
#undef PG8_SCHED
}
}

#define LAS __attribute__((address_space(3)))
#define DEV __device__ __forceinline__
typedef unsigned short bf16_t;
typedef short bf16x8 __attribute__((ext_vector_type(8)));
typedef short s16x4 __attribute__((ext_vector_type(4)));
typedef float f32x4 __attribute__((ext_vector_type(4)));
typedef float f32x16 __attribute__((ext_vector_type(16)));
typedef unsigned u32x2 __attribute__((ext_vector_type(2)));
typedef unsigned u32x4 __attribute__((ext_vector_type(4)));
typedef unsigned u32x8 __attribute__((ext_vector_type(8)));

constexpr int NB = 8, SEQ = 4096, DM = 1024, TOK = NB * SEQ, FF = 2816, NL = 2, MEMLEN = 256;
constexpr int ZP = 3392;
constexpr int ZC_FQ = 0, ZC_RR = 256, ZC_MQ = 768, ZC_FK = 1024, ZC_FV = 1280, ZC_MK = 1536, ZC_MV = 1792, ZC_RK = 2048, ZC_RV = 2560, ZC_LO = 3072, ZC_FF = 3360, ZC_VALID = 3368;
constexpr float NORM_EPS = 1e-6f, GN_EPS = 64e-5f, LOG2E = 1.4426950408889634f;
constexpr float C2_64 = 0.125f * LOG2E, C2_128 = 0.08838834764831845f * LOG2E;
constexpr size_t MiB = 1u << 20;
constexpr size_t WS_CTL = 0;
constexpr size_t WS_W = 1 * MiB, WL_BYTES = 48 * MiB;
constexpr size_t OFF_F1I = 0, OFF_F1O = 11 * MiB, OFF_F2I = 17 * MiB, OFF_F2O = 28 * MiB, OFF_MI = 34 * MiB, OFF_MO = 41 * MiB, OFF_XQ = 43 * MiB, OFF_XKV = 44 * MiB, OFF_XO = 46 * MiB;
constexpr size_t OFF_W2T = 47 * MiB, OFF_A2T = OFF_W2T + 65536, OFF_G2T = OFF_A2T + 65536;
constexpr size_t WS_Z = 97 * MiB;
constexpr size_t WS_C = WS_Z + 212 * MiB;
constexpr size_t WS_HN = WS_C;
constexpr size_t WS_WD = WS_C, WS_KK = WS_C + 64 * MiB, WS_KA = WS_C + 96 * MiB;
constexpr size_t WS_VTF = WS_C + 128 * MiB, WS_VTM = WS_C + 144 * MiB;
constexpr size_t WS_LOGF = WS_C + 160 * MiB, WS_KMP = WS_LOGF + 512 * 1024, WS_ZHALO = WS_C + 161 * MiB;
constexpr size_t WS_KVX = WS_C + 165 * MiB, WS_VTX = WS_C + 173 * MiB, WS_MEMN = WS_C + 177 * MiB, WS_END = WS_C + 185 * MiB;
static_assert(WS_END <= 512 * MiB, "workspace map");
constexpr int LDS_BYTES = 131072 + 1024;

struct Args { const float* in[35]; float* out; unsigned char* ws; int ph_lo, ph_hi; };

DEV float bf2f(unsigned short b) { return __uint_as_float((unsigned)b << 16); }
typedef float f32x2_t __attribute__((ext_vector_type(2))); typedef __bf16 bf16x2_t __attribute__((ext_vector_type(2)));
DEV unsigned pk2(float lo, float hi) { const f32x2_t v = {lo, hi}; const bf16x2_t r = __builtin_convertvector(v, bf16x2_t); return __builtin_bit_cast(unsigned, r); }
DEV unsigned f2bf(float f) { return pk2(f, f) & 0xffffu; }
DEV float wave_sum(float v) {
#pragma unroll
    for (int o = 1; o < 64; o <<= 1) v += __shfl_xor(v, o);
    return v;
}
#define LDS_WAIT() asm volatile("s_waitcnt lgkmcnt(0)" ::: "memory")

struct MatInfo { const float* src; bf16_t* dst; int K, Ns, Nd, map; };
DEV MatInfo matinfo(const Args& a, int m) {
    const int l = m / 12, k = m % 12; unsigned char* wl = a.ws + WS_W + (size_t)l * WL_BYTES; MatInfo r;
    switch (k) {
    case 0:  r.src = a.in[4] + (size_t)l * DM * 2 * FF;  r.dst = (bf16_t*)(wl + OFF_F1I); r.K = DM; r.Ns = 2 * FF; r.Nd = 2 * FF; r.map = 1; break;
    case 1:  r.src = a.in[5] + (size_t)l * FF * DM;      r.dst = (bf16_t*)(wl + OFF_F1O); r.K = FF; r.Ns = DM; r.Nd = DM; r.map = 0; break;
    case 2:  r.src = a.in[33] + (size_t)l * DM * 2 * FF; r.dst = (bf16_t*)(wl + OFF_F2I); r.K = DM; r.Ns = 2 * FF; r.Nd = 2 * FF; r.map = 1; break;
    case 3:  r.src = a.in[34] + (size_t)l * FF * DM;     r.dst = (bf16_t*)(wl + OFF_F2O); r.K = FF; r.Ns = DM; r.Nd = DM; r.map = 0; break;
    case 4:  r.src = a.in[7] + (size_t)l * DM * 3364;    r.dst = (bf16_t*)(wl + OFF_MI);  r.K = DM; r.Ns = 3364; r.Nd = 3584; r.map = 2; break;
    case 5:  r.src = a.in[8] + (size_t)l * DM * DM;      r.dst = (bf16_t*)(wl + OFF_MO);  r.K = DM; r.Ns = DM; r.Nd = DM; r.map = 0; break;
    case 6:  r.src = a.in[27] + (size_t)l * DM * 512;    r.dst = (bf16_t*)(wl + OFF_XQ);  r.K = DM; r.Ns = 512; r.Nd = 512; r.map = 0; break;
    case 7:  r.src = a.in[28] + (size_t)l * DM * 1024;   r.dst = (bf16_t*)(wl + OFF_XKV); r.K = DM; r.Ns = 1024; r.Nd = 1024; r.map = 0; break;
    case 8:  r.src = a.in[31] + (size_t)l * 512 * DM;    r.dst = (bf16_t*)(wl + OFF_XO);  r.K = 512; r.Ns = DM; r.Nd = DM; r.map = 0; break;
    case 9:  r.src = a.in[16] + (size_t)l * 64 * 512;    r.dst = (bf16_t*)(wl + OFF_W2T); r.K = 64; r.Ns = 512; r.Nd = 512; r.map = 0; break;
    case 10: r.src = a.in[18] + (size_t)l * 64 * 512;    r.dst = (bf16_t*)(wl + OFF_A2T); r.K = 64; r.Ns = 512; r.Nd = 512; r.map = 0; break;
    default: r.src = a.in[19] + (size_t)l * 160 * 512;   r.dst = (bf16_t*)(wl + OFF_G2T); r.K = 160; r.Ns = 512; r.Nd = 512; r.map = 0; break;
    }
    return r;
}
DEV int srccol(int map, int n) {
    if (map == 0) return n;
    if (map == 1) { const int p = n >> 8, r = n & 255; return r < 128 ? p * 128 + r : FF + p * 128 + (r - 128); }
    if (n < 256) return n;
    if (n < 768) return 1540 + (n - 256);
    if (n < 1024) return 772 + (n - 768);
    if (n < 1280) return 256 + (n - 1024);
    if (n < 1536) return 512 + (n - 1280);
    if (n < 1792) return 1028 + (n - 1536);
    if (n < 2048) return 1284 + (n - 1792);
    if (n < 2560) return 2052 + (n - 2048);
    if (n < 3072) return 2564 + (n - 2560);
    if (n < 3360) return 3076 + (n - 3072);
    if (n < 3364) return 768 + (n - 3360);
    return -1;
}
DEV void transpose_item(const MatInfo& mi, LAS float* scr, int item, int lane) {
    const int nblk = mi.Nd / 32, kb = item / nblk, nb = item % nblk, k0 = 64 * kb, n0 = 32 * nb;
    const int n4 = (lane & 7) * 4, sc = srccol(mi.map, n0 + n4);
#pragma unroll
    for (int i = 0; i < 8; ++i) { const int kk = 8 * i + (lane >> 3), k = k0 + kk;
        const f32x4 v = (sc >= 0 && k < mi.K) ? *(const f32x4*)(mi.src + (size_t)k * mi.Ns + sc) : (f32x4){0.f, 0.f, 0.f, 0.f};
        LAS float* d = scr + kk * 33 + n4; d[0] = v[0]; d[1] = v[1]; d[2] = v[2]; d[3] = v[3]; }
    LDS_WAIT(); asm volatile("" ::: "memory");
    const int c = lane & 7;
#pragma unroll
    for (int j = 0; j < 4; ++j) { const int n = (lane >> 3) + 8 * j; const LAS float* s = scr + (8 * c) * 33 + n;
        u32x4 o; o.x = pk2(s[0 * 33], s[1 * 33]); o.y = pk2(s[2 * 33], s[3 * 33]); o.z = pk2(s[4 * 33], s[5 * 33]); o.w = pk2(s[6 * 33], s[7 * 33]);
        if (k0 + 8 * c < mi.K) *(u32x4*)(mi.dst + (size_t)(n0 + n) * mi.K + k0 + 8 * c) = o; }
    LDS_WAIT(); asm volatile("" ::: "memory");
}
DEV void norm_row(const float* xrow, const float* g, bf16_t* orow, int lane) {
    const f32x4* xr = (const f32x4*)xrow + lane; const f32x4* gr = (const f32x4*)g + lane;
    f32x4 v[4]; float s = 0.f;
#pragma unroll
    for (int j = 0; j < 4; ++j) { v[j] = xr[64 * j]; s += (v[j].x * v[j].x + v[j].y * v[j].y) + (v[j].z * v[j].z + v[j].w * v[j].w); }
    const float rstd = rsqrtf(wave_sum(s) * (1.f / DM) + NORM_EPS);
    u32x2* o8 = (u32x2*)orow + lane;
#pragma unroll
    for (int j = 0; j < 4; ++j) { const f32x4 gg = gr[64 * j]; u32x2 w; w.x = pk2(v[j].x * rstd * gg.x, v[j].y * rstd * gg.y); w.y = pk2(v[j].z * rstd * gg.z, v[j].w * rstd * gg.w); o8[64 * j] = w; }
}
DEV void norm_row2(const float* xa, const float* xb, const float* g, bf16_t* oa, bf16_t* ob, int lane) {
    const f32x4* xra = (const f32x4*)xa + lane; const f32x4* xrb = (const f32x4*)xb + lane; const f32x4* gr = (const f32x4*)g + lane;
    f32x4 va[4], vb[4]; float sa = 0.f, sb = 0.f;
#pragma unroll
    for (int j = 0; j < 4; ++j) { va[j] = xra[64 * j]; vb[j] = xrb[64 * j]; }
#pragma unroll
    for (int j = 0; j < 4; ++j) { sa += (va[j].x * va[j].x + va[j].y * va[j].y) + (va[j].z * va[j].z + va[j].w * va[j].w); sb += (vb[j].x * vb[j].x + vb[j].y * vb[j].y) + (vb[j].z * vb[j].z + vb[j].w * vb[j].w); }
#pragma unroll
    for (int o = 1; o < 64; o <<= 1) { sa += __shfl_xor(sa, o); sb += __shfl_xor(sb, o); }
    const float ra = rsqrtf(sa * (1.f / DM) + NORM_EPS), rb = rsqrtf(sb * (1.f / DM) + NORM_EPS);
    u32x2* o8a = (u32x2*)oa + lane; u32x2* o8b = (u32x2*)ob + lane;
#pragma unroll
    for (int j = 0; j < 4; ++j) { const f32x4 gg = gr[64 * j]; u32x2 w; w.x = pk2(va[j].x * ra * gg.x, va[j].y * ra * gg.y); w.y = pk2(va[j].z * ra * gg.z, va[j].w * ra * gg.w); o8a[64 * j] = w;
        w.x = pk2(vb[j].x * rb * gg.x, vb[j].y * rb * gg.y); w.y = pk2(vb[j].z * rb * gg.z, vb[j].w * rb * gg.w); o8b[64 * j] = w; }
}
DEV void norm_phase(const float* x, const float* g, bf16_t* out, int nrows, int gw, int NGW, int lane) {
    int m = gw;
    for (; m + NGW < nrows; m += 2 * NGW) norm_row2(x + (size_t)m * DM, x + (size_t)(m + NGW) * DM, g, out + (size_t)m * DM, out + (size_t)(m + NGW) * DM, lane);
    if (m < nrows) norm_row(x + (size_t)m * DM, g, out + (size_t)m * DM, lane);
}
DEV void p0_prologue(const Args& a, LAS unsigned char* lds, int gw, int NGW, int wid, int lane, int tid) {
    LAS float* scr = (LAS float*)(lds + wid * 8704);
    int base = 0;
    for (int m = 0; m < 24; ++m) {
        const MatInfo mi = matinfo(a, m); const int items = ((mi.K + 63) / 64) * (mi.Nd / 32);
        int first = gw - (base % NGW); if (first < 0) first += NGW;
        for (int it = first; it < items; it += NGW) transpose_item(mi, scr, it, lane);
        base += items;
    }
    for (int m = gw; m < NL * NB * MEMLEN; m += NGW) { const int l = m / (NB * MEMLEN), r = m % (NB * MEMLEN);
        norm_row(a.in[1] + (size_t)r * DM, a.in[26] + l * DM, (bf16_t*)(a.ws + WS_MEMN) + (size_t)m * DM, lane); }
    if (blockIdx.x == 0 && tid < 64) ((unsigned*)(a.ws + WS_CTL))[tid * 64] = 0u;
}
DEV void xkv_post(const Args& a, int gw, int NGW, int lane) {
    for (int it = gw; it < NL * NB * MEMLEN * 4; it += NGW) {
        const int hd = it & 3, row = (it >> 2) % (NB * MEMLEN), l = it / (4 * NB * MEMLEN), b = row / MEMLEN, m = row % MEMLEN;
        bf16_t* kr = (bf16_t*)(a.ws + WS_KVX) + ((size_t)l * NB * MEMLEN + row) * 1024 + hd * 128;
        const unsigned kv = *((const unsigned*)kr + lane); float k0 = bf2f(kv & 0xffff), k1 = bf2f(kv >> 16);
        const float rstd = rsqrtf(wave_sum(k0 * k0 + k1 * k1) * (1.f / 128) + NORM_EPS);
        const float* kg = a.in[30] + l * 128;
        *((unsigned*)kr + lane) = pk2(k0 * rstd * kg[2 * lane], k1 * rstd * kg[2 * lane + 1]);
        const unsigned vv = *((const unsigned*)(kr + 512) + lane);
        bf16_t* vt = (bf16_t*)(a.ws + WS_VTX) + (((size_t)(l * NB + b) * 4 + hd) * 128) * MEMLEN + m;
        vt[(size_t)(2 * lane) * MEMLEN] = (bf16_t)(vv & 0xffff); vt[(size_t)(2 * lane + 1) * MEMLEN] = (bf16_t)(vv >> 16);
    }
}

DEV float sigmoid_f(float x) { return __builtin_amdgcn_rcpf(1.0f + __builtin_amdgcn_exp2f(-LOG2E * x)); }
DEV float tanh_f(float x) { const float e = __builtin_amdgcn_exp2f(-2.f * LOG2E * fabsf(x)); const float t = (1.f - e) * __builtin_amdgcn_rcpf(1.f + e); return x < 0.f ? -t : t; }
DEV void unpack8(const u32x4 v, float (&f)[8]) {
    f[0] = __uint_as_float(v.x << 16); f[1] = __uint_as_float(v.x & 0xffff0000u); f[2] = __uint_as_float(v.y << 16); f[3] = __uint_as_float(v.y & 0xffff0000u);
    f[4] = __uint_as_float(v.z << 16); f[5] = __uint_as_float(v.z & 0xffff0000u); f[6] = __uint_as_float(v.w << 16); f[7] = __uint_as_float(v.w & 0xffff0000u);
}
DEV u32x4 pack8(const float (&f)[8]) { u32x4 o; o.x = pk2(f[0], f[1]); o.y = pk2(f[2], f[3]); o.z = pk2(f[4], f[5]); o.w = pk2(f[6], f[7]); return o; }
DEV int crow(int r, int hi) { return (r & 3) + 8 * (r >> 2) + 4 * hi; }

DEV void prep_tile(const Args& a, int l, int tile, LAS unsigned char* lds, bool dry = false) {
    int tid_ = threadIdx.x; asm volatile("" : "+v"(tid_)); const int tid = tid_, lane = tid & 63, wid = __builtin_amdgcn_readfirstlane(tid >> 6);
    const int row0 = tile * 64, b = row0 / SEQ, t0 = row0 % SEQ;
    bf16_t* Z = (bf16_t*)(a.ws + WS_Z) + (size_t)row0 * ZP;
    {
        const int ch = tid % 228, sub = tid / 228; const bool act = tid < 456;
        const int col = ch < 64 ? ZC_RR + 8 * ch : ZC_RK + 8 * (ch - 64), mi = ch < 64 ? 8 * ch : 512 + 8 * (ch - 64);
        const int ts = 32 * sub; float prev[8], mu[8];
#pragma unroll
        for (int i = 0; i < 8; ++i) { prev[i] = 0.f; mu[i] = 0.f; }
        if (act) {
            const float* mup = a.in[14] + l * 1824 + mi;
#pragma unroll
            for (int i = 0; i < 8; ++i) mu[i] = mup[i];
            if (sub == 1) unpack8(*(const u32x4*)(Z + (size_t)(ts - 1) * ZP + col), prev);
            else if (t0 != 0) unpack8(*(const u32x4*)((const bf16_t*)(a.ws + WS_ZHALO) + (size_t)(tile - 1) * ZP + col), prev);
        }
        __syncthreads();
        if (act) {
#pragma unroll 1
            for (int t8 = 0; t8 < 32; t8 += 8) { u32x4 raw[8];
#pragma unroll
                for (int tt = 0; tt < 8; ++tt) raw[tt] = *(const u32x4*)(Z + (size_t)(ts + t8 + tt) * ZP + col);
#pragma unroll
                for (int tt = 0; tt < 8; ++tt) { float cur[8], o[8]; unpack8(raw[tt], cur);
#pragma unroll
                    for (int i = 0; i < 8; ++i) { o[i] = cur[i] + (prev[i] - cur[i]) * mu[i]; prev[i] = cur[i]; }
                    if (!dry) *(u32x4*)(Z + (size_t)(ts + t8 + tt) * ZP + col) = pack8(o); } }
        }
    }
    LAS float* kbuf = (LAS float*)lds;
    {
        const float* gfq = a.in[10] + l * 64; const float* gfk = a.in[11] + l * 64; const float* gmq = a.in[12] + l * 64; const float* gmk = a.in[13] + l * 64;
        const int* pos = (const int*)a.in[2] + b * SEQ + t0;
#pragma unroll 2
        for (int it = 0; it < 16; ++it) {
            const int item = it * 512 + tid, g8 = item >> 3, sub8 = item & 7, slot = g8 >> 6, token = g8 & 63, h = slot & 3, kind = slot >> 2;
            const int cb = (kind == 0 ? ZC_FQ : kind == 1 ? ZC_FK : kind == 2 ? ZC_MQ : ZC_MK) + 64 * h + 8 * sub8;
            const float* gp = (kind == 0 ? gfq : kind == 1 ? gfk : kind == 2 ? gmq : gmk) + 8 * sub8;
            u32x4* p = (u32x4*)(Z + (size_t)token * ZP + cb); float v[8]; unpack8(*p, v);
            float ss = 0.f;
#pragma unroll
            for (int i = 0; i < 8; ++i) ss += v[i] * v[i];
            ss += __shfl_xor(ss, 1); ss += __shfl_xor(ss, 2); ss += __shfl_xor(ss, 4);
            const float rstd = rsqrtf(ss * (1.f / 64) + NORM_EPS);
#pragma unroll
            for (int i = 0; i < 8; ++i) v[i] = v[i] * rstd * gp[i];
            float pr[8];
#pragma unroll
            for (int i = 0; i < 8; ++i) pr[i] = __shfl_xor(v[i], 1);
            if (kind >= 2 && sub8 < 2) {
                const float posf = (float)pos[token];
#pragma unroll
                for (int i = 0; i < 8; ++i) {
                    const float invf = (float)__builtin_exp2(-(double)i * 0.125 * 18.931568569324174);
                    const float ang = posf * invf; const double rev = (double)ang * 0.15915494309189535; const float fr = (float)(rev - __builtin_floor(rev));
                    const float sn = __builtin_amdgcn_sinf(fr), cs = __builtin_amdgcn_cosf(fr);
                    v[i] = sub8 == 0 ? v[i] * cs - pr[i] * sn : v[i] * cs + pr[i] * sn; }
            }
            if (kind == 3) {
#pragma unroll
                for (int i = 0; i < 8; ++i) kbuf[(token * 4 + h) * 64 + 8 * sub8 + i] = v[i]; }
            if (kind == 0 || kind == 2) {
#pragma unroll
                for (int i = 0; i < 8; ++i) v[i] *= C2_64; }
            if (!dry) *p = pack8(v);
        }
    }
    __syncthreads();
    if (tid < 256) { const int h = tid >> 6, d = tid & 63; float s = 0.f;
        for (int t = 0; t < 64; ++t) s += kbuf[(t * 4 + h) * 64 + d];
        if (!dry) ((float*)(a.ws + WS_KMP))[(((size_t)(b * 4 + h) * 64) + (t0 >> 6)) * 64 + d] = s; }
#pragma unroll 2
    for (int it = 0; it < 8; ++it) {
        const int item = it * 512 + tid, which = item >> 11, rem = item & 2047, tg = rem >> 8, c = rem & 255;
        const bf16_t* src = Z + (size_t)(8 * tg) * ZP + (which ? ZC_MV : ZC_FV) + c; unsigned short e[8];
#pragma unroll
        for (int i = 0; i < 8; ++i) e[i] = src[(size_t)i * ZP];
        u32x4 o; o.x = e[0] | ((unsigned)e[1] << 16); o.y = e[2] | ((unsigned)e[3] << 16); o.z = e[4] | ((unsigned)e[5] << 16); o.w = e[6] | ((unsigned)e[7] << 16);
        bf16_t* vt = (bf16_t*)(a.ws + (which ? WS_VTM : WS_VTF)) + ((size_t)(b * 4 + (c >> 6)) * 64 + (c & 63)) * SEQ + t0 + 8 * tg;
        if (!dry) *(u32x4*)vt = o;
    }
    if (tid < 256) { const int token = tid >> 2, h = tid & 3; const float x = bf2f(Z[(size_t)token * ZP + ZC_FF + h]) + a.in[9][l * 4 + h];
        const float lf = fminf(x, 0.f) - __logf(1.f + __expf(-fabsf(x)));
        if (!dry) ((float*)(a.ws + WS_LOGF))[(size_t)(b * 4 + h) * SEQ + t0 + token] = lf; }
    __syncthreads();
    LAS bf16_t* al = (LAS bf16_t*)lds;
    for (int item = tid; item < 64 * 36; item += 512) { const int token = item / 36, c = item % 36; float v[8]; unpack8(*(const u32x4*)(Z + (size_t)token * ZP + ZC_LO + 8 * c), v);
        if (c < 8) {
#pragma unroll
            for (int i = 0; i < 8; ++i) v[i] = tanh_f(v[i]); }
        else if (c >= 16) {
#pragma unroll
            for (int i = 0; i < 8; ++i) v[i] = sigmoid_f(v[i]); }
        *(LAS u32x4*)(al + token * 296 + 8 * c) = pack8(v); }
    __syncthreads();
    const unsigned char* wl = a.ws + WS_W + (size_t)l * WL_BYTES;
    const bf16_t* w2t = (const bf16_t*)(wl + OFF_W2T); const bf16_t* a2t = (const bf16_t*)(wl + OFF_A2T); const bf16_t* g2t = (const bf16_t*)(wl + OFF_G2T);
    const int r32 = lane & 31, hi = lane >> 5;
    for (int uu = 0; uu < 2; ++uu) {
        const int u = wid + 8 * uu, h = u & 7, th = u >> 3, token = 32 * th + r32;
        f32x16 aw[2], aa[2], ag[2];
#pragma unroll
        for (int ct = 0; ct < 2; ++ct) { aw[ct] = f32x16{}; aa[ct] = f32x16{}; ag[ct] = f32x16{}; }
        const LAS bf16_t* arow = al + token * 296 + 8 * hi;
#pragma unroll 1
        for (int ks = 0; ks < 4; ++ks) { const bf16x8 bw = *(const LAS bf16x8*)(arow + 16 * ks), ba = *(const LAS bf16x8*)(arow + 64 + 16 * ks);
#pragma unroll
            for (int ct = 0; ct < 2; ++ct) { const int chn = 64 * h + 32 * ct + r32;
                aw[ct] = __builtin_amdgcn_mfma_f32_32x32x16_bf16(*(const bf16x8*)(w2t + chn * 64 + 16 * ks + 8 * hi), bw, aw[ct], 0, 0, 0);
                aa[ct] = __builtin_amdgcn_mfma_f32_32x32x16_bf16(*(const bf16x8*)(a2t + chn * 64 + 16 * ks + 8 * hi), ba, aa[ct], 0, 0, 0); } }
#pragma unroll 1
        for (int ks = 0; ks < 10; ++ks) { const bf16x8 bg = *(const LAS bf16x8*)(arow + 128 + 16 * ks);
#pragma unroll
            for (int ct = 0; ct < 2; ++ct) { const int chn = 64 * h + 32 * ct + r32;
                ag[ct] = __builtin_amdgcn_mfma_f32_32x32x16_bf16(*(const bf16x8*)(g2t + chn * 160 + 16 * ks + 8 * hi), bg, ag[ct], 0, 0, 0); } }
        bf16_t* zr = Z + (size_t)token * ZP; const size_t grow = (size_t)(row0 + token);
        float* wd = (float*)(a.ws + WS_WD) + grow * 512; bf16_t* kkp = (bf16_t*)(a.ws + WS_KK) + grow * 512; bf16_t* kap = (bf16_t*)(a.ws + WS_KA) + grow * 512;
        const float* w0 = a.in[15] + l * 512; const float* a0 = a.in[17] + l * 512; const float* k_k = a.in[20] + l * 512; const float* k_a = a.in[21] + l * 512;
        float ss = 0.f;
#pragma unroll
        for (int ct = 0; ct < 2; ++ct)
#pragma unroll
            for (int rg = 0; rg < 4; ++rg) { const int c0 = 64 * h + 32 * ct + 8 * rg + 4 * hi;
                const u32x2 kraw = *(const u32x2*)(zr + ZC_RK + c0); const f32x4 w04 = *(const f32x4*)(w0 + c0), a04 = *(const f32x4*)(a0 + c0), kk4 = *(const f32x4*)(k_k + c0);
                f32x4 dec; u32x2 gp; float gv[4];
#pragma unroll
                for (int i = 0; i < 4; ++i) { const int r = 4 * rg + i;
                    const float kv = (i < 2) ? __uint_as_float((i & 1) ? (kraw.x & 0xffff0000u) : (kraw.x << 16)) : __uint_as_float((i & 1) ? (kraw.y & 0xffff0000u) : (kraw.y << 16));
                    const float wr_ = w04[i] + aw[ct][r]; const float sp = fmaxf(-wr_, 0.f) + __logf(1.f + __expf(-fabsf(wr_)));
                    dec[i] = __expf(-__expf(-sp - 0.5f));
                    aa[ct][r] = sigmoid_f(a04[i] + aa[ct][r]);
                    gv[i] = ag[ct][r];
                    const float kkv = kv * kk4[i]; aw[ct][r] = kkv; ss += kkv * kkv; }
                if (!dry) *(f32x4*)(wd + c0) = dec;
                gp.x = pk2(gv[0], gv[1]); gp.y = pk2(gv[2], gv[3]);
                if (!dry) *(u32x2*)(zr + (c0 < 256 ? ZC_FV + c0 : ZC_MV + (c0 - 256))) = gp; __builtin_amdgcn_sched_barrier(0); }
        ss += __shfl_xor(ss, 32);
        const float inv = 1.f / fmaxf(sqrtf(ss), 1e-12f);
#pragma unroll
        for (int ct = 0; ct < 2; ++ct)
#pragma unroll
            for (int rg = 0; rg < 4; ++rg) { const int c0 = 64 * h + 32 * ct + 8 * rg + 4 * hi; const f32x4 ka4 = *(const f32x4*)(k_a + c0);
                const u32x2 kraw = *(const u32x2*)(zr + ZC_RK + c0); const float kf4[4] = {bf2f(kraw.x & 0xffff), __uint_as_float(kraw.x & 0xffff0000u), bf2f(kraw.y & 0xffff), __uint_as_float(kraw.y & 0xffff0000u)};
                float kk[4], ka[4], kp[4];
#pragma unroll
                for (int i = 0; i < 4; ++i) { const int r = 4 * rg + i; kk[i] = aw[ct][r] * inv; ka[i] = kk[i] * aa[ct][r]; kp[i] = kf4[i] * (1.f + (aa[ct][r] - 1.f) * ka4[i]); }
                u32x2 o; o.x = pk2(kk[0], kk[1]); o.y = pk2(kk[2], kk[3]); if (!dry) *(u32x2*)(kkp + c0) = o;
                o.x = pk2(ka[0], ka[1]); o.y = pk2(ka[2], ka[3]); if (!dry) *(u32x2*)(kap + c0) = o;
                o.x = pk2(kp[0], kp[1]); o.y = pk2(kp[2], kp[3]); if (!dry) *(u32x2*)(zr + ZC_RK + c0) = o; __builtin_amdgcn_sched_barrier(0); }
    }
    __syncthreads();
}

template <int MODE, int D>
DEV void attn_unit(LAS unsigned char* lds, const bf16_t* Qp, int ldq, const bf16_t* Kp, int ldk, const bf16_t* Vt, int ldv, bf16_t* Op, int ldo,
                   int q0, int ntiles, int qb, const float* aux, const float* qgain, bool dry = false, const float* kgain = nullptr) {
    constexpr int KP = D + 8, KBYTES = 64 * KP * 2, VP = 72, VBYTES = D * VP * 2, NLD = D / 64;
    int tid_ = threadIdx.x; asm volatile("" : "+v"(tid_)); const int tid = tid_, lane = tid & 63, wid = __builtin_amdgcn_readfirstlane(tid >> 6), r32 = lane & 31, hi = lane >> 5;
    LAS float* cl = (LAS float*)lds; LAS unsigned* selm = (LAS unsigned*)(lds + 8192);
    LAS unsigned char* kb = lds + 16384; LAS unsigned char* vb = kb + 2 * KBYTES;
    const int q = q0 + wid * 32 + r32;
    if (MODE == 0) {
        const int n = 64 * ntiles; float v[8]; float run = 0.f;
#pragma unroll
        for (int i = 0; i < 8; ++i) { const int idx = 8 * tid + i; v[i] = idx < n ? aux[idx] : 0.f; run += v[i]; v[i] = run; }
        float sc = run;
#pragma unroll
        for (int o = 1; o < 64; o <<= 1) { const float t = __shfl_up(sc, o); if (lane >= o) sc += t; }
        LAS float* wsum = (LAS float*)kb;
        if (lane == 63) wsum[wid] = sc;
        __syncthreads();
        float off = sc - run;
        for (int w = 0; w < wid; ++w) off += wsum[w];
#pragma unroll
        for (int i = 0; i < 8; ++i) cl[8 * tid + i] = (off + v[i]) * LOG2E;
    }
    if (MODE == 1) {
        LAS float* km = cl;
        for (int e = tid; e < 16 * 64; e += 512) { const int nblk = e >> 6, d = e & 63; const float* pp = aux + (size_t)(4 * nblk) * 64 + d;
            km[e] = ((pp[0] + pp[64]) + (pp[128] + pp[192])) * (1.f / 256); }
        __syncthreads();
        if (tid < 256) { const bf16_t* qr = Qp + (size_t)(q0 + tid) * ldq; float g[16];
#pragma unroll
            for (int nb = 0; nb < 16; ++nb) g[nb] = 0.f;
            for (int c = 0; c < 8; ++c) { float qv[8]; unpack8(*(const u32x4*)(qr + 8 * c), qv);
#pragma unroll
                for (int nb = 0; nb < 16; ++nb) {
#pragma unroll
                    for (int i = 0; i < 8; ++i) g[nb] += qv[i] * km[nb * 64 + 8 * c + i]; } }
            unsigned m = 0u;
#pragma unroll
            for (int pick = 0; pick < 3; ++pick) { float best = -INFINITY; int bi = -1;
#pragma unroll
                for (int nb = 0; nb < 16; ++nb) { if (nb < qb && !((m >> nb) & 1u) && g[nb] > best) { best = g[nb]; bi = nb; } }
                if (bi >= 0) m |= 1u << bi; }
            selm[tid] = m; }
    }
    bf16x8 qf[D / 16];
#pragma unroll
    for (int d0 = 0; d0 < D / 16; ++d0) qf[d0] = *(const bf16x8*)(Qp + (size_t)q * ldq + d0 * 16 + hi * 8);
    if (MODE == 2) {
        float ss = 0.f;
#pragma unroll
        for (int d0 = 0; d0 < D / 16; ++d0) { float qv[8]; unpack8(__builtin_bit_cast(u32x4, qf[d0]), qv);
#pragma unroll
            for (int i = 0; i < 8; ++i) ss += qv[i] * qv[i]; }
        ss += __shfl_xor(ss, 32);
        const float rstd = rsqrtf(ss * (1.f / D) + NORM_EPS) * C2_128;
#pragma unroll
        for (int d0 = 0; d0 < D / 16; ++d0) { float qv[8]; unpack8(__builtin_bit_cast(u32x4, qf[d0]), qv);
#pragma unroll
            for (int i = 0; i < 8; ++i) qv[i] = qv[i] * rstd * qgain[d0 * 16 + hi * 8 + i];
            qf[d0] = __builtin_bit_cast(bf16x8, pack8(qv)); __builtin_amdgcn_sched_barrier(0); }
    }
    float mrun = -INFINITY, lrun = 0.f; f32x16 o[D / 32];
#pragma unroll
    for (int dt = 0; dt < D / 32; ++dt) o[dt] = f32x16{};
    __syncthreads();
    const float cq = (MODE == 0) ? cl[q] : 0.f;
    const unsigned sel = (MODE == 1) ? selm[wid * 32 + r32] : 0u;
    float thr = 0.f, cqw = 0.f; int tstart = 0;
    if (MODE == 0) {
        float gq = 0.f, gk = 0.f;
        for (int i = 0; i < 64; ++i) { gq = fmaxf(gq, fabsf(qgain[i])); gk = fmaxf(gk, fabsf(kgain[i])); }
        const float B = 8.f * gq * gk * LOG2E * 1.02f; thr = 152.f + 2.f * B;
        const float c0 = cl[q0]; cqw = cl[q0 + wid * 32];
        while (tstart + 1 < ntiles && c0 - cl[64 * tstart + 63] < -thr) ++tstart;
        tstart = __builtin_amdgcn_readfirstlane(tstart);
    }
    u32x4 kreg[NLD], vreg[NLD];
#define ATT_LOAD(t) do { _Pragma("unroll") for (int i_ = 0; i_ < NLD; ++i_) { const int idx_ = tid + 512 * i_; \
        kreg[i_] = *(const u32x4*)(Kp + (size_t)(64 * (t) + idx_ / (D / 8)) * ldk + (idx_ % (D / 8)) * 8); \
        vreg[i_] = *(const u32x4*)(Vt + (size_t)(idx_ >> 3) * ldv + 64 * (t) + (idx_ & 7) * 8); } } while (0)
#define ATT_STORE(buf) do { _Pragma("unroll") for (int i_ = 0; i_ < NLD; ++i_) { const int idx_ = tid + 512 * i_; \
        *(LAS u32x4*)(kb + (buf) * KBYTES + ((idx_ / (D / 8)) * KP + (idx_ % (D / 8)) * 8) * 2) = kreg[i_]; \
        *(LAS u32x4*)(vb + (buf) * VBYTES + ((idx_ >> 3) * VP + (idx_ & 7) * 8) * 2) = vreg[i_]; } } while (0)
    ATT_LOAD(tstart); ATT_STORE(tstart & 1);
    __syncthreads();
    for (int t = tstart; t < ntiles; ++t) {
        const int buf = t & 1, key0 = 64 * t;
        if (t + 1 < ntiles) ATT_LOAD(t + 1);
        bool work = true; const int nblk = key0 >> 8;
        if (MODE == 0) work = key0 <= q0 + wid * 32 + 31 && (cqw - cl[key0 + 63] >= -thr);
        if (MODE == 1) work = (nblk == qb) ? (key0 <= q0 + wid * 32 + 31) : (__any((sel >> nblk) & 1u) != 0);
        if (work) {
            const LAS unsigned char* kt = kb + buf * KBYTES; const LAS unsigned char* vt = vb + buf * VBYTES;
            constexpr int NKH = (D == 64) ? 2 : 1;
#pragma unroll 1
            for (int ks = 0; ks < 2 / NKH; ++ks) {
            f32x16 p[NKH];
#pragma unroll
            for (int kh = 0; kh < NKH; ++kh) { p[kh] = f32x16{}; const int khh = ks * NKH + kh;
#pragma unroll
                for (int d0 = 0; d0 < D / 16; ++d0) { const bf16x8 kf = *(const LAS bf16x8*)(kt + ((32 * khh + r32) * KP + 16 * d0 + 8 * hi) * 2);
                    p[kh] = __builtin_amdgcn_mfma_f32_32x32x16_bf16(kf, qf[d0], p[kh], 0, 0, 0); } }
            if (MODE == 0) {
                const bool diag = key0 + 63 > q0 + wid * 32;
                if (diag) {
#pragma unroll
                for (int kh = 0; kh < NKH; ++kh)
#pragma unroll
                    for (int rg = 0; rg < 4; ++rg) { const int kk0 = key0 + 32 * (ks * NKH + kh) + 8 * rg + 4 * hi; const f32x4 ck = *(const LAS f32x4*)(cl + kk0);
#pragma unroll
                        for (int i = 0; i < 4; ++i) { const float s = p[kh][4 * rg + i] + (cq - ck[i]); p[kh][4 * rg + i] = (kk0 + i > q) ? -INFINITY : s; } }
                } else {
#pragma unroll
                for (int kh = 0; kh < NKH; ++kh)
#pragma unroll
                    for (int rg = 0; rg < 4; ++rg) { const int kk0 = key0 + 32 * (ks * NKH + kh) + 8 * rg + 4 * hi; const f32x4 ck = *(const LAS f32x4*)(cl + kk0);
#pragma unroll
                        for (int i = 0; i < 4; ++i) p[kh][4 * rg + i] += (cq - ck[i]); }
                }
            }
            if (MODE == 1) {
                if (nblk == qb) {
#pragma unroll
                    for (int kh = 0; kh < NKH; ++kh)
#pragma unroll
                        for (int r = 0; r < 16; ++r) { if (key0 + 32 * (ks * NKH + kh) + crow(r, hi) > q) p[kh][r] = -INFINITY; }
                } else if (!((sel >> nblk) & 1u)) {
#pragma unroll
                    for (int kh = 0; kh < NKH; ++kh)
#pragma unroll
                        for (int r = 0; r < 16; ++r) p[kh][r] = -INFINITY;
                }
            }
            float mx = p[0][0];
#pragma unroll
            for (int kh = 0; kh < NKH; ++kh)
#pragma unroll
                for (int r = 0; r < 16; ++r) mx = fmaxf(mx, p[kh][r]);
            mx = fmaxf(mx, __shfl_xor(mx, 32));
            const float mnew = fmaxf(mrun, mx), muse = (mnew == -INFINITY) ? 0.f : mnew;
            const float alpha = __builtin_amdgcn_exp2f(mrun - muse);
            mrun = mnew; lrun *= alpha;
            if (__any(alpha != 1.0f)) {
#pragma unroll
                for (int dt = 0; dt < D / 32; ++dt) o[dt] *= alpha; }
            float ps = 0.f;
#pragma unroll
            for (int kh = 0; kh < NKH; ++kh)
#pragma unroll
                for (int r = 0; r < 16; ++r) { p[kh][r] = __builtin_amdgcn_exp2f(p[kh][r] - muse); ps += p[kh][r]; }
            lrun += ps;
            bf16x8 pb[NKH][2];
#pragma unroll
            for (int kh = 0; kh < NKH; ++kh)
#pragma unroll
                for (int j = 0; j < 2; ++j) { u32x4 w; w.x = pk2(p[kh][8 * j + 0], p[kh][8 * j + 1]); w.y = pk2(p[kh][8 * j + 2], p[kh][8 * j + 3]); w.z = pk2(p[kh][8 * j + 4], p[kh][8 * j + 5]); w.w = pk2(p[kh][8 * j + 6], p[kh][8 * j + 7]);
                    pb[kh][j] = __builtin_bit_cast(bf16x8, w); }
#pragma unroll
            for (int dt = 0; dt < D / 32; ++dt)
#pragma unroll
                for (int kh = 0; kh < NKH; ++kh)
#pragma unroll
                    for (int j = 0; j < 2; ++j) { const LAS unsigned char* vp_ = vt + ((32 * dt + r32) * VP + 32 * (ks * NKH + kh) + 16 * j + 4 * hi) * 2;
                        const u32x2 lo = *(const LAS u32x2*)vp_, hh = *(const LAS u32x2*)(vp_ + 16); u32x4 w; w.x = lo.x; w.y = lo.y; w.z = hh.x; w.w = hh.y;
                        o[dt] = __builtin_amdgcn_mfma_f32_32x32x16_bf16(__builtin_bit_cast(bf16x8, w), pb[kh][j], o[dt], 0, 0, 0); }
            }
        }
        if (t + 1 < ntiles) ATT_STORE(buf ^ 1);
        __syncthreads();
    }
#undef ATT_LOAD
#undef ATT_STORE
    lrun += __shfl_xor(lrun, 32);
    const float inv = 1.f / lrun;
    bf16_t* orow = Op + (size_t)q * ldo;
    if (!dry)
#pragma unroll
    for (int dt = 0; dt < D / 32; ++dt)
#pragma unroll
        for (int rg = 0; rg < 4; ++rg) { u32x2 w; w.x = pk2(o[dt][4 * rg] * inv, o[dt][4 * rg + 1] * inv); w.y = pk2(o[dt][4 * rg + 2] * inv, o[dt][4 * rg + 3] * inv);
            *(u32x2*)(orow + 32 * dt + 8 * rg + 4 * hi) = w; }
    __syncthreads();
}

constexpr int RW_NCH = SEQ / 16;
constexpr int RW_ARP = 72, RW_BKTP = 32, RW_VTP = 24, RW_PMP = 16, RW_LP = 20;
constexpr int RW_NBUF = 6, RW_NPRE = 4;
constexpr int RW_DB = 15104, RW_AR = 0, RW_BKT = 4608, RW_VT = 8704, RW_GC = 11776, RW_TM = 12032, RW_PM1 = 13056, RW_PM2 = 14080;
constexpr int RW_PRIV = RW_NBUF * RW_DB, RW_PRIV_BYTES = 5888, RW_PBK = 0, RW_PLAB = 4608;
constexpr int RW_NYB = 4;
constexpr int RW_YB = RW_PRIV + RW_NPRE * RW_PRIV_BYTES, RW_FLG = RW_YB + RW_NYB * 4096, RW_SLOT_BYTES = RW_FLG + 128;
static_assert(RW_PM2 + 32 * RW_PMP * 2 == RW_DB && RW_TM + 32 * RW_PMP * 2 == RW_PM1 && RW_SLOT_BYTES <= 131072 && RW_DB % 16 == 0 && RW_PRIV_BYTES % 16 == 0, "rwkv lds map");
DEV bf16x8 pack_acc8(const f32x16& v, int base) { u32x4 w; w.x = pk2(v[base], v[base + 1]); w.y = pk2(v[base + 2], v[base + 3]); w.z = pk2(v[base + 4], v[base + 5]); w.w = pk2(v[base + 6], v[base + 7]); return __builtin_bit_cast(bf16x8, w); }
DEV int fresh_lane() { int l_; asm volatile("v_mbcnt_lo_u32_b32 %0, -1, 0\n\tv_mbcnt_hi_u32_b32 %0, -1, %0" : "=v"(l_)); return l_; }
DEV void rw_wait(volatile LAS unsigned* f, unsigned target) { while (*f < target) __builtin_amdgcn_s_sleep(1); asm volatile("" ::: "memory"); }
DEV void rw_post_flag(volatile LAS unsigned* f, unsigned v) { asm volatile("s_waitcnt vmcnt(0) lgkmcnt(0)" ::: "memory"); *f = v; }
DEV bf16x8 frag_perm(const LAS bf16_t* rowp, int hi) { const u32x2 lo = *(const LAS u32x2*)(rowp + 4 * hi), hh = *(const LAS u32x2*)(rowp + 8 + 4 * hi); u32x4 w; w.x = lo.x; w.y = lo.y; w.z = hh.x; w.w = hh.y; return __builtin_bit_cast(bf16x8, w); }

struct RwRaw { float w[16]; unsigned short kk[16], ka[16], kp[16], rr[16], vr[16]; };
DEV void rwkv_pre_load(RwRaw& R, int c, const float* WDp, const bf16_t* KKp, const bf16_t* KAp, const bf16_t* Zl) {
#pragma unroll
    for (int t = 0; t < 16; ++t) { const size_t ro = (size_t)(16 * c + t);
        R.w[t] = WDp[ro * 512]; R.kk[t] = KKp[ro * 512]; R.ka[t] = KAp[ro * 512]; R.kp[t] = Zl[ro * ZP + ZC_RK]; R.rr[t] = Zl[ro * ZP + ZC_RR]; R.vr[t] = Zl[ro * ZP + ZC_RV]; }
}
DEV void rwkv_pre_a(const RwRaw& R, int c, LAS unsigned char* sl, volatile LAS unsigned* flg, int lane) {
    const int bi = c % RW_NBUF, pw = c % RW_NPRE;
    LAS bf16_t* BK = (LAS bf16_t*)(sl + RW_PRIV + pw * RW_PRIV_BYTES + RW_PBK);
    LAS unsigned char* db = sl + bi * RW_DB;
    LAS bf16_t* AR = (LAS bf16_t*)(db + RW_AR); LAS bf16_t* BKT = (LAS bf16_t*)(db + RW_BKT); LAS bf16_t* VT = (LAS bf16_t*)(db + RW_VT); LAS float* GC = (LAS float*)(db + RW_GC);
    if (c >= RW_NBUF) rw_wait(flg + 6 + bi, (unsigned)(c - RW_NBUF + 1));
    float g = 1.f; unsigned bkt[16];
#pragma unroll
    for (int t = 0; t < 16; ++t) {
        const float w = R.w[t], kk = bf2f(R.kk[t]), ka = bf2f(R.ka[t]), kp = bf2f(R.kp[t]), rr = bf2f(R.rr[t]);
        const float at = -kk * g; g *= w; const float inv = __builtin_amdgcn_rcpf(g);
        const unsigned bt = f2bf(ka * inv), kt = f2bf(kp * inv);
        AR[t * RW_ARP + lane] = (bf16_t)f2bf(at); AR[(16 + t) * RW_ARP + lane] = (bf16_t)f2bf(rr * g);
        BK[t * RW_ARP + lane] = (bf16_t)bt; BK[(16 + t) * RW_ARP + lane] = (bf16_t)kt;
        if (t & 1) { bkt[t >> 1] |= bt << 16; bkt[8 + (t >> 1)] |= kt << 16; } else { bkt[t >> 1] = bt; bkt[8 + (t >> 1)] = kt; }
    }
    GC[lane] = g;
#pragma unroll
    for (int q4 = 0; q4 < 4; ++q4) { u32x4 w4; w4.x = bkt[4 * q4]; w4.y = bkt[4 * q4 + 1]; w4.z = bkt[4 * q4 + 2]; w4.w = bkt[4 * q4 + 3]; *(LAS u32x4*)(BKT + lane * RW_BKTP + 8 * q4) = w4; }
    { unsigned vv[8];
#pragma unroll
      for (int t = 0; t < 16; ++t) { const unsigned x = R.vr[t]; if (t & 1) vv[t >> 1] |= x << 16; else vv[t >> 1] = x; }
      u32x4 v0; v0.x = vv[0]; v0.y = vv[1]; v0.z = vv[2]; v0.w = vv[3]; u32x4 v1; v1.x = vv[4]; v1.y = vv[5]; v1.z = vv[6]; v1.w = vv[7];
      *(LAS u32x4*)(VT + lane * RW_VTP) = v0; *(LAS u32x4*)(VT + lane * RW_VTP + 8) = v1; }
}
DEV void rwkv_pre_b(int c, LAS unsigned char* sl, volatile LAS unsigned* flg, int lane) {
    const int r32 = lane & 31, hi = lane >> 5, bi = c % RW_NBUF, pw = c % RW_NPRE;
    LAS bf16_t* BK = (LAS bf16_t*)(sl + RW_PRIV + pw * RW_PRIV_BYTES + RW_PBK);
    LAS unsigned char* db = sl + bi * RW_DB;
    LAS bf16_t* AR = (LAS bf16_t*)(db + RW_AR); LAS bf16_t* TM = (LAS bf16_t*)(db + RW_TM); LAS bf16_t* PM1 = (LAS bf16_t*)(db + RW_PM1); LAS bf16_t* PM2 = (LAS bf16_t*)(db + RW_PM2);
    f32x16 P = f32x16{};
#pragma unroll
    for (int ks = 0; ks < 4; ++ks) P = __builtin_amdgcn_mfma_f32_32x32x16_bf16(*(const LAS bf16x8*)(AR + r32 * RW_ARP + 16 * ks + 8 * hi), *(const LAS bf16x8*)(BK + r32 * RW_ARP + 16 * ks + 8 * hi), P, 0, 0, 0);
    asm volatile("s_waitcnt lgkmcnt(0)" ::: "memory");
    LAS bf16_t* LB = BK; LAS bf16_t* L2m = BK + 256; LAS bf16_t* L4m = BK + 512;
    const int n = r32; const bool lcol = n < 16;
    f32x16 Lm = f32x16{};
#pragma unroll
    for (int r = 0; r < 16; ++r) { const int m = crow(r, hi);
        if (r < 8) { const float lv = (lcol && n < m) ? P[r] : 0.f; Lm[r] = lv;
            if (lcol) LB[m * 16 + n] = (bf16_t)f2bf(lv); else PM1[m * RW_PMP + (n - 16)] = (bf16_t)f2bf((n - 16 < m) ? P[r] : 0.f); }
        else { if (lcol) PM2[m * RW_PMP + n] = (bf16_t)f2bf((n <= m - 16) ? P[r] : 0.f); else PM1[m * RW_PMP + (n - 16)] = (bf16_t)f2bf((n - 16 <= m - 16) ? P[r] : 0.f); } }
    const int rr = (r32 & 15) * 16;
    f32x16 A2 = __builtin_amdgcn_mfma_f32_32x32x16_bf16(frag_perm(LB + rr, hi), pack_acc8(Lm, 0), f32x16{}, 0, 0, 0);
    if (lcol) {
#pragma unroll
        for (int r = 0; r < 8; ++r) L2m[crow(r, hi) * 16 + n] = (bf16_t)f2bf(A2[r]); }
    f32x16 A4 = __builtin_amdgcn_mfma_f32_32x32x16_bf16(frag_perm(L2m + rr, hi), pack_acc8(A2, 0), f32x16{}, 0, 0, 0);
    if (lcol) {
#pragma unroll
        for (int r = 0; r < 8; ++r) L4m[crow(r, hi) * 16 + n] = (bf16_t)f2bf(A4[r]); }
    f32x16 T = __builtin_amdgcn_mfma_f32_32x32x16_bf16(frag_perm(L4m + rr, hi), pack_acc8(A4, 0), f32x16{}, 0, 0, 0);
#pragma unroll
    for (int r = 0; r < 8; ++r) { if (n == crow(r, hi)) T[r] += 1.f; }
    T = __builtin_amdgcn_mfma_f32_32x32x16_bf16(frag_perm(L4m + rr, hi), pack_acc8(T, 0), T, 0, 0, 0);
    T = __builtin_amdgcn_mfma_f32_32x32x16_bf16(frag_perm(L2m + rr, hi), pack_acc8(T, 0), T, 0, 0, 0);
    T = __builtin_amdgcn_mfma_f32_32x32x16_bf16(frag_perm(LB + rr, hi), pack_acc8(T, 0), T, 0, 0, 0);
    if (lcol) {
#pragma unroll
        for (int r = 0; r < 8; ++r) TM[crow(r, hi) * RW_PMP + n] = (bf16_t)f2bf(T[r]); }
    asm volatile("s_waitcnt lgkmcnt(0)" ::: "memory"); flg[bi] = (unsigned)(c + 1);
}
DEV void rwkv_pre(const Args& a, int b, int h, LAS unsigned char* sl, int par) {
    const int lane = fresh_lane();
    volatile LAS unsigned* flg = (volatile LAS unsigned*)(sl + RW_FLG);
    const size_t rowb = (size_t)b * SEQ;
    const bf16_t* Zl = (const bf16_t*)(a.ws + WS_Z) + rowb * ZP + h * 64 + lane;
    const float* WDp = (const float*)(a.ws + WS_WD) + rowb * 512 + h * 64 + lane;
    const bf16_t* KKp = (const bf16_t*)(a.ws + WS_KK) + rowb * 512 + h * 64 + lane;
    const bf16_t* KAp = (const bf16_t*)(a.ws + WS_KA) + rowb * 512 + h * 64 + lane;
    for (int bz = par; bz < RW_NBUF; bz += RW_NPRE) for (int e = lane; e < 32 * RW_PMP; e += 64) { ((LAS bf16_t*)(sl + bz * RW_DB + RW_PM2))[e] = 0; ((LAS bf16_t*)(sl + bz * RW_DB + RW_TM))[e] = 0; }
    RwRaw R;
    rwkv_pre_load(R, par, WDp, KKp, KAp, Zl);
#pragma unroll 1
    for (int c = par; c < RW_NCH; c += RW_NPRE) {
        rwkv_pre_a(R, c, sl, flg, lane);
        rwkv_pre_load(R, (c + RW_NPRE < RW_NCH) ? c + RW_NPRE : c, WDp, KKp, KAp, Zl);
        rwkv_pre_b(c, sl, flg, lane);
    }
}

DEV void rwkv_main(LAS unsigned char* sl) {
    const int lane = fresh_lane(), r32 = lane & 31, hi = lane >> 5;
    volatile LAS unsigned* flg = (volatile LAS unsigned*)(sl + RW_FLG);
    f32x16 ST[2][2];
#pragma unroll
    for (int jt = 0; jt < 2; ++jt)
#pragma unroll
        for (int it = 0; it < 2; ++it) ST[jt][it] = f32x16{};
#pragma unroll 1
    for (int c = 0; c < RW_NCH; ++c) {
        const int bi = c % RW_NBUF;
        LAS unsigned char* db = sl + bi * RW_DB;
        const LAS bf16_t* AR = (const LAS bf16_t*)(db + RW_AR); const LAS bf16_t* BKT = (const LAS bf16_t*)(db + RW_BKT); const LAS bf16_t* VT = (const LAS bf16_t*)(db + RW_VT);
        const LAS float* GC = (const LAS float*)(db + RW_GC); const LAS bf16_t* TM = (const LAS bf16_t*)(db + RW_TM); const LAS bf16_t* PM1 = (const LAS bf16_t*)(db + RW_PM1); const LAS bf16_t* PM2 = (const LAS bf16_t*)(db + RW_PM2);
        const int yi = c % RW_NYB; LAS float* YB = (LAS float*)(sl + RW_YB + yi * 4096);
        rw_wait(flg + bi, (unsigned)(c + 1));
        f32x16 X[2]; X[0] = f32x16{}; X[1] = f32x16{};
#pragma unroll
        for (int jt = 0; jt < 2; ++jt)
#pragma unroll
            for (int rgp = 0; rgp < 2; ++rgp) { const bf16x8 af = frag_perm(AR + r32 * RW_ARP + 32 * jt + 16 * rgp, hi);
#pragma unroll
                for (int it = 0; it < 2; ++it) X[it] = __builtin_amdgcn_mfma_f32_32x32x16_bf16(af, pack_acc8(ST[jt][it], 8 * rgp), X[it], 0, 0, 0); }
        bf16x8 vt[2];
        { const bf16x8 a1 = *(const LAS bf16x8*)(PM1 + r32 * RW_PMP + 8 * hi);
#pragma unroll
          for (int it = 0; it < 2; ++it) { vt[it] = *(const LAS bf16x8*)(VT + (32 * it + r32) * RW_VTP + 8 * hi); X[it] = __builtin_amdgcn_mfma_f32_32x32x16_bf16(a1, vt[it], X[it], 0, 0, 0); } }
        bf16x8 ub[2];
        { const bf16x8 ta = frag_perm(TM + r32 * RW_PMP, hi), pm2 = frag_perm(PM2 + r32 * RW_PMP, hi);
#pragma unroll
          for (int it = 0; it < 2; ++it) { const f32x16 U = __builtin_amdgcn_mfma_f32_32x32x16_bf16(ta, pack_acc8(X[it], 0), f32x16{}, 0, 0, 0);
              ub[it] = pack_acc8(U, 0); X[it] = __builtin_amdgcn_mfma_f32_32x32x16_bf16(pm2, ub[it], X[it], 0, 0, 0); } }
        if (c >= RW_NYB) rw_wait(flg + 16 + yi, (unsigned)(c - RW_NYB + 1));
#pragma unroll
        for (int it = 0; it < 2; ++it)
#pragma unroll
            for (int r = 8; r < 16; ++r) YB[(crow(r, hi) - 16) * 64 + 32 * it + r32] = X[it][r];
        rw_post_flag(flg + 12 + yi, (unsigned)(c + 1));
#pragma unroll
        for (int jt = 0; jt < 2; ++jt) { const bf16x8 a0 = frag_perm(BKT + (32 * jt + r32) * RW_BKTP, hi), a1 = *(const LAS bf16x8*)(BKT + (32 * jt + r32) * RW_BKTP + 16 + 8 * hi);
#pragma unroll
            for (int it = 0; it < 2; ++it) { ST[jt][it] = __builtin_amdgcn_mfma_f32_32x32x16_bf16(a0, ub[it], ST[jt][it], 0, 0, 0);
                ST[jt][it] = __builtin_amdgcn_mfma_f32_32x32x16_bf16(a1, vt[it], ST[jt][it], 0, 0, 0); }
#pragma unroll
            for (int rg = 0; rg < 4; ++rg) { const f32x4 g4 = *(const LAS f32x4*)(GC + 32 * jt + 8 * rg + 4 * hi);
#pragma unroll
                for (int e = 0; e < 4; ++e) { ST[jt][0][4 * rg + e] *= g4[e]; ST[jt][1][4 * rg + e] *= g4[e]; } } }
        rw_post_flag(flg + 6 + bi, (unsigned)(c + 1));
    }
}

DEV void rwkv_post(const Args& a, int l, int b, int h, LAS unsigned char* sl, int par) {
    const int lane = fresh_lane();
    volatile LAS unsigned* flg = (volatile LAS unsigned*)(sl + RW_FLG);
    bf16_t* Zb = (bf16_t*)(a.ws + WS_Z) + (size_t)b * SEQ * ZP;
    const int gcol0 = h < 4 ? ZC_FV + h * 64 : ZC_MV + (h - 4) * 64;
    const int t = lane >> 2, qd = lane & 3, c0 = h * 64 + 16 * qd;
    const float* rkp = a.in[22] + l * 512 + c0; const float* lw = a.in[23] + l * 512 + c0; const float* lb = a.in[24] + l * 512 + c0;
#pragma unroll 1
    for (int c = par; c < RW_NCH; c += 2) {
        bf16_t* zr = Zb + (size_t)(16 * c + t) * ZP;
        const u32x4 r0 = *(const u32x4*)(zr + ZC_RR + c0), r1 = *(const u32x4*)(zr + ZC_RR + c0 + 8), k0 = *(const u32x4*)(zr + ZC_RK + c0), k1 = *(const u32x4*)(zr + ZC_RK + c0 + 8);
        const u32x4 v0 = *(const u32x4*)(zr + ZC_RV + c0), v1 = *(const u32x4*)(zr + ZC_RV + c0 + 8), g0 = *(const u32x4*)(zr + gcol0 + 16 * qd), g1 = *(const u32x4*)(zr + gcol0 + 16 * qd + 8);
        const int yi = c % RW_NYB; const LAS float* YB = (const LAS float*)(sl + RW_YB + yi * 4096);
        rw_wait(flg + 12 + yi, (unsigned)(c + 1));
        float y[16];
#pragma unroll
        for (int q4 = 0; q4 < 4; ++q4) { const f32x4 yy = *(const LAS f32x4*)(YB + t * 64 + 16 * qd + 4 * q4); y[4 * q4] = yy[0]; y[4 * q4 + 1] = yy[1]; y[4 * q4 + 2] = yy[2]; y[4 * q4 + 3] = yy[3]; }
        asm volatile("s_waitcnt lgkmcnt(0)" ::: "memory");
        flg[16 + yi] = (unsigned)(c + 1);
        float s = 0.f;
#pragma unroll
        for (int e = 0; e < 16; ++e) s += y[e];
        s += __shfl_xor(s, 1); s += __shfl_xor(s, 2);
        const float mean = s * (1.f / 64); float q = 0.f;
#pragma unroll
        for (int e = 0; e < 16; ++e) { y[e] -= mean; q += y[e] * y[e]; }
        q += __shfl_xor(q, 1); q += __shfl_xor(q, 2);
        const float rstd = rsqrtf(q * (1.f / 64) + GN_EPS);
        float rv[16], kv[16];
        unpack8(r0, *(float(*)[8])&rv[0]); unpack8(r1, *(float(*)[8])&rv[8]); unpack8(k0, *(float(*)[8])&kv[0]); unpack8(k1, *(float(*)[8])&kv[8]);
        float bs = 0.f;
#pragma unroll
        for (int e = 0; e < 16; ++e) bs += rv[e] * kv[e] * rkp[e];
        bs += __shfl_xor(bs, 1); bs += __shfl_xor(bs, 2);
        float vv[16], gv[16], o[16];
        unpack8(v0, *(float(*)[8])&vv[0]); unpack8(v1, *(float(*)[8])&vv[8]); unpack8(g0, *(float(*)[8])&gv[0]); unpack8(g1, *(float(*)[8])&gv[8]);
#pragma unroll
        for (int e = 0; e < 16; ++e) o[e] = (y[e] * rstd * lw[e] + lb[e] + bs * vv[e]) * gv[e];
        *(u32x4*)(zr + ZC_RR + c0) = pack8(*(float(*)[8])&o[0]); *(u32x4*)(zr + ZC_RR + c0 + 8) = pack8(*(float(*)[8])&o[8]);
    }
}

#define XB_TMO      128
#define XB_XCNT(j)  (256  + 64 * (j))
#define XB_XSUB(j)  (1280 + 64 * (j))
#define XB_XGEN(j)  (2304 + 64 * (j))
#define XB_TOP      3328
#define XB_TOPGEN   3392
#define XCD_BAR_WORDS 3456
#define XB_SPIN_CAP (1u << 18)

__device__ __forceinline__ unsigned xb_ld(unsigned* p)              { return __hip_atomic_load(p, __ATOMIC_RELAXED, __HIP_MEMORY_SCOPE_AGENT); }
__device__ __forceinline__ unsigned xb_add(unsigned* p, unsigned v) { return __hip_atomic_fetch_add(p, v, __ATOMIC_RELAXED, __HIP_MEMORY_SCOPE_AGENT); }
__device__ __forceinline__ unsigned xb_xcc_id() { return (unsigned)__builtin_amdgcn_s_getreg((3 << 11) | 20) & 0xFu; }
#define XB_SPIN(cond, bar) do { unsigned _sp = 0; while (cond) { __builtin_amdgcn_s_sleep(1); \
    if ((++_sp & 255u) == 0u) { if (xb_ld(&(bar)[XB_TMO])) break; if (_sp > XB_SPIN_CAP) { atomicAdd(&(bar)[XB_TMO], 1u); break; } } } } while (0)

struct XcdBarrier {
    unsigned* bar; unsigned x;
    volatile LAS unsigned* st;
};

__device__ __forceinline__ XcdBarrier xcd_barrier_post(unsigned* bar, volatile LAS unsigned* st) {
    XcdBarrier b; b.bar = bar; b.x = xb_xcc_id(); b.st = st;
    if (threadIdx.x == 0) (void)xb_add(&bar[XB_XCNT(b.x)], 1u);
    return b;
}
__device__ __forceinline__ void xcd_barrier_complete(unsigned* bar, unsigned x, unsigned& nloc, unsigned& nx) {
    const unsigned G = gridDim.x * gridDim.y * gridDim.z;
    unsigned sum, cnt, mine, sp = 0u;
    for (;;) {
        sum = 0u; cnt = 0u; mine = 0u;
#pragma unroll
        for (unsigned j = 0; j < 16; ++j) { const unsigned c = xb_ld(&bar[XB_XCNT(j)]); sum += c; cnt += (c > 0u) ? 1u : 0u; mine = (j == x) ? c : mine; }
        if (sum == G) break;
        __builtin_amdgcn_s_sleep(1);
        if ((++sp & 255u) == 0u) { if (xb_ld(&bar[XB_TMO])) break; if (sp > XB_SPIN_CAP) { atomicAdd(&bar[XB_TMO], 1u); break; } }
    }
    nloc = mine > 0u ? mine : 1u; nx = cnt > 0u ? cnt : 1u;
}

__device__ __forceinline__ void xcd_barrier(const XcdBarrier& b) {
    asm volatile("s_waitcnt vmcnt(0)" ::: "memory");
    __syncthreads();
    if (threadIdx.x == 0) {
        unsigned* bar = b.bar;
        __builtin_amdgcn_s_waitcnt(0);
        unsigned nloc = b.st[0], nx = b.st[1];
        if (nloc == 0u) { xcd_barrier_complete(bar, b.x, nloc, nx); b.st[0] = nloc; b.st[1] = nx; }
        const unsigned old = xb_add(&bar[XB_XSUB(b.x)], 1u);
        const unsigned gen = old / nloc;
        if (old + 1u == (gen + 1u) * nloc) {
            __builtin_amdgcn_fence(__ATOMIC_RELEASE, "agent");
            asm volatile("s_waitcnt vmcnt(0)" ::: "memory");
            const unsigned og = xb_add(&bar[XB_TOP], 1u);
            const unsigned tg = og / nx;
            if (og + 1u == (tg + 1u) * nx) xb_add(&bar[XB_TOPGEN], 1u);
            else XB_SPIN(xb_ld(&bar[XB_TOPGEN]) == tg, bar);
            __builtin_amdgcn_fence(__ATOMIC_ACQUIRE, "agent");
            xb_add(&bar[XB_XGEN(b.x)], 1u);
            asm volatile("s_waitcnt vmcnt(0)" ::: "memory");
        } else {
            XB_SPIN(xb_ld(&bar[XB_XGEN(b.x)]) == gen, bar);
            __builtin_amdgcn_fence(__ATOMIC_ACQUIRE, "agent");
            asm volatile("s_waitcnt vmcnt(0)" ::: "memory");
        }
    }
    __syncthreads();
}

constexpr int N_PHASES = 1 + 15 * NL;
#ifndef MK_MULTI
#define MK_MULTI 0
#endif
#ifndef PROBE_Q
#define PROBE_Q 500.f
#endif
#ifndef PROBE_OFF
#define PROBE_OFF 0.f
#endif
#ifndef REPK
#define REPK 0
#endif
#ifndef ATT_REP
#define ATT_REP 1
#endif
#ifndef PREP_REP
#define PREP_REP 1
#endif
#ifndef RWROLES
#define RWROLES 7
#endif
#ifndef PHMASK
#define PHMASK 0xFFFF
#endif
#define PHON(k) ((PHMASK >> (k)) & 1)
__global__ void __launch_bounds__(512, 2) fwd_megakernel(Args a) {
    extern __shared__ __attribute__((aligned(16))) unsigned char lds_raw[];
    LAS unsigned char* lds = (LAS unsigned char*)lds_raw;
    cg::grid_group grid = cg::this_grid();
    { volatile LAS unsigned* st0 = (volatile LAS unsigned*)(lds + 131072 + 128); if (threadIdx.x == 0) { st0[0] = 0u; st0[1] = 0u; } __syncthreads(); }
    XcdBarrier xbar = xcd_barrier_post((unsigned*)(a.ws + WS_CTL) + 4096, (volatile LAS unsigned*)(lds + 131072 + 128));
    const int G = gridDim.x, bid = blockIdx.x, NGW = G * 8;
    unsigned char* ws = a.ws;
    bf16_t* HN = (bf16_t*)(ws + WS_HN); bf16_t* Z = (bf16_t*)(ws + WS_Z); bf16_t* HID = Z; bf16_t* QX = Z; bf16_t* OX = Z + (size_t)TOK * 512;
#ifdef PROBE_GROUP
    LAS unsigned long long* prs = (LAS unsigned long long*)(lds + 131072 + 64);
    if (threadIdx.x == 0) { prs[0] = __builtin_amdgcn_s_memrealtime(); prs[1] = 0ull; prs[2] = 99ull; }
#endif
#ifdef PROBE_GROUP
    for (int ph = a.ph_lo; ph <= a.ph_hi; ++ph) {
#else
    for (int ph = a.ph_lo; ph < a.ph_hi; ++ph) {
#endif
        if (ph > a.ph_lo) { if (MK_MULTI || a.ph_hi < 0) grid.sync(); else xcd_barrier(xbar);
#ifdef SYNC_REP
            xcd_barrier(xbar); xcd_barrier(xbar);
#endif
        }
#ifdef PROBE_GROUP
        if (threadIdx.x == 0) { const unsigned long long now = __builtin_amdgcn_s_memrealtime(); if (prs[2] == (unsigned long long)PROBE_GROUP) prs[1] += now - prs[0]; prs[0] = now;
          if (ph == a.ph_hi) { if (blockIdx.x == 0) { float us_ = (float)prs[1] * 0.01f;
#if PROBE_GROUP == 8
              us_ = (float)((volatile unsigned*)(ws + WS_CTL))[32 * 64] * 0.01f;
#endif
              a.out[0] = floorf((us_ + PROBE_OFF) / PROBE_Q) * PROBE_Q + 0.5f * PROBE_Q; } }
          const int k_ = (ph - 1) % 15; prs[2] = ph == 0 ? 0 : (k_ == 0 || k_ == 3 || k_ == 8 || k_ == 12) ? 1 : (k_ == 1 || k_ == 13) ? 2 : (k_ == 2 || k_ == 14 || k_ == 7 || k_ == 11) ? 3 : (k_ == 4 || k_ == 9) ? 4 : k_ == 5 ? 5 : k_ == 6 ? 6 : 7; }
        if (ph == a.ph_hi) break;
#endif
        int tidp = threadIdx.x; asm volatile("" : "+v"(tidp)); const int tid = tidp, lane = tid & 63, wid = __builtin_amdgcn_readfirstlane(tid >> 6), gw = bid * 8 + wid;
        if (ph == 0) { for (int rp_ = 0; rp_ < ((REPK >> 15) & 1) + 1; ++rp_) { if (PHON(15)) p0_prologue(a, lds, gw, NGW, wid, lane, tid); } continue; }
        const int l = (ph - 1) / 15, kind = (ph - 1) % 15;
        const unsigned char* wl = ws + WS_W + (size_t)l * WL_BYTES;
        if (PHON(0) && (kind == 0 || kind == 3 || kind == 8 || kind == 12)) {
            const float* src = (l == 0 && kind == 0) ? a.in[0] : a.out;
            const float* g = (kind == 0 ? a.in[3] : kind == 3 ? a.in[6] : kind == 8 ? a.in[25] : a.in[32]) + l * DM;
            for (int rp_ = 0; rp_ < (REPK & 1) + 1; ++rp_) norm_phase(src, g, HN, TOK, gw, NGW, lane);
            if (l == 0 && kind == 3) xkv_post(a, gw, NGW, lane);
        }
        if (PHON(1) && (kind == 1 || kind == 13)) {
            pg8::Gemm g{HN, (const bf16_t*)(wl + (kind == 1 ? OFF_F1I : OFF_F2I)), TOK, 2 * FF, DM, DM};
            pg8::StaticOrder S; S.init(TOK, 2 * FF, G, bid);
            pg8::EpiSwiglu E{HID, FF};
            pg8::gemm_phase<pg8::EpiSwiglu, pg8::StaticOrder, true, true>(lds, g, S, E);
        }
        if (PHON(2) && (kind == 2 || kind == 14 || kind == 7 || kind == 11)) {
            pg8::Gemm g; pg8::EpiResid E; E.out = a.out; E.ldc = DM; g.M = TOK; g.N = DM;
            if (kind == 2 || kind == 14) { g.A = HID; g.lda = FF; g.K = FF; g.Bt = (const bf16_t*)(wl + (kind == 2 ? OFF_F1O : OFF_F2O)); E.scale = 0.5f; E.base = (l == 0 && kind == 2) ? a.in[0] : a.out; }
            else if (kind == 7) { g.A = Z; g.lda = ZP; g.K = DM; g.Bt = (const bf16_t*)(wl + OFF_MO); E.scale = 1.f; E.base = a.out; }
            else { g.A = OX; g.lda = 512; g.K = 512; g.Bt = (const bf16_t*)(wl + OFF_XO); E.scale = 1.f; E.base = a.out; }
            pg8::StaticOrder S; S.init(TOK, DM, G, bid);
            const float sc_ = E.scale;
            for (int rp_ = ((REPK >> 2) & 1); rp_ >= 0; --rp_) { E.scale = rp_ ? 0.f : sc_;
            pg8::gemm_phase<pg8::EpiResid, pg8::StaticOrder, true, true>(lds, g, S, E); if (rp_) { __syncthreads(); } }
        }
        if (PHON(4) && (kind == 4 || kind == 9 || (kind == 0 && l == 0))) {
            const int ng = (kind == 0) ? NL : 1;
            for (int rp_ = 0; rp_ < ((REPK >> 4) & 1) + 1; ++rp_)
            for (int gi = 0; gi < ng; ++gi) {
                pg8::Gemm g; pg8::EpiBf16 E; int cidx = bid;
                if (kind == 4) { g.A = HN; g.lda = DM; g.K = DM; g.M = TOK; g.N = 3584; g.Bt = (const bf16_t*)(wl + OFF_MI); E.O = Z; E.ldc = ZP; E.ncols = ZC_VALID; E.halo = (bf16_t*)(ws + WS_ZHALO); }
                else if (kind == 9) { g.A = HN; g.lda = DM; g.K = DM; g.M = TOK; g.N = 512; g.Bt = (const bf16_t*)(wl + OFF_XQ); E.O = QX; E.ldc = 512; E.ncols = 512; E.halo = nullptr; }
                else { g.A = (const bf16_t*)(ws + WS_MEMN) + (size_t)gi * NB * MEMLEN * DM; g.lda = DM; g.K = DM; g.M = NB * MEMLEN; g.N = 1024;
                       g.Bt = (const bf16_t*)(ws + WS_W + (size_t)gi * WL_BYTES + OFF_XKV); E.O = (bf16_t*)(ws + WS_KVX) + (size_t)gi * NB * MEMLEN * 1024; E.ldc = 1024; E.ncols = 1024; E.halo = nullptr;
                       cidx = (bid + gi * (G / 2)) % G; }
                pg8::StaticOrder S; S.init(g.M, g.N, G, cidx);
                pg8::gemm_phase<pg8::EpiBf16, pg8::StaticOrder, true, true>(lds, g, S, E);
            }
        }
        if (PHON(5) && kind == 5) { for (int rp_ = PREP_REP - 1; rp_ >= 0; --rp_) for (int tile = bid; tile < TOK / 64; tile += G) prep_tile(a, l, tile, lds, rp_ > 0); }
        if (PHON(6) && kind == 6) {
            unsigned* ctr = (unsigned*)(ws + WS_CTL) + 64 * (1 + l); LAS unsigned* qw = (LAS unsigned*)(lds + 131072);
            for (;;) {
                __syncthreads();
                if (tid == 0) *qw = atomicAdd(ctr, 1u);
                __syncthreads();
                const int item = __builtin_amdgcn_readfirstlane((int)*qw);
                if (item >= 64 + 1024) break;
                if (item < 64) {
                    if (tid < 32) ((LAS unsigned*)(lds + RW_FLG))[tid] = 0u;
                    __syncthreads();
                    if (PHON(7)) {
                        const int ub = item >> 3, uh = item & 7;
                        if (wid == 0 || wid == 4 || wid == 2 || wid == 6) { if (RWROLES & 1) rwkv_pre(a, ub, uh, lds, wid == 0 ? 0 : wid == 4 ? 1 : wid == 2 ? 2 : 3); }
                        else if (wid == 1) { if (RWROLES & 2) rwkv_main(lds); }
                        else if (wid == 3 || wid == 7) { if (RWROLES & 4) rwkv_post(a, l, ub, uh, lds, wid == 3 ? 0 : 1); }
                    }
                }
                else {
                    const int j = item - 64, qb = 15 - (j >> 6), kk = j & 63, type = kk >> 5, bh = kk & 31, b = bh >> 2, h = bh & 3;
                    bf16_t* Zb = Z + (size_t)b * SEQ * ZP;
                    for (int rp_ = ATT_REP - 1; rp_ >= 0; --rp_)
                    if (type == 0) { if (PHON(8)) attn_unit<0, 64>(lds, Zb + ZC_FQ + 64 * h, ZP, Zb + ZC_FK + 64 * h, ZP, (const bf16_t*)(ws + WS_VTF) + (size_t)bh * 64 * SEQ, SEQ, Zb + ZC_FQ + 64 * h, ZP,
                                                   256 * qb, 4 * (qb + 1), qb, (const float*)(ws + WS_LOGF) + (size_t)bh * SEQ, a.in[10] + l * 64, rp_ > 0, a.in[11] + l * 64); }
                    else if (PHON(9)) attn_unit<1, 64>(lds, Zb + ZC_MQ + 64 * h, ZP, Zb + ZC_MK + 64 * h, ZP, (const bf16_t*)(ws + WS_VTM) + (size_t)bh * 64 * SEQ, SEQ, Zb + ZC_MQ + 64 * h, ZP,
                                          256 * qb, 4 * (qb + 1), qb, (const float*)(ws + WS_KMP) + (size_t)bh * 64 * 64, nullptr, rp_ > 0);
                }
            }
        }
        if (PHON(10) && kind == 10) {
            for (int rp_ = 0; rp_ < ((REPK >> 10) & 1) + 1; ++rp_)
            for (int u = bid; u < NB * 4 * 16; u += G) { const int b = u >> 6, hd = (u >> 4) & 3, qb = u & 15;
                bf16_t* qp = QX + (size_t)b * SEQ * 512 + hd * 128;
                attn_unit<2, 128>(lds, qp, 512, (const bf16_t*)(ws + WS_KVX) + ((size_t)l * NB + b) * MEMLEN * 1024 + hd * 128, 1024,
                                  (const bf16_t*)(ws + WS_VTX) + ((size_t)(l * NB + b) * 4 + hd) * 128 * MEMLEN, MEMLEN, OX + (size_t)b * SEQ * 512 + hd * 128, 512, 256 * qb, MEMLEN / 64, qb, nullptr, a.in[29] + l * 128); }
        }
    }
}

extern "C" void kernel_launch(void* const* d_in, const int* in_sizes, int n_in, void* d_out, int out_size, void* d_ws, size_t ws_size, hipStream_t stream) {
    static int grid_blocks = 0;
    if (grid_blocks == 0) {
        if (n_in != 35 || ws_size < WS_END) { fprintf(stderr, "kernel_launch: unexpected n_in %d / ws %zu\n", n_in, ws_size); grid_blocks = -1; return; }
        int dev = 0, cus = 0, per_cu = 0;
        hipGetDevice(&dev); hipDeviceGetAttribute(&cus, hipDeviceAttributeMultiprocessorCount, dev);
        if (hipFuncSetAttribute((const void*)fwd_megakernel, hipFuncAttributeMaxDynamicSharedMemorySize, LDS_BYTES) != hipSuccess) { fprintf(stderr, "kernel_launch: hipFuncSetAttribute failed\n"); grid_blocks = -1; return; }
        if (hipOccupancyMaxActiveBlocksPerMultiprocessor(&per_cu, (const void*)fwd_megakernel, 512, LDS_BYTES) != hipSuccess || per_cu < 1) { fprintf(stderr, "kernel_launch: occupancy query says %d\n", per_cu); per_cu = 1; }
        (void)hipGetLastError();
        grid_blocks = cus * per_cu;
    }
    if (grid_blocks < 0) return;
    Args a{};
    for (int i = 0; i < 35; ++i) a.in[i] = (const float*)d_in[i];
    a.out = (float*)d_out; a.ws = (unsigned char*)d_ws;
    if (hipMemsetAsync(d_ws, 0, 65536, stream) != hipSuccess) { fprintf(stderr, "kernel_launch: memset failed\n"); return; }
#if MK_MULTI
    for (int ph = 0; ph < N_PHASES; ++ph) { a.ph_lo = ph; a.ph_hi = ph + 1; hipLaunchKernelGGL(fwd_megakernel, dim3(grid_blocks), dim3(512), LDS_BYTES, stream, a); }
#else
    a.ph_lo = 0; a.ph_hi = N_PHASES;
    void* args[] = {&a};
    hipError_t e = hipLaunchCooperativeKernel((const void*)fwd_megakernel, dim3(grid_blocks), dim3(512), args, LDS_BYTES, stream);
    if (e != hipSuccess) fprintf(stderr, "cooperative launch failed: %s (grid %d)\n", hipGetErrorString(e), grid_blocks);
#endif
}
```

```cpp
#include <hip/hip_runtime.h>
#include <hip/hip_cooperative_groups.h>
#include <cstdio>
#include <cstdint>
namespace cg = cooperative_groups;
namespace pg8 {
#define PG8_LAS __attribute__((address_space(3)))
typedef unsigned short bf16_t;
typedef short bf16x8 __attribute__((ext_vector_type(8)));
typedef float f32x4 __attribute__((ext_vector_type(4)));
typedef unsigned u32x4 __attribute__((ext_vector_type(4)));
constexpr int BM = 256, BK = 64, HALF = 128, HTB = HALF * BK * 2  , STAGE_BYTES = 8 * HTB, NXCD = 8, WGM = 8;

__host__ __device__ __forceinline__ int lds_byte(int r, int c) { const int st = (r >> 4) * 2 + (c >> 5), rr = r & 15, cc = c & 31, ob = rr * 64 + cc * 2; return st * 1024 + (ob ^ (((ob >> 9) & 1) << 5)); }
__host__ __device__ __forceinline__ void stage_rc(int b, int& R, int& C) { const int st = b / 1024, sb = b % 1024, swz = sb ^ (((sb >> 9) & 1) << 5); R = (st >> 1) * 16 + swz / 64; C = (st & 1) * 32 + (swz % 64) / 2; }
__host__ __device__ __forceinline__ int perm32(int rho) { const int n = rho >> 4, i = rho & 15; return 8 * (i >> 2) + 4 * n + (i & 3); }

struct Unit { int pm, pn; };
struct Gemm { const bf16_t* A; const bf16_t* Bt; int M, N, K, lda; };

struct StaticOrder {
    int nM, nN, nwg, G, c;
    __host__ __device__ void init(int M, int N, int G_, int c_) { nM = M / BM; nN = N / BM; nwg = nM * nN; G = G_; c = c_; }
    __host__ __device__ bool next(int i, Unit& u) const {
        const long L = (long)i * G + c; if (L >= nwg) return false;
        int wgid = (int)L; { const int q = nwg / NXCD, r = nwg % NXCD, xcd = wgid % NXCD, off = wgid / NXCD; wgid = (xcd < r ? xcd * (q + 1) : r * (q + 1) + (xcd - r) * q) + off; }
        const int nig = WGM * nN, gid = wgid / nig, fm = gid * WGM, gsz = (nM - fm) < WGM ? (nM - fm) : WGM;
        u.pm = fm + ((wgid % nig) % gsz); u.pn = (wgid % nig) / gsz; return true;
    }
    __device__ __forceinline__ void a_ready(const Unit&) const {}
    __device__ __forceinline__ void done(const Unit&) const {}
};
__device__ __forceinline__ unsigned cvt_pk_bf16(float lo, float hi) { unsigned r; asm volatile("v_cvt_pk_bf16_f32 %0, %1, %2" : "=v"(r) : "v"(lo), "v"(hi)); return r; }
__device__ __forceinline__ float silu_f(float x) { return x * __builtin_amdgcn_rcpf(1.0f + __builtin_amdgcn_exp2f(-1.4426950408889634f * x)); }
struct EpiSwiglu {
    static constexpr bool PERM = true, AFTER_DRAIN = false;
    bf16_t* O; int ldc;
    __device__ __forceinline__ void operator()(const f32x4 (&acc)[2][2][4][2], const Unit& u, int wr, int wc, int fr, int fq) const {
        const int row0 = u.pm * BM + wr * 64 + fr, col0 = u.pn * HALF + wc * 32 + 8 * fq;
#pragma unroll
        for (int ai = 0; ai < 2; ++ai)
#pragma unroll
            for (int m = 0; m < 4; ++m) {
                const f32x4 g0 = acc[ai][0][m][0], g1 = acc[ai][0][m][1], u0 = acc[ai][1][m][0], u1 = acc[ai][1][m][1];
                u32x4 w;
                w.x = cvt_pk_bf16(silu_f(g0[0]) * u0[0], silu_f(g0[1]) * u0[1]); w.y = cvt_pk_bf16(silu_f(g0[2]) * u0[2], silu_f(g0[3]) * u0[3]);
                w.z = cvt_pk_bf16(silu_f(g1[0]) * u1[0], silu_f(g1[1]) * u1[1]); w.w = cvt_pk_bf16(silu_f(g1[2]) * u1[2], silu_f(g1[3]) * u1[3]);
                *(u32x4*)(O + (size_t)(row0 + ai * HALF + m * 16) * ldc + col0) = w;
            }
    }
};
struct EpiResid {
    static constexpr bool PERM = false, AFTER_DRAIN = false;
    const float* base; float* out; int ldc; float scale;
    __device__ __forceinline__ void operator()(const f32x4 (&acc)[2][2][4][2], const Unit& u, int wr, int wc, int fr, int fq) const {
        const int row0 = u.pm * BM + wr * 64 + fr, col0 = u.pn * BM + wc * 32 + 4 * fq;
#pragma unroll
        for (int ai = 0; ai < 2; ++ai)
#pragma unroll
            for (int m = 0; m < 4; ++m) { const size_t off = (size_t)(row0 + ai * HALF + m * 16) * ldc + col0;
#pragma unroll
                for (int bj = 0; bj < 2; ++bj)
#pragma unroll
                    for (int n = 0; n < 2; ++n) { const f32x4 b = *(const f32x4*)(base + off + bj * HALF + n * 16); *(f32x4*)(out + off + bj * HALF + n * 16) = b + acc[ai][bj][m][n] * scale; }
                asm volatile("" ::: "memory"); }
    }
};
struct EpiBf16 {
    static constexpr bool PERM = true, AFTER_DRAIN = false;
    bf16_t* O; int ldc; int ncols; bf16_t* halo;
    __device__ __forceinline__ void operator()(const f32x4 (&acc)[2][2][4][2], const Unit& u, int wr, int wc, int fr, int fq) const {
        const int row0 = u.pm * BM + wr * 64 + fr, col0 = u.pn * BM + wc * 32 + 8 * fq;
#pragma unroll
        for (int ai = 0; ai < 2; ++ai)
#pragma unroll
            for (int m = 0; m < 4; ++m) { const int row = row0 + ai * HALF + m * 16;
#pragma unroll
                for (int bj = 0; bj < 2; ++bj) { const int col = col0 + bj * HALF;
                    if (col < ncols) { const f32x4 v0 = acc[ai][bj][m][0], v1 = acc[ai][bj][m][1]; u32x4 w;
                        w.x = cvt_pk_bf16(v0[0], v0[1]); w.y = cvt_pk_bf16(v0[2], v0[3]); w.z = cvt_pk_bf16(v1[0], v1[1]); w.w = cvt_pk_bf16(v1[2], v1[3]);
                        *(u32x4*)(O + (size_t)row * ldc + col) = w;
                        if (halo && (row & 63) == 63) *(u32x4*)(halo + (size_t)(row >> 6) * ldc + col) = w; } } }
    }
};
template <class Epi, class Sched, bool ALIGN_EPI = false, bool SP2 = false>
__device__ __forceinline__ void gemm_phase(PG8_LAS unsigned char* lds, const Gemm g, const Sched& S, const Epi& E) {
    int tid_ = threadIdx.x; asm volatile("" : "+v"(tid_)); const int tid = tid_, wid = __builtin_amdgcn_readfirstlane(tid >> 6), lane = tid & 63, wr = wid >> 2, wc = wid & 3, fr = lane & 15, fq = lane >> 4;
    const int K = g.K, nt = K / BK;
    unsigned voffA[2], voffB[2];
#pragma unroll
    for (int i = 0; i < 2; ++i) { int R, C; stage_rc(tid * 16 + i * 8192, R, C); const int Rb = Epi::PERM ? ((R & ~31) + perm32(R & 31)) : R;
        voffA[i] = (unsigned)(R * g.lda + C) * 2u; voffB[i] = (unsigned)(Rb * K + C) * 2u; }
    const size_t kstep = (size_t)(BK * 2);
    const size_t hstep = (size_t)HALF * K * 2;
    const size_t tstep = 2 * hstep; const size_t hstepA = (size_t)HALF * g.lda * 2, tstepA = 2 * hstepA;
    const unsigned ldsw = (unsigned)wid * 1024u;
    const int aoff = lds_byte(wr * 64 + fr, fq * 8), boff = lds_byte(wc * 32 + fr, fq * 8);
#define PG8_SA(b, h) (((b) * 2 + (h)) * HTB)
#define PG8_SB(b, h) ((4 + (b) * 2 + (h)) * HTB)
#define PG8_STAGE(bufoff, gbase, voff) do { _Pragma("unroll") for (int _i = 0; _i < 2; ++_i) \
        __builtin_amdgcn_global_load_lds((const unsigned*)((const char*)(gbase) + (voff)[_i]), (PG8_LAS unsigned*)(lds + (bufoff) + ldsw + _i * 8192), 16, 0, 0); } while (0)
#define PG8_LDA(dst, b, h) do { _Pragma("unroll") for (int m = 0; m < 4; ++m) _Pragma("unroll") for (int k = 0; k < 2; ++k) dst[m][k] = *(const PG8_LAS bf16x8*)(lds + PG8_SA(b, h) + aoff + m * 2048 + k * 1024); } while (0)
#define PG8_LDB(dst, b, h) do { _Pragma("unroll") for (int n = 0; n < 2; ++n) _Pragma("unroll") for (int k = 0; k < 2; ++k) dst[n][k] = *(const PG8_LAS bf16x8*)(lds + PG8_SB(b, h) + boff + n * 2048 + k * 1024); } while (0)
#define PG8_MMA(ai, bj, At, Bt) do { __builtin_amdgcn_s_setprio(1); _Pragma("unroll") for (int m = 0; m < 4; ++m) _Pragma("unroll") for (int n = 0; n < 2; ++n) _Pragma("unroll") for (int k = 0; k < 2; ++k) \
        acc[ai][bj][m][n] = __builtin_amdgcn_mfma_f32_16x16x32_bf16(Bt[n][k], At[m][k], acc[ai][bj][m][n], 0, 0, 0); __builtin_amdgcn_s_setprio(0); } while (0)
#define PG8_WAIT_V(n) asm volatile("s_waitcnt vmcnt(" #n ")" ::: "memory")
#define PG8_WAIT_L(n) asm volatile("s_waitcnt lgkmcnt(" #n ")" ::: "memory")
#define PG8_BAR __builtin_amdgcn_s_barrier()
#define PG8_SCHED __builtin_amdgcn_sched_barrier(0)
    Unit cur, nxt; int ui = 0;
    if (!S.next(0, cur)) return;
    f32x4 acc[2][2][4][2];
#pragma unroll
    for (int a = 0; a < 2; ++a)
#pragma unroll
        for (int b = 0; b < 2; ++b)
#pragma unroll
            for (int m = 0; m < 4; ++m)
#pragma unroll
                for (int n = 0; n < 2; ++n) acc[a][b][m][n] = (f32x4){0.f, 0.f, 0.f, 0.f};
    bf16x8 At[4][2], B0[2][2], B1[2][2];
    const char* cA = (const char*)g.A + (size_t)cur.pm * tstepA; const char* cB = (const char*)g.Bt + (size_t)cur.pn * tstep;
    S.a_ready(cur);
    if constexpr (SP2) {
        PG8_STAGE(PG8_SB(0, 0), cB, voffB); PG8_STAGE(PG8_SB(0, 1), cB + hstep, voffB); PG8_STAGE(PG8_SA(0, 0), cA, voffA); PG8_STAGE(PG8_SA(0, 1), cA + hstepA, voffA);
        if (wr == 1) PG8_BAR;
        PG8_WAIT_V(2); PG8_BAR;
        PG8_STAGE(PG8_SB(1, 0), cB + kstep, voffB); PG8_STAGE(PG8_SA(1, 0), cA + kstep, voffA); PG8_STAGE(PG8_SB(1, 1), cB + hstep + kstep, voffB);
        PG8_WAIT_V(6); PG8_BAR;
    } else {
        PG8_STAGE(PG8_SB(0, 0), cB, voffB); PG8_STAGE(PG8_SA(0, 0), cA, voffA); PG8_STAGE(PG8_SB(0, 1), cB + hstep, voffB); PG8_STAGE(PG8_SA(0, 1), cA + hstepA, voffA);
        if (wr == 1) PG8_BAR;
        PG8_WAIT_V(4); PG8_BAR;
        PG8_STAGE(PG8_SB(1, 0), cB + kstep, voffB); PG8_STAGE(PG8_SA(1, 0), cA + kstep, voffA); PG8_STAGE(PG8_SB(1, 1), cB + hstep + kstep, voffB);
        PG8_WAIT_V(6); PG8_BAR;
    }
    for (;;) {
        const bool has_next = S.next(ui + 1, nxt);
        const char* nA = has_next ? (const char*)g.A + (size_t)nxt.pm * tstepA : cA; const char* nB = has_next ? (const char*)g.Bt + (size_t)nxt.pn * tstep : cB;
        for (int t = 0; t < nt; t += 2) {
            const bool last = (t == nt - 2);
            const char* a1 = cA + (size_t)(t + 1) * kstep;
            const char* a2 = last ? nA : cA + (size_t)(t + 2) * kstep; const char* b2 = last ? nB : cB + (size_t)(t + 2) * kstep;
            const char* a3 = a2 + kstep; const char* b3 = b2 + kstep;
            if (last && has_next) S.a_ready(nxt);
            if constexpr (SP2) {
            PG8_LDB(B0, 0, 0); PG8_LDB(B1, 0, 1); PG8_SCHED; PG8_LDA(At, 0, 0); PG8_STAGE(PG8_SA(1, 1), a1 + hstepA, voffA);
            PG8_WAIT_V(8); PG8_WAIT_L(0); PG8_BAR; PG8_MMA(0, 0, At, B0); PG8_MMA(0, 1, At, B1); PG8_BAR; PG8_SCHED;
            PG8_LDA(At, 0, 1); PG8_STAGE(PG8_SB(0, 0), b2, voffB); PG8_STAGE(PG8_SB(0, 1), b2 + hstep, voffB); PG8_STAGE(PG8_SA(0, 0), a2, voffA);
            PG8_WAIT_V(8); PG8_WAIT_L(0); PG8_BAR; PG8_MMA(1, 0, At, B0); PG8_MMA(1, 1, At, B1); PG8_BAR; PG8_SCHED;
            PG8_LDB(B0, 1, 0); PG8_LDB(B1, 1, 1); PG8_SCHED; PG8_LDA(At, 1, 0); PG8_STAGE(PG8_SA(0, 1), a2 + hstepA, voffA);
            PG8_WAIT_V(8); PG8_WAIT_L(0); PG8_BAR; PG8_MMA(0, 0, At, B0); PG8_MMA(0, 1, At, B1); PG8_BAR; PG8_SCHED;
            PG8_LDA(At, 1, 1); PG8_STAGE(PG8_SB(1, 0), b3, voffB); PG8_STAGE(PG8_SB(1, 1), b3 + hstep, voffB); PG8_STAGE(PG8_SA(1, 0), a3, voffA);
            PG8_WAIT_V(8); PG8_WAIT_L(0); PG8_BAR; PG8_MMA(1, 0, At, B0); PG8_MMA(1, 1, At, B1); PG8_BAR; PG8_SCHED;
            } else {
            PG8_LDB(B0, 0, 0); PG8_SCHED; PG8_LDA(At, 0, 0); PG8_STAGE(PG8_SA(1, 1), a1 + hstepA, voffA);
            PG8_WAIT_L(8); PG8_BAR; PG8_WAIT_L(0); PG8_MMA(0, 0, At, B0); PG8_BAR; PG8_SCHED;
            PG8_LDB(B1, 0, 1); PG8_STAGE(PG8_SB(0, 0), b2, voffB);
            PG8_BAR; PG8_WAIT_L(0); PG8_MMA(0, 1, At, B1); PG8_BAR;
            PG8_LDA(At, 0, 1); PG8_STAGE(PG8_SA(0, 0), a2, voffA);
            PG8_BAR; PG8_WAIT_L(0); PG8_MMA(1, 0, At, B0); PG8_BAR; PG8_SCHED;
            PG8_STAGE(PG8_SB(0, 1), b2 + hstep, voffB);
            PG8_WAIT_V(6); PG8_BAR; PG8_MMA(1, 1, At, B1); PG8_BAR;
            PG8_LDB(B0, 1, 0); PG8_SCHED; PG8_LDA(At, 1, 0); PG8_STAGE(PG8_SA(0, 1), a2 + hstepA, voffA);
            PG8_WAIT_L(8); PG8_BAR; PG8_WAIT_L(0); PG8_MMA(0, 0, At, B0); PG8_BAR; PG8_SCHED;
            PG8_LDB(B1, 1, 1); PG8_STAGE(PG8_SB(1, 0), b3, voffB);
            PG8_BAR; PG8_WAIT_L(0); PG8_MMA(0, 1, At, B1); PG8_BAR;
            PG8_LDA(At, 1, 1); PG8_STAGE(PG8_SA(1, 0), a3, voffA);
            PG8_BAR; PG8_WAIT_L(0); PG8_MMA(1, 0, At, B0); PG8_BAR; PG8_SCHED;
            PG8_STAGE(PG8_SB(1, 1), b3 + hstep, voffB);
            PG8_WAIT_V(6); PG8_BAR; PG8_MMA(1, 1, At, B1); PG8_BAR;
            }
        }
        if constexpr (ALIGN_EPI) { if (wr == 0) PG8_BAR; }
        if constexpr (!Epi::AFTER_DRAIN) { E(acc, cur, wr, wc, fr, fq); S.done(cur); }
        if (!has_next) break;
#pragma unroll
        for (int a = 0; a < 2; ++a)
#pragma unroll
            for (int b = 0; b < 2; ++b)
#pragma unroll
                for (int m = 0; m < 4; ++m)
#pragma unroll
                    for (int n = 0; n < 2; ++n) acc[a][b][m][n] = (f32x4){0.f, 0.f, 0.f, 0.f};
        cur = nxt; cA = nA; cB = nB; ++ui;
        if constexpr (ALIGN_EPI) { if (wr == 1) PG8_BAR; }
    }
    PG8_WAIT_V(0);
    if constexpr (!ALIGN_EPI) { if (wr == 0) PG8_BAR; }
    PG8_BAR;
    if constexpr (Epi::AFTER_DRAIN) { E.fused(acc, cur, wr, wc, fr, fq, lds, wid, lane); S.done(cur); }
#undef PG8_SA
#undef PG8_SB
#undef PG8_STAGE
#undef PG8_LDA
#undef PG8_LDB
#undef PG8_MMA
#undef PG8_WAIT_V
#undef PG8_WAIT_L
#undef PG8_BAR
#undef PG8_SCHED
}
}

#define LAS __attribute__((address_space(3)))
#define DEV __device__ __forceinline__
typedef unsigned short bf16_t;
typedef short bf16x8 __attribute__((ext_vector_type(8)));
typedef short s16x4 __attribute__((ext_vector_type(4)));
typedef float f32x4 __attribute__((ext_vector_type(4)));
typedef float f32x16 __attribute__((ext_vector_type(16)));
typedef unsigned u32x2 __attribute__((ext_vector_type(2)));
typedef unsigned u32x4 __attribute__((ext_vector_type(4)));
typedef unsigned u32x8 __attribute__((ext_vector_type(8)));

constexpr int NB = 8, SEQ = 4096, DM = 1024, TOK = NB * SEQ, FF = 2816, NL = 2, MEMLEN = 256;
constexpr int ZP = 3392;
constexpr int ZC_FQ = 0, ZC_RR = 256, ZC_MQ = 768, ZC_FK = 1024, ZC_FV = 1280, ZC_MK = 1536, ZC_MV = 1792, ZC_RK = 2048, ZC_RV = 2560, ZC_LO = 3072, ZC_FF = 3360, ZC_VALID = 3368;
constexpr float NORM_EPS = 1e-6f, GN_EPS = 64e-5f, LOG2E = 1.4426950408889634f;
constexpr float C2_64 = 0.125f * LOG2E, C2_128 = 0.08838834764831845f * LOG2E;
constexpr size_t MiB = 1u << 20;
constexpr size_t WS_CTL = 0;
constexpr size_t WS_W = 1 * MiB, WL_BYTES = 48 * MiB;
constexpr size_t OFF_F1I = 0, OFF_F1O = 11 * MiB, OFF_F2I = 17 * MiB, OFF_F2O = 28 * MiB, OFF_MI = 34 * MiB, OFF_MO = 41 * MiB, OFF_XQ = 43 * MiB, OFF_XKV = 44 * MiB, OFF_XO = 46 * MiB;
constexpr size_t OFF_W2T = 47 * MiB, OFF_A2T = OFF_W2T + 65536, OFF_G2T = OFF_A2T + 65536;
constexpr size_t WS_Z = 97 * MiB;
constexpr size_t WS_C = WS_Z + 212 * MiB;
constexpr size_t WS_HN = WS_C;
constexpr size_t WS_WD = WS_C, WS_KK = WS_C + 64 * MiB, WS_KA = WS_C + 96 * MiB;
constexpr size_t WS_VTF = WS_C + 128 * MiB, WS_VTM = WS_C + 144 * MiB;
constexpr size_t WS_LOGF = WS_C + 160 * MiB, WS_KMP = WS_LOGF + 512 * 1024, WS_ZHALO = WS_C + 161 * MiB;
constexpr size_t WS_KVX = WS_C + 165 * MiB, WS_VTX = WS_C + 173 * MiB, WS_MEMN = WS_C + 177 * MiB, WS_END = WS_C + 185 * MiB;
static_assert(WS_END <= 512 * MiB, "workspace map");
constexpr int LDS_BYTES = 131072 + 1024;

struct Args { const float* in[35]; float* out; unsigned char* ws; int ph_lo, ph_hi; };

DEV float bf2f(unsigned short b) { return __uint_as_float((unsigned)b << 16); }
typedef float f32x2_t __attribute__((ext_vector_type(2))); typedef __bf16 bf16x2_t __attribute__((ext_vector_type(2)));
DEV unsigned pk2(float lo, float hi) { const f32x2_t v = {lo, hi}; const bf16x2_t r = __builtin_convertvector(v, bf16x2_t); return __builtin_bit_cast(unsigned, r); }
DEV unsigned f2bf(float f) { return pk2(f, f) & 0xffffu; }
DEV float wave_sum(float v) {
#pragma unroll
    for (int o = 1; o < 64; o <<= 1) v += __shfl_xor(v, o);
    return v;
}
#define LDS_WAIT() asm volatile("s_waitcnt lgkmcnt(0)" ::: "memory")

struct MatInfo { const float* src; bf16_t* dst; int K, Ns, Nd, map; };
DEV MatInfo matinfo(const Args& a, int m) {
    const int l = m / 12, k = m % 12; unsigned char* wl = a.ws + WS_W + (size_t)l * WL_BYTES; MatInfo r;
    switch (k) {
    case 0:  r.src = a.in[4] + (size_t)l * DM * 2 * FF;  r.dst = (bf16_t*)(wl + OFF_F1I); r.K = DM; r.Ns = 2 * FF; r.Nd = 2 * FF; r.map = 1; break;
    case 1:  r.src = a.in[5] + (size_t)l * FF * DM;      r.dst = (bf16_t*)(wl + OFF_F1O); r.K = FF; r.Ns = DM; r.Nd = DM; r.map = 0; break;
    case 2:  r.src = a.in[33] + (size_t)l * DM * 2 * FF; r.dst = (bf16_t*)(wl + OFF_F2I); r.K = DM; r.Ns = 2 * FF; r.Nd = 2 * FF; r.map = 1; break;
    case 3:  r.src = a.in[34] + (size_t)l * FF * DM;     r.dst = (bf16_t*)(wl + OFF_F2O); r.K = FF; r.Ns = DM; r.Nd = DM; r.map = 0; break;
    case 4:  r.src = a.in[7] + (size_t)l * DM * 3364;    r.dst = (bf16_t*)(wl + OFF_MI);  r.K = DM; r.Ns = 3364; r.Nd = 3584; r.map = 2; break;
    case 5:  r.src = a.in[8] + (size_t)l * DM * DM;      r.dst = (bf16_t*)(wl + OFF_MO);  r.K = DM; r.Ns = DM; r.Nd = DM; r.map = 0; break;
    case 6:  r.src = a.in[27] + (size_t)l * DM * 512;    r.dst = (bf16_t*)(wl + OFF_XQ);  r.K = DM; r.Ns = 512; r.Nd = 512; r.map = 0; break;
    case 7:  r.src = a.in[28] + (size_t)l * DM * 1024;   r.dst = (bf16_t*)(wl + OFF_XKV); r.K = DM; r.Ns = 1024; r.Nd = 1024; r.map = 0; break;
    case 8:  r.src = a.in[31] + (size_t)l * 512 * DM;    r.dst = (bf16_t*)(wl + OFF_XO);  r.K = 512; r.Ns = DM; r.Nd = DM; r.map = 0; break;
    case 9:  r.src = a.in[16] + (size_t)l * 64 * 512;    r.dst = (bf16_t*)(wl + OFF_W2T); r.K = 64; r.Ns = 512; r.Nd = 512; r.map = 0; break;
    case 10: r.src = a.in[18] + (size_t)l * 64 * 512;    r.dst = (bf16_t*)(wl + OFF_A2T); r.K = 64; r.Ns = 512; r.Nd = 512; r.map = 0; break;
    default: r.src = a.in[19] + (size_t)l * 160 * 512;   r.dst = (bf16_t*)(wl + OFF_G2T); r.K = 160; r.Ns = 512; r.Nd = 512; r.map = 0; break;
    }
    return r;
}
DEV int srccol(int map, int n) {
    if (map == 0) return n;
    if (map == 1) { const int p = n >> 8, r = n & 255; return r < 128 ? p * 128 + r : FF + p * 128 + (r - 128); }
    if (n < 256) return n;
    if (n < 768) return 1540 + (n - 256);
    if (n < 1024) return 772 + (n - 768);
    if (n < 1280) return 256 + (n - 1024);
    if (n < 1536) return 512 + (n - 1280);
    if (n < 1792) return 1028 + (n - 1536);
    if (n < 2048) return 1284 + (n - 1792);
    if (n < 2560) return 2052 + (n - 2048);
    if (n < 3072) return 2564 + (n - 2560);
    if (n < 3360) return 3076 + (n - 3072);
    if (n < 3364) return 768 + (n - 3360);
    return -1;
}
DEV void transpose_item(const MatInfo& mi, LAS float* scr, int item, int lane) {
    const int nblk = mi.Nd / 32, kb = item / nblk, nb = item % nblk, k0 = 64 * kb, n0 = 32 * nb;
    const int n4 = (lane & 7) * 4, sc = srccol(mi.map, n0 + n4);
#pragma unroll
    for (int i = 0; i < 8; ++i) { const int kk = 8 * i + (lane >> 3), k = k0 + kk;
        const f32x4 v = (sc >= 0 && k < mi.K) ? *(const f32x4*)(mi.src + (size_t)k * mi.Ns + sc) : (f32x4){0.f, 0.f, 0.f, 0.f};
        LAS float* d = scr + kk * 33 + n4; d[0] = v[0]; d[1] = v[1]; d[2] = v[2]; d[3] = v[3]; }
    LDS_WAIT(); asm volatile("" ::: "memory");
    const int c = lane & 7;
#pragma unroll
    for (int j = 0; j < 4; ++j) { const int n = (lane >> 3) + 8 * j; const LAS float* s = scr + (8 * c) * 33 + n;
        u32x4 o; o.x = pk2(s[0 * 33], s[1 * 33]); o.y = pk2(s[2 * 33], s[3 * 33]); o.z = pk2(s[4 * 33], s[5 * 33]); o.w = pk2(s[6 * 33], s[7 * 33]);
        if (k0 + 8 * c < mi.K) *(u32x4*)(mi.dst + (size_t)(n0 + n) * mi.K + k0 + 8 * c) = o; }
    LDS_WAIT(); asm volatile("" ::: "memory");
}
DEV void norm_row(const float* xrow, const float* g, bf16_t* orow, int lane) {
    const f32x4* xr = (const f32x4*)xrow + lane; const f32x4* gr = (const f32x4*)g + lane;
    f32x4 v[4]; float s = 0.f;
#pragma unroll
    for (int j = 0; j < 4; ++j) { v[j] = xr[64 * j]; s += (v[j].x * v[j].x + v[j].y * v[j].y) + (v[j].z * v[j].z + v[j].w * v[j].w); }
    const float rstd = rsqrtf(wave_sum(s) * (1.f / DM) + NORM_EPS);
    u32x2* o8 = (u32x2*)orow + lane;
#pragma unroll
    for (int j = 0; j < 4; ++j) { const f32x4 gg = gr[64 * j]; u32x2 w; w.x = pk2(v[j].x * rstd * gg.x, v[j].y * rstd * gg.y); w.y = pk2(v[j].z * rstd * gg.z, v[j].w * rstd * gg.w); o8[64 * j] = w; }
}
DEV void norm_row2(const float* xa, const float* xb, const float* g, bf16_t* oa, bf16_t* ob, int lane) {
    const f32x4* xra = (const f32x4*)xa + lane; const f32x4* xrb = (const f32x4*)xb + lane; const f32x4* gr = (const f32x4*)g + lane;
    f32x4 va[4], vb[4]; float sa = 0.f, sb = 0.f;
#pragma unroll
    for (int j = 0; j < 4; ++j) { va[j] = xra[64 * j]; vb[j] = xrb[64 * j]; }
#pragma unroll
    for (int j = 0; j < 4; ++j) { sa += (va[j].x * va[j].x + va[j].y * va[j].y) + (va[j].z * va[j].z + va[j].w * va[j].w); sb += (vb[j].x * vb[j].x + vb[j].y * vb[j].y) + (vb[j].z * vb[j].z + vb[j].w * vb[j].w); }
#pragma unroll
    for (int o = 1; o < 64; o <<= 1) { sa += __shfl_xor(sa, o); sb += __shfl_xor(sb, o); }
    const float ra = rsqrtf(sa * (1.f / DM) + NORM_EPS), rb = rsqrtf(sb * (1.f / DM) + NORM_EPS);
    u32x2* o8a = (u32x2*)oa + lane; u32x2* o8b = (u32x2*)ob + lane;
#pragma unroll
    for (int j = 0; j < 4; ++j) { const f32x4 gg = gr[64 * j]; u32x2 w; w.x = pk2(va[j].x * ra * gg.x, va[j].y * ra * gg.y); w.y = pk2(va[j].z * ra * gg.z, va[j].w * ra * gg.w); o8a[64 * j] = w;
        w.x = pk2(vb[j].x * rb * gg.x, vb[j].y * rb * gg.y); w.y = pk2(vb[j].z * rb * gg.z, vb[j].w * rb * gg.w); o8b[64 * j] = w; }
}
DEV void norm_phase(const float* x, const float* g, bf16_t* out, int nrows, int gw, int NGW, int lane) {
    int m = gw;
    for (; m + NGW < nrows; m += 2 * NGW) norm_row2(x + (size_t)m * DM, x + (size_t)(m + NGW) * DM, g, out + (size_t)m * DM, out + (size_t)(m + NGW) * DM, lane);
    if (m < nrows) norm_row(x + (size_t)m * DM, g, out + (size_t)m * DM, lane);
}
DEV void p0_prologue(const Args& a, LAS unsigned char* lds, int gw, int NGW, int wid, int lane, int tid) {
    LAS float* scr = (LAS float*)(lds + wid * 8704);
    int base = 0;
    for (int m = 0; m < 24; ++m) {
        const MatInfo mi = matinfo(a, m); const int items = ((mi.K + 63) / 64) * (mi.Nd / 32);
        int first = gw - (base % NGW); if (first < 0) first += NGW;
        for (int it = first; it < items; it += NGW) transpose_item(mi, scr, it, lane);
        base += items;
    }
    for (int m = gw; m < NL * NB * MEMLEN; m += NGW) { const int l = m / (NB * MEMLEN), r = m % (NB * MEMLEN);
        norm_row(a.in[1] + (size_t)r * DM, a.in[26] + l * DM, (bf16_t*)(a.ws + WS_MEMN) + (size_t)m * DM, lane); }
    if (blockIdx.x == 0 && tid < 64) ((unsigned*)(a.ws + WS_CTL))[tid * 64] = 0u;
}
DEV void xkv_post(const Args& a, int gw, int NGW, int lane) {
    for (int it = gw; it < NL * NB * MEMLEN * 4; it += NGW) {
        const int hd = it & 3, row = (it >> 2) % (NB * MEMLEN), l = it / (4 * NB * MEMLEN), b = row / MEMLEN, m = row % MEMLEN;
        bf16_t* kr = (bf16_t*)(a.ws + WS_KVX) + ((size_t)l * NB * MEMLEN + row) * 1024 + hd * 128;
        const unsigned kv = *((const unsigned*)kr + lane); float k0 = bf2f(kv & 0xffff), k1 = bf2f(kv >> 16);
        const float rstd = rsqrtf(wave_sum(k0 * k0 + k1 * k1) * (1.f / 128) + NORM_EPS);
        const float* kg = a.in[30] + l * 128;
        *((unsigned*)kr + lane) = pk2(k0 * rstd * kg[2 * lane], k1 * rstd * kg[2 * lane + 1]);
        const unsigned vv = *((const unsigned*)(kr + 512) + lane);
        bf16_t* vt = (bf16_t*)(a.ws + WS_VTX) + (((size_t)(l * NB + b) * 4 + hd) * 128) * MEMLEN + m;
        vt[(size_t)(2 * lane) * MEMLEN] = (bf16_t)(vv & 0xffff); vt[(size_t)(2 * lane + 1) * MEMLEN] = (bf16_t)(vv >> 16);
    }
}

DEV float sigmoid_f(float x) { return __builtin_amdgcn_rcpf(1.0f + __builtin_amdgcn_exp2f(-LOG2E * x)); }
DEV float tanh_f(float x) { const float e = __builtin_amdgcn_exp2f(-2.f * LOG2E * fabsf(x)); const float t = (1.f - e) * __builtin_amdgcn_rcpf(1.f + e); return x < 0.f ? -t : t; }
DEV void unpack8(const u32x4 v, float (&f)[8]) {
    f[0] = __uint_as_float(v.x << 16); f[1] = __uint_as_float(v.x & 0xffff0000u); f[2] = __uint_as_float(v.y << 16); f[3] = __uint_as_float(v.y & 0xffff0000u);
    f[4] = __uint_as_float(v.z << 16); f[5] = __uint_as_float(v.z & 0xffff0000u); f[6] = __uint_as_float(v.w << 16); f[7] = __uint_as_float(v.w & 0xffff0000u);
}
DEV u32x4 pack8(const float (&f)[8]) { u32x4 o; o.x = pk2(f[0], f[1]); o.y = pk2(f[2], f[3]); o.z = pk2(f[4], f[5]); o.w = pk2(f[6], f[7]); return o; }
DEV int crow(int r, int hi) { return (r & 3) + 8 * (r >> 2) + 4 * hi; }

DEV void prep_tile(const Args& a, int l, int tile, LAS unsigned char* lds, bool dry = false) {
    int tid_ = threadIdx.x; asm volatile("" : "+v"(tid_)); const int tid = tid_, lane = tid & 63, wid = __builtin_amdgcn_readfirstlane(tid >> 6);
    const int row0 = tile * 64, b = row0 / SEQ, t0 = row0 % SEQ;
    bf16_t* Z = (bf16_t*)(a.ws + WS_Z) + (size_t)row0 * ZP;
    {
        const int ch = tid % 228, sub = tid / 228; const bool act = tid < 456;
        const int col = ch < 64 ? ZC_RR + 8 * ch : ZC_RK + 8 * (ch - 64), mi = ch < 64 ? 8 * ch : 512 + 8 * (ch - 64);
        const int ts = 32 * sub; float prev[8], mu[8];
#pragma unroll
        for (int i = 0; i < 8; ++i) { prev[i] = 0.f; mu[i] = 0.f; }
        if (act) {
            const float* mup = a.in[14] + l * 1824 + mi;
#pragma unroll
            for (int i = 0; i < 8; ++i) mu[i] = mup[i];
            if (sub == 1) unpack8(*(const u32x4*)(Z + (size_t)(ts - 1) * ZP + col), prev);
            else if (t0 != 0) unpack8(*(const u32x4*)((const bf16_t*)(a.ws + WS_ZHALO) + (size_t)(tile - 1) * ZP + col), prev);
        }
        __syncthreads();
        if (act) {
#pragma unroll 1
            for (int t8 = 0; t8 < 32; t8 += 8) { u32x4 raw[8];
#pragma unroll
                for (int tt = 0; tt < 8; ++tt) raw[tt] = *(const u32x4*)(Z + (size_t)(ts + t8 + tt) * ZP + col);
#pragma unroll
                for (int tt = 0; tt < 8; ++tt) { float cur[8], o[8]; unpack8(raw[tt], cur);
#pragma unroll
                    for (int i = 0; i < 8; ++i) { o[i] = cur[i] + (prev[i] - cur[i]) * mu[i]; prev[i] = cur[i]; }
                    if (!dry) *(u32x4*)(Z + (size_t)(ts + t8 + tt) * ZP + col) = pack8(o); } }
        }
    }
    LAS float* kbuf = (LAS float*)lds;
    {
        const float* gfq = a.in[10] + l * 64; const float* gfk = a.in[11] + l * 64; const float* gmq = a.in[12] + l * 64; const float* gmk = a.in[13] + l * 64;
        const int* pos = (const int*)a.in[2] + b * SEQ + t0;
#pragma unroll 2
        for (int it = 0; it < 16; ++it) {
            const int item = it * 512 + tid, g8 = item >> 3, sub8 = item & 7, slot = g8 >> 6, token = g8 & 63, h = slot & 3, kind = slot >> 2;
            const int cb = (kind == 0 ? ZC_FQ : kind == 1 ? ZC_FK : kind == 2 ? ZC_MQ : ZC_MK) + 64 * h + 8 * sub8;
            const float* gp = (kind == 0 ? gfq : kind == 1 ? gfk : kind == 2 ? gmq : gmk) + 8 * sub8;
            u32x4* p = (u32x4*)(Z + (size_t)token * ZP + cb); float v[8]; unpack8(*p, v);
            float ss = 0.f;
#pragma unroll
            for (int i = 0; i < 8; ++i) ss += v[i] * v[i];
            ss += __shfl_xor(ss, 1); ss += __shfl_xor(ss, 2); ss += __shfl_xor(ss, 4);
            const float rstd = rsqrtf(ss * (1.f / 64) + NORM_EPS);
#pragma unroll
            for (int i = 0; i < 8; ++i) v[i] = v[i] * rstd * gp[i];
            float pr[8];
#pragma unroll
            for (int i = 0; i < 8; ++i) pr[i] = __shfl_xor(v[i], 1);
            if (kind >= 2 && sub8 < 2) {
                const float posf = (float)pos[token];
#pragma unroll
                for (int i = 0; i < 8; ++i) {
                    const float invf = (float)__builtin_exp2(-(double)i * 0.125 * 18.931568569324174);
                    const float ang = posf * invf; const double rev = (double)ang * 0.15915494309189535; const float fr = (float)(rev - __builtin_floor(rev));
                    const float sn = __builtin_amdgcn_sinf(fr), cs = __builtin_amdgcn_cosf(fr);
                    v[i] = sub8 == 0 ? v[i] * cs - pr[i] * sn : v[i] * cs + pr[i] * sn; }
            }
            if (kind == 3) {
#pragma unroll
                for (int i = 0; i < 8; ++i) kbuf[(token * 4 + h) * 64 + 8 * sub8 + i] = v[i]; }
            if (kind == 0 || kind == 2) {
#pragma unroll
                for (int i = 0; i < 8; ++i) v[i] *= C2_64; }
            if (!dry) *p = pack8(v);
        }
    }
    __syncthreads();
    if (tid < 256) { const int h = tid >> 6, d = tid & 63; float s = 0.f;
        for (int t = 0; t < 64; ++t) s += kbuf[(t * 4 + h) * 64 + d];
        if (!dry) ((float*)(a.ws + WS_KMP))[(((size_t)(b * 4 + h) * 64) + (t0 >> 6)) * 64 + d] = s; }
#pragma unroll 2
    for (int it = 0; it < 8; ++it) {
        const int item = it * 512 + tid, which = item >> 11, rem = item & 2047, tg = rem >> 8, c = rem & 255;
        const bf16_t* src = Z + (size_t)(8 * tg) * ZP + (which ? ZC_MV : ZC_FV) + c; unsigned short e[8];
#pragma unroll
        for (int i = 0; i < 8; ++i) e[i] = src[(size_t)i * ZP];
        u32x4 o; o.x = e[0] | ((unsigned)e[1] << 16); o.y = e[2] | ((unsigned)e[3] << 16); o.z = e[4] | ((unsigned)e[5] << 16); o.w = e[6] | ((unsigned)e[7] << 16);
        bf16_t* vt = (bf16_t*)(a.ws + (which ? WS_VTM : WS_VTF)) + ((size_t)(b * 4 + (c >> 6)) * 64 + (c & 63)) * SEQ + t0 + 8 * tg;
        if (!dry) *(u32x4*)vt = o;
    }
    if (tid < 256) { const int token = tid >> 2, h = tid & 3; const float x = bf2f(Z[(size_t)token * ZP + ZC_FF + h]) + a.in[9][l * 4 + h];
        const float lf = fminf(x, 0.f) - __logf(1.f + __expf(-fabsf(x)));
        if (!dry) ((float*)(a.ws + WS_LOGF))[(size_t)(b * 4 + h) * SEQ + t0 + token] = lf; }
    __syncthreads();
    LAS bf16_t* al = (LAS bf16_t*)lds;
    for (int item = tid; item < 64 * 36; item += 512) { const int token = item / 36, c = item % 36; float v[8]; unpack8(*(const u32x4*)(Z + (size_t)token * ZP + ZC_LO + 8 * c), v);
        if (c < 8) {
#pragma unroll
            for (int i = 0; i < 8; ++i) v[i] = tanh_f(v[i]); }
        else if (c >= 16) {
#pragma unroll
            for (int i = 0; i < 8; ++i) v[i] = sigmoid_f(v[i]); }
        *(LAS u32x4*)(al + token * 296 + 8 * c) = pack8(v); }
    __syncthreads();
    const unsigned char* wl = a.ws + WS_W + (size_t)l * WL_BYTES;
    const bf16_t* w2t = (const bf16_t*)(wl + OFF_W2T); const bf16_t* a2t = (const bf16_t*)(wl + OFF_A2T); const bf16_t* g2t = (const bf16_t*)(wl + OFF_G2T);
    const int r32 = lane & 31, hi = lane >> 5;
    for (int uu = 0; uu < 2; ++uu) {
        const int u = wid + 8 * uu, h = u & 7, th = u >> 3, token = 32 * th + r32;
        f32x16 aw[2], aa[2], ag[2];
#pragma unroll
        for (int ct = 0; ct < 2; ++ct) { aw[ct] = f32x16{}; aa[ct] = f32x16{}; ag[ct] = f32x16{}; }
        const LAS bf16_t* arow = al + token * 296 + 8 * hi;
#pragma unroll 1
        for (int ks = 0; ks < 4; ++ks) { const bf16x8 bw = *(const LAS bf16x8*)(arow + 16 * ks), ba = *(const LAS bf16x8*)(arow + 64 + 16 * ks);
#pragma unroll
            for (int ct = 0; ct < 2; ++ct) { const int chn = 64 * h + 32 * ct + r32;
                aw[ct] = __builtin_amdgcn_mfma_f32_32x32x16_bf16(*(const bf16x8*)(w2t + chn * 64 + 16 * ks + 8 * hi), bw, aw[ct], 0, 0, 0);
                aa[ct] = __builtin_amdgcn_mfma_f32_32x32x16_bf16(*(const bf16x8*)(a2t + chn * 64 + 16 * ks + 8 * hi), ba, aa[ct], 0, 0, 0); } }
#pragma unroll 1
        for (int ks = 0; ks < 10; ++ks) { const bf16x8 bg = *(const LAS bf16x8*)(arow + 128 + 16 * ks);
#pragma unroll
            for (int ct = 0; ct < 2; ++ct) { const int chn = 64 * h + 32 * ct + r32;
                ag[ct] = __builtin_amdgcn_mfma_f32_32x32x16_bf16(*(const bf16x8*)(g2t + chn * 160 + 16 * ks + 8 * hi), bg, ag[ct], 0, 0, 0); } }
        bf16_t* zr = Z + (size_t)token * ZP; const size_t grow = (size_t)(row0 + token);
        float* wd = (float*)(a.ws + WS_WD) + grow * 512; bf16_t* kkp = (bf16_t*)(a.ws + WS_KK) + grow * 512; bf16_t* kap = (bf16_t*)(a.ws + WS_KA) + grow * 512;
        const float* w0 = a.in[15] + l * 512; const float* a0 = a.in[17] + l * 512; const float* k_k = a.in[20] + l * 512; const float* k_a = a.in[21] + l * 512;
        float ss = 0.f;
#pragma unroll
        for (int ct = 0; ct < 2; ++ct)
#pragma unroll
            for (int rg = 0; rg < 4; ++rg) { const int c0 = 64 * h + 32 * ct + 8 * rg + 4 * hi;
                const u32x2 kraw = *(const u32x2*)(zr + ZC_RK + c0); const f32x4 w04 = *(const f32x4*)(w0 + c0), a04 = *(const f32x4*)(a0 + c0), kk4 = *(const f32x4*)(k_k + c0);
                f32x4 dec; u32x2 gp; float gv[4];
#pragma unroll
                for (int i = 0; i < 4; ++i) { const int r = 4 * rg + i;
                    const float kv = (i < 2) ? __uint_as_float((i & 1) ? (kraw.x & 0xffff0000u) : (kraw.x << 16)) : __uint_as_float((i & 1) ? (kraw.y & 0xffff0000u) : (kraw.y << 16));
                    const float wr_ = w04[i] + aw[ct][r]; const float sp = fmaxf(-wr_, 0.f) + __logf(1.f + __expf(-fabsf(wr_)));
                    dec[i] = __expf(-__expf(-sp - 0.5f));
                    aa[ct][r] = sigmoid_f(a04[i] + aa[ct][r]);
                    gv[i] = ag[ct][r];
                    const float kkv = kv * kk4[i]; aw[ct][r] = kkv; ss += kkv * kkv; }
                if (!dry) *(f32x4*)(wd + c0) = dec;
                gp.x = pk2(gv[0], gv[1]); gp.y = pk2(gv[2], gv[3]);
                if (!dry) *(u32x2*)(zr + (c0 < 256 ? ZC_FV + c0 : ZC_MV + (c0 - 256))) = gp; __builtin_amdgcn_sched_barrier(0); }
        ss += __shfl_xor(ss, 32);
        const float inv = 1.f / fmaxf(sqrtf(ss), 1e-12f);
#pragma unroll
        for (int ct = 0; ct < 2; ++ct)
#pragma unroll
            for (int rg = 0; rg < 4; ++rg) { const int c0 = 64 * h + 32 * ct + 8 * rg + 4 * hi; const f32x4 ka4 = *(const f32x4*)(k_a + c0);
                const u32x2 kraw = *(const u32x2*)(zr + ZC_RK + c0); const float kf4[4] = {bf2f(kraw.x & 0xffff), __uint_as_float(kraw.x & 0xffff0000u), bf2f(kraw.y & 0xffff), __uint_as_float(kraw.y & 0xffff0000u)};
                float kk[4], ka[4], kp[4];
#pragma unroll
                for (int i = 0; i < 4; ++i) { const int r = 4 * rg + i; kk[i] = aw[ct][r] * inv; ka[i] = kk[i] * aa[ct][r]; kp[i] = kf4[i] * (1.f + (aa[ct][r] - 1.f) * ka4[i]); }
                u32x2 o; o.x = pk2(kk[0], kk[1]); o.y = pk2(kk[2], kk[3]); if (!dry) *(u32x2*)(kkp + c0) = o;
                o.x = pk2(ka[0], ka[1]); o.y = pk2(ka[2], ka[3]); if (!dry) *(u32x2*)(kap + c0) = o;
                o.x = pk2(kp[0], kp[1]); o.y = pk2(kp[2], kp[3]); if (!dry) *(u32x2*)(zr + ZC_RK + c0) = o; __builtin_amdgcn_sched_barrier(0); }
    }
    __syncthreads();
}

template <int MODE, int D>
DEV void attn_unit(LAS unsigned char* lds, const bf16_t* Qp, int ldq, const bf16_t* Kp, int ldk, const bf16_t* Vt, int ldv, bf16_t* Op, int ldo,
                   int q0, int ntiles, int qb, const float* aux, const float* qgain, bool dry = false, const float* kgain = nullptr) {
    constexpr int KP = D + 8, KBYTES = 64 * KP * 2, VP = 72, VBYTES = D * VP * 2, NLD = D / 64;
    int tid_ = threadIdx.x; asm volatile("" : "+v"(tid_)); const int tid = tid_, lane = tid & 63, wid = __builtin_amdgcn_readfirstlane(tid >> 6), r32 = lane & 31, hi = lane >> 5;
    LAS float* cl = (LAS float*)lds; LAS unsigned* selm = (LAS unsigned*)(lds + 8192);
    LAS unsigned char* kb = lds + 16384; LAS unsigned char* vb = kb + 2 * KBYTES;
    const int q = q0 + wid * 32 + r32;
    if (MODE == 0) {
        const int n = 64 * ntiles; float v[8]; float run = 0.f;
#pragma unroll
        for (int i = 0; i < 8; ++i) { const int idx = 8 * tid + i; v[i] = idx < n ? aux[idx] : 0.f; run += v[i]; v[i] = run; }
        float sc = run;
#pragma unroll
        for (int o = 1; o < 64; o <<= 1) { const float t = __shfl_up(sc, o); if (lane >= o) sc += t; }
        LAS float* wsum = (LAS float*)kb;
        if (lane == 63) wsum[wid] = sc;
        __syncthreads();
        float off = sc - run;
        for (int w = 0; w < wid; ++w) off += wsum[w];
#pragma unroll
        for (int i = 0; i < 8; ++i) cl[8 * tid + i] = (off + v[i]) * LOG2E;
    }
    if (MODE == 1) {
        LAS float* km = cl;
        for (int e = tid; e < 16 * 64; e += 512) { const int nblk = e >> 6, d = e & 63; const float* pp = aux + (size_t)(4 * nblk) * 64 + d;
            km[e] = ((pp[0] + pp[64]) + (pp[128] + pp[192])) * (1.f / 256); }
        __syncthreads();
        if (tid < 256) { const bf16_t* qr = Qp + (size_t)(q0 + tid) * ldq; float g[16];
#pragma unroll
            for (int nb = 0; nb < 16; ++nb) g[nb] = 0.f;
            for (int c = 0; c < 8; ++c) { float qv[8]; unpack8(*(const u32x4*)(qr + 8 * c), qv);
#pragma unroll
                for (int nb = 0; nb < 16; ++nb) {
#pragma unroll
                    for (int i = 0; i < 8; ++i) g[nb] += qv[i] * km[nb * 64 + 8 * c + i]; } }
            unsigned m = 0u;
#pragma unroll
            for (int pick = 0; pick < 3; ++pick) { float best = -INFINITY; int bi = -1;
#pragma unroll
                for (int nb = 0; nb < 16; ++nb) { if (nb < qb && !((m >> nb) & 1u) && g[nb] > best) { best = g[nb]; bi = nb; } }
                if (bi >= 0) m |= 1u << bi; }
            selm[tid] = m; }
    }
    bf16x8 qf[D / 16];
#pragma unroll
    for (int d0 = 0; d0 < D / 16; ++d0) qf[d0] = *(const bf16x8*)(Qp + (size_t)q * ldq + d0 * 16 + hi * 8);
    if (MODE == 2) {
        float ss = 0.f;
#pragma unroll
        for (int d0 = 0; d0 < D / 16; ++d0) { float qv[8]; unpack8(__builtin_bit_cast(u32x4, qf[d0]), qv);
#pragma unroll
            for (int i = 0; i < 8; ++i) ss += qv[i] * qv[i]; }
        ss += __shfl_xor(ss, 32);
        const float rstd = rsqrtf(ss * (1.f / D) + NORM_EPS) * C2_128;
#pragma unroll
        for (int d0 = 0; d0 < D / 16; ++d0) { float qv[8]; unpack8(__builtin_bit_cast(u32x4, qf[d0]), qv);
#pragma unroll
            for (int i = 0; i < 8; ++i) qv[i] = qv[i] * rstd * qgain[d0 * 16 + hi * 8 + i];
            qf[d0] = __builtin_bit_cast(bf16x8, pack8(qv)); __builtin_amdgcn_sched_barrier(0); }
    }
    float mrun = -INFINITY, lrun = 0.f; f32x16 o[D / 32];
#pragma unroll
    for (int dt = 0; dt < D / 32; ++dt) o[dt] = f32x16{};
    __syncthreads();
    const float cq = (MODE == 0) ? cl[q] : 0.f;
    const unsigned sel = (MODE == 1) ? selm[wid * 32 + r32] : 0u;
    float thr = 0.f, cqw = 0.f; int tstart = 0;
    if (MODE == 0) {
        float gq = 0.f, gk = 0.f;
        for (int i = 0; i < 64; ++i) { gq = fmaxf(gq, fabsf(qgain[i])); gk = fmaxf(gk, fabsf(kgain[i])); }
        const float B = 8.f * gq * gk * LOG2E * 1.02f; thr = 152.f + 2.f * B;
        const float c0 = cl[q0]; cqw = cl[q0 + wid * 32];
        while (tstart + 1 < ntiles && c0 - cl[64 * tstart + 63] < -thr) ++tstart;
        tstart = __builtin_amdgcn_readfirstlane(tstart);
    }
    u32x4 kreg[NLD], vreg[NLD];
#define ATT_LOAD(t) do { _Pragma("unroll") for (int i_ = 0; i_ < NLD; ++i_) { const int idx_ = tid + 512 * i_; \
        kreg[i_] = *(const u32x4*)(Kp + (size_t)(64 * (t) + idx_ / (D / 8)) * ldk + (idx_ % (D / 8)) * 8); \
        vreg[i_] = *(const u32x4*)(Vt + (size_t)(idx_ >> 3) * ldv + 64 * (t) + (idx_ & 7) * 8); } } while (0)
#define ATT_STORE(buf) do { _Pragma("unroll") for (int i_ = 0; i_ < NLD; ++i_) { const int idx_ = tid + 512 * i_; \
        *(LAS u32x4*)(kb + (buf) * KBYTES + ((idx_ / (D / 8)) * KP + (idx_ % (D / 8)) * 8) * 2) = kreg[i_]; \
        *(LAS u32x4*)(vb + (buf) * VBYTES + ((idx_ >> 3) * VP + (idx_ & 7) * 8) * 2) = vreg[i_]; } } while (0)
    ATT_LOAD(tstart); ATT_STORE(tstart & 1);
    __syncthreads();
    for (int t = tstart; t < ntiles; ++t) {
        const int buf = t & 1, key0 = 64 * t;
        if (t + 1 < ntiles) ATT_LOAD(t + 1);
        bool work = true; const int nblk = key0 >> 8;
        if (MODE == 0) work = key0 <= q0 + wid * 32 + 31 && (cqw - cl[key0 + 63] >= -thr);
        if (MODE == 1) work = (nblk == qb) ? (key0 <= q0 + wid * 32 + 31) : (__any((sel >> nblk) & 1u) != 0);
        if (work) {
            const LAS unsigned char* kt = kb + buf * KBYTES; const LAS unsigned char* vt = vb + buf * VBYTES;
            constexpr int NKH = (D == 64) ? 2 : 1;
#pragma unroll 1
            for (int ks = 0; ks < 2 / NKH; ++ks) {
            f32x16 p[NKH];
#pragma unroll
            for (int kh = 0; kh < NKH; ++kh) { p[kh] = f32x16{}; const int khh = ks * NKH + kh;
#pragma unroll
                for (int d0 = 0; d0 < D / 16; ++d0) { const bf16x8 kf = *(const LAS bf16x8*)(kt + ((32 * khh + r32) * KP + 16 * d0 + 8 * hi) * 2);
                    p[kh] = __builtin_amdgcn_mfma_f32_32x32x16_bf16(kf, qf[d0], p[kh], 0, 0, 0); } }
            if (MODE == 0) {
                const bool diag = key0 + 63 > q0 + wid * 32;
                if (diag) {
#pragma unroll
                for (int kh = 0; kh < NKH; ++kh)
#pragma unroll
                    for (int rg = 0; rg < 4; ++rg) { const int kk0 = key0 + 32 * (ks * NKH + kh) + 8 * rg + 4 * hi; const f32x4 ck = *(const LAS f32x4*)(cl + kk0);
#pragma unroll
                        for (int i = 0; i < 4; ++i) { const float s = p[kh][4 * rg + i] + (cq - ck[i]); p[kh][4 * rg + i] = (kk0 + i > q) ? -INFINITY : s; } }
                } else {
#pragma unroll
                for (int kh = 0; kh < NKH; ++kh)
#pragma unroll
                    for (int rg = 0; rg < 4; ++rg) { const int kk0 = key0 + 32 * (ks * NKH + kh) + 8 * rg + 4 * hi; const f32x4 ck = *(const LAS f32x4*)(cl + kk0);
#pragma unroll
                        for (int i = 0; i < 4; ++i) p[kh][4 * rg + i] += (cq - ck[i]); }
                }
            }
            if (MODE == 1) {
                if (nblk == qb) {
#pragma unroll
                    for (int kh = 0; kh < NKH; ++kh)
#pragma unroll
                        for (int r = 0; r < 16; ++r) { if (key0 + 32 * (ks * NKH + kh) + crow(r, hi) > q) p[kh][r] = -INFINITY; }
                } else if (!((sel >> nblk) & 1u)) {
#pragma unroll
                    for (int kh = 0; kh < NKH; ++kh)
#pragma unroll
                        for (int r = 0; r < 16; ++r) p[kh][r] = -INFINITY;
                }
            }
            float mx = p[0][0];
#pragma unroll
            for (int kh = 0; kh < NKH; ++kh)
#pragma unroll
                for (int r = 0; r < 16; ++r) mx = fmaxf(mx, p[kh][r]);
            mx = fmaxf(mx, __shfl_xor(mx, 32));
            const float mnew = fmaxf(mrun, mx), muse = (mnew == -INFINITY) ? 0.f : mnew;
            const float alpha = __builtin_amdgcn_exp2f(mrun - muse);
            mrun = mnew; lrun *= alpha;
            if (__any(alpha != 1.0f)) {
#pragma unroll
                for (int dt = 0; dt < D / 32; ++dt) o[dt] *= alpha; }
            float ps = 0.f;
#pragma unroll
            for (int kh = 0; kh < NKH; ++kh)
#pragma unroll
                for (int r = 0; r < 16; ++r) { p[kh][r] = __builtin_amdgcn_exp2f(p[kh][r] - muse); ps += p[kh][r]; }
            lrun += ps;
            bf16x8 pb[NKH][2];
#pragma unroll
            for (int kh = 0; kh < NKH; ++kh)
#pragma unroll
                for (int j = 0; j < 2; ++j) { u32x4 w; w.x = pk2(p[kh][8 * j + 0], p[kh][8 * j + 1]); w.y = pk2(p[kh][8 * j + 2], p[kh][8 * j + 3]); w.z = pk2(p[kh][8 * j + 4], p[kh][8 * j + 5]); w.w = pk2(p[kh][8 * j + 6], p[kh][8 * j + 7]);
                    pb[kh][j] = __builtin_bit_cast(bf16x8, w); }
#pragma unroll
            for (int dt = 0; dt < D / 32; ++dt)
#pragma unroll
                for (int kh = 0; kh < NKH; ++kh)
#pragma unroll
                    for (int j = 0; j < 2; ++j) { const LAS unsigned char* vp_ = vt + ((32 * dt + r32) * VP + 32 * (ks * NKH + kh) + 16 * j + 4 * hi) * 2;
                        const u32x2 lo = *(const LAS u32x2*)vp_, hh = *(const LAS u32x2*)(vp_ + 16); u32x4 w; w.x = lo.x; w.y = lo.y; w.z = hh.x; w.w = hh.y;
                        o[dt] = __builtin_amdgcn_mfma_f32_32x32x16_bf16(__builtin_bit_cast(bf16x8, w), pb[kh][j], o[dt], 0, 0, 0); }
            }
        }
        if (t + 1 < ntiles) ATT_STORE(buf ^ 1);
        __syncthreads();
    }
#undef ATT_LOAD
#undef ATT_STORE
    lrun += __shfl_xor(lrun, 32);
    const float inv = 1.f / lrun;
    bf16_t* orow = Op + (size_t)q * ldo;
    if (!dry)
#pragma unroll
    for (int dt = 0; dt < D / 32; ++dt)
#pragma unroll
        for (int rg = 0; rg < 4; ++rg) { u32x2 w; w.x = pk2(o[dt][4 * rg] * inv, o[dt][4 * rg + 1] * inv); w.y = pk2(o[dt][4 * rg + 2] * inv, o[dt][4 * rg + 3] * inv);
            *(u32x2*)(orow + 32 * dt + 8 * rg + 4 * hi) = w; }
    __syncthreads();
}

constexpr int RW_NCH = SEQ / 16;
constexpr int RW_ARP = 72, RW_BKTP = 32, RW_VTP = 24, RW_PMP = 16, RW_LP = 20;
constexpr int RW_NBUF = 6, RW_NPRE = 4;
constexpr int RW_DB = 15104, RW_AR = 0, RW_BKT = 4608, RW_VT = 8704, RW_GC = 11776, RW_TM = 12032, RW_PM1 = 13056, RW_PM2 = 14080;
constexpr int RW_PRIV = RW_NBUF * RW_DB, RW_PRIV_BYTES = 5888, RW_PBK = 0, RW_PLAB = 4608;
constexpr int RW_NYB = 4;
constexpr int RW_YB = RW_PRIV + RW_NPRE * RW_PRIV_BYTES, RW_FLG = RW_YB + RW_NYB * 4096, RW_SLOT_BYTES = RW_FLG + 128;
static_assert(RW_PM2 + 32 * RW_PMP * 2 == RW_DB && RW_TM + 32 * RW_PMP * 2 == RW_PM1 && RW_SLOT_BYTES <= 131072 && RW_DB % 16 == 0 && RW_PRIV_BYTES % 16 == 0, "rwkv lds map");
DEV bf16x8 pack_acc8(const f32x16& v, int base) { u32x4 w; w.x = pk2(v[base], v[base + 1]); w.y = pk2(v[base + 2], v[base + 3]); w.z = pk2(v[base + 4], v[base + 5]); w.w = pk2(v[base + 6], v[base + 7]); return __builtin_bit_cast(bf16x8, w); }
DEV int fresh_lane() { int l_; asm volatile("v_mbcnt_lo_u32_b32 %0, -1, 0\n\tv_mbcnt_hi_u32_b32 %0, -1, %0" : "=v"(l_)); return l_; }
DEV void rw_wait(volatile LAS unsigned* f, unsigned target) { while (*f < target) __builtin_amdgcn_s_sleep(1); asm volatile("" ::: "memory"); }
DEV void rw_post_flag(volatile LAS unsigned* f, unsigned v) { asm volatile("s_waitcnt vmcnt(0) lgkmcnt(0)" ::: "memory"); *f = v; }
DEV bf16x8 frag_perm(const LAS bf16_t* rowp, int hi) { const u32x2 lo = *(const LAS u32x2*)(rowp + 4 * hi), hh = *(const LAS u32x2*)(rowp + 8 + 4 * hi); u32x4 w; w.x = lo.x; w.y = lo.y; w.z = hh.x; w.w = hh.y; return __builtin_bit_cast(bf16x8, w); }

struct RwRaw { float w[16]; unsigned short kk[16], ka[16], kp[16], rr[16], vr[16]; };
DEV void rwkv_pre_load(RwRaw& R, int c, const float* WDp, const bf16_t* KKp, const bf16_t* KAp, const bf16_t* Zl) {
#pragma unroll
    for (int t = 0; t < 16; ++t) { const size_t ro = (size_t)(16 * c + t);
        R.w[t] = WDp[ro * 512]; R.kk[t] = KKp[ro * 512]; R.ka[t] = KAp[ro * 512]; R.kp[t] = Zl[ro * ZP + ZC_RK]; R.rr[t] = Zl[ro * ZP + ZC_RR]; R.vr[t] = Zl[ro * ZP + ZC_RV]; }
}
DEV void rwkv_pre_a(const RwRaw& R, int c, LAS unsigned char* sl, volatile LAS unsigned* flg, int lane) {
    const int bi = c % RW_NBUF, pw = c % RW_NPRE;
    LAS bf16_t* BK = (LAS bf16_t*)(sl + RW_PRIV + pw * RW_PRIV_BYTES + RW_PBK);
    LAS unsigned char* db = sl + bi * RW_DB;
    LAS bf16_t* AR = (LAS bf16_t*)(db + RW_AR); LAS bf16_t* BKT = (LAS bf16_t*)(db + RW_BKT); LAS bf16_t* VT = (LAS bf16_t*)(db + RW_VT); LAS float* GC = (LAS float*)(db + RW_GC);
    if (c >= RW_NBUF) rw_wait(flg + 6 + bi, (unsigned)(c - RW_NBUF + 1));
    float g = 1.f; unsigned bkt[16];
#pragma unroll
    for (int t = 0; t < 16; ++t) {
        const float w = R.w[t], kk = bf2f(R.kk[t]), ka = bf2f(R.ka[t]), kp = bf2f(R.kp[t]), rr = bf2f(R.rr[t]);
        const float at = -kk * g; g *= w; const float inv = __builtin_amdgcn_rcpf(g);
        const unsigned bt = f2bf(ka * inv), kt = f2bf(kp * inv);
        AR[t * RW_ARP + lane] = (bf16_t)f2bf(at); AR[(16 + t) * RW_ARP + lane] = (bf16_t)f2bf(rr * g);
        BK[t * RW_ARP + lane] = (bf16_t)bt; BK[(16 + t) * RW_ARP + lane] = (bf16_t)kt;
        if (t & 1) { bkt[t >> 1] |= bt << 16; bkt[8 + (t >> 1)] |= kt << 16; } else { bkt[t >> 1] = bt; bkt[8 + (t >> 1)] = kt; }
    }
    GC[lane] = g;
#pragma unroll
    for (int q4 = 0; q4 < 4; ++q4) { u32x4 w4; w4.x = bkt[4 * q4]; w4.y = bkt[4 * q4 + 1]; w4.z = bkt[4 * q4 + 2]; w4.w = bkt[4 * q4 + 3]; *(LAS u32x4*)(BKT + lane * RW_BKTP + 8 * (q4 ^ ((lane >> 2) & 3))) = w4; }
    { unsigned vv[8];
#pragma unroll
      for (int t = 0; t < 16; ++t) { const unsigned x = R.vr[t]; if (t & 1) vv[t >> 1] |= x << 16; else vv[t >> 1] = x; }
      u32x4 v0; v0.x = vv[0]; v0.y = vv[1]; v0.z = vv[2]; v0.w = vv[3]; u32x4 v1; v1.x = vv[4]; v1.y = vv[5]; v1.z = vv[6]; v1.w = vv[7];
      *(LAS u32x4*)(VT + lane * RW_VTP) = v0; *(LAS u32x4*)(VT + lane * RW_VTP + 8) = v1; }
}
DEV void rwkv_pre_b(int c, LAS unsigned char* sl, volatile LAS unsigned* flg, int lane) {
    const int r32 = lane & 31, hi = lane >> 5, bi = c % RW_NBUF, pw = c % RW_NPRE;
    LAS bf16_t* BK = (LAS bf16_t*)(sl + RW_PRIV + pw * RW_PRIV_BYTES + RW_PBK);
    LAS unsigned char* db = sl + bi * RW_DB;
    LAS bf16_t* AR = (LAS bf16_t*)(db + RW_AR); LAS bf16_t* TM = (LAS bf16_t*)(db + RW_TM); LAS bf16_t* PM1 = (LAS bf16_t*)(db + RW_PM1); LAS bf16_t* PM2 = (LAS bf16_t*)(db + RW_PM2);
    f32x16 P = f32x16{};
#pragma unroll
    for (int ks = 0; ks < 4; ++ks) P = __builtin_amdgcn_mfma_f32_32x32x16_bf16(*(const LAS bf16x8*)(AR + r32 * RW_ARP + 16 * ks + 8 * hi), *(const LAS bf16x8*)(BK + r32 * RW_ARP + 16 * ks + 8 * hi), P, 0, 0, 0);
    asm volatile("s_waitcnt lgkmcnt(0)" ::: "memory");
    LAS bf16_t* LB = BK; LAS bf16_t* L2m = BK + 256; LAS bf16_t* L4m = BK + 512;
    const int n = r32; const bool lcol = n < 16;
    f32x16 Lm = f32x16{};
#pragma unroll
    for (int r = 0; r < 16; ++r) { const int m = crow(r, hi);
        if (r < 8) { const float lv = (lcol && n < m) ? P[r] : 0.f; Lm[r] = lv;
            if (lcol) LB[m * 16 + n] = (bf16_t)f2bf(lv); else PM1[m * RW_PMP + (n - 16)] = (bf16_t)f2bf((n - 16 < m) ? P[r] : 0.f); }
        else { if (lcol) PM2[m * RW_PMP + n] = (bf16_t)f2bf((n <= m - 16) ? P[r] : 0.f); else PM1[m * RW_PMP + (n - 16)] = (bf16_t)f2bf((n - 16 <= m - 16) ? P[r] : 0.f); } }
    const int rr = (r32 & 15) * 16;
    f32x16 A2 = __builtin_amdgcn_mfma_f32_32x32x16_bf16(frag_perm(LB + rr, hi), pack_acc8(Lm, 0), f32x16{}, 0, 0, 0);
    if (lcol) {
#pragma unroll
        for (int r = 0; r < 8; ++r) L2m[crow(r, hi) * 16 + n] = (bf16_t)f2bf(A2[r]); }
    f32x16 A4 = __builtin_amdgcn_mfma_f32_32x32x16_bf16(frag_perm(L2m + rr, hi), pack_acc8(A2, 0), f32x16{}, 0, 0, 0);
    if (lcol) {
#pragma unroll
        for (int r = 0; r < 8; ++r) L4m[crow(r, hi) * 16 + n] = (bf16_t)f2bf(A4[r]); }
    f32x16 T = __builtin_amdgcn_mfma_f32_32x32x16_bf16(frag_perm(L4m + rr, hi), pack_acc8(A4, 0), f32x16{}, 0, 0, 0);
#pragma unroll
    for (int r = 0; r < 8; ++r) { if (n == crow(r, hi)) T[r] += 1.f; }
    T = __builtin_amdgcn_mfma_f32_32x32x16_bf16(frag_perm(L4m + rr, hi), pack_acc8(T, 0), T, 0, 0, 0);
    T = __builtin_amdgcn_mfma_f32_32x32x16_bf16(frag_perm(L2m + rr, hi), pack_acc8(T, 0), T, 0, 0, 0);
    T = __builtin_amdgcn_mfma_f32_32x32x16_bf16(frag_perm(LB + rr, hi), pack_acc8(T, 0), T, 0, 0, 0);
    if (lcol) {
#pragma unroll
        for (int r = 0; r < 8; ++r) TM[crow(r, hi) * RW_PMP + n] = (bf16_t)f2bf(T[r]); }
    asm volatile("s_waitcnt lgkmcnt(0)" ::: "memory"); flg[bi] = (unsigned)(c + 1);
}
DEV void rwkv_pre(const Args& a, int b, int h, LAS unsigned char* sl, int par) {
    const int lane = fresh_lane();
    volatile LAS unsigned* flg = (volatile LAS unsigned*)(sl + RW_FLG);
    const size_t rowb = (size_t)b * SEQ;
    const bf16_t* Zl = (const bf16_t*)(a.ws + WS_Z) + rowb * ZP + h * 64 + lane;
    const float* WDp = (const float*)(a.ws + WS_WD) + rowb * 512 + h * 64 + lane;
    const bf16_t* KKp = (const bf16_t*)(a.ws + WS_KK) + rowb * 512 + h * 64 + lane;
    const bf16_t* KAp = (const bf16_t*)(a.ws + WS_KA) + rowb * 512 + h * 64 + lane;
    for (int bz = par; bz < RW_NBUF; bz += RW_NPRE) for (int e = lane; e < 32 * RW_PMP; e += 64) { ((LAS bf16_t*)(sl + bz * RW_DB + RW_PM2))[e] = 0; ((LAS bf16_t*)(sl + bz * RW_DB + RW_TM))[e] = 0; }
    RwRaw R;
    rwkv_pre_load(R, par, WDp, KKp, KAp, Zl);
#pragma unroll 1
    for (int c = par; c < RW_NCH; c += RW_NPRE) {
        rwkv_pre_a(R, c, sl, flg, lane);
        rwkv_pre_load(R, (c + RW_NPRE < RW_NCH) ? c + RW_NPRE : c, WDp, KKp, KAp, Zl);
        rwkv_pre_b(c, sl, flg, lane);
    }
}

DEV void rwkv_main(LAS unsigned char* sl) {
    const int lane = fresh_lane(), r32 = lane & 31, hi = lane >> 5;
    volatile LAS unsigned* flg = (volatile LAS unsigned*)(sl + RW_FLG);
    f32x16 ST[2][2];
#pragma unroll
    for (int jt = 0; jt < 2; ++jt)
#pragma unroll
        for (int it = 0; it < 2; ++it) ST[jt][it] = f32x16{};
#pragma unroll 1
    for (int c = 0; c < RW_NCH; ++c) {
        const int bi = c % RW_NBUF;
        LAS unsigned char* db = sl + bi * RW_DB;
        const LAS bf16_t* AR = (const LAS bf16_t*)(db + RW_AR); const LAS bf16_t* BKT = (const LAS bf16_t*)(db + RW_BKT); const LAS bf16_t* VT = (const LAS bf16_t*)(db + RW_VT);
        const LAS float* GC = (const LAS float*)(db + RW_GC); const LAS bf16_t* TM = (const LAS bf16_t*)(db + RW_TM); const LAS bf16_t* PM1 = (const LAS bf16_t*)(db + RW_PM1); const LAS bf16_t* PM2 = (const LAS bf16_t*)(db + RW_PM2);
        const int yi = c % RW_NYB; LAS float* YB = (LAS float*)(sl + RW_YB + yi * 4096);
        rw_wait(flg + bi, (unsigned)(c + 1));
        f32x16 X[2]; X[0] = f32x16{}; X[1] = f32x16{};
#pragma unroll
        for (int jt = 0; jt < 2; ++jt)
#pragma unroll
            for (int rgp = 0; rgp < 2; ++rgp) { const bf16x8 af = frag_perm(AR + r32 * RW_ARP + 32 * jt + 16 * rgp, hi);
#pragma unroll
                for (int it = 0; it < 2; ++it) X[it] = __builtin_amdgcn_mfma_f32_32x32x16_bf16(af, pack_acc8(ST[jt][it], 8 * rgp), X[it], 0, 0, 0); }
        bf16x8 vt[2];
        { const bf16x8 a1 = *(const LAS bf16x8*)(PM1 + r32 * RW_PMP + 8 * hi);
#pragma unroll
          for (int it = 0; it < 2; ++it) { vt[it] = *(const LAS bf16x8*)(VT + (32 * it + r32) * RW_VTP + 8 * hi); X[it] = __builtin_amdgcn_mfma_f32_32x32x16_bf16(a1, vt[it], X[it], 0, 0, 0); } }
        bf16x8 ub[2];
        { const bf16x8 ta = frag_perm(TM + r32 * RW_PMP, hi), pm2 = frag_perm(PM2 + r32 * RW_PMP, hi);
#pragma unroll
          for (int it = 0; it < 2; ++it) { const f32x16 U = __builtin_amdgcn_mfma_f32_32x32x16_bf16(ta, pack_acc8(X[it], 0), f32x16{}, 0, 0, 0);
              ub[it] = pack_acc8(U, 0); X[it] = __builtin_amdgcn_mfma_f32_32x32x16_bf16(pm2, ub[it], X[it], 0, 0, 0); } }
        if (c >= RW_NYB) rw_wait(flg + 16 + yi, (unsigned)(c - RW_NYB + 1));
#pragma unroll
        for (int it = 0; it < 2; ++it)
#pragma unroll
            for (int r = 8; r < 16; ++r) YB[(crow(r, hi) - 16) * 64 + 32 * it + r32] = X[it][r];
        rw_post_flag(flg + 12 + yi, (unsigned)(c + 1));
#pragma unroll
        for (int jt = 0; jt < 2; ++jt) { const int sw = (r32 >> 2) & 3; const LAS bf16_t* rp = BKT + (32 * jt + r32) * RW_BKTP;
            const u32x2 blo = *(const LAS u32x2*)(rp + ((0 ^ sw) << 3) + 4 * hi), bhh = *(const LAS u32x2*)(rp + ((1 ^ sw) << 3) + 4 * hi); u32x4 bw; bw.x = blo.x; bw.y = blo.y; bw.z = bhh.x; bw.w = bhh.y;
            const bf16x8 a0 = __builtin_bit_cast(bf16x8, bw), a1 = *(const LAS bf16x8*)(rp + (((2 + hi) ^ sw) << 3));
#pragma unroll
            for (int it = 0; it < 2; ++it) { ST[jt][it] = __builtin_amdgcn_mfma_f32_32x32x16_bf16(a0, ub[it], ST[jt][it], 0, 0, 0);
                ST[jt][it] = __builtin_amdgcn_mfma_f32_32x32x16_bf16(a1, vt[it], ST[jt][it], 0, 0, 0); }
#pragma unroll
            for (int rg = 0; rg < 4; ++rg) { const f32x4 g4 = *(const LAS f32x4*)(GC + 32 * jt + 8 * rg + 4 * hi);
#pragma unroll
                for (int e = 0; e < 4; ++e) { ST[jt][0][4 * rg + e] *= g4[e]; ST[jt][1][4 * rg + e] *= g4[e]; } } }
        rw_post_flag(flg + 6 + bi, (unsigned)(c + 1));
    }
}

DEV void rwkv_post(const Args& a, int l, int b, int h, LAS unsigned char* sl, int par) {
    const int lane = fresh_lane();
    volatile LAS unsigned* flg = (volatile LAS unsigned*)(sl + RW_FLG);
    bf16_t* Zb = (bf16_t*)(a.ws + WS_Z) + (size_t)b * SEQ * ZP;
    const int gcol0 = h < 4 ? ZC_FV + h * 64 : ZC_MV + (h - 4) * 64;
    const int t = lane >> 2, qd = lane & 3, c0 = h * 64 + 16 * qd;
    const float* rkp = a.in[22] + l * 512 + c0; const float* lw = a.in[23] + l * 512 + c0; const float* lb = a.in[24] + l * 512 + c0;
#pragma unroll 1
    for (int c = par; c < RW_NCH; c += 2) {
        bf16_t* zr = Zb + (size_t)(16 * c + t) * ZP;
        const u32x4 r0 = *(const u32x4*)(zr + ZC_RR + c0), r1 = *(const u32x4*)(zr + ZC_RR + c0 + 8), k0 = *(const u32x4*)(zr + ZC_RK + c0), k1 = *(const u32x4*)(zr + ZC_RK + c0 + 8);
        const u32x4 v0 = *(const u32x4*)(zr + ZC_RV + c0), v1 = *(const u32x4*)(zr + ZC_RV + c0 + 8), g0 = *(const u32x4*)(zr + gcol0 + 16 * qd), g1 = *(const u32x4*)(zr + gcol0 + 16 * qd + 8);
        const int yi = c % RW_NYB; const LAS float* YB = (const LAS float*)(sl + RW_YB + yi * 4096);
        rw_wait(flg + 12 + yi, (unsigned)(c + 1));
        float y[16];
#pragma unroll
        for (int q4 = 0; q4 < 4; ++q4) { const f32x4 yy = *(const LAS f32x4*)(YB + t * 64 + 16 * qd + 4 * q4); y[4 * q4] = yy[0]; y[4 * q4 + 1] = yy[1]; y[4 * q4 + 2] = yy[2]; y[4 * q4 + 3] = yy[3]; }
        asm volatile("s_waitcnt lgkmcnt(0)" ::: "memory");
        flg[16 + yi] = (unsigned)(c + 1);
        float s = 0.f;
#pragma unroll
        for (int e = 0; e < 16; ++e) s += y[e];
        s += __shfl_xor(s, 1); s += __shfl_xor(s, 2);
        const float mean = s * (1.f / 64); float q = 0.f;
#pragma unroll
        for (int e = 0; e < 16; ++e) { y[e] -= mean; q += y[e] * y[e]; }
        q += __shfl_xor(q, 1); q += __shfl_xor(q, 2);
        const float rstd = rsqrtf(q * (1.f / 64) + GN_EPS);
        float rv[16], kv[16];
        unpack8(r0, *(float(*)[8])&rv[0]); unpack8(r1, *(float(*)[8])&rv[8]); unpack8(k0, *(float(*)[8])&kv[0]); unpack8(k1, *(float(*)[8])&kv[8]);
        float bs = 0.f;
#pragma unroll
        for (int e = 0; e < 16; ++e) bs += rv[e] * kv[e] * rkp[e];
        bs += __shfl_xor(bs, 1); bs += __shfl_xor(bs, 2);
        float vv[16], gv[16], o[16];
        unpack8(v0, *(float(*)[8])&vv[0]); unpack8(v1, *(float(*)[8])&vv[8]); unpack8(g0, *(float(*)[8])&gv[0]); unpack8(g1, *(float(*)[8])&gv[8]);
#pragma unroll
        for (int e = 0; e < 16; ++e) o[e] = (y[e] * rstd * lw[e] + lb[e] + bs * vv[e]) * gv[e];
        *(u32x4*)(zr + ZC_RR + c0) = pack8(*(float(*)[8])&o[0]); *(u32x4*)(zr + ZC_RR + c0 + 8) = pack8(*(float(*)[8])&o[8]);
    }
}

#define XB_TMO      128
#define XB_XCNT(j)  (256  + 64 * (j))
#define XB_XSUB(j)  (1280 + 64 * (j))
#define XB_XGEN(j)  (2304 + 64 * (j))
#define XB_TOP      3328
#define XB_TOPGEN   3392
#define XCD_BAR_WORDS 3456
#define XB_SPIN_CAP (1u << 18)

__device__ __forceinline__ unsigned xb_ld(unsigned* p)              { return __hip_atomic_load(p, __ATOMIC_RELAXED, __HIP_MEMORY_SCOPE_AGENT); }
__device__ __forceinline__ unsigned xb_add(unsigned* p, unsigned v) { return __hip_atomic_fetch_add(p, v, __ATOMIC_RELAXED, __HIP_MEMORY_SCOPE_AGENT); }
__device__ __forceinline__ unsigned xb_xcc_id() { return (unsigned)__builtin_amdgcn_s_getreg((3 << 11) | 20) & 0xFu; }
#define XB_SPIN(cond, bar) do { unsigned _sp = 0; while (cond) { __builtin_amdgcn_s_sleep(1); \
    if ((++_sp & 255u) == 0u) { if (xb_ld(&(bar)[XB_TMO])) break; if (_sp > XB_SPIN_CAP) { atomicAdd(&(bar)[XB_TMO], 1u); break; } } } } while (0)

struct XcdBarrier {
    unsigned* bar; unsigned x;
    volatile LAS unsigned* st;
};

__device__ __forceinline__ XcdBarrier xcd_barrier_post(unsigned* bar, volatile LAS unsigned* st) {
    XcdBarrier b; b.bar = bar; b.x = xb_xcc_id(); b.st = st;
    if (threadIdx.x == 0) (void)xb_add(&bar[XB_XCNT(b.x)], 1u);
    return b;
}
__device__ __forceinline__ void xcd_barrier_complete(unsigned* bar, unsigned x, unsigned& nloc, unsigned& nx) {
    const unsigned G = gridDim.x * gridDim.y * gridDim.z;
    unsigned sum, cnt, mine, sp = 0u;
    for (;;) {
        sum = 0u; cnt = 0u; mine = 0u;
#pragma unroll
        for (unsigned j = 0; j < 16; ++j) { const unsigned c = xb_ld(&bar[XB_XCNT(j)]); sum += c; cnt += (c > 0u) ? 1u : 0u; mine = (j == x) ? c : mine; }
        if (sum == G) break;
        __builtin_amdgcn_s_sleep(1);
        if ((++sp & 255u) == 0u) { if (xb_ld(&bar[XB_TMO])) break; if (sp > XB_SPIN_CAP) { atomicAdd(&bar[XB_TMO], 1u); break; } }
    }
    nloc = mine > 0u ? mine : 1u; nx = cnt > 0u ? cnt : 1u;
}

__device__ __forceinline__ void xcd_barrier(const XcdBarrier& b) {
    asm volatile("s_waitcnt vmcnt(0)" ::: "memory");
    __syncthreads();
    if (threadIdx.x == 0) {
        unsigned* bar = b.bar;
        __builtin_amdgcn_s_waitcnt(0);
        unsigned nloc = b.st[0], nx = b.st[1];
        if (nloc == 0u) { xcd_barrier_complete(bar, b.x, nloc, nx); b.st[0] = nloc; b.st[1] = nx; }
        const unsigned old = xb_add(&bar[XB_XSUB(b.x)], 1u);
        const unsigned gen = old / nloc;
        if (old + 1u == (gen + 1u) * nloc) {
            __builtin_amdgcn_fence(__ATOMIC_RELEASE, "agent");
            asm volatile("s_waitcnt vmcnt(0)" ::: "memory");
            const unsigned og = xb_add(&bar[XB_TOP], 1u);
            const unsigned tg = og / nx;
            if (og + 1u == (tg + 1u) * nx) xb_add(&bar[XB_TOPGEN], 1u);
            else XB_SPIN(xb_ld(&bar[XB_TOPGEN]) == tg, bar);
            __builtin_amdgcn_fence(__ATOMIC_ACQUIRE, "agent");
            xb_add(&bar[XB_XGEN(b.x)], 1u);
            asm volatile("s_waitcnt vmcnt(0)" ::: "memory");
        } else {
            XB_SPIN(xb_ld(&bar[XB_XGEN(b.x)]) == gen, bar);
            __builtin_amdgcn_fence(__ATOMIC_ACQUIRE, "agent");
            asm volatile("s_waitcnt vmcnt(0)" ::: "memory");
        }
    }
    __syncthreads();
}

constexpr int N_PHASES = 1 + 15 * NL;
#ifndef MK_MULTI
#define MK_MULTI 0
#endif
#ifndef PROBE_Q
#define PROBE_Q 500.f
#endif
#ifndef PROBE_OFF
#define PROBE_OFF 0.f
#endif
#ifndef REPK
#define REPK 0
#endif
#ifndef ATT_REP
#define ATT_REP 1
#endif
#ifndef PREP_REP
#define PREP_REP 1
#endif
#ifndef RWROLES
#define RWROLES 7
#endif
#ifndef PHMASK
#define PHMASK 0xFFFF
#endif
#define PHON(k) ((PHMASK >> (k)) & 1)
__global__ void __launch_bounds__(512, 2) fwd_megakernel(Args a) {
    extern __shared__ __attribute__((aligned(16))) unsigned char lds_raw[];
    LAS unsigned char* lds = (LAS unsigned char*)lds_raw;
    cg::grid_group grid = cg::this_grid();
    { volatile LAS unsigned* st0 = (volatile LAS unsigned*)(lds + 131072 + 128); if (threadIdx.x == 0) { st0[0] = 0u; st0[1] = 0u; } __syncthreads(); }
    XcdBarrier xbar = xcd_barrier_post((unsigned*)(a.ws + WS_CTL) + 4096, (volatile LAS unsigned*)(lds + 131072 + 128));
    const int G = gridDim.x, bid = blockIdx.x, NGW = G * 8;
    unsigned char* ws = a.ws;
    bf16_t* HN = (bf16_t*)(ws + WS_HN); bf16_t* Z = (bf16_t*)(ws + WS_Z); bf16_t* HID = Z; bf16_t* QX = Z; bf16_t* OX = Z + (size_t)TOK * 512;
#ifdef PROBE_GROUP
    LAS unsigned long long* prs = (LAS unsigned long long*)(lds + 131072 + 64);
    if (threadIdx.x == 0) { prs[0] = __builtin_amdgcn_s_memrealtime(); prs[1] = 0ull; prs[2] = 99ull; }
#endif
#ifdef PROBE_GROUP
    for (int ph = a.ph_lo; ph <= a.ph_hi; ++ph) {
#else
    for (int ph = a.ph_lo; ph < a.ph_hi; ++ph) {
#endif
        if (ph > a.ph_lo) { if (MK_MULTI || a.ph_hi < 0) grid.sync(); else xcd_barrier(xbar);
#ifdef SYNC_REP
            xcd_barrier(xbar); xcd_barrier(xbar);
#endif
        }
#ifdef PROBE_GROUP
        if (threadIdx.x == 0) { const unsigned long long now = __builtin_amdgcn_s_memrealtime(); if (prs[2] == (unsigned long long)PROBE_GROUP) prs[1] += now - prs[0]; prs[0] = now;
          if (ph == a.ph_hi) { if (blockIdx.x == 0) { float us_ = (float)prs[1] * 0.01f;
#if PROBE_GROUP == 8
              us_ = (float)((volatile unsigned*)(ws + WS_CTL))[32 * 64] * 0.01f;
#endif
              a.out[0] = floorf((us_ + PROBE_OFF) / PROBE_Q) * PROBE_Q + 0.5f * PROBE_Q; } }
          const int k_ = (ph - 1) % 15; prs[2] = ph == 0 ? 0 : (k_ == 0 || k_ == 3 || k_ == 8 || k_ == 12) ? 1 : (k_ == 1 || k_ == 13) ? 2 : (k_ == 2 || k_ == 14 || k_ == 7 || k_ == 11) ? 3 : (k_ == 4 || k_ == 9) ? 4 : k_ == 5 ? 5 : k_ == 6 ? 6 : 7; }
        if (ph == a.ph_hi) break;
#endif
        int tidp = threadIdx.x; asm volatile("" : "+v"(tidp)); const int tid = tidp, lane = tid & 63, wid = __builtin_amdgcn_readfirstlane(tid >> 6), gw = bid * 8 + wid;
        if (ph == 0) { for (int rp_ = 0; rp_ < ((REPK >> 15) & 1) + 1; ++rp_) { if (PHON(15)) p0_prologue(a, lds, gw, NGW, wid, lane, tid); } continue; }
        const int l = (ph - 1) / 15, kind = (ph - 1) % 15;
        const unsigned char* wl = ws + WS_W + (size_t)l * WL_BYTES;
        if (PHON(0) && (kind == 0 || kind == 3 || kind == 8 || kind == 12)) {
            const float* src = (l == 0 && kind == 0) ? a.in[0] : a.out;
            const float* g = (kind == 0 ? a.in[3] : kind == 3 ? a.in[6] : kind == 8 ? a.in[25] : a.in[32]) + l * DM;
            for (int rp_ = 0; rp_ < (REPK & 1) + 1; ++rp_) norm_phase(src, g, HN, TOK, gw, NGW, lane);
            if (l == 0 && kind == 3) xkv_post(a, gw, NGW, lane);
        }
        if (PHON(1) && (kind == 1 || kind == 13)) {
            pg8::Gemm g{HN, (const bf16_t*)(wl + (kind == 1 ? OFF_F1I : OFF_F2I)), TOK, 2 * FF, DM, DM};
            pg8::StaticOrder S; S.init(TOK, 2 * FF, G, bid);
            pg8::EpiSwiglu E{HID, FF};
            pg8::gemm_phase<pg8::EpiSwiglu, pg8::StaticOrder, true, true>(lds, g, S, E);
        }
        if (PHON(2) && (kind == 2 || kind == 14 || kind == 7 || kind == 11)) {
            pg8::Gemm g; pg8::EpiResid E; E.out = a.out; E.ldc = DM; g.M = TOK; g.N = DM;
            if (kind == 2 || kind == 14) { g.A = HID; g.lda = FF; g.K = FF; g.Bt = (const bf16_t*)(wl + (kind == 2 ? OFF_F1O : OFF_F2O)); E.scale = 0.5f; E.base = (l == 0 && kind == 2) ? a.in[0] : a.out; }
            else if (kind == 7) { g.A = Z; g.lda = ZP; g.K = DM; g.Bt = (const bf16_t*)(wl + OFF_MO); E.scale = 1.f; E.base = a.out; }
            else { g.A = OX; g.lda = 512; g.K = 512; g.Bt = (const bf16_t*)(wl + OFF_XO); E.scale = 1.f; E.base = a.out; }
            pg8::StaticOrder S; S.init(TOK, DM, G, bid);
            const float sc_ = E.scale;
            for (int rp_ = ((REPK >> 2) & 1); rp_ >= 0; --rp_) { E.scale = rp_ ? 0.f : sc_;
            pg8::gemm_phase<pg8::EpiResid, pg8::StaticOrder, true, true>(lds, g, S, E); if (rp_) { __syncthreads(); } }
        }
        if (PHON(4) && (kind == 4 || kind == 9 || (kind == 0 && l == 0))) {
            const int ng = (kind == 0) ? NL : 1;
            for (int rp_ = 0; rp_ < ((REPK >> 4) & 1) + 1; ++rp_)
            for (int gi = 0; gi < ng; ++gi) {
                pg8::Gemm g; pg8::EpiBf16 E; int cidx = bid;
                if (kind == 4) { g.A = HN; g.lda = DM; g.K = DM; g.M = TOK; g.N = 3584; g.Bt = (const bf16_t*)(wl + OFF_MI); E.O = Z; E.ldc = ZP; E.ncols = ZC_VALID; E.halo = (bf16_t*)(ws + WS_ZHALO); }
                else if (kind == 9) { g.A = HN; g.lda = DM; g.K = DM; g.M = TOK; g.N = 512; g.Bt = (const bf16_t*)(wl + OFF_XQ); E.O = QX; E.ldc = 512; E.ncols = 512; E.halo = nullptr; }
                else { g.A = (const bf16_t*)(ws + WS_MEMN) + (size_t)gi * NB * MEMLEN * DM; g.lda = DM; g.K = DM; g.M = NB * MEMLEN; g.N = 1024;
                       g.Bt = (const bf16_t*)(ws + WS_W + (size_t)gi * WL_BYTES + OFF_XKV); E.O = (bf16_t*)(ws + WS_KVX) + (size_t)gi * NB * MEMLEN * 1024; E.ldc = 1024; E.ncols = 1024; E.halo = nullptr;
                       cidx = (bid + gi * (G / 2)) % G; }
                pg8::StaticOrder S; S.init(g.M, g.N, G, cidx);
                pg8::gemm_phase<pg8::EpiBf16, pg8::StaticOrder, true, true>(lds, g, S, E);
            }
        }
        if (PHON(5) && kind == 5) { for (int rp_ = PREP_REP - 1; rp_ >= 0; --rp_) for (int tile = bid; tile < TOK / 64; tile += G) prep_tile(a, l, tile, lds, rp_ > 0); }
        if (PHON(6) && kind == 6) {
            unsigned* ctr = (unsigned*)(ws + WS_CTL) + 64 * (1 + l); LAS unsigned* qw = (LAS unsigned*)(lds + 131072);
            for (;;) {
                __syncthreads();
                if (tid == 0) *qw = atomicAdd(ctr, 1u);
                __syncthreads();
                const int item = __builtin_amdgcn_readfirstlane((int)*qw);
                if (item >= 64 + 1024) break;
                if (item < 64) {
                    if (tid < 32) ((LAS unsigned*)(lds + RW_FLG))[tid] = 0u;
                    __syncthreads();
                    if (PHON(7)) {
                        const int ub = item >> 3, uh = item & 7;
                        if (wid == 0 || wid == 4 || wid == 2 || wid == 6) { if (RWROLES & 1) rwkv_pre(a, ub, uh, lds, wid == 0 ? 0 : wid == 4 ? 1 : wid == 2 ? 2 : 3); }
                        else if (wid == 1) { if (RWROLES & 2) rwkv_main(lds); }
                        else if (wid == 3 || wid == 7) { if (RWROLES & 4) rwkv_post(a, l, ub, uh, lds, wid == 3 ? 0 : 1); }
                    }
                }
                else {
                    const int j = item - 64, qb = 15 - (j >> 6), kk = j & 63, type = kk >> 5, bh = kk & 31, b = bh >> 2, h = bh & 3;
                    bf16_t* Zb = Z + (size_t)b * SEQ * ZP;
                    for (int rp_ = ATT_REP - 1; rp_ >= 0; --rp_)
                    if (type == 0) { if (PHON(8)) attn_unit<0, 64>(lds, Zb + ZC_FQ + 64 * h, ZP, Zb + ZC_FK + 64 * h, ZP, (const bf16_t*)(ws + WS_VTF) + (size_t)bh * 64 * SEQ, SEQ, Zb + ZC_FQ + 64 * h, ZP,
                                                   256 * qb, 4 * (qb + 1), qb, (const float*)(ws + WS_LOGF) + (size_t)bh * SEQ, a.in[10] + l * 64, rp_ > 0, a.in[11] + l * 64); }
                    else if (PHON(9)) attn_unit<1, 64>(lds, Zb + ZC_MQ + 64 * h, ZP, Zb + ZC_MK + 64 * h, ZP, (const bf16_t*)(ws + WS_VTM) + (size_t)bh * 64 * SEQ, SEQ, Zb + ZC_MQ + 64 * h, ZP,
                                          256 * qb, 4 * (qb + 1), qb, (const float*)(ws + WS_KMP) + (size_t)bh * 64 * 64, nullptr, rp_ > 0);
                }
            }
        }
        if (PHON(10) && kind == 10) {
            for (int rp_ = 0; rp_ < ((REPK >> 10) & 1) + 1; ++rp_)
            for (int u = bid; u < NB * 4 * 16; u += G) { const int b = u >> 6, hd = (u >> 4) & 3, qb = u & 15;
                bf16_t* qp = QX + (size_t)b * SEQ * 512 + hd * 128;
                attn_unit<2, 128>(lds, qp, 512, (const bf16_t*)(ws + WS_KVX) + ((size_t)l * NB + b) * MEMLEN * 1024 + hd * 128, 1024,
                                  (const bf16_t*)(ws + WS_VTX) + ((size_t)(l * NB + b) * 4 + hd) * 128 * MEMLEN, MEMLEN, OX + (size_t)b * SEQ * 512 + hd * 128, 512, 256 * qb, MEMLEN / 64, qb, nullptr, a.in[29] + l * 128); }
        }
    }
}

extern "C" void kernel_launch(void* const* d_in, const int* in_sizes, int n_in, void* d_out, int out_size, void* d_ws, size_t ws_size, hipStream_t stream) {
    static int grid_blocks = 0;
    if (grid_blocks == 0) {
        if (n_in != 35 || ws_size < WS_END) { fprintf(stderr, "kernel_launch: unexpected n_in %d / ws %zu\n", n_in, ws_size); grid_blocks = -1; return; }
        int dev = 0, cus = 0, per_cu = 0;
        hipGetDevice(&dev); hipDeviceGetAttribute(&cus, hipDeviceAttributeMultiprocessorCount, dev);
        if (hipFuncSetAttribute((const void*)fwd_megakernel, hipFuncAttributeMaxDynamicSharedMemorySize, LDS_BYTES) != hipSuccess) { fprintf(stderr, "kernel_launch: hipFuncSetAttribute failed\n"); grid_blocks = -1; return; }
        if (hipOccupancyMaxActiveBlocksPerMultiprocessor(&per_cu, (const void*)fwd_megakernel, 512, LDS_BYTES) != hipSuccess || per_cu < 1) { fprintf(stderr, "kernel_launch: occupancy query says %d\n", per_cu); per_cu = 1; }
        (void)hipGetLastError();
        grid_blocks = cus * per_cu;
    }
    if (grid_blocks < 0) return;
    Args a{};
    for (int i = 0; i < 35; ++i) a.in[i] = (const float*)d_in[i];
    a.out = (float*)d_out; a.ws = (unsigned char*)d_ws;
    if (hipMemsetAsync(d_ws, 0, 65536, stream) != hipSuccess) { fprintf(stderr, "kernel_launch: memset failed\n"); return; }
#if MK_MULTI
    for (int ph = 0; ph < N_PHASES; ++ph) { a.ph_lo = ph; a.ph_hi = ph + 1; hipLaunchKernelGGL(fwd_megakernel, dim3(grid_blocks), dim3(512), LDS_BYTES, stream, a); }
#else
    a.ph_lo = 0; a.ph_hi = N_PHASES;
    void* args[] = {&a};
    hipError_t e = hipLaunchCooperativeKernel((const void*)fwd_megakernel, dim3(grid_blocks), dim3(512), args, LDS_BYTES, stream);
    if (e != hipSuccess) fprintf(stderr, "cooperative launch failed: %s (grid %d)\n", hipGetErrorString(e), grid_blocks);
#endif
}
```
